# Optimizing an MI355X kernel written in HIP

```python
import math
import jax, jax.numpy as jnp
from jax import lax
import numpy as np

D_MODEL = 1024
BATCH = 4
SEQ = 4096
DEPTH = 4
DEC_BATCH = 16
DEC_SEQ = 4096
PAST_LEN = 128

GRID_W = 64
HEAD_DIM = D_MODEL // 16
NA_HEADS = 4
NA_KH_MAX = 8
NA_KW = 16
GQA_HEADS = 8
GQA_KV_HEADS = 2
Q_BLOCK = 128
ROPE_THETA = 10000.0
SG_GROUPS = 4
SG_CHUNK = 128
NA_WIDTH = NA_HEADS * HEAD_DIM
GQA_WIDTH = GQA_HEADS * HEAD_DIM
KV_WIDTH = GQA_KV_HEADS * HEAD_DIM
SG_WIDTH = SG_GROUPS * HEAD_DIM
D_MIX = NA_WIDTH + GQA_WIDTH + SG_WIDTH
D_IN = 3 * NA_WIDTH + GQA_WIDTH + 2 * KV_WIDTH + 2 * SG_WIDTH
N_EXPERTS = 16
CAPACITY_FACTOR = 2
D_EXPERT = 2048
LN_EPS = 1e-5
QK_EPS = 1e-6
DN_ALPHA = (2 * DEPTH) ** 0.25
DN_BETA = (8 * DEPTH) ** -0.25

kernel_name = "hybrid_bidir_na_gqa_sgu_ec_encoder"


def layer_norm(x, g, b):
    xf = x.astype(jnp.float32)
    mu = jnp.mean(xf, -1, keepdims=True)
    var = jnp.mean(jnp.square(xf - mu), -1, keepdims=True)
    return ((xf - mu) * lax.rsqrt(var + LN_EPS) * g + b).astype(x.dtype)


def rms_norm(x, g):
    xf = x.astype(jnp.float32)
    return (xf * lax.rsqrt(jnp.mean(xf * xf, -1, keepdims=True) + QK_EPS) * g).astype(x.dtype)


def axial_rope_angles(S):
    t = jnp.arange(S)
    row = (t // GRID_W).astype(jnp.float32)
    col = (t % GRID_W).astype(jnp.float32)
    n_freq = HEAD_DIM // 4
    inv = ROPE_THETA ** (-jnp.arange(n_freq, dtype=jnp.float32) / n_freq)
    ang = jnp.concatenate([row[:, None] * inv, col[:, None] * inv], -1)
    return jnp.cos(ang), jnp.sin(ang)


def apply_rope(x, cos, sin):
    xf = x.astype(jnp.float32).reshape(*x.shape[:-1], HEAD_DIM // 2, 2)
    x0, x1 = xf[..., 0], xf[..., 1]
    c = cos[None, :, None, :]
    s = sin[None, :, None, :]
    out = jnp.stack([x0 * c - x1 * s, x0 * s + x1 * c], -1)
    return out.reshape(x.shape).astype(x.dtype)


def neighbourhood_attention(q, k, v, rpb):
    B, S, H, dh = q.shape
    rows = S // GRID_W
    kh = min(NA_KH_MAX, rows)
    qg = q.reshape(B, rows, GRID_W, H, dh)
    kg = k.reshape(B, rows, GRID_W, H, dh)
    vg = v.reshape(B, rows, GRID_W, H, dh)
    col = jnp.arange(GRID_W)
    col_start = jnp.clip(col - NA_KW // 2, 0, GRID_W - NA_KW)
    col_idx = col_start[:, None] + jnp.arange(NA_KW)[None, :]
    dcol = col_idx - col[:, None] + (NA_KW - 1)
    scale = HEAD_DIM ** -0.5

    def row_block(r):
        rs = jnp.clip(r - kh // 2, 0, rows - kh)
        qr = lax.dynamic_index_in_dim(qg, r, axis=1, keepdims=False)
        kb = lax.dynamic_slice_in_dim(kg, rs, kh, axis=1)
        vb = lax.dynamic_slice_in_dim(vg, rs, kh, axis=1)
        kn = kb[:, :, col_idx]
        vn = vb[:, :, col_idx]
        drow = rs + jnp.arange(kh) - r + (NA_KH_MAX - 1)
        bias = rpb[:, drow][:, :, dcol].transpose(0, 2, 1, 3)
        s = jnp.einsum('bwhd,biwjhd->bhwij', qr, kn,
                       preferred_element_type=jnp.float32) * scale + bias[None].astype(jnp.float32)
        p = jax.nn.softmax(s.reshape(B, H, GRID_W, kh * NA_KW), axis=-1)
        p = p.reshape(B, H, GRID_W, kh, NA_KW).astype(vn.dtype)
        return jnp.einsum('bhwij,biwjhd->bwhd', p, vn)

    o = lax.map(row_block, jnp.arange(rows))
    return jnp.moveaxis(o, 0, 1).reshape(B, S, H, dh)


def gqa_attention(q, k, v):
    B, S, H, dh = q.shape
    G = H // GQA_KV_HEADS
    nb = S // Q_BLOCK
    scale = HEAD_DIM ** -0.5
    qb = q.reshape(B, nb, Q_BLOCK, GQA_KV_HEADS, G, dh).transpose(1, 0, 2, 3, 4, 5)

    def block(qi):
        s = jnp.einsum('bqkgd,bskd->bkgqs', qi, k, preferred_element_type=jnp.float32) * scale
        p = jax.nn.softmax(s, axis=-1).astype(v.dtype)
        return jnp.einsum('bkgqs,bskd->bqkgd', p, v)

    o = lax.map(block, qb)
    return o.transpose(1, 0, 2, 3, 4, 5).reshape(B, S, H, dh)


def spatial_gating(u, v, w_s, b_s, g_v, b_v):
    B, S, G, c = v.shape
    vn = layer_norm(v, g_v, b_v)
    nc = S // SG_CHUNK
    vc = vn.reshape(B, nc, SG_CHUNK, G, c)
    mixed = jnp.einsum('gpq,bnqgc->bnpgc', w_s, vc) + b_s.T[None, None, :, :, None]
    return u * mixed.reshape(B, S, G, c)


def token_mixer(x, w_in, rpb, q_norm, k_norm, w_s, b_s, g_v, b_v, w_out, cos, sin):
    B, S, _ = x.shape
    h = x @ w_in
    sizes = (NA_WIDTH, NA_WIDTH, NA_WIDTH, GQA_WIDTH, KV_WIDTH, KV_WIDTH, SG_WIDTH, SG_WIDTH)
    points = [int(p) for p in np.cumsum(sizes)[:-1]]
    qa, ka, va, qb, kb, vb, uc, vc = jnp.split(h, points, axis=-1)

    def heads(t, n):
        return t.reshape(B, S, n, HEAD_DIM)

    ya = neighbourhood_attention(heads(qa, NA_HEADS), heads(ka, NA_HEADS), heads(va, NA_HEADS), rpb)
    qb = apply_rope(rms_norm(heads(qb, GQA_HEADS), q_norm), cos, sin)
    kb = apply_rope(rms_norm(heads(kb, GQA_KV_HEADS), k_norm), cos, sin)
    yb = gqa_attention(qb, kb, heads(vb, GQA_KV_HEADS))
    yc = spatial_gating(jax.nn.gelu(heads(uc, SG_GROUPS)), jax.nn.gelu(heads(vc, SG_GROUPS)),
                        w_s, b_s, g_v, b_v)
    y = jnp.concatenate([ya.reshape(B, S, NA_WIDTH), yb.reshape(B, S, GQA_WIDTH),
                         yc.reshape(B, S, SG_WIDTH)], axis=-1)
    return y @ w_out


def expert_choice_ffn(x, w_router, w_gate, w_up, w_down):
    B, S, D = x.shape
    n = B * S
    cap = CAPACITY_FACTOR * n // N_EXPERTS
    xt = x.reshape(n, D)
    aff = jax.nn.softmax((xt @ w_router).astype(jnp.float32), axis=-1)
    gate, idx = lax.top_k(aff.T, cap)
    xe = xt[idx]
    hid = jax.nn.silu(jnp.einsum('ecd,edf->ecf', xe, w_gate)) * jnp.einsum('ecd,edf->ecf', xe, w_up)
    ye = jnp.einsum('ecf,efd->ecd', hid, w_down) * gate[..., None].astype(x.dtype)
    out = jnp.zeros_like(xt).at[idx.reshape(-1)].add(ye.reshape(-1, D))
    return out.reshape(B, S, D)


def run_trunk(x, ln_in_g, ln_in_b, w_in, na_rpb, q_norm, k_norm, sg_w, sg_b, sg_ln_g, sg_ln_b,
              w_out, ln1_g, ln1_b, w_router, w_gate, w_up, w_down, ln2_g, ln2_b):
    S = x.shape[1]
    cos, sin = axial_rope_angles(S)
    x = layer_norm(x, ln_in_g, ln_in_b)
    for l in range(DEPTH):
        mix = token_mixer(x, w_in[l], na_rpb[l], q_norm[l], k_norm[l], sg_w[l], sg_b[l],
                          sg_ln_g[l], sg_ln_b[l], w_out[l], cos, sin)
        x = layer_norm(DN_ALPHA * x + mix, ln1_g[l], ln1_b[l])
        ffn = expert_choice_ffn(x, w_router[l], w_gate[l], w_up[l], w_down[l])
        x = layer_norm(DN_ALPHA * x + ffn, ln2_g[l], ln2_b[l])
    return x


def setup_inputs(seed: int = 0) -> dict:
    key = jax.random.key(seed)
    ks = jax.random.split(key, 21)
    f32 = jnp.float32

    def nrm(k, shape, scale):
        return jax.random.normal(k, shape, f32) * scale

    def gain(k, shape):
        return 1.0 + 0.02 * jax.random.normal(k, shape, f32)

    return {
        "x_prompt": nrm(ks[0], (BATCH, SEQ, D_MODEL), 1.0),
        "x_sample": nrm(ks[1], (DEC_BATCH, DEC_SEQ, D_MODEL), 1.0),
        "ln_in_g": gain(ks[2], (D_MODEL,)),
        "ln_in_b": nrm(ks[3], (D_MODEL,), 0.02),
        "w_in": nrm(ks[4], (DEPTH, D_MODEL, D_IN), D_MODEL ** -0.5),
        "na_rpb": nrm(ks[5], (DEPTH, NA_HEADS, 2 * NA_KH_MAX - 1, 2 * NA_KW - 1), 0.1),
        "q_norm": gain(ks[6], (DEPTH, HEAD_DIM)),
        "k_norm": gain(ks[7], (DEPTH, HEAD_DIM)),
        "sg_w": nrm(ks[8], (DEPTH, SG_GROUPS, SG_CHUNK, SG_CHUNK), SG_CHUNK ** -0.5),
        "sg_b": gain(ks[9], (DEPTH, SG_GROUPS, SG_CHUNK)),
        "sg_ln_g": gain(ks[10], (DEPTH, SG_GROUPS, HEAD_DIM)),
        "sg_ln_b": nrm(ks[11], (DEPTH, SG_GROUPS, HEAD_DIM), 0.02),
        "w_out": nrm(ks[12], (DEPTH, D_MIX, D_MODEL), DN_BETA * D_MIX ** -0.5),
        "ln1_g": gain(ks[13], (DEPTH, D_MODEL)),
        "ln1_b": nrm(ks[14], (DEPTH, D_MODEL), 0.02),
        "w_router": nrm(ks[15], (DEPTH, D_MODEL, N_EXPERTS), D_MODEL ** -0.5),
        "w_gate": nrm(ks[16], (DEPTH, N_EXPERTS, D_MODEL, D_EXPERT), D_MODEL ** -0.5),
        "w_up": nrm(ks[17], (DEPTH, N_EXPERTS, D_MODEL, D_EXPERT), D_MODEL ** -0.5),
        "w_down": nrm(ks[18], (DEPTH, N_EXPERTS, D_EXPERT, D_MODEL), DN_BETA * D_EXPERT ** -0.5),
        "ln2_g": gain(ks[19], (DEPTH, D_MODEL)),
        "ln2_b": nrm(ks[20], (DEPTH, D_MODEL), 0.02),
    }


def reference(x_prompt, x_sample, ln_in_g, ln_in_b, w_in, na_rpb, q_norm, k_norm, sg_w, sg_b,
              sg_ln_g, sg_ln_b, w_out, ln1_g, ln1_b, w_router, w_gate, w_up, w_down, ln2_g, ln2_b):
    y_prompt = run_trunk(x_prompt, ln_in_g, ln_in_b, w_in, na_rpb, q_norm, k_norm, sg_w, sg_b,
                         sg_ln_g, sg_ln_b, w_out, ln1_g, ln1_b, w_router, w_gate, w_up, w_down,
                         ln2_g, ln2_b)
    y_sample = run_trunk(x_sample, ln_in_g, ln_in_b, w_in, na_rpb, q_norm, k_norm, sg_w, sg_b,
                         sg_ln_g, sg_ln_b, w_out, ln1_g, ln1_b, w_router, w_gate, w_up, w_down,
                         ln2_g, ln2_b)
    return (y_prompt, y_sample)
```

```cpp
#include <hip/hip_runtime.h>
#include <hip/hip_bf16.h>
#include <cstdio>
#include <cstdint>
#ifndef BAL_PROBE
#define BAL_PROBE 0
#endif
#ifndef BAL_PROBE_N
#define BAL_PROBE_N 0
#endif
#ifndef LN1_ROWS
#define LN1_ROWS 4
#endif
#ifndef GQA_MSUM
#define GQA_MSUM false
#endif
namespace pg8 {
#define PG8_LAS __attribute__((address_space(3)))
typedef unsigned short bf16_t;
typedef short bf16x8 __attribute__((ext_vector_type(8)));
typedef float f32x4 __attribute__((ext_vector_type(4)));
typedef unsigned u32x4 __attribute__((ext_vector_type(4)));
typedef int v4i_t __attribute__((ext_vector_type(4)));
typedef int v8i_t __attribute__((ext_vector_type(8)));
constexpr int BM = 256, BK = 64, HALF = 128, HTB = HALF * BK * 2  , STAGE_BYTES = 8 * HTB, NXCD = 8, WGM = 8;

__host__ __device__ __forceinline__ int lds_byte(int r, int c) { const int st = (r >> 4) * 2 + (c >> 5), rr = r & 15, cc = c & 31, ob = rr * 64 + cc * 2; return st * 1024 + (ob ^ (((ob >> 9) & 1) << 5)); }
__host__ __device__ __forceinline__ void stage_rc(int b, int& R, int& C) { const int st = b / 1024, sb = b % 1024, swz = sb ^ (((sb >> 9) & 1) << 5); R = (st >> 1) * 16 + swz / 64; C = (st & 1) * 32 + (swz % 64) / 2; }
__host__ __device__ __forceinline__ int perm32(int rho) { const int n = rho >> 4, i = rho & 15; return 8 * (i >> 2) + 4 * n + (i & 3); }

struct Unit { int pm, pn; };
struct Gemm { const bf16_t* A; const bf16_t* Bt; int M, N, K; size_t estride; const int* idx; };
__host__ __device__ __forceinline__ int expert_of_tile(int pm) { return pm < 128 ? (pm >> 3) : ((pm - 128) >> 5); }

struct StaticOrder {
    int nM, nN, nwg, G, c;
    __host__ __device__ void init(int M, int N, int G_, int c_) { nM = M / BM; nN = N / BM; nwg = nM * nN; G = G_; c = c_; }
    __host__ __device__ bool next(int i, Unit& u) const {
        const long L = (long)i * G + c; if (L >= nwg) return false;
        int wgid = (int)L; { const int q = nwg / NXCD, r = nwg % NXCD, xcd = wgid % NXCD, off = wgid / NXCD; wgid = (xcd < r ? xcd * (q + 1) : r * (q + 1) + (xcd - r) * q) + off; }
        const int nig = WGM * nN, gid = wgid / nig, fm = gid * WGM, gsz = (nM - fm) < WGM ? (nM - fm) : WGM;
        u.pm = fm + ((wgid % nig) % gsz); u.pn = (wgid % nig) / gsz; return true;
    }
    __device__ __forceinline__ void a_ready(const Unit&) const {}
    __device__ __forceinline__ void done(const Unit&) const {}
};

struct RotOrder {
    StaticOrder S;
    __host__ __device__ void init(int M, int N, int G_, int c_) { S.init(M, N, G_, c_); }
    __host__ __device__ bool next(int i, Unit& u) const {
        if (S.G != 256) return S.next(i, u);
        StaticOrder T = S; T.c = (S.c & 63) + 64 * (((S.c >> 6) + (i >> 1)) & 3);
        return T.next(i, u);
    }
    __device__ __forceinline__ void a_ready(const Unit&) const {}
    __device__ __forceinline__ void done(const Unit&) const {}
};

__device__ __forceinline__ unsigned cvt_pk_bf16(float lo, float hi) { unsigned r; asm volatile("v_cvt_pk_bf16_f32 %0, %1, %2" : "=v"(r) : "v"(lo), "v"(hi)); return r; }
typedef float f32x2 __attribute__((ext_vector_type(2)));

__device__ __forceinline__ void mfma_fp8(f32x4& acc, const v8i_t& a, const v8i_t& b, int sc) {
    asm volatile("v_mfma_scale_f32_16x16x128_f8f6f4 %0, %1, %2, %0, %3, %3 op_sel_hi:[0,0,0]" : "+v"(acc) : "v"(a), "v"(b), "v"(sc));
}
template <class Epi, class Sched, bool ALIGN_EPI = false, bool SP2 = false, bool GROUPED = false, bool FP8 = false, bool GATHER = false, bool BAL = false>
__device__ __forceinline__ void gemm_phase(PG8_LAS unsigned char* lds, const Gemm g, const Sched& S, const Epi& E) {
    int tid_ = threadIdx.x; asm volatile("" : "+v"(tid_));
    const int tid = tid_, wid = __builtin_amdgcn_readfirstlane(tid >> 6), lane = tid & 63, wr = wid >> 2, wc = wid & 3, fr = lane & 15, fq = lane >> 4;
    const int K = g.K, nt = K / BK;
    unsigned voffA[2], voffB[2];
#pragma unroll
    for (int i = 0; i < 2; ++i) { int R, C; stage_rc(tid * 16 + i * 8192, R, C); const int Rb = Epi::PERM ? ((R & ~31) + perm32(R & 31)) : R;
        voffA[i] = (unsigned)(R * K + C) * 2u; voffB[i] = (unsigned)(Rb * K + C) * 2u; }
    const size_t kstep = (size_t)(BK * 2);
    const size_t hstep = (size_t)HALF * K * 2;
    const size_t tstep = 2 * hstep;
    const unsigned ldsw = (unsigned)wid * 1024u;
    const int aoff = lds_byte(wr * 64 + fr, fq * 8), boff = lds_byte(wc * 32 + fr, fq * 8);
#define PG8_SA(b, h) (((b) * 2 + (h)) * HTB)
#define PG8_SB(b, h) ((4 + (b) * 2 + (h)) * HTB)
#define PG8_STAGE(bufoff, gbase, voff) do { _Pragma("unroll") for (int _i = 0; _i < 2; ++_i) \
        __builtin_amdgcn_global_load_lds((const unsigned*)((const char*)(gbase) + (voff)[_i]), (PG8_LAS unsigned*)(lds + (bufoff) + ldsw + _i * 8192), 16, 0, 0); } while (0)
    static_assert(!GATHER || SP2, "GATHER is wired into the SP2 loop only");
    unsigned vC[2][2], vN[2][2]; unsigned cC[2];
    PG8_LAS unsigned char* gtab = lds + 131072 + 1024 + wid * 512;
    if constexpr (GATHER) {
#pragma unroll
        for (int i = 0; i < 2; ++i) { int R, C; stage_rc(tid * 16 + i * 8192, R, C); cC[i] = (unsigned)C * 2u; }
    }
    const int grow = ((lane >> 5) & 1) * 128 + ((lane >> 4) & 1) * 64 + (wid >> 1) * 16 + (lane & 15);
#define PG8_GDMA(unit, buf) __builtin_amdgcn_global_load_lds((const unsigned*)(g.idx + (size_t)(unit).pm * BM + grow), (PG8_LAS unsigned*)(gtab + (buf) * 256), 4, 0, 0)
#define PG8_GREAD(dst, buf) do { unsigned r00_, r01_, r10_, r11_; const unsigned ga_ = (unsigned)(size_t)gtab + (unsigned)(buf) * 256u + (unsigned)(lane >> 2) * 4u; \
        asm volatile("ds_read_b32 %0, %4\n\tds_read_b32 %1, %4 offset:64\n\tds_read_b32 %2, %4 offset:128\n\tds_read_b32 %3, %4 offset:192\n\ts_waitcnt lgkmcnt(0)" \
                     : "=&v"(r00_), "=&v"(r01_), "=&v"(r10_), "=&v"(r11_) : "v"(ga_) : "memory"); \
        dst[0][0] = r00_ * (unsigned)(K * 2) + cC[0]; dst[0][1] = r01_ * (unsigned)(K * 2) + cC[1]; dst[1][0] = r10_ * (unsigned)(K * 2) + cC[0]; dst[1][1] = r11_ * (unsigned)(K * 2) + cC[1]; } while (0)
#define PG8_GSTAGE(bufoff, kb, h, nx) do { _Pragma("unroll") for (int _i = 0; _i < 2; ++_i) \
        __builtin_amdgcn_global_load_lds((const unsigned*)((const char*)g.A + (kb) + ((nx) ? vN[h][_i] : vC[h][_i])), (PG8_LAS unsigned*)(lds + (bufoff) + ldsw + _i * 8192), 16, 0, 0); } while (0)
#define PG8_STA(bufoff, ptr, kb, h, nx) do { if constexpr (GATHER) { PG8_GSTAGE(bufoff, kb, h, nx); } else { PG8_STAGE(bufoff, ptr, voffA); } } while (0)
#define PG8_LDA(dst, b, h) do { if constexpr (FP8) { _Pragma("unroll") for (int m = 0; m < 4; ++m) dst##8[m] = PG8_CAT(*(const PG8_LAS bf16x8*)(lds + PG8_SA(b, h) + aoff + m * 2048), *(const PG8_LAS bf16x8*)(lds + PG8_SA(b, h) + aoff + m * 2048 + 1024)); } \
        else { _Pragma("unroll") for (int m = 0; m < 4; ++m) _Pragma("unroll") for (int k = 0; k < 2; ++k) dst[m][k] = *(const PG8_LAS bf16x8*)(lds + PG8_SA(b, h) + aoff + m * 2048 + k * 1024); } } while (0)
#define PG8_LDB(dst, b, h) do { if constexpr (FP8) { _Pragma("unroll") for (int n = 0; n < 2; ++n) dst##8[n] = PG8_CAT(*(const PG8_LAS bf16x8*)(lds + PG8_SB(b, h) + boff + n * 2048), *(const PG8_LAS bf16x8*)(lds + PG8_SB(b, h) + boff + n * 2048 + 1024)); } \
        else { _Pragma("unroll") for (int n = 0; n < 2; ++n) _Pragma("unroll") for (int k = 0; k < 2; ++k) dst[n][k] = *(const PG8_LAS bf16x8*)(lds + PG8_SB(b, h) + boff + n * 2048 + k * 1024); } } while (0)
#define PG8_MMA(ai, bj, At, Bt) do { __builtin_amdgcn_s_setprio(1); if constexpr (FP8) { _Pragma("unroll") for (int m = 0; m < 4; ++m) _Pragma("unroll") for (int n = 0; n < 2; ++n) \
        mfma_fp8(acc[ai][bj][m][n], Bt##8[n], At##8[m], sc8); } \
        else { _Pragma("unroll") for (int m = 0; m < 4; ++m) _Pragma("unroll") for (int n = 0; n < 2; ++n) _Pragma("unroll") for (int k = 0; k < 2; ++k) \
        acc[ai][bj][m][n] = __builtin_amdgcn_mfma_f32_16x16x32_bf16(Bt[n][k], At[m][k], acc[ai][bj][m][n], 0, 0, 0); } __builtin_amdgcn_s_setprio(0); } while (0)
#define PG8_CAT(x, y) __builtin_shufflevector(__builtin_bit_cast(v4i_t, (x)), __builtin_bit_cast(v4i_t, (y)), 0, 1, 2, 3, 4, 5, 6, 7)
#define PG8_WAIT_V(n) asm volatile("s_waitcnt vmcnt(" #n ")" ::: "memory")
#define PG8_WAIT_L(n) asm volatile("s_waitcnt lgkmcnt(" #n ")" ::: "memory")
#define PG8_BAR __builtin_amdgcn_s_barrier()
#define PG8_SCHED __builtin_amdgcn_sched_barrier(0)
    Unit cur, nxt; int ui = 0;
    if (!S.next(0, cur)) return;
    f32x4 acc[2][2][4][2];
#pragma unroll
    for (int a = 0; a < 2; ++a)
#pragma unroll
        for (int b = 0; b < 2; ++b)
#pragma unroll
            for (int m = 0; m < 4; ++m)
#pragma unroll
                for (int n = 0; n < 2; ++n) acc[a][b][m][n] = (f32x4){0.f, 0.f, 0.f, 0.f};
    int sc8 = 0x7f7f7f7f; if constexpr (FP8) asm volatile("" : "+v"(sc8));
    bf16x8 At[4][2], B0[2][2], B1[2][2]; v8i_t At8[4], B08[2], B18[2];
    const char* cA = (const char*)g.A + (size_t)cur.pm * tstep; const char* cB = (const char*)g.Bt + (size_t)cur.pn * tstep + (GROUPED ? (size_t)expert_of_tile(cur.pm) * g.estride : (size_t)0);
    S.a_ready(cur);
    if constexpr (SP2) {
        if constexpr (GATHER) { PG8_GDMA(cur, 0); PG8_WAIT_V(0); PG8_GREAD(vC, 0); }
        PG8_STAGE(PG8_SB(0, 0), cB, voffB); PG8_STAGE(PG8_SB(0, 1), cB + hstep, voffB); PG8_STA(PG8_SA(0, 0), cA, 0, 0, false); PG8_STA(PG8_SA(0, 1), cA + hstep, 0, 1, false);
        if (wr == 1) PG8_BAR;
        PG8_WAIT_V(2); PG8_BAR;
        if constexpr (BAL) { PG8_STAGE(PG8_SB(1, 0), cB + kstep, voffB); PG8_STAGE(PG8_SB(1, 1), cB + hstep + kstep, voffB); PG8_WAIT_V(4); PG8_BAR; }
        else {
        PG8_STAGE(PG8_SB(1, 0), cB + kstep, voffB); PG8_STA(PG8_SA(1, 0), cA + kstep, kstep, 0, false); PG8_STAGE(PG8_SB(1, 1), cB + hstep + kstep, voffB);
        PG8_WAIT_V(6); PG8_BAR;
        }
    } else {
        PG8_STAGE(PG8_SB(0, 0), cB, voffB); PG8_STAGE(PG8_SA(0, 0), cA, voffA); PG8_STAGE(PG8_SB(0, 1), cB + hstep, voffB); PG8_STAGE(PG8_SA(0, 1), cA + hstep, voffA);
        if (wr == 1) PG8_BAR;
        PG8_WAIT_V(4); PG8_BAR;
        PG8_STAGE(PG8_SB(1, 0), cB + kstep, voffB); PG8_STAGE(PG8_SA(1, 0), cA + kstep, voffA); PG8_STAGE(PG8_SB(1, 1), cB + hstep + kstep, voffB);
        PG8_WAIT_V(6); PG8_BAR;
    }
    for (;;) {
        const bool has_next = S.next(ui + 1, nxt);
        if constexpr (GATHER) { if (has_next) PG8_GDMA(nxt, (ui + 1) & 1); }
        const char* nA = has_next ? (const char*)g.A + (size_t)nxt.pm * tstep : cA; const char* nB = has_next ? (const char*)g.Bt + (size_t)nxt.pn * tstep + (GROUPED ? (size_t)expert_of_tile(nxt.pm) * g.estride : (size_t)0) : cB;
        for (int t = 0; t < nt; t += 2) {
            const bool last = (t == nt - 2);
            const char* a1 = cA + (size_t)(t + 1) * kstep;
            const char* a2 = last ? nA : cA + (size_t)(t + 2) * kstep; const char* b2 = last ? nB : cB + (size_t)(t + 2) * kstep;
            const char* a3 = a2 + kstep; const char* b3 = b2 + kstep;
            if (last && has_next) S.a_ready(nxt);
            if constexpr (SP2) {
            const bool nx = last && has_next; const size_t kb2 = last ? (size_t)0 : (size_t)(t + 2) * kstep;
            if constexpr (GATHER) { if (nx) PG8_GREAD(vN, (ui + 1) & 1); }
            if constexpr (BAL) {
            PG8_LDB(B0, 0, 0); PG8_LDB(B1, 0, 1); PG8_SCHED; PG8_LDA(At, 0, 0); PG8_STA(PG8_SA(1, 0), a1, (size_t)(t + 1) * kstep, 0, false); PG8_STA(PG8_SA(1, 1), a1 + hstep, (size_t)(t + 1) * kstep, 1, false);
            PG8_WAIT_V(8); PG8_WAIT_L(0); PG8_BAR; PG8_MMA(0, 0, At, B0); PG8_MMA(0, 1, At, B1); PG8_BAR; PG8_SCHED;
            PG8_LDA(At, 0, 1); PG8_STAGE(PG8_SB(0, 0), b2, voffB); PG8_STAGE(PG8_SB(0, 1), b2 + hstep, voffB);
            PG8_WAIT_V(6); PG8_WAIT_L(0); PG8_BAR; PG8_MMA(1, 0, At, B0); PG8_MMA(1, 1, At, B1); PG8_BAR; PG8_SCHED;
            PG8_LDB(B0, 1, 0); PG8_LDB(B1, 1, 1); PG8_SCHED; PG8_LDA(At, 1, 0); PG8_STA(PG8_SA(0, 0), a2, kb2, 0, nx); PG8_STA(PG8_SA(0, 1), a2 + hstep, kb2, 1, nx);
            PG8_WAIT_V(8); PG8_WAIT_L(0); PG8_BAR; PG8_MMA(0, 0, At, B0); PG8_MMA(0, 1, At, B1); PG8_BAR; PG8_SCHED;
            PG8_LDA(At, 1, 1); PG8_STAGE(PG8_SB(1, 0), b3, voffB); PG8_STAGE(PG8_SB(1, 1), b3 + hstep, voffB);
            PG8_WAIT_V(6); PG8_WAIT_L(0); PG8_BAR; PG8_MMA(1, 0, At, B0); PG8_MMA(1, 1, At, B1); PG8_BAR; PG8_SCHED;
            } else {
            PG8_LDB(B0, 0, 0); PG8_LDB(B1, 0, 1); PG8_SCHED; PG8_LDA(At, 0, 0); PG8_STA(PG8_SA(1, 1), a1 + hstep, (size_t)(t + 1) * kstep, 1, false);
            PG8_WAIT_V(8); PG8_WAIT_L(0); PG8_BAR; PG8_MMA(0, 0, At, B0); PG8_MMA(0, 1, At, B1); PG8_BAR; PG8_SCHED;
            PG8_LDA(At, 0, 1); PG8_STAGE(PG8_SB(0, 0), b2, voffB); PG8_STAGE(PG8_SB(0, 1), b2 + hstep, voffB); PG8_STA(PG8_SA(0, 0), a2, kb2, 0, nx);
            PG8_WAIT_V(8); PG8_WAIT_L(0); PG8_BAR; PG8_MMA(1, 0, At, B0); PG8_MMA(1, 1, At, B1); PG8_BAR; PG8_SCHED;
            PG8_LDB(B0, 1, 0); PG8_LDB(B1, 1, 1); PG8_SCHED; PG8_LDA(At, 1, 0); PG8_STA(PG8_SA(0, 1), a2 + hstep, kb2, 1, nx);
            PG8_WAIT_V(8); PG8_WAIT_L(0); PG8_BAR; PG8_MMA(0, 0, At, B0); PG8_MMA(0, 1, At, B1); PG8_BAR; PG8_SCHED;
            PG8_LDA(At, 1, 1); PG8_STAGE(PG8_SB(1, 0), b3, voffB); PG8_STAGE(PG8_SB(1, 1), b3 + hstep, voffB); PG8_STA(PG8_SA(1, 0), a3, kb2 + kstep, 0, nx);
            PG8_WAIT_V(8); PG8_WAIT_L(0); PG8_BAR; PG8_MMA(1, 0, At, B0); PG8_MMA(1, 1, At, B1); PG8_BAR; PG8_SCHED;
            }
            } else {
            PG8_LDB(B0, 0, 0); PG8_SCHED; PG8_LDA(At, 0, 0); PG8_STAGE(PG8_SA(1, 1), a1 + hstep, voffA);
            PG8_WAIT_L(8); PG8_BAR; PG8_WAIT_L(0); PG8_MMA(0, 0, At, B0); PG8_BAR; PG8_SCHED;
            PG8_LDB(B1, 0, 1); PG8_STAGE(PG8_SB(0, 0), b2, voffB);
            PG8_BAR; PG8_WAIT_L(0); PG8_MMA(0, 1, At, B1); PG8_BAR;
            PG8_LDA(At, 0, 1); PG8_STAGE(PG8_SA(0, 0), a2, voffA);
            PG8_BAR; PG8_WAIT_L(0); PG8_MMA(1, 0, At, B0); PG8_BAR; PG8_SCHED;
            PG8_STAGE(PG8_SB(0, 1), b2 + hstep, voffB);
            PG8_WAIT_V(6); PG8_BAR; PG8_MMA(1, 1, At, B1); PG8_BAR;
            PG8_LDB(B0, 1, 0); PG8_SCHED; PG8_LDA(At, 1, 0); PG8_STAGE(PG8_SA(0, 1), a2 + hstep, voffA);
            PG8_WAIT_L(8); PG8_BAR; PG8_WAIT_L(0); PG8_MMA(0, 0, At, B0); PG8_BAR; PG8_SCHED;
            PG8_LDB(B1, 1, 1); PG8_STAGE(PG8_SB(1, 0), b3, voffB);
            PG8_BAR; PG8_WAIT_L(0); PG8_MMA(0, 1, At, B1); PG8_BAR;
            PG8_LDA(At, 1, 1); PG8_STAGE(PG8_SA(1, 0), a3, voffA);
            PG8_BAR; PG8_WAIT_L(0); PG8_MMA(1, 0, At, B0); PG8_BAR; PG8_SCHED;
            PG8_STAGE(PG8_SB(1, 1), b3 + hstep, voffB);
            PG8_WAIT_V(6); PG8_BAR; PG8_MMA(1, 1, At, B1); PG8_BAR;
            }
        }
        if constexpr (FP8) asm volatile("s_nop 15\n\ts_nop 7" ::: "memory");
        if constexpr (ALIGN_EPI) { if (wr == 0) PG8_BAR; }
        if constexpr (!Epi::AFTER_DRAIN) { int fr_ = fr, fq_ = fq; asm volatile("" : "+v"(fr_), "+v"(fq_));
            E(acc, cur, wr, wc, fr_, fq_); S.done(cur); }
        if (!has_next) break;
#pragma unroll
        for (int a = 0; a < 2; ++a)
#pragma unroll
            for (int b = 0; b < 2; ++b)
#pragma unroll
                for (int m = 0; m < 4; ++m)
#pragma unroll
                    for (int n = 0; n < 2; ++n) acc[a][b][m][n] = (f32x4){0.f, 0.f, 0.f, 0.f};
        cur = nxt; cA = nA; cB = nB; ++ui;
        if constexpr (GATHER) { vC[0][0] = vN[0][0]; vC[0][1] = vN[0][1]; vC[1][0] = vN[1][0]; vC[1][1] = vN[1][1]; }
        if constexpr (ALIGN_EPI) { if (wr == 1) PG8_BAR; }
    }
    PG8_WAIT_V(0);
    if constexpr (!ALIGN_EPI) { if (wr == 0) PG8_BAR; }
    PG8_BAR;
    if constexpr (Epi::AFTER_DRAIN) { E.fused(acc, cur, wr, wc, fr, fq, lds, wid, lane); S.done(cur); }
#undef PG8_SA
#undef PG8_SB
#undef PG8_STAGE
#undef PG8_GDMA
#undef PG8_GREAD
#undef PG8_GSTAGE
#undef PG8_STA
#undef PG8_LDA
#undef PG8_LDB
#undef PG8_MMA
#undef PG8_CAT
#undef PG8_WAIT_V
#undef PG8_WAIT_L
#undef PG8_BAR
#undef PG8_SCHED
}
}

#define GAS __attribute__((address_space(1)))
#define LAS __attribute__((address_space(3)))
typedef unsigned v4u __attribute__((ext_vector_type(4)));
using pg8::f32x4;
typedef GAS unsigned gu32;
typedef GAS unsigned long long gu64;
#define RLX_AGENT __ATOMIC_RELAXED, __HIP_MEMORY_SCOPE_AGENT
#define LDS_WAIT() asm volatile("s_waitcnt lgkmcnt(0)" ::: "memory")
#define VM_WAIT() asm volatile("s_waitcnt vmcnt(0)" ::: "memory")

#define XB_TMO      128
#define XB_XCNT(j)  (256  + 64 * (j))
#define XB_XSUB(j)  (1280 + 64 * (j))
#define XB_XGEN(j)  (2304 + 64 * (j))
#define XB_TOP      3328
#define XB_TOPGEN   3392
#define XCD_BAR_WORDS 3456
#define XB_SPIN_CAP (1u << 18)

__device__ __forceinline__ unsigned xb_ld(unsigned* p)              { return __hip_atomic_load(p, __ATOMIC_RELAXED, __HIP_MEMORY_SCOPE_AGENT); }
__device__ __forceinline__ unsigned xb_add(unsigned* p, unsigned v) { return __hip_atomic_fetch_add(p, v, __ATOMIC_RELAXED, __HIP_MEMORY_SCOPE_AGENT); }
__device__ __forceinline__ unsigned xb_xcc_id() { return (unsigned)__builtin_amdgcn_s_getreg((3 << 11) | 20) & 0xFu; }
#define XB_SPIN(cond, bar) do { unsigned _sp = 0; while (cond) { __builtin_amdgcn_s_sleep(1); \
    if ((++_sp & 255u) == 0u) { if (xb_ld(&(bar)[XB_TMO])) break; if (_sp > XB_SPIN_CAP) { atomicAdd(&(bar)[XB_TMO], 1u); break; } } } } while (0)

struct XcdBarrier {
    unsigned* bar; unsigned x;
    volatile LAS unsigned* st;
};

__device__ __forceinline__ XcdBarrier xcd_barrier_post(unsigned* bar, volatile LAS unsigned* st) {
    XcdBarrier b; b.bar = bar; b.x = xb_xcc_id(); b.st = st;
    if (threadIdx.x == 0) (void)xb_add(&bar[XB_XCNT(b.x)], 1u);
    return b;
}
__device__ __forceinline__ void xcd_barrier_complete(unsigned* bar, unsigned x, unsigned& nloc, unsigned& nx) {
    const unsigned G = gridDim.x * gridDim.y * gridDim.z;
    unsigned sum, cnt, mine, sp = 0u;
    for (;;) {
        sum = 0u; cnt = 0u; mine = 0u;
#pragma unroll
        for (unsigned j = 0; j < 16; ++j) { const unsigned c = xb_ld(&bar[XB_XCNT(j)]); sum += c; cnt += (c > 0u) ? 1u : 0u; mine = (j == x) ? c : mine; }
        if (sum == G) break;
        __builtin_amdgcn_s_sleep(1);
        if ((++sp & 255u) == 0u) { if (xb_ld(&bar[XB_TMO])) break; if (sp > XB_SPIN_CAP) { atomicAdd(&bar[XB_TMO], 1u); break; } }
    }
    nloc = mine > 0u ? mine : 1u; nx = cnt > 0u ? cnt : 1u;
}

__device__ __forceinline__ void xcd_barrier(const XcdBarrier& b) {
    asm volatile("s_waitcnt vmcnt(0)" ::: "memory");
    __syncthreads();
    if (threadIdx.x == 0) {
        unsigned* bar = b.bar;
        __builtin_amdgcn_s_waitcnt(0);
        unsigned nloc = b.st[0], nx = b.st[1];
        if (nloc == 0u) { xcd_barrier_complete(bar, b.x, nloc, nx); b.st[0] = nloc; b.st[1] = nx; }
        const unsigned old = xb_add(&bar[XB_XSUB(b.x)], 1u);
        const unsigned gen = old / nloc;
        if (old + 1u == (gen + 1u) * nloc) {
            __builtin_amdgcn_fence(__ATOMIC_RELEASE, "agent");
            asm volatile("s_waitcnt vmcnt(0)" ::: "memory");
            const unsigned og = xb_add(&bar[XB_TOP], 1u);
            const unsigned tg = og / nx;
            if (og + 1u == (tg + 1u) * nx) xb_add(&bar[XB_TOPGEN], 1u);
            else XB_SPIN(xb_ld(&bar[XB_TOPGEN]) == tg, bar);
            __builtin_amdgcn_fence(__ATOMIC_ACQUIRE, "agent");
            xb_add(&bar[XB_XGEN(b.x)], 1u);
            asm volatile("s_waitcnt vmcnt(0)" ::: "memory");
        } else {
            XB_SPIN(xb_ld(&bar[XB_XGEN(b.x)]) == gen, bar);
            __builtin_amdgcn_fence(__ATOMIC_ACQUIRE, "agent");
            asm volatile("s_waitcnt vmcnt(0)" ::: "memory");
        }
    }
    __syncthreads();
}


namespace attn_body {
using bf16=__hip_bfloat16;
using bf16x8=__attribute__((ext_vector_type(8)))short;
using s16x4=__attribute__((ext_vector_type(4)))short;
using f32x16=__attribute__((ext_vector_type(16)))float;
using u32x4=__attribute__((ext_vector_type(4)))unsigned;
constexpr int SEQ=4096,D=64,KP=2048,OP=1024;
constexpr int NW=8,QBLK=32,QB=QBLK*NW,KVBLK=64,NQB=SEQ/QB;
__device__ __forceinline__ int crow(int r,int hi){return (r&3)+8*(r>>2)+4*hi;}
#define SBAR() __builtin_amdgcn_sched_barrier(0)
constexpr int NSLOT=3, SLOTB=8192;
constexpr int LDS_K=0, LDS_V=NSLOT*SLOTB, LDS_WS=2*NSLOT*SLOTB, LDS_OST=LDS_WS+NW*64*4, LDS_BYTES=LDS_OST+NW*4096;
constexpr float C2=0.125f*1.4426950408889634f;
__device__ __forceinline__ void glds16(const void*gsrc,unsigned lds_dst){unsigned keep;
  asm volatile("s_mov_b32 %0, m0\n\ts_mov_b32 m0, %2\n\ts_nop 0\n\tglobal_load_lds_dwordx4 %1, off\n\ts_mov_b32 m0, %0":"=&s"(keep):"v"(gsrc),"s"(lds_dst):"memory");}
__device__ __forceinline__ float max3f(float a,float b,float c){float r;asm("v_max3_f32 %0, %1, %2, %3":"=v"(r):"v"(a),"v"(b),"v"(c));return r;}
__device__ __forceinline__ float max2f(float a,float b){float r;asm("v_max_f32_e32 %0, %1, %2":"=v"(r):"v"(a),"v"(b));return r;}
__device__ __forceinline__ float fadd_s(float a,float b){float r;asm("v_add_f32_e32 %0, %1, %2":"=v"(r):"v"(a),"v"(b));return r;}
__device__ __forceinline__ float fsub_s(float a,float b){float r;asm("v_sub_f32_e32 %0, %1, %2":"=v"(r):"v"(a),"v"(b));return r;}
typedef float f32x2_t __attribute__((ext_vector_type(2))); typedef __bf16 bf16x2_t __attribute__((ext_vector_type(2)));
__device__ __forceinline__ unsigned cvtpk_s(float lo,float hi){f32x2_t v={lo,hi};bf16x2_t b=__builtin_convertvector(v,bf16x2_t);return __builtin_bit_cast(unsigned,b);}
#define WAIT_BAR(N) asm volatile("s_waitcnt vmcnt(" #N ") lgkmcnt(0)\n\ts_barrier":::"memory")

__device__ __forceinline__ void qkt(f32x16&p0,f32x16&p1,const char*Kslot,const bf16x8*qr,const f32x16&negm,int r32,int hi){
  const char*kb=Kslot+hi*1024+r32*16;
  #pragma unroll
  for(int d0=0;d0<4;++d0){
    const bf16x8 b0=*reinterpret_cast<const bf16x8*>(kb+d0*2048);
    const bf16x8 b1=*reinterpret_cast<const bf16x8*>(kb+d0*2048+512);
    if(d0==0){p0=__builtin_amdgcn_mfma_f32_32x32x16_bf16(b0,qr[0],negm,0,0,0);p1=__builtin_amdgcn_mfma_f32_32x32x16_bf16(b1,qr[0],negm,0,0,0);}
    else{p0=__builtin_amdgcn_mfma_f32_32x32x16_bf16(b0,qr[d0],p0,0,0,0);p1=__builtin_amdgcn_mfma_f32_32x32x16_bf16(b1,qr[d0],p1,0,0,0);}}
}
typedef __attribute__((address_space(3))) const char* lds_cptr;
typedef short v4i16_t __attribute__((ext_vector_type(4)));
__device__ __forceinline__ void kload8(bf16x8*kf,lds_cptr kp){
  kf[0]=*(const __attribute__((address_space(3))) bf16x8*)(kp);      kf[1]=*(const __attribute__((address_space(3))) bf16x8*)(kp+512);
  kf[2]=*(const __attribute__((address_space(3))) bf16x8*)(kp+2048); kf[3]=*(const __attribute__((address_space(3))) bf16x8*)(kp+2560);
  kf[4]=*(const __attribute__((address_space(3))) bf16x8*)(kp+4096); kf[5]=*(const __attribute__((address_space(3))) bf16x8*)(kp+4608);
  kf[6]=*(const __attribute__((address_space(3))) bf16x8*)(kp+6144); kf[7]=*(const __attribute__((address_space(3))) bf16x8*)(kp+6656);
}
__device__ __forceinline__ void kload2(bf16x8*kf,lds_cptr kp,int j){ kf[2*j]=*(const __attribute__((address_space(3))) bf16x8*)(kp+j*2048); kf[2*j+1]=*(const __attribute__((address_space(3))) bf16x8*)(kp+j*2048+512); }
__device__ __forceinline__ s16x4 vtr(lds_cptr p){ return __builtin_bit_cast(s16x4,__builtin_amdgcn_ds_read_tr16_b64_v4i16((__attribute__((address_space(3))) v4i16_t*)p)); }
__device__ __forceinline__ float rowmax(const f32x16&p0,const f32x16&p1){
  float a=max3f(p0[0],p0[1],p1[0]),b=max3f(p0[2],p0[3],p1[1]);a=max3f(a,p1[2],p1[3]);
  #pragma unroll
  for(int r=4;r<16;r+=4){a=max3f(a,p0[r],p0[r+1]);b=max3f(b,p0[r+2],p0[r+3]);a=max3f(a,p1[r],p1[r+1]);b=max3f(b,p1[r+2],p1[r+3]);}
  const float m=max2f(a,b);
  auto rr=__builtin_amdgcn_permlane32_swap(__float_as_uint(m),__float_as_uint(m),false,false);
  return max2f(__uint_as_float(rr[0]),__uint_as_float(rr[1]));
}
__device__ __forceinline__ void pv(f32x16*o,int vb,bf16x8 pa0,bf16x8 pa1,bf16x8 pa2,bf16x8 pa3){
  #pragma unroll
  for(int d0=0;d0<2;++d0){s16x4 lo[4],hi[4];
    #pragma unroll
    for(int ks=0;ks<4;++ks){
      asm volatile("ds_read_b64_tr_b16 %0,%1 offset:%c2":"=&v"(lo[ks]):"v"(vb),"i"(d0*4096+ks*1024):"memory");
      asm volatile("ds_read_b64_tr_b16 %0,%1 offset:%c2":"=&v"(hi[ks]):"v"(vb),"i"(d0*4096+ks*1024+512):"memory");}
    asm volatile("s_waitcnt lgkmcnt(0)":::"memory");SBAR();
    #define PK(k) (bf16x8){lo[k][0],lo[k][1],lo[k][2],lo[k][3],hi[k][0],hi[k][1],hi[k][2],hi[k][3]}
    o[d0]=__builtin_amdgcn_mfma_f32_32x32x16_bf16(pa0,PK(0),o[d0],0,0,0);
    o[d0]=__builtin_amdgcn_mfma_f32_32x32x16_bf16(pa1,PK(1),o[d0],0,0,0);
    o[d0]=__builtin_amdgcn_mfma_f32_32x32x16_bf16(pa2,PK(2),o[d0],0,0,0);
    o[d0]=__builtin_amdgcn_mfma_f32_32x32x16_bf16(pa3,PK(3),o[d0],0,0,0);
    #undef PK
  }
}

#ifndef ATTN_STORE16
#define ATTN_STORE16(p,v) (*(u32x4*)(p)=(v))
#endif
template<int THRL,bool NOMAX=false,bool MSUM=true> __device__ __forceinline__ void attn_unit(const bf16*Qw0,const bf16*__restrict__ Kh,const bf16*__restrict__ Vh,bf16*Ow0,char*shm){
  int tid_=threadIdx.x; asm volatile("":"+v"(tid_));
  const int tid=tid_,lane=tid&63,r32=lane&31,hi=lane>>5; const int wid=__builtin_amdgcn_readfirstlane(tid>>6);
  const bf16*Qw=Qw0+(long)(wid*QBLK)*KP;
  const unsigned lds0=(unsigned)(uintptr_t)shm;
  float*wsf=(float*)(shm+LDS_WS)+wid*64;
  const bf16*ksrc=Kh+(long)lane*KP+wid*8;
  const bf16*vsrc=Vh+(long)(16*(wid&3)+(lane>>2))*KP+(wid>>2)*32+(lane&3)*8;
  const unsigned kdst=lds0+LDS_K+wid*1024, vdst=lds0+LDS_V+wid*1024;
  #define DMA_K(t,slot) glds16(ksrc+(long)(t)*KVBLK*KP,(unsigned)__builtin_amdgcn_readfirstlane(kdst+(slot)))
  #define DMA_V(t,slot) glds16(vsrc+(long)(t)*KVBLK*KP,(unsigned)__builtin_amdgcn_readfirstlane(vdst+(slot)))
  const int vb0=(int)(lds0+LDS_V)+((lane>>4)&1)*32+(lane&3)*8+(4*hi+((lane&15)>>2))*64;
  const char*Kbase=shm+LDS_K; bf16x8 kf[8];
  const lds_cptr shm3=(lds_cptr)shm; const lds_cptr kp0=shm3+LDS_K+hi*1024+r32*16; const lds_cptr vp0=shm3+LDS_V+((lane>>4)&1)*32+(lane&3)*8+(4*hi+((lane&15)>>2))*64;
  constexpr int NT=SEQ/KVBLK;
  DMA_K(0,0);DMA_V(0,0);DMA_K(1,SLOTB);
  bf16x8 qr[4];
  #pragma unroll
  for(int d0=0;d0<4;++d0)qr[d0]=*reinterpret_cast<const bf16x8*>(&Qw[(long)r32*KP+d0*16+hi*8]);
  float mhat=0.f,l_reg=0.f;f32x16 o[2];o[0]=f32x16{};o[1]=f32x16{};f32x16 negm=f32x16{};if constexpr(!NOMAX)asm volatile("":"+v"(negm));
  f32x16 lsum=f32x16{}; const bf16x8 ONESF={(short)0x3F80,(short)0x3F80,(short)0x3F80,(short)0x3F80,(short)0x3F80,(short)0x3F80,(short)0x3F80,(short)0x3F80};
  #define CMASK(P0,P1,t) do{}while(0)
  bool resc=false;
  #define START(P0,P1) do{ if constexpr(!NOMAX){ const float rm=rowmax(P0,P1); resc=false; \
    { const float dl=rm; mhat=fadd_s(mhat,dl); \
      _Pragma("unroll") for(int r=0;r<16;++r){P0[r]=fsub_s(P0[r],dl);P1[r]=fsub_s(P1[r],dl);} \
      _Pragma("unroll") for(int r=0;r<16;++r)negm[r]=-mhat; asm volatile("":"+v"(negm)); } } \
    _Pragma("unroll") for(int r=0;r<16;++r)P0[r]=__builtin_amdgcn_exp2f(P0[r]); }while(0)
  #define RESC() do{ if(resc){ asm volatile("s_waitcnt lgkmcnt(0)":::"memory"); \
      _Pragma("unroll") for(int d_=0;d_<2;++d_) _Pragma("unroll") for(int r=0;r<16;++r)o[d_][r]*=wsf[crow(r,hi)]; } }while(0)
  f32x16 pA0,pA1,pB0,pB1;
  int sl_prev=0,sl_cur=0,sl_next=SLOTB;
  #define ROT() do{sl_prev=sl_cur;sl_cur=sl_next;sl_next=(sl_next==(NSLOT-1)*SLOTB)?0:sl_next+SLOTB;}while(0)
  DMA_K(2,2*SLOTB);
  WAIT_BAR(3);
  qkt(pA0,pA1,Kbase,qr,negm,r32,hi);asm volatile("s_nop 15\n\ts_nop 7":"+v"(pA0),"+v"(pA1));CMASK(pA0,pA1,0);
  START(pA0,pA1);
  _Pragma("unroll") for(int r=0;r<16;++r)pA1[r]=__builtin_amdgcn_exp2f(pA1[r]);
  WAIT_BAR(0);
  DMA_K(3,0);DMA_V(1,SLOTB);
  ROT();
  kload8(kf,kp0+sl_cur);
  WAIT_BAR(2);
  s16x4 vlo[8],vhi[8]; u32x4 pw0,pw1,pw2,pw3;
  #define PKW(P,B) cvtpk_s(P[B],P[B+1])
  #define PAF(k) __builtin_bit_cast(bf16x8,pw##k)
  #define VFR(i) (bf16x8){vlo[i][0],vlo[i][1],vlo[i][2],vlo[i][3],vhi[i][0],vhi[i][1],vhi[i][2],vhi[i][3]}
  #define PIN(x) asm volatile("":"+v"(x))
  #define MX3(a,b,c) __builtin_fmaxf(__builtin_fmaxf((a),(b)),(c))
  #define GAPA(MF,A0,A1,A2,A3,W0,W1,PW) do{ MF; if constexpr(!(NOMAX&&MSUM)){ sacc+=A0; sacc+=A1; sacc+=A2; sacc+=A3; PIN(sacc); } W0; W1; PIN(PW); SBAR(); }while(0)
  #define LSUM(k) do{ if constexpr(NOMAX&&MSUM){ lsum=__builtin_amdgcn_mfma_f32_32x32x16_bf16(PAF(k),ONESF,lsum,0,0,0); SBAR(); } }while(0)
  #define EX(v) __builtin_amdgcn_exp2f(v)
  #define GAPB(MF,X,B) do{ MF; X[B]=EX(X[B]); X[B+1]=EX(X[B+1]); X[B+2]=EX(X[B+2]); X[B+3]=EX(X[B+3]); PIN(X); SBAR(); }while(0)
  #define VRD(i) do{ vlo[i]=vtr(vp_+(((i)>>2)*4096+((i)&3)*1024)); vhi[i]=vtr(vp_+(((i)>>2)*4096+((i)&3)*1024+512)); }while(0)
  #define KRD(G,j) do{ if(G){ kload2(kf,kp0+sl_next,j); SBAR(); } }while(0)
  #define STEP(C0,C1,P0,P1,t,GK,GV,GL) do{ SBAR(); \
    const lds_cptr vp_=vp0+sl_prev; \
    VRD(0); SBAR(); float sacc=0.f; if constexpr(!(NOMAX&&MSUM)) sacc=(P0[0]+P0[1]); \
    GAPA(C0=__builtin_amdgcn_mfma_f32_32x32x16_bf16(kf[0],qr[0],negm,0,0,0), P0[2],P0[3],P0[4],P0[5],     pw0[0]=PKW(P0,0), pw0[1]=PKW(P0,2), pw0); \
    VRD(4); SBAR(); GAPA(C1=__builtin_amdgcn_mfma_f32_32x32x16_bf16(kf[1],qr[0],negm,0,0,0), P0[6],P0[7],P0[8],P0[9],     pw0[2]=PKW(P0,4), pw0[3]=PKW(P0,6), pw0); \
    VRD(1); SBAR(); GAPA(C0=__builtin_amdgcn_mfma_f32_32x32x16_bf16(kf[2],qr[1],C0,0,0,0),   P0[10],P0[11],P0[12],P0[13], pw1[0]=PKW(P0,8), pw1[1]=PKW(P0,10), pw1); \
    VRD(5); SBAR(); GAPA(C1=__builtin_amdgcn_mfma_f32_32x32x16_bf16(kf[3],qr[1],C1,0,0,0),   P0[14],P0[15],P1[0],P1[1],   pw1[2]=PKW(P0,12),pw1[3]=PKW(P0,14), pw1); \
    VRD(2); SBAR(); GAPA(C0=__builtin_amdgcn_mfma_f32_32x32x16_bf16(kf[4],qr[2],C0,0,0,0),   P1[2],P1[3],P1[4],P1[5],     pw2[0]=PKW(P1,0), pw2[1]=PKW(P1,2), pw2); \
    VRD(6); SBAR(); GAPA(C1=__builtin_amdgcn_mfma_f32_32x32x16_bf16(kf[5],qr[2],C1,0,0,0),   P1[6],P1[7],P1[8],P1[9],     pw2[2]=PKW(P1,4), pw2[3]=PKW(P1,6), pw2); \
    VRD(3); SBAR(); GAPA(C0=__builtin_amdgcn_mfma_f32_32x32x16_bf16(kf[6],qr[3],C0,0,0,0),   P1[10],P1[11],P1[12],P1[13], pw3[0]=PKW(P1,8), pw3[1]=PKW(P1,10), pw3); \
    VRD(7); SBAR(); GAPA(C1=__builtin_amdgcn_mfma_f32_32x32x16_bf16(kf[7],qr[3],C1,0,0,0),   P1[14],P1[15],0.f,0.f,       pw3[2]=PKW(P1,12),pw3[3]=PKW(P1,14), pw3); \
    l_reg+=sacc; \
    if(GK){DMA_K((t)+3,sl_cur);} if(GV){DMA_V((t)+1,sl_next);} \
    CMASK(C0,C1,t); \
    if constexpr(!NOMAX){ float a=MX3(C0[0],C0[1],C1[0]),b=MX3(C0[2],C0[3],C1[1]); a=MX3(a,C1[2],C1[3]); \
      _Pragma("unroll") for(int r=4;r<16;r+=4){a=MX3(a,C0[r],C0[r+1]);b=MX3(b,C0[r+2],C0[r+3]);a=MX3(a,C1[r],C1[r+1]);b=MX3(b,C1[r+2],C1[r+3]);} \
      float rm=__builtin_fmaxf(a,b); { auto rr=__builtin_amdgcn_permlane32_swap(__float_as_uint(rm),__float_as_uint(rm),false,false); rm=__builtin_fmaxf(__uint_as_float(rr[0]),__uint_as_float(rr[1])); } \
      resc=false; \
      if(__builtin_expect(__any(rm>(float)THRL),0)){ const float dl=__builtin_fmaxf(rm,0.f); mhat+=dl; \
        _Pragma("unroll") for(int r=0;r<16;++r){C0[r]-=dl;C1[r]-=dl;} \
        _Pragma("unroll") for(int r=0;r<16;++r)negm[r]=-mhat; asm volatile("":"+v"(negm)); \
        const float f=__builtin_amdgcn_exp2f(-dl); l_reg*=f; if(hi==0)wsf[r32]=f; resc=true; } } \
    SBAR(); \
    GAPB(o[0]=__builtin_amdgcn_mfma_f32_32x32x16_bf16(PAF(0),VFR(0),o[0],0,0,0), C0,0); \
    GAPB(o[1]=__builtin_amdgcn_mfma_f32_32x32x16_bf16(PAF(0),VFR(4),o[1],0,0,0), C0,4); LSUM(0); \
    KRD(GL,0); GAPB(o[0]=__builtin_amdgcn_mfma_f32_32x32x16_bf16(PAF(1),VFR(1),o[0],0,0,0), C0,8); \
    KRD(GL,1); GAPB(o[1]=__builtin_amdgcn_mfma_f32_32x32x16_bf16(PAF(1),VFR(5),o[1],0,0,0), C0,12); LSUM(1); \
    KRD(GL,2); GAPB(o[0]=__builtin_amdgcn_mfma_f32_32x32x16_bf16(PAF(2),VFR(2),o[0],0,0,0), C1,0); \
    KRD(GL,3); GAPB(o[1]=__builtin_amdgcn_mfma_f32_32x32x16_bf16(PAF(2),VFR(6),o[1],0,0,0), C1,4); LSUM(2); \
    GAPB(o[0]=__builtin_amdgcn_mfma_f32_32x32x16_bf16(PAF(3),VFR(3),o[0],0,0,0), C1,8); \
    GAPB(o[1]=__builtin_amdgcn_mfma_f32_32x32x16_bf16(PAF(3),VFR(7),o[1],0,0,0), C1,12); LSUM(3); \
    }while(0)
  int t=1;
  for(;t+5<NT;t+=2){
    STEP(pB0,pB1,pA0,pA1,t,true,true,true);     WAIT_BAR(2); RESC(); ROT();
    STEP(pA0,pA1,pB0,pB1,t+1,true,true,true);   WAIT_BAR(2); RESC(); ROT();
  }
  #define ENDW(tt) do{ if((tt)+3<NT){WAIT_BAR(2);} else if((tt)+2<NT){WAIT_BAR(1);} else {WAIT_BAR(0);} }while(0)
  for(;t+1<NT;t+=2){
    STEP(pB0,pB1,pA0,pA1,t,(t+3<NT),(t+1<NT),(t+1<NT));       ENDW(t);   RESC(); ROT();
    STEP(pA0,pA1,pB0,pB1,t+1,(t+4<NT),(t+2<NT),(t+2<NT));     ENDW(t+1); RESC(); ROT();
  }
  STEP(pB0,pB1,pA0,pA1,NT-1,false,false,false); RESC();
  { if constexpr(!(NOMAX&&MSUM)){ float sacc=pB0[0]+pB0[1]; _Pragma("unroll") for(int r=2;r<16;++r)sacc+=pB0[r]; _Pragma("unroll") for(int r=0;r<16;++r)sacc+=pB1[r]; l_reg+=sacc; }
    pw0=(u32x4){PKW(pB0,0),PKW(pB0,2),PKW(pB0,4),PKW(pB0,6)};pw1=(u32x4){PKW(pB0,8),PKW(pB0,10),PKW(pB0,12),PKW(pB0,14)};pw2=(u32x4){PKW(pB1,0),PKW(pB1,2),PKW(pB1,4),PKW(pB1,6)};pw3=(u32x4){PKW(pB1,8),PKW(pB1,10),PKW(pB1,12),PKW(pB1,14)};
    SBAR(); pv(o,vb0+sl_cur,PAF(0),PAF(1),PAF(2),PAF(3)); LSUM(0); LSUM(1); LSUM(2); LSUM(3); }
  #undef PKW
  #undef PAF
  #undef VFR
  #undef PIN
  #undef MX3
  #undef GAPA
  #undef LSUM
  #undef GAPB
  #undef EX
  #undef VRD
  #undef KRD
  #undef STEP
  #undef ENDW
  float rli[16];
  if constexpr(NOMAX&&MSUM){
    #pragma unroll
    for(int r=0;r<16;++r)rli[r]=__builtin_amdgcn_rcpf(lsum[r]);
  } else {
  {auto rr=__builtin_amdgcn_permlane32_swap(__float_as_uint(l_reg),__float_as_uint(l_reg),false,false);l_reg=__uint_as_float(rr[0])+__uint_as_float(rr[1]);}
  if(hi==0)wsf[32+r32]=l_reg;asm volatile("s_waitcnt lgkmcnt(0)":::"memory");
  #pragma unroll
  for(int r=0;r<16;++r)rli[r]=__builtin_amdgcn_rcpf(wsf[32+crow(r,hi)]);
  }
  bf16*Ow=Ow0+(long)(wid*QBLK)*OP;
  { bf16*stg=(bf16*)(shm+LDS_OST)+wid*2048;
    #pragma unroll
    for(int r=0;r<16;++r){const int orow=crow(r,hi);
      #pragma unroll
      for(int d0=0;d0<2;++d0)stg[orow*64+d0*32+r32]=__float2bfloat16(o[d0][r]*rli[r]);}
    asm volatile("s_waitcnt lgkmcnt(0)":::"memory");
    #pragma unroll
    for(int i=0;i<4;++i){const int row=i*8+(lane>>3),ch=lane&7; const u32x4 v=*(const u32x4*)(stg+row*64+ch*8); ATTN_STORE16(Ow+(long)row*OP+ch*8,v);} }
  asm volatile("s_waitcnt lgkmcnt(0)\n\ts_barrier":::"memory");
  #undef DMA_K
  #undef DMA_V
  #undef CMASK
  #undef START
  #undef RESC
  #undef ROT
}
constexpr int ATTN_LDS_BYTES=LDS_BYTES;
#undef SBAR
#undef WAIT_BAR
}

typedef unsigned short bf16;
typedef float f32x16 __attribute__((ext_vector_type(16)));
typedef short s16x4 __attribute__((ext_vector_type(4)));
typedef short v4i16_t __attribute__((ext_vector_type(4)));
typedef unsigned u32x2 __attribute__((ext_vector_type(2)));
typedef float f32x2v __attribute__((ext_vector_type(2)));
using pg8::bf16x8; using pg8::u32x4;

constexpr int DM = 1024, SEQ = 4096, T_P = 4 * 4096, T_S = 16 * 4096, TT = T_P + T_S, NBATCH = 20;
constexpr int DIN = 2048, NLAYER = 4, NEXP = 16, DEXP = 2048;
constexpr int CAP_P = T_P / 8, CAP_S = T_S / 8, ROWS_P = NEXP * CAP_P, ROWS_E = 2 * TT;
constexpr float LN_EPS = 1e-5f, QK_EPS = 1e-6f;
constexpr float DN_ALPHA = 1.6817928305074290861f;
constexpr float LOG2E = 1.4426950408889634f;
constexpr float C2 = 0.125f * LOG2E;
constexpr int H_NAQ = 0, H_NAK = 256, H_NAV = 512, H_GQ = 768, H_GK = 1280, H_GV = 1408, H_UC = 1536, H_VC = 1792;
constexpr int Y_NA = 0, Y_GQA = 256, Y_SG = 768;

constexpr size_t MiB = 1u << 20;
constexpr size_t WS_CTL = 0, CTL_ZERO_BYTES = 1 * MiB;
constexpr size_t WS_ROPE = 1 * MiB;
constexpr size_t WS_WSBF = 2 * MiB;
constexpr size_t WS_WIN = 4 * MiB;
constexpr size_t WS_WOUT = 8 * MiB;
constexpr size_t WS_WGU = 16 * MiB;
constexpr size_t WS_WD = 144 * MiB;
constexpr size_t WS_AFF = 208 * MiB;
constexpr size_t WS_SLOTOF = 214 * MiB;
constexpr size_t WS_IDX = 220 * MiB;
constexpr size_t WS_GATE = 221 * MiB;
constexpr size_t WS_STATS = 222 * MiB;
constexpr size_t WS_XB = 224 * MiB;
constexpr size_t WS_H = 384 * MiB;
constexpr size_t WS_HID = 704 * MiB;
constexpr size_t WS_XB8 = 1344 * MiB;
constexpr size_t WS_VT = 1424 * MiB;
constexpr size_t WS_DUMMY = 1468 * MiB;
constexpr size_t WS_END = 1468 * MiB;
constexpr int VTP = SEQ + 64;
constexpr int CW_TMO = 0, CW_BAR = 4096;

constexpr int NWAVES = 8;
constexpr int RING_BYTES = 131072, LDSCTL_OFF = RING_BYTES, MISC_OFF = LDSCTL_OFF + 320, LDS_BYTES = 147456;

__device__ __forceinline__ unsigned f2bf(float f) { unsigned u = __builtin_bit_cast(unsigned, f); return (u + 0x7fffu + ((u >> 16) & 1u)) >> 16; }
__device__ __forceinline__ unsigned pk2(float lo, float hi) { return f2bf(lo) | (f2bf(hi) << 16); }
__device__ __forceinline__ float bf2f(unsigned short b) { return __builtin_bit_cast(float, (unsigned)b << 16); }
template <int O> __device__ __forceinline__ float shx(float v) {
    static_assert(O >= 1 && O < 32, "ds_swizzle bit mode covers xor distances 1..31");
    return __builtin_bit_cast(float, __builtin_amdgcn_ds_swizzle(__builtin_bit_cast(int, v), 0x1f | (O << 10)));
}
__device__ __forceinline__ float sum32(float v) { const auto rr = __builtin_amdgcn_permlane32_swap(__float_as_uint(v), __float_as_uint(v), false, false); return __uint_as_float(rr[0]) + __uint_as_float(rr[1]); }
__device__ __forceinline__ float max32(float v) { const auto rr = __builtin_amdgcn_permlane32_swap(__float_as_uint(v), __float_as_uint(v), false, false); return fmaxf(__uint_as_float(rr[0]), __uint_as_float(rr[1])); }
__device__ __forceinline__ float other32(float v, bool upper) { const auto rr = __builtin_amdgcn_permlane32_swap(__float_as_uint(v), __float_as_uint(v), false, false); return __uint_as_float(upper ? rr[0] : rr[1]); }
__device__ __forceinline__ float wave_sum(float v) {
    v += shx<1>(v); v += shx<2>(v); v += shx<4>(v); v += shx<8>(v); v += shx<16>(v);
    return sum32(v);
}
__device__ __forceinline__ float gelu_tanh(float x) {
    const float u = 0.7978845608028654f * (x + 0.044715f * x * x * x);
    const float e = __builtin_amdgcn_exp2f((2.0f * LOG2E) * u);
    const float th = 1.0f - 2.0f * __builtin_amdgcn_rcpf(e + 1.0f);
    return 0.5f * x * (1.0f + th);
}
__device__ __forceinline__ float clamp8(float v) { return __builtin_amdgcn_fmed3f(v, -440.f, 440.f); }
__device__ __forceinline__ unsigned pk4_fp8(float a, float b, float c, float d) { int w = 0; w = __builtin_amdgcn_cvt_pk_fp8_f32(clamp8(a), clamp8(b), w, false); w = __builtin_amdgcn_cvt_pk_fp8_f32(clamp8(c), clamp8(d), w, true); return (unsigned)w; }
constexpr float WGU_SCALE = 64.f, WD_SCALE = 128.f, HID_SCALE = 8.f, YE_SCALE = 64.f;
__device__ __forceinline__ int crow(int r, int hi) { return (r & 3) + 8 * (r >> 2) + 4 * hi; }
__device__ __forceinline__ s16x4 tr_read(const LAS unsigned char* p) { return __builtin_bit_cast(s16x4, __builtin_amdgcn_ds_read_tr16_b64_v4i16((LAS v4i16_t*)p)); }
#define MFMA32(a, b, c) __builtin_amdgcn_mfma_f32_32x32x16_bf16((a), (b), (c), 0, 0, 0)

using pg8::Unit; using pg8::BM; using pg8::HALF;
__device__ __forceinline__ u32x4 pack8(const f32x4& a, const f32x4& b) { u32x4 w; w.x = pg8::cvt_pk_bf16(a[0], a[1]); w.y = pg8::cvt_pk_bf16(a[2], a[3]); w.z = pg8::cvt_pk_bf16(b[0], b[1]); w.w = pg8::cvt_pk_bf16(b[2], b[3]); return w; }

struct EpiIn {
    static constexpr bool PERM = true, AFTER_DRAIN = false;
    bf16* H; const float* qn; const float* kn; const float* gv; const float* bv; const float* rope; bf16* VT;
    __device__ __forceinline__ void operator()(const f32x4 (&acc)[2][2][4][2], const Unit& u, int wr, int wc, int fr, int fq) const {
        const int pn = u.pn;
        int mode; const float* gain = qn; float osc = 1.f;
        if (pn == 0) { mode = 1; osc = C2; } else if (pn <= 2) mode = 0; else if (pn <= 4) { mode = 2; gain = qn; osc = C2; }
        else if (pn == 5) { if (wc < 2) { mode = 2; gain = kn; osc = 1.f; } else mode = 0; } else if (pn == 6) mode = 3; else mode = 4;
        const int row0 = u.pm * BM + wr * 64 + fr;
        bf16* Hb = H + (size_t)row0 * DIN + pn * 256 + wc * 64 + 8 * fq;
#define EPI_ROWS(BODY) _Pragma("unroll") for (int ai = 0; ai < 2; ++ai) _Pragma("unroll") for (int m = 0; m < 4; ++m) { const int rofs = ai * HALF + m * 16; f32x4 v[2][2]; \
            _Pragma("unroll") for (int bj = 0; bj < 2; ++bj) _Pragma("unroll") for (int n = 0; n < 2; ++n) v[bj][n] = acc[ai][bj][m][n]; \
            BODY \
            bf16* rowp = Hb + (size_t)rofs * DIN; _Pragma("unroll") for (int bj = 0; bj < 2; ++bj) *(u32x4*)(rowp + 32 * bj) = pack8(v[bj][0], v[bj][1]); }
#define EPI_ALL(EXPR) _Pragma("unroll") for (int bj = 0; bj < 2; ++bj) _Pragma("unroll") for (int n = 0; n < 2; ++n) { EXPR }
        if (mode == 5) {
#pragma unroll
            for (int ai = 0; ai < 2; ++ai)
#pragma unroll
                for (int m = 0; m < 4; ++m) { const int t = row0 + ai * HALF + m * 16; bf16* vb = VT + ((size_t)((t >> 12) * 4 + wc) * 64 + 8 * fq) * VTP + (t & (SEQ - 1));
#pragma unroll
                    for (int bj = 0; bj < 2; ++bj)
#pragma unroll
                        for (int n = 0; n < 2; ++n)
#pragma unroll
                            for (int i = 0; i < 4; ++i) vb[(size_t)(32 * bj + 4 * n + i) * VTP] = (bf16)f2bf(acc[ai][bj][m][n][i]); }
        }
        else if (mode == 0) { EPI_ROWS( ; ) }
        else if (mode == 1) { EPI_ROWS( EPI_ALL( v[bj][n] = v[bj][n] * osc; ) ) }
        else if (mode == 2) {
            EPI_ROWS(
                float ss = 0.f;
                EPI_ALL( const f32x4 x = v[bj][n]; ss += (x[0] * x[0] + x[1] * x[1]) + (x[2] * x[2] + x[3] * x[3]); )
                ss += shx<16>(ss); ss = sum32(ss);
                const float rstd = osc * __builtin_amdgcn_rsqf(ss * (1.0f / 64.0f) + QK_EPS);
                const int sp = (row0 + rofs) & (SEQ - 1);
                EPI_ALL(
                    const f32x4 gg = *(const f32x4*)(gain + 32 * bj + 8 * fq + 4 * n);
                    const f32x4 cs = *(const f32x4*)(rope + ((size_t)sp * 32 + 16 * bj + 4 * fq + 2 * n) * 2);
                    const f32x4 x = v[bj][n] * rstd * gg;
                    f32x4 o; o[0] = x[0] * cs[0] - x[1] * cs[1]; o[1] = x[0] * cs[1] + x[1] * cs[0]; o[2] = x[2] * cs[2] - x[3] * cs[3]; o[3] = x[2] * cs[3] + x[3] * cs[2];
                    v[bj][n] = o; )
                asm volatile("" ::: "memory");
            )
        } else if (mode == 3) {
            EPI_ROWS( EPI_ALL( f32x4 x = v[bj][n]; x[0] = gelu_tanh(x[0]); x[1] = gelu_tanh(x[1]); x[2] = gelu_tanh(x[2]); x[3] = gelu_tanh(x[3]); v[bj][n] = x; ) )
        } else {
            EPI_ROWS(
                EPI_ALL( f32x4 x = v[bj][n]; x[0] = gelu_tanh(x[0]); x[1] = gelu_tanh(x[1]); x[2] = gelu_tanh(x[2]); x[3] = gelu_tanh(x[3]); v[bj][n] = x; )
                float sm = 0.f;
                EPI_ALL( const f32x4 x = v[bj][n]; sm += (x[0] + x[1]) + (x[2] + x[3]); )
                sm += shx<16>(sm); sm = sum32(sm);
                const float mean = sm * (1.0f / 64.0f); float q = 0.f;
                EPI_ALL( const f32x4 d = v[bj][n] - mean; v[bj][n] = d; q += (d[0] * d[0] + d[1] * d[1]) + (d[2] * d[2] + d[3] * d[3]); )
                q += shx<16>(q); q = sum32(q);
                const float rstd = __builtin_amdgcn_rsqf(q * (1.0f / 64.0f) + LN_EPS);
                EPI_ALL( const f32x4 gg = *(const f32x4*)(gv + wc * 64 + 32 * bj + 8 * fq + 4 * n); const f32x4 bb = *(const f32x4*)(bv + wc * 64 + 32 * bj + 8 * fq + 4 * n); v[bj][n] = v[bj][n] * rstd * gg + bb; )
                asm volatile("" ::: "memory");
            )
        }
#undef EPI_ROWS
#undef EPI_ALL
    }
};
struct EpiRes {
    static constexpr bool PERM = true, AFTER_DRAIN = false;
    const bf16* XB; float* S;
    __device__ __forceinline__ void operator()(const f32x4 (&acc)[2][2][4][2], const Unit& u, int wr, int wc, int fr, int fq) const {
        const int row0 = u.pm * BM + wr * 64 + fr, col0 = u.pn * BM + wc * 32 + 8 * fq;
#pragma unroll
        for (int ai = 0; ai < 2; ++ai)
#pragma unroll
            for (int m = 0; m < 4; ++m) { const size_t ro = (size_t)(row0 + ai * HALF + m * 16) * DM + col0;
#pragma unroll
                for (int bj = 0; bj < 2; ++bj) { const u32x4 xw = *(const u32x4*)(XB + ro + bj * HALF);
                    f32x4 x0, x1; x0[0] = __builtin_bit_cast(float, xw.x << 16); x0[1] = __builtin_bit_cast(float, xw.x & 0xffff0000u); x0[2] = __builtin_bit_cast(float, xw.y << 16); x0[3] = __builtin_bit_cast(float, xw.y & 0xffff0000u);
                    x1[0] = __builtin_bit_cast(float, xw.z << 16); x1[1] = __builtin_bit_cast(float, xw.z & 0xffff0000u); x1[2] = __builtin_bit_cast(float, xw.w << 16); x1[3] = __builtin_bit_cast(float, xw.w & 0xffff0000u);
                    *(f32x4*)(S + ro + bj * HALF) = x0 * DN_ALPHA + acc[ai][bj][m][0]; *(f32x4*)(S + ro + bj * HALF + 4) = x1 * DN_ALPHA + acc[ai][bj][m][1]; } }
    }
};
struct EpiSwiglu {
    static constexpr bool PERM = true, AFTER_DRAIN = false;
    unsigned char* HID;
    __device__ __forceinline__ void operator()(const f32x4 (&acc)[2][2][4][2], const Unit& u, int wr, int wc, int fr, int fq) const {
        const int row0 = u.pm * BM + wr * 64 + fr, col0 = u.pn * 128 + wc * 32 + 8 * fq;
        constexpr float IS = 1.0f / WGU_SCALE, OS = HID_SCALE / WGU_SCALE;
#pragma unroll
        for (int ai = 0; ai < 2; ++ai)
#pragma unroll
            for (int m = 0; m < 4; ++m) { f32x4 o[2];
#pragma unroll
                for (int n = 0; n < 2; ++n) { const f32x4 g = acc[ai][0][m][n] * IS, up = acc[ai][1][m][n] * OS;
#pragma unroll
                    for (int i = 0; i < 4; ++i) o[n][i] = g[i] * __builtin_amdgcn_rcpf(1.0f + __builtin_amdgcn_exp2f(-LOG2E * g[i])) * up[i]; }
                u32x2 w; w.x = pk4_fp8(o[0][0], o[0][1], o[0][2], o[0][3]); w.y = pk4_fp8(o[1][0], o[1][1], o[1][2], o[1][3]);
                *(u32x2*)(HID + (size_t)(row0 + ai * HALF + m * 16) * DEXP + col0) = w; }
    }
};
struct EpiDown {
    static constexpr bool PERM = true, AFTER_DRAIN = false;
    unsigned char* YE; const float* gate;
    __device__ __forceinline__ void operator()(const f32x4 (&acc)[2][2][4][2], const Unit& u, int wr, int wc, int fr, int fq) const {
        const int row0 = u.pm * BM + wr * 64 + fr, col0 = u.pn * BM + wc * 32 + 8 * fq;
#pragma unroll
        for (int ai = 0; ai < 2; ++ai)
#pragma unroll
            for (int m = 0; m < 4; ++m) { const int row = row0 + ai * HALF + m * 16; const float gt = gate[row] * (YE_SCALE / (WD_SCALE * HID_SCALE));
#pragma unroll
                for (int bj = 0; bj < 2; ++bj) { const f32x4 a = acc[ai][bj][m][0] * gt, c = acc[ai][bj][m][1] * gt; u32x2 w; w.x = pk4_fp8(a[0], a[1], a[2], a[3]); w.y = pk4_fp8(c[0], c[1], c[2], c[3]);
                    *(u32x2*)(YE + (size_t)row * DM + col0 + bj * HALF) = w; } }
    }
};

struct Frame {
    LAS unsigned char* lds;
    int tid, lane, wave, vcu, G, gw, NGW;
};

__device__ __forceinline__ void transpose_item(const float* W, int N, int K, bf16* dst_row0, LAS float* scr, int k0, int n0, int lane) {
    float tv[32];
#pragma unroll
    for (int i = 0; i < 32; ++i) tv[i] = __builtin_nontemporal_load(W + (size_t)(k0 + 2 * i + (lane >> 5)) * N + n0 + (lane & 31));
#pragma unroll
    for (int i = 0; i < 32; ++i) scr[(2 * i + (lane >> 5)) * 33 + (lane & 31)] = tv[i];
    asm volatile("s_waitcnt lgkmcnt(0)" ::: "memory");
    const int c = lane & 7;
#pragma unroll
    for (int j = 0; j < 4; ++j) { const int n = (lane >> 3) + 8 * j; const LAS float* s = scr + (8 * c) * 33 + n;
        u32x4 o; o.x = pk2(s[0 * 33], s[1 * 33]); o.y = pk2(s[2 * 33], s[3 * 33]); o.z = pk2(s[4 * 33], s[5 * 33]); o.w = pk2(s[6 * 33], s[7 * 33]);
        *(u32x4*)(dst_row0 + (size_t)n * K + k0 + 8 * c) = o; }
    asm volatile("s_waitcnt lgkmcnt(0)" ::: "memory");
}
__device__ __forceinline__ void transpose_item_fp8(const float* W, int N, int K, unsigned char* dst_row0, LAS float* scr, int k0, int n0, int lane, float sc) {
    float tv[32];
#pragma unroll
    for (int i = 0; i < 32; ++i) tv[i] = __builtin_nontemporal_load(W + (size_t)(k0 + 2 * i + (lane >> 5)) * N + n0 + (lane & 31));
#pragma unroll
    for (int i = 0; i < 32; ++i) scr[(2 * i + (lane >> 5)) * 33 + (lane & 31)] = tv[i];
    asm volatile("s_waitcnt lgkmcnt(0)" ::: "memory");
    const int c = lane & 7;
#pragma unroll
    for (int j = 0; j < 4; ++j) { const int n = (lane >> 3) + 8 * j; const LAS float* s = scr + (8 * c) * 33 + n;
        u32x2 o; o.x = pk4_fp8(s[0 * 33] * sc, s[1 * 33] * sc, s[2 * 33] * sc, s[3 * 33] * sc); o.y = pk4_fp8(s[4 * 33] * sc, s[5 * 33] * sc, s[6 * 33] * sc, s[7 * 33] * sc);
        *(u32x2*)(dst_row0 + (size_t)n * K + k0 + 8 * c) = o; }
    asm volatile("s_waitcnt lgkmcnt(0)" ::: "memory");
}
__device__ __forceinline__ void conv_phase(Frame& F, int l, const float* w_in, const float* w_out, const float* w_gate, const float* w_up, const float* w_down, const float* sg_w, unsigned char* ws) {
    LAS float* scr = (LAS float*)(F.lds + F.wave * 16384);
    bf16* WIN = (bf16*)(ws + WS_WIN); bf16* WOUT = (bf16*)(ws + WS_WOUT); unsigned char* WGU = ws + WS_WGU; unsigned char* WD = ws + WS_WD; bf16* WSB = (bf16*)(ws + WS_WSBF);
    constexpr int I_IN = 16 * 64, I_OUT = 16 * 32, I_G = 16 * 1024, I_D = 16 * 1024, NIT = I_IN + I_OUT + 2 * I_G + I_D;
    for (int it = F.gw; it < NIT; it += F.NGW) {
        int r = it;
        if (r < I_IN) { const int kb = r >> 6, nb = r & 63, n0 = 32 * nb; const int pn = n0 >> 8, c = n0 & 255, wc = c >> 6, bj = (c >> 5) & 1;
            transpose_item(w_in + (size_t)l * DM * DIN, DIN, DM, WIN + (size_t)(256 * pn + 128 * bj + 32 * wc) * DM, scr, 64 * kb, n0, F.lane); continue; }
        r -= I_IN;
        if (r < I_OUT) { const int kb = r >> 5, nb = r & 31, n0 = 32 * nb;
            transpose_item(w_out + (size_t)l * DM * DM, DM, DM, WOUT + (size_t)n0 * DM, scr, 64 * kb, n0, F.lane); continue; }
        r -= I_OUT;
        if (r < 2 * I_G) { const int which = r >= I_G; if (which) r -= I_G; const int e = r >> 10, kb = (r >> 6) & 15, nb = r & 63, n0 = 32 * nb;
            const float* W = (which ? w_up : w_gate) + ((size_t)l * NEXP + e) * DM * DEXP;
            transpose_item_fp8(W, DEXP, DM, WGU + ((size_t)e * 4096 + (n0 >> 7) * 256 + which * 128 + (n0 & 127)) * DM, scr, 64 * kb, n0, F.lane, WGU_SCALE); continue; }
        r -= 2 * I_G;
        { const int e = r >> 10, kb = (r >> 5) & 31, nb = r & 31, n0 = 32 * nb;
            transpose_item_fp8(w_down + ((size_t)l * NEXP + e) * DEXP * DM, DM, DEXP, WD + ((size_t)e * DM + n0) * DEXP, scr, 64 * kb, n0, F.lane, WD_SCALE); }
    }
    const float* sw = sg_w + (size_t)l * 4 * 128 * 128;
    for (int i = F.gw * 64 + F.lane; i < 4 * 128 * 128; i += F.NGW * 64) WSB[i] = (bf16)f2bf(sw[i]);
}

__device__ __forceinline__ void row_ln(f32x4 (&v)[4], const float* g, const float* b, int lane) {
    float s = 0.f;
#pragma unroll
    for (int j = 0; j < 4; ++j) s += (v[j][0] + v[j][1]) + (v[j][2] + v[j][3]);
    const float mean = wave_sum(s) * (1.f / DM); float s2 = 0.f;
#pragma unroll
    for (int j = 0; j < 4; ++j) { v[j] = v[j] - mean; s2 += (v[j][0] * v[j][0] + v[j][1] * v[j][1]) + (v[j][2] * v[j][2] + v[j][3] * v[j][3]); }
    const float rstd = 1.f / sqrtf(wave_sum(s2) * (1.f / DM) + LN_EPS);
#pragma unroll
    for (int j = 0; j < 4; ++j) { const f32x4 gg = *(const f32x4*)(g + 4 * lane + 256 * j), bb = *(const f32x4*)(b + 4 * lane + 256 * j); v[j] = v[j] * rstd * gg + bb; }
}
__device__ __forceinline__ void row_ln_stats(f32x4 (&v)[4], const float* g, const float* b, int lane, float& mean_o, float& rstd_o) {
    float s = 0.f;
#pragma unroll
    for (int j = 0; j < 4; ++j) s += (v[j][0] + v[j][1]) + (v[j][2] + v[j][3]);
    const float mean = wave_sum(s) * (1.f / DM); float s2 = 0.f;
#pragma unroll
    for (int j = 0; j < 4; ++j) { v[j] = v[j] - mean; s2 += (v[j][0] * v[j][0] + v[j][1] * v[j][1]) + (v[j][2] * v[j][2] + v[j][3] * v[j][3]); }
    const float rstd = 1.f / sqrtf(wave_sum(s2) * (1.f / DM) + LN_EPS);
#pragma unroll
    for (int j = 0; j < 4; ++j) { const f32x4 gg = *(const f32x4*)(g + 4 * lane + 256 * j), bb = *(const f32x4*)(b + 4 * lane + 256 * j); v[j] = v[j] * rstd * gg + bb; }
    mean_o = mean; rstd_o = rstd;
}
__device__ __forceinline__ void store_row(const f32x4 (&v)[4], float* xrow, bf16* xbrow, int lane) {
#pragma unroll
    for (int j = 0; j < 4; ++j) { *(f32x4*)(xrow + 4 * lane + 256 * j) = v[j]; u32x2 w; w.x = pk2(v[j][0], v[j][1]); w.y = pk2(v[j][2], v[j][3]); *(u32x2*)(xbrow + 4 * lane + 256 * j) = w; }
}

__device__ __forceinline__ void store_row_bf(const f32x4 (&v)[4], bf16* xbrow, int lane) {
#pragma unroll
    for (int j = 0; j < 4; ++j) { u32x2 w; w.x = pk2(v[j][0], v[j][1]); w.y = pk2(v[j][2], v[j][3]); *(u32x2*)(xbrow + 4 * lane + 256 * j) = w; }
}
__device__ __forceinline__ void prologue_phase(Frame& F, const float* xp, const float* xs, const float* g, const float* b, float* X, unsigned char* ws) {
    float* rope = (float*)(ws + WS_ROPE);
    for (int i = F.gw * 64 + F.lane; i < SEQ * 32; i += F.NGW * 64) {
        const int s = i >> 5, p = i & 31, fi = p & 15; const float pos = (float)((p < 16) ? (s >> 6) : (s & 63));
        const float inv = powf(10000.0f, -(float)fi / 16.0f); const float ang = pos * inv;
        rope[2 * i] = cosf(ang); rope[2 * i + 1] = sinf(ang);
    }
    bf16* XB = (bf16*)(ws + WS_XB);
    for (int m = F.gw; m < TT; m += F.NGW) {
        const float* src = (m < T_P) ? xp + (size_t)m * DM : xs + (size_t)(m - T_P) * DM;
        f32x4 v[4];
#pragma unroll
        for (int j = 0; j < 4; ++j) v[j] = *(const f32x4*)(src + 4 * F.lane + 256 * j);
        row_ln(v, g, b, F.lane);
        store_row_bf(v, XB + (size_t)m * DM, F.lane);
    }
}

__device__ __forceinline__ float router_reduce(float (&lg)[16], int lane) {
    float r8[8], r4[4], r2[2], r1;
    const bool b5 = lane & 32, b4 = lane & 16, b3 = lane & 8, b2 = lane & 4;
#pragma unroll
    for (int i = 0; i < 8; ++i) { const float snd = b5 ? lg[i] : lg[i + 8], kp = b5 ? lg[i + 8] : lg[i]; r8[i] = kp + other32(snd, b5); }
#pragma unroll
    for (int i = 0; i < 4; ++i) { const float snd = b4 ? r8[i] : r8[i + 4], kp = b4 ? r8[i + 4] : r8[i]; r4[i] = kp + shx<16>(snd); }
#pragma unroll
    for (int i = 0; i < 2; ++i) { const float snd = b3 ? r4[i] : r4[i + 2], kp = b3 ? r4[i + 2] : r4[i]; r2[i] = kp + shx<8>(snd); }
    { const float snd = b2 ? r2[0] : r2[1], kp = b2 ? r2[1] : r2[0]; r1 = kp + shx<4>(snd); }
    r1 += shx<1>(r1); r1 += shx<2>(r1);
    float mx = r1;
    mx = fmaxf(mx, shx<4>(mx)); mx = fmaxf(mx, shx<8>(mx)); mx = fmaxf(mx, shx<16>(mx)); mx = max32(mx);
    const float ex = expf(r1 - mx); float sm = ex;
    sm += shx<4>(sm); sm += shx<8>(sm); sm += shx<16>(sm); sm = sum32(sm);
    return ex / sm;
}
template <bool DRY> __device__ __forceinline__ void ln1_router_phase(Frame& F, float* X, const float* g, const float* b, const float* wr, unsigned char* ws) {
    constexpr int NR = LN1_ROWS;
    LAS float* wl = (LAS float*)F.lds;
    for (int i = F.tid; i < DM * NEXP; i += NWAVES * 64) wl[(i & 15) * DM + (i >> 4)] = wr[i];
    __syncthreads();
    unsigned char* XB8 = ws + (DRY ? WS_DUMMY + 400 * MiB : WS_XB8); float* AFF = (float*)(ws + (DRY ? WS_DUMMY + 500 * MiB : WS_AFF)); float* ST = (float*)(ws + (DRY ? WS_DUMMY : WS_STATS));
    const int lane = F.lane, e_mine = ((lane >> 5) & 1) * 8 + ((lane >> 4) & 1) * 4 + ((lane >> 3) & 1) * 2 + ((lane >> 2) & 1);
    int m = NR * F.gw;
    f32x4 nx[NR][4];
#pragma unroll
    for (int r = 0; r < NR; ++r)
#pragma unroll
        for (int j = 0; j < 4; ++j) nx[r][j] = (f32x4){0.f, 0.f, 0.f, 0.f};
    if (m < TT) {
#pragma unroll
        for (int r = 0; r < NR; ++r)
#pragma unroll
            for (int j = 0; j < 4; ++j) nx[r][j] = *(const f32x4*)(X + (size_t)(m + r) * DM + 4 * lane + 256 * j); }
    for (; m < TT; m += NR * F.NGW) {
        f32x4 v[NR][4];
#pragma unroll
        for (int r = 0; r < NR; ++r)
#pragma unroll
            for (int j = 0; j < 4; ++j) v[r][j] = nx[r][j];
        { const int mn = m + NR * F.NGW;
          if (mn < TT) {
#pragma unroll
            for (int r = 0; r < NR; ++r)
#pragma unroll
                for (int j = 0; j < 4; ++j) nx[r][j] = *(const f32x4*)(X + (size_t)(mn + r) * DM + 4 * lane + 256 * j); } }
        float mu[NR], rs[NR];
#pragma unroll
        for (int r = 0; r < NR; ++r) row_ln_stats(v[r], g, b, lane, mu[r], rs[r]);
        if (lane == 0) {
#pragma unroll
            for (int r = 0; r < NR; r += 2) { f32x4 st; st[0] = mu[r]; st[1] = rs[r]; st[2] = mu[r + 1]; st[3] = rs[r + 1]; *(f32x4*)(ST + (size_t)(m + r) * 2) = st; } }
#pragma unroll
        for (int r = 0; r < NR; ++r)
#pragma unroll
            for (int j = 0; j < 4; ++j) *(unsigned*)(XB8 + (size_t)(m + r) * DM + 4 * lane + 256 * j) = pk4_fp8(v[r][j][0], v[r][j][1], v[r][j][2], v[r][j][3]);
        float lg[NR][16];
#pragma unroll
        for (int e = 0; e < 16; ++e) { f32x4 a[NR];
#pragma unroll
            for (int r = 0; r < NR; ++r) a[r] = (f32x4){0.f, 0.f, 0.f, 0.f};
#pragma unroll
            for (int j = 0; j < 4; ++j) { const f32x4 w = *(const LAS f32x4*)(wl + e * DM + 4 * lane + 256 * j);
#pragma unroll
                for (int r = 0; r < NR; ++r) a[r] += v[r][j] * w; }
#pragma unroll
            for (int r = 0; r < NR; ++r) lg[r][e] = (a[r][0] + a[r][1]) + (a[r][2] + a[r][3]);
            if ((e & 3) == 3) asm volatile("" ::: "memory"); }
        float af[NR];
#pragma unroll
        for (int r = 0; r < NR; ++r) af[r] = router_reduce(lg[r], lane);
        if ((lane & 3) == 0) { const size_t off = (m < T_P) ? (size_t)e_mine * T_P + m : (size_t)16 * T_P + (size_t)e_mine * T_S + (m - T_P);
#pragma unroll
            for (int r = 0; r < NR; ++r) AFF[off + r] = af[r]; }
    }
    __syncthreads();
}

constexpr int TK_COPIES = 8, TK_STRIDE = 2048;
template <int NB>
__device__ __forceinline__ void bin_search(LAS unsigned* hist, LAS unsigned* wtot, LAS unsigned* res, unsigned remaining, int tid, int lane, int wave, unsigned& bin, unsigned& rem_out) {
    constexpr int BPT = NB / 512;
    unsigned hb[BPT]; unsigned own = 0;
#pragma unroll
    for (int k = 0; k < BPT; ++k) { unsigned a = 0;
#pragma unroll
        for (int c = 0; c < TK_COPIES; ++c) a += hist[c * TK_STRIDE + tid * BPT + k];
        hb[k] = a; own += a; }
    unsigned x = own;
#pragma unroll
    for (int o = 1; o < 64; o <<= 1) { const unsigned y = (unsigned)__builtin_amdgcn_ds_bpermute((lane + o) << 2, (int)x); if (lane + o < 64) x += y; }
    if (lane == 0) wtot[wave] = x;
    __syncthreads();
    unsigned above = 0;
#pragma unroll
    for (int w = 0; w < 8; ++w) above += (w > wave) ? wtot[w] : 0u;
    const unsigned suf_incl = x + above, suf_excl = suf_incl - own;
    if (suf_excl < remaining && remaining <= suf_incl) {
        unsigned c = suf_excl; bool done = false;
#pragma unroll
        for (int k = BPT - 1; k >= 0; --k) { if (!done && c + hb[k] >= remaining) { res[0] = (unsigned)(tid * BPT + k); res[1] = remaining - c; done = true; } c += hb[k]; }
    }
    __syncthreads();
    bin = res[0]; rem_out = res[1];
    __syncthreads();
}
template <int NPT>
__device__ __forceinline__ void topk_block(Frame& F, const unsigned* vals, int cap, int slotbase, int tokbase, int e, unsigned char* ws) {
    LAS unsigned* hist = (LAS unsigned*)F.lds; LAS unsigned* wtot = hist + TK_COPIES * TK_STRIDE; LAS unsigned* res = wtot + 16;
    const int base = F.wave * (NPT * 64) + F.lane;
    unsigned v[NPT];
#pragma unroll
    for (int j = 0; j < NPT; ++j) v[j] = vals[base + j * 64];
    LAS unsigned* hc = hist + (F.lane & 7) * TK_STRIDE;
    unsigned remaining = (unsigned)cap, prefix = 0, bin;
#define TK_ZERO() do { for (int i = F.tid; i < TK_COPIES * TK_STRIDE; i += 512) hist[i] = 0u; __syncthreads(); } while (0)
#define TK_ADD(idx) (void)__hip_atomic_fetch_add(&hc[(idx)], 1u, __ATOMIC_RELAXED, __HIP_MEMORY_SCOPE_WORKGROUP)
    TK_ZERO();
#pragma unroll
    for (int j = 0; j < NPT; ++j) { unsigned vv = v[j]; asm volatile("" : "+v"(vv) :: "memory"); TK_ADD(vv >> 21); }
    __syncthreads();
    bin_search<2048>(hist, wtot, res, remaining, F.tid, F.lane, F.wave, bin, remaining); prefix = bin;
    TK_ZERO();
#pragma unroll
    for (int j = 0; j < NPT; ++j) { unsigned vv = v[j]; asm volatile("" : "+v"(vv) :: "memory"); if ((vv >> 21) == prefix) TK_ADD((vv >> 10) & 2047u); }
    __syncthreads();
    bin_search<2048>(hist, wtot, res, remaining, F.tid, F.lane, F.wave, bin, remaining); prefix = (prefix << 11) | bin;
    TK_ZERO();
#pragma unroll
    for (int j = 0; j < NPT; ++j) { unsigned vv = v[j]; asm volatile("" : "+v"(vv) :: "memory"); if ((vv >> 10) == prefix) TK_ADD(vv & 1023u); }
    __syncthreads();
    bin_search<1024>(hist, wtot, res, remaining, F.tid, F.lane, F.wave, bin, remaining);
#undef TK_ZERO
#undef TK_ADD
    const unsigned thr = (prefix << 10) | bin, need_eq = remaining;
    unsigned cg = 0, ce = 0;
#pragma unroll
    for (int j = 0; j < NPT; ++j) { unsigned vv = v[j]; asm volatile("" : "+v"(vv)); cg += (unsigned)__popcll(__ballot(vv > thr)); ce += (unsigned)__popcll(__ballot(vv == thr)); asm volatile("" : "+v"(cg), "+v"(ce)); }
    if (F.lane == 0) { wtot[F.wave] = cg; wtot[8 + F.wave] = ce; }
    __syncthreads();
    unsigned run_gt = 0, run_eq = 0;
#pragma unroll
    for (int w = 0; w < 8; ++w) { run_gt += (w < F.wave) ? wtot[w] : 0u; run_eq += (w < F.wave) ? wtot[8 + w] : 0u; }
    int* IDX = (int*)(ws + WS_IDX); float* GATE = (float*)(ws + WS_GATE); int* SLOTOF = (int*)(ws + WS_SLOTOF);
    const unsigned long long ltmask = (1ull << F.lane) - 1ull;
#pragma unroll
    for (int j = 0; j < NPT; ++j) {
        unsigned vv = v[j]; asm volatile("" : "+v"(vv));
        const bool gt = vv > thr, eq = vv == thr;
        const unsigned long long bg = __ballot(gt), be = __ballot(eq);
        const unsigned gb = (unsigned)__popcll(bg & ltmask), eb = (unsigned)__popcll(be & ltmask);
        const unsigned eq_rank = run_eq + eb;
        const bool sel = gt || (eq && eq_rank < need_eq);
        const unsigned slot = run_gt + gb + (eq_rank < need_eq ? eq_rank : need_eq);
        const int tok = tokbase + base + j * 64;
        if (sel) { IDX[slotbase + slot] = tok; GATE[slotbase + slot] = __builtin_bit_cast(float, vv); }
        SLOTOF[(size_t)e * TT + tok] = sel ? (int)(slotbase + slot) : -1;
        run_gt += (unsigned)__popcll(bg); run_eq += (unsigned)__popcll(be); asm volatile("" : "+v"(run_gt), "+v"(run_eq));
    }
    __syncthreads();
}
__device__ __forceinline__ void topk_phase(Frame& F, unsigned char* ws) {
    if (blockIdx.x >= 32) return;
    const int g = blockIdx.x >> 4, e = blockIdx.x & 15;
    const unsigned* aff = (const unsigned*)(ws + WS_AFF);
    if (g == 0) topk_block<T_P / 512>(F, aff + (size_t)e * T_P, CAP_P, e * CAP_P, 0, e, ws);
    else        topk_block<T_S / 512>(F, aff + (size_t)16 * T_P + (size_t)e * T_S, CAP_S, ROWS_P + e * CAP_S, T_P, e, ws);
}

__device__ __forceinline__ void gather_phase(Frame& F, unsigned char* ws) {
    const int* IDX = (const int*)(ws + WS_IDX); const unsigned char* XB8 = ws + WS_XB8; unsigned char* XE = ws + WS_H;
    for (int r = F.gw; r < ROWS_E; r += F.NGW) { const int tok = IDX[r];
        *(u32x4*)(XE + (size_t)r * DM + 16 * F.lane) = *(const u32x4*)(XB8 + (size_t)tok * DM + 16 * F.lane); }
}

template <bool DRY> __device__ __forceinline__ void combine_phase(Frame& F, float* X, const float* g1, const float* b1, const float* g, const float* b, unsigned char* ws, bool last_layer) {
    const int* SLOTOF = (const int*)(ws + WS_SLOTOF); const unsigned char* YE = ws + WS_H; bf16* XB = (bf16*)(ws + (DRY ? WS_DUMMY + 400 * MiB : WS_XB)); float* Xo = DRY ? (float*)(ws + WS_DUMMY) : X;
    const int lane = F.lane;
    int m = 2 * F.gw;
    int so_n = (m < TT) ? SLOTOF[(size_t)(lane & 15) * TT + m + ((lane >> 4) & 1)] : -1;
    for (; m < TT; m += 2 * F.NGW) {
        const int so = so_n; const int mn = m + 2 * F.NGW;
        so_n = (mn < TT) ? SLOTOF[(size_t)(lane & 15) * TT + mn + ((lane >> 4) & 1)] : -1;
        f32x4 v0[4], v1[4];
#pragma unroll
        for (int j = 0; j < 4; ++j) { v0[j] = *(const f32x4*)(X + (size_t)m * DM + 4 * lane + 256 * j); v1[j] = *(const f32x4*)(X + (size_t)(m + 1) * DM + 4 * lane + 256 * j); }
        { const f32x4 st = *(const f32x4*)((const float*)(ws + WS_STATS) + (size_t)m * 2);
#pragma unroll
          for (int j = 0; j < 4; ++j) { const f32x4 gg = *(const f32x4*)(g1 + 4 * lane + 256 * j) * DN_ALPHA, bb = *(const f32x4*)(b1 + 4 * lane + 256 * j) * DN_ALPHA;
              v0[j] = (v0[j] - st[0]) * st[1] * gg + bb; v1[j] = (v1[j] - st[2]) * st[3] * gg + bb; } }
        constexpr int CK = 4;
        unsigned m0 = (unsigned)__ballot(so >= 0); unsigned m1 = (m0 >> 16) & 0xffffu; m0 &= 0xffffu;
        unsigned w0[CK][4], w1[CK][4]; float f0[CK], f1[CK];
#pragma unroll
        for (int k = 0; k < CK; ++k) {
            const int e0 = m0 ? __builtin_ctz(m0) : 0, e1 = m1 ? __builtin_ctz(m1) : 0;
            const int sl0 = __builtin_amdgcn_readlane(so, e0), sl1 = __builtin_amdgcn_readlane(so, 16 + e1);
            const size_t r0 = (size_t)(m0 ? sl0 : 0) * DM, r1 = (size_t)(m1 ? sl1 : 0) * DM;
            f0[k] = m0 ? (1.0f / YE_SCALE) : 0.f; f1[k] = m1 ? (1.0f / YE_SCALE) : 0.f;
#pragma unroll
            for (int j = 0; j < 4; ++j) { w0[k][j] = *(const unsigned*)(YE + r0 + 4 * lane + 256 * j); w1[k][j] = *(const unsigned*)(YE + r1 + 4 * lane + 256 * j); }
            m0 &= m0 - 1; m1 &= m1 - 1;
        }
#pragma unroll
        for (int k = 0; k < CK; ++k)
#pragma unroll
            for (int j = 0; j < 4; ++j) {
                { const f32x2v lo = __builtin_amdgcn_cvt_pk_f32_fp8((int)w0[k][j], false), hi = __builtin_amdgcn_cvt_pk_f32_fp8((int)w0[k][j], true);
                  v0[j][0] += lo[0] * f0[k]; v0[j][1] += lo[1] * f0[k]; v0[j][2] += hi[0] * f0[k]; v0[j][3] += hi[1] * f0[k]; }
                { const f32x2v lo = __builtin_amdgcn_cvt_pk_f32_fp8((int)w1[k][j], false), hi = __builtin_amdgcn_cvt_pk_f32_fp8((int)w1[k][j], true);
                  v1[j][0] += lo[0] * f1[k]; v1[j][1] += lo[1] * f1[k]; v1[j][2] += hi[0] * f1[k]; v1[j][3] += hi[1] * f1[k]; }
            }
        while (m0) { const int sl = __builtin_amdgcn_readlane(so, __builtin_ctz(m0)); m0 &= m0 - 1;
#pragma unroll
            for (int j = 0; j < 4; ++j) { const unsigned w = *(const unsigned*)(YE + (size_t)sl * DM + 4 * lane + 256 * j);
                const f32x2v lo = __builtin_amdgcn_cvt_pk_f32_fp8((int)w, false), hi = __builtin_amdgcn_cvt_pk_f32_fp8((int)w, true);
                v0[j][0] += lo[0] * (1.0f / YE_SCALE); v0[j][1] += lo[1] * (1.0f / YE_SCALE); v0[j][2] += hi[0] * (1.0f / YE_SCALE); v0[j][3] += hi[1] * (1.0f / YE_SCALE); } }
        while (m1) { const int sl = __builtin_amdgcn_readlane(so, 16 + __builtin_ctz(m1)); m1 &= m1 - 1;
#pragma unroll
            for (int j = 0; j < 4; ++j) { const unsigned w = *(const unsigned*)(YE + (size_t)sl * DM + 4 * lane + 256 * j);
                const f32x2v lo = __builtin_amdgcn_cvt_pk_f32_fp8((int)w, false), hi = __builtin_amdgcn_cvt_pk_f32_fp8((int)w, true);
                v1[j][0] += lo[0] * (1.0f / YE_SCALE); v1[j][1] += lo[1] * (1.0f / YE_SCALE); v1[j][2] += hi[0] * (1.0f / YE_SCALE); v1[j][3] += hi[1] * (1.0f / YE_SCALE); } }
        row_ln(v0, g, b, lane); row_ln(v1, g, b, lane);
        if (last_layer) {
#pragma unroll
            for (int j = 0; j < 4; ++j) { *(f32x4*)(Xo + (size_t)m * DM + 4 * lane + 256 * j) = v0[j]; *(f32x4*)(Xo + (size_t)(m + 1) * DM + 4 * lane + 256 * j) = v1[j]; }
        } else { store_row_bf(v0, XB + (size_t)m * DM, lane); store_row_bf(v1, XB + (size_t)(m + 1) * DM, lane); }
    }
}

template <bool NA>
__device__ __forceinline__ void attn_wave(const bf16* __restrict__ Qb, const bf16* __restrict__ Kb, const bf16* __restrict__ Vb, bf16* __restrict__ Ob, int ntiles,
                                          LAS unsigned char* wl, const LAS float* rpbh, int rr, int rs, int qh, int lane) {
    const int r = lane & 31, h = lane >> 5;
    bf16x8 qf[4];
#pragma unroll
    for (int d0 = 0; d0 < 4; ++d0) qf[d0] = *(const bf16x8*)(Qb + (size_t)r * DIN + 16 * d0 + 8 * h);
    f32x16 o0, o1;
#pragma unroll
    for (int i = 0; i < 16; ++i) { o0[i] = 0.f; o1[i] = 0.f; }
    float m = -1e30f, l = 0.f;
    LAS unsigned char* vl = wl; LAS float* wsf = (LAS float*)(wl + 4608);
    const bf16* vsrc = Vb + (size_t)(lane >> 3) * DIN + 8 * (lane & 7);
    const bf16* ksrc = Kb + (size_t)r * DIN + 8 * h;
    const int vwoff = (lane >> 3) * 144 + (lane & 7) * 16;
    const int i16 = lane & 15, tq = i16 >> 2, tp = i16 & 3, blk = (lane >> 4) & 1;
    const int troff = (4 * h + tq) * 144 + (16 * blk + 4 * tp) * 2;
    const int qc = 32 * qh + r; const int cs = qc - 8 < 0 ? 0 : (qc - 8 > 48 ? 48 : qc - 8);
    for (int t = 0; t < ntiles; ++t) {
        const size_t ko = (size_t)(32 * t) * DIN;
        bf16x8 kf[4];
#pragma unroll
        for (int d0 = 0; d0 < 4; ++d0) kf[d0] = *(const bf16x8*)(ksrc + ko + 16 * d0);
        u32x4 vr[4];
#pragma unroll
        for (int i = 0; i < 4; ++i) vr[i] = *(const u32x4*)(vsrc + ko + (size_t)(8 * i) * DIN);
        f32x16 s;
#pragma unroll
        for (int i = 0; i < 16; ++i) s[i] = 0.f;
#pragma unroll
        for (int d0 = 0; d0 < 4; ++d0) s = MFMA32(kf[d0], qf[d0], s);
        unsigned okm = 0xffffu;
        if (NA) {
            okm = 0u; const int kr = rs + (t >> 1), kh = t & 1, brow = (kr - rr + 7) * 31;
#pragma unroll
            for (int i = 0; i < 16; ++i) { const int kc = 32 * kh + crow(i, h); const bool ok = (kc >= cs) && (kc < cs + 16); const int idx = ok ? brow + kc - qc + 15 : 0;
                const float bia = rpbh[idx]; s[i] = ok ? s[i] + bia : -1e30f; okm |= ok ? (1u << i) : 0u; }
        }
        float mx = s[0];
#pragma unroll
        for (int i = 1; i < 16; ++i) mx = fmaxf(mx, s[i]);
        mx = max32(mx);
        const float mn = fmaxf(m, mx), alpha = __builtin_amdgcn_exp2f(m - mn); m = mn;
        float rsum = 0.f;
#pragma unroll
        for (int i = 0; i < 16; ++i) { float p = __builtin_amdgcn_exp2f(s[i] - mn); if (NA) p = ((okm >> i) & 1u) ? p : 0.f; s[i] = p; rsum += p; }
        l = l * alpha + rsum;
#pragma unroll
        for (int i = 0; i < 4; ++i) *(LAS u32x4*)(vl + vwoff + i * 8 * 144) = vr[i];
        if (h == 0) wsf[r] = alpha;
        asm volatile("s_waitcnt lgkmcnt(0)" ::: "memory");
#pragma unroll
        for (int g4 = 0; g4 < 4; ++g4) { const f32x4 a4 = *(const LAS f32x4*)(wsf + 8 * g4 + 4 * h);
#pragma unroll
            for (int j = 0; j < 4; ++j) { o0[4 * g4 + j] *= a4[j]; o1[4 * g4 + j] *= a4[j]; } }
        u32x4 pw0, pw1;
        pw0.x = pg8::cvt_pk_bf16(s[0], s[1]); pw0.y = pg8::cvt_pk_bf16(s[2], s[3]); pw0.z = pg8::cvt_pk_bf16(s[4], s[5]); pw0.w = pg8::cvt_pk_bf16(s[6], s[7]);
        pw1.x = pg8::cvt_pk_bf16(s[8], s[9]); pw1.y = pg8::cvt_pk_bf16(s[10], s[11]); pw1.z = pg8::cvt_pk_bf16(s[12], s[13]); pw1.w = pg8::cvt_pk_bf16(s[14], s[15]);
        const bf16x8 pa0 = __builtin_bit_cast(bf16x8, pw0), pa1 = __builtin_bit_cast(bf16x8, pw1);
#pragma unroll
        for (int sp = 0; sp < 2; ++sp) {
#pragma unroll
            for (int db = 0; db < 2; ++db) {
                const s16x4 lo = tr_read(vl + troff + (16 * sp) * 144 + 64 * db), hi = tr_read(vl + troff + (16 * sp + 8) * 144 + 64 * db);
                const bf16x8 bfr = __builtin_shufflevector(lo, hi, 0, 1, 2, 3, 4, 5, 6, 7);
                if (db == 0) o0 = MFMA32(sp ? pa1 : pa0, bfr, o0); else o1 = MFMA32(sp ? pa1 : pa0, bfr, o1);
            }
        }
        asm volatile("s_waitcnt lgkmcnt(0)" ::: "memory");
    }
    l = sum32(l);
    if (h == 0) wsf[32 + r] = l;
    asm volatile("s_waitcnt lgkmcnt(0)" ::: "memory");
#pragma unroll
    for (int i = 0; i < 16; ++i) { const int q = crow(i, h); const float rl = 1.0f / wsf[32 + q];
        Ob[(size_t)q * DM + r] = (bf16)f2bf(o0[i] * rl); Ob[(size_t)q * DM + 32 + r] = (bf16)f2bf(o1[i] * rl); }
    asm volatile("s_waitcnt lgkmcnt(0)" ::: "memory");
}

__device__ __forceinline__ void sgu_part(Frame& F, int l, const float* sg_b, unsigned char* ws) {
    const bf16* H = (const bf16*)(ws + WS_H); bf16* Y = (bf16*)(ws + WS_HID); const bf16* WSB = (const bf16*)(ws + WS_WSBF);
    const int lane = F.lane, r = lane & 31, h = lane >> 5;
    LAS unsigned char* vnl = F.lds;
    const int pt = F.wave >> 1, ct = F.wave & 1;
    const int i16 = lane & 15, tq = i16 >> 2, tp = i16 & 3, blk = (lane >> 4) & 1;
    u32x4 stg[2];
    { const int u = F.vcu; if (u < NBATCH * 32 * 4) { const int g = u & 3, ch = (u >> 2) & 31, b = u >> 7; const size_t tok0 = (size_t)b * SEQ + ch * 128;
#pragma unroll
        for (int i = 0; i < 2; ++i) { const int idx = F.tid + 512 * i, row = idx >> 3, chunk = idx & 7; stg[i] = *(const u32x4*)(H + (tok0 + row) * DIN + H_VC + 64 * g + 8 * chunk); } } }
    for (int u = F.vcu; u < NBATCH * 32 * 4; u += F.G) {
        const int g = u & 3, ch = (u >> 2) & 31, b = u >> 7; const size_t tok0 = (size_t)b * SEQ + ch * 128;
#pragma unroll
        for (int i = 0; i < 2; ++i) { const int idx = F.tid + 512 * i, row = idx >> 3, chunk = idx & 7; *(LAS u32x4*)(vnl + row * 144 + chunk * 16) = stg[i]; }
        __syncthreads();
        { const int un = u + F.G; if (un < NBATCH * 32 * 4) { const int gn = un & 3, chn = (un >> 2) & 31, bn = un >> 7; const size_t tokn = (size_t)bn * SEQ + chn * 128;
#pragma unroll
            for (int i = 0; i < 2; ++i) { const int idx = F.tid + 512 * i, row = idx >> 3, chunk = idx & 7; stg[i] = *(const u32x4*)(H + (tokn + row) * DIN + H_VC + 64 * gn + 8 * chunk); } } }
        unsigned short uu[16];
#pragma unroll
        for (int i = 0; i < 16; ++i) uu[i] = H[(tok0 + 32 * pt + crow(i, h)) * DIN + H_UC + 64 * g + 32 * ct + r];
        f32x16 z;
#pragma unroll
        for (int i = 0; i < 16; ++i) z[i] = 0.f;
#pragma unroll
        for (int s = 0; s < 8; ++s) {
            const bf16x8 a = *(const bf16x8*)(WSB + ((size_t)(g * 128 + 32 * pt + r) * 128 + 16 * s + 8 * h));
            const s16x4 lo = tr_read(vnl + (16 * s + 8 * h + tq) * 144 + (32 * ct + 16 * blk + 4 * tp) * 2), hi = tr_read(vnl + (16 * s + 8 * h + 4 + tq) * 144 + (32 * ct + 16 * blk + 4 * tp) * 2);
            z = MFMA32(a, __builtin_shufflevector(lo, hi, 0, 1, 2, 3, 4, 5, 6, 7), z);
        }
        const float* bs = sg_b + ((size_t)l * 4 + g) * 128;
#pragma unroll
        for (int i = 0; i < 16; ++i) { const int pp = 32 * pt + crow(i, h); const size_t tok = tok0 + pp; const int c = 32 * ct + r;
            Y[tok * DM + Y_SG + 64 * g + c] = (bf16)f2bf(bf2f(uu[i]) * (z[i] + bs[pp])); }
        __syncthreads();
    }
}
__device__ __forceinline__ void gqa_part(int vcu, int G, char* lds, unsigned char* ws, const float* qn, const float* kn) {
    const bf16* H = (const bf16*)(ws + WS_H); bf16* Y = (bf16*)(ws + WS_HID);
    float gq = 0.f, gk = 0.f;
    for (int i = 0; i < 64; ++i) { gq = fmaxf(gq, fabsf(qn[i])); gk = fmaxf(gk, fabsf(kn[i])); }
    const bool nomax = (64.0f * C2 * gq * gk) * 1.02f <= 40.0f;
    if (nomax) {
        for (int id = vcu; id < NBATCH * 8 * 16; id += G) {
            const int qb = id & 15, hg = (id >> 4) & 3, kvh = (id >> 6) & 1, b = id >> 7, hq = kvh * 4 + hg;
            const size_t t0 = (size_t)b * SEQ;
            attn_body::attn_unit<8, true, GQA_MSUM>((const attn_body::bf16*)(H + (t0 + 256 * qb) * DIN + H_GQ + 64 * hq), (const attn_body::bf16*)(H + t0 * DIN + H_GK + 64 * kvh),
                                          (const attn_body::bf16*)(H + t0 * DIN + H_GV + 64 * kvh), (attn_body::bf16*)(Y + (t0 + 256 * qb) * DM + Y_GQA + 64 * hq), lds);
        }
    } else {
        for (int id = vcu; id < NBATCH * 8 * 16; id += G) {
            const int qb = id & 15, hg = (id >> 4) & 3, kvh = (id >> 6) & 1, b = id >> 7, hq = kvh * 4 + hg;
            const size_t t0 = (size_t)b * SEQ;
            attn_body::attn_unit<8, false>((const attn_body::bf16*)(H + (t0 + 256 * qb) * DIN + H_GQ + 64 * hq), (const attn_body::bf16*)(H + t0 * DIN + H_GK + 64 * kvh),
                                           (const attn_body::bf16*)(H + t0 * DIN + H_GV + 64 * kvh), (attn_body::bf16*)(Y + (t0 + 256 * qb) * DM + Y_GQA + 64 * hq), lds);
        }
    }
    __syncthreads();
}
typedef float f32x4_t __attribute__((ext_vector_type(4)));
#define MFMA16(a, b, c) __builtin_amdgcn_mfma_f32_16x16x32_bf16((a), (b), (c), 0, 0, 0)
constexpr int NA_VP = 144;
__device__ __forceinline__ void na_wave(const bf16* __restrict__ H, const LAS unsigned char* vl, bf16* __restrict__ Y, const LAS float* rpbh, int b, int hd, int rr, int rs, int qb4, int lane) {
    const int n16 = lane & 15, g = lane >> 4;
    const int c0 = 16 * qb4, w0 = (16 * qb4 - 8 < 0) ? 0 : (16 * qb4 - 8 > 32 ? 32 : 16 * qb4 - 8);
    const size_t t0 = (size_t)b * SEQ, qtok = t0 + rr * 64 + c0 + n16;
    bf16x8 qf[2];
#pragma unroll
    for (int ks = 0; ks < 2; ++ks) qf[ks] = *(const bf16x8*)(H + qtok * DIN + H_NAQ + 64 * hd + 32 * ks + 8 * g);
    f32x4_t s[16];
    const bf16* kb = H + (t0 + rs * 64 + w0 + 8 * (n16 >> 2) + (n16 & 3)) * DIN + H_NAK + 64 * hd + 8 * g;
    {
        bf16x8 kf[16][2];
#pragma unroll
        for (int T = 0; T < 16; ++T) { const bf16* kp = kb + (size_t)((T >> 1) * 64 + 4 * (T & 1)) * DIN; kf[T][0] = *(const bf16x8*)kp; kf[T][1] = *(const bf16x8*)(kp + 32); }
        asm volatile("" ::: "memory");
#pragma unroll
        for (int T = 0; T < 16; ++T) { f32x4_t z = {0.f, 0.f, 0.f, 0.f}; z = MFMA16(kf[T][0], qf[0], z); s[T] = MFMA16(kf[T][1], qf[1], z); }
    }
    const int qc = c0 + n16, cs = qc - 8 < 0 ? 0 : (qc - 8 > 48 ? 48 : qc - 8);
    const LAS float* tb[8];
#pragma unroll
    for (int j = 0; j < 8; ++j) { const int kc = w0 + 8 * g + 4 * (j >> 2) + (j & 3); const bool ok = (unsigned)(kc - cs) < 16u; tb[j] = rpbh + (rs - rr + 7) * 32 + (ok ? kc - qc + 15 : 31); }
    float mx = -1e30f;
#pragma unroll
    for (int T = 0; T < 16; ++T)
#pragma unroll
        for (int i = 0; i < 4; ++i) { const float v = s[T][i] + tb[(T & 1) * 4 + i][(T >> 1) * 32]; s[T][i] = v; mx = fmaxf(mx, v); }
    mx = fmaxf(mx, shx<16>(mx)); mx = max32(mx);
    float sum = 0.f;
#pragma unroll
    for (int T = 0; T < 16; ++T)
#pragma unroll
        for (int i = 0; i < 4; ++i) { const float p = __builtin_amdgcn_exp2f(s[T][i] - mx); s[T][i] = p; sum += p; }
    sum += shx<16>(sum); sum = sum32(sum);
    f32x4_t o[4];
#pragma unroll
    for (int db = 0; db < 4; ++db) o[db] = (f32x4_t){0.f, 0.f, 0.f, 0.f};
    const LAS unsigned char* vb = vl + (w0 + 8 * g + (n16 >> 2)) * NA_VP + (n16 & 3) * 8;
#pragma unroll
    for (int kr = 0; kr < 8; ++kr) {
        u32x4 pw; pw.x = pg8::cvt_pk_bf16(s[2 * kr][0], s[2 * kr][1]); pw.y = pg8::cvt_pk_bf16(s[2 * kr][2], s[2 * kr][3]);
        pw.z = pg8::cvt_pk_bf16(s[2 * kr + 1][0], s[2 * kr + 1][1]); pw.w = pg8::cvt_pk_bf16(s[2 * kr + 1][2], s[2 * kr + 1][3]);
        const bf16x8 pb = __builtin_bit_cast(bf16x8, pw);
#pragma unroll
        for (int db = 0; db < 4; ++db) { const LAS unsigned char* vp = vb + (kr * 64) * NA_VP + db * 32;
            const s16x4 lo = tr_read(vp), hi = tr_read(vp + 4 * NA_VP);
            o[db] = MFMA16(__builtin_shufflevector(lo, hi, 0, 1, 2, 3, 4, 5, 6, 7), pb, o[db]); }
    }
    const float rl = 1.0f / sum;
    bf16* yp = Y + qtok * DM + Y_NA + 64 * hd + 4 * g;
#pragma unroll
    for (int db = 0; db < 4; ++db) { u32x2 w; w.x = pg8::cvt_pk_bf16(o[db][0] * rl, o[db][1] * rl); w.y = pg8::cvt_pk_bf16(o[db][2] * rl, o[db][3] * rl); *(u32x2*)(yp + 16 * db) = w; }
}
__device__ __forceinline__ void na_part(Frame& F, int l, const float* na_rpb, unsigned char* ws) {
    const bf16* H = (const bf16*)(ws + WS_H); bf16* Y = (bf16*)(ws + WS_HID);
    LAS float* rpbl = (LAS float*)(F.lds + 90112);
    for (int i = F.tid; i < 4 * 15 * 32; i += 512) { const int c = i & 31, hr = i >> 5; rpbl[i] = (c < 31) ? na_rpb[(size_t)l * 4 * 15 * 31 + hr * 31 + c] * LOG2E : -1e30f; }
    LAS unsigned char* vl = F.lds;
    u32x4 stg[9];
#define NA_VSRC(id_) (H + ((size_t)((id_) >> 7) * SEQ + (2 * ((id_) & 31) - 4 < 0 ? 0 : (2 * ((id_) & 31) - 4 > 56 ? 56 : 2 * ((id_) & 31) - 4)) * 64) * DIN + H_NAV + 64 * (((id_) >> 5) & 3))
    if (F.vcu < NBATCH * 4 * 32) { const bf16* vsrc = NA_VSRC(F.vcu);
#pragma unroll
        for (int i = 0; i < 9; ++i) { const int idx = F.tid + 512 * i, tok = idx >> 3, ch = idx & 7; stg[i] = *(const u32x4*)(vsrc + (size_t)tok * DIN + ch * 8); } }
    for (int id = F.vcu; id < NBATCH * 4 * 32; id += F.G) {
        const int rp = id & 31, hd = (id >> 5) & 3, b = id >> 7, rr0 = 2 * rp;
        const int sb = rr0 - 4 < 0 ? 0 : (rr0 - 4 > 56 ? 56 : rr0 - 4);
        __syncthreads();
#pragma unroll
        for (int i = 0; i < 9; ++i) { const int idx = F.tid + 512 * i, tok = idx >> 3, ch = idx & 7; *(LAS u32x4*)(vl + tok * NA_VP + ch * 16) = stg[i]; }
        __syncthreads();
        { const int idn = id + F.G; if (idn < NBATCH * 4 * 32) { const bf16* vsrc = NA_VSRC(idn);
#pragma unroll
            for (int i = 0; i < 9; ++i) { const int idx = F.tid + 512 * i, tok = idx >> 3, ch = idx & 7; stg[i] = *(const u32x4*)(vsrc + (size_t)tok * DIN + ch * 8); } } }
        const int rr = rr0 + (F.wave >> 2); const int rs = rr - 4 < 0 ? 0 : (rr - 4 > 56 ? 56 : rr - 4);
        na_wave(H, vl + (rs - sb) * 64 * NA_VP, Y, rpbl + hd * 480, b, hd, rr, rs, F.wave & 3, F.lane);
    }
#undef NA_VSRC
    __syncthreads();
}

__device__ __forceinline__ void frame_init(Frame& F, LAS unsigned char* lds) {
    int t = threadIdx.x; asm volatile("" : "+v"(t));
    F.lds = lds; F.tid = t; F.lane = t & 63; F.wave = __builtin_amdgcn_readfirstlane(t >> 6);
    int G_ = gridDim.x; asm volatile("" : "+s"(G_));
    F.G = G_; { const int bx = blockIdx.x; F.vcu = (F.G % 8 == 0) ? (bx % 8) * (F.G / 8) + bx / 8 : bx; }
    F.gw = F.vcu * NWAVES + F.wave; F.NGW = F.G * NWAVES;
}
#ifndef MK_FUSED
#define MK_FUSED 1
#endif
struct Args { const float* in[21]; float* out; unsigned char* ws; int l_lo, l_hi, ph_lo, ph_hi, use_bar, pad; };
constexpr int NPH = 10;

__global__ void __launch_bounds__(NWAVES * 64, 2) enc_fwd(Args a) {
    extern __shared__ __attribute__((aligned(16))) unsigned char lds[];
    Frame F0; frame_init(F0, (LAS unsigned char*)lds);
#define FRAME() Frame F; frame_init(F, (LAS unsigned char*)lds)
    volatile LAS unsigned* MISC = (volatile LAS unsigned*)(F0.lds + MISC_OFF);
    for (int u = F0.tid; u < (LDS_BYTES - LDSCTL_OFF) / 4; u += NWAVES * 64) ((LAS unsigned*)(F0.lds + LDSCTL_OFF))[u] = 0u;
    __syncthreads();
    unsigned* ctl = (unsigned*)(a.ws + WS_CTL);
    XcdBarrier bar; bar.bar = ctl + CW_BAR; bar.x = 0; bar.st = nullptr;
    if (a.use_bar) bar = xcd_barrier_post(ctl + CW_BAR, MISC + 8);
#if MK_FUSED
#define SEAM() xcd_barrier(bar)
#else
#define SEAM() do { if (a.use_bar) xcd_barrier(bar); } while (0)
#endif
    typedef const __attribute__((address_space(4))) Args* KArgP;
#define KA() ({ KArgP p_ = (KArgP)__builtin_amdgcn_kernarg_segment_ptr(); asm volatile("" : "+s"(p_)); p_; })
#if !MK_FUSED
    const int lo = a.ph_lo, hi = a.ph_hi;
#endif
#ifndef ONLY_PH
#define ONLY_PH -1
#endif
#if MK_FUSED
#define IN(k) (ONLY_PH < 0 || ONLY_PH == (k))
#else
#define IN(k) ((ONLY_PH < 0 || ONLY_PH == (k)) && lo <= (k) && (k) < hi)
#endif
#ifndef REP0
#define REP0 1
#endif
#ifndef REP2
#define REP2 1
#endif
#ifndef REP4
#define REP4 1
#endif
#ifndef REP9
#define REP9 1
#endif
#ifndef REP1
#define REP1 1
#endif
#ifndef REP2A
#define REP2A 1
#endif
#ifndef REP2B
#define REP2B 1
#endif
#ifndef REP2C
#define REP2C 1
#endif
#ifndef NA_VAR
#define NA_VAR 1
#endif
#ifndef REP3
#define REP3 1
#endif
#ifndef REPP
#define REPP 1
#endif
#ifndef REP5
#define REP5 1
#endif
#ifndef REP6
#define REP6 1
#endif
#ifndef REP7
#define REP7 1
#endif
#ifndef REP8
#define REP8 1
#endif
#define REPEAT(n) _Pragma("nounroll") for (int rep_ = 0; rep_ < (n); ++rep_)
#if MK_FUSED
    for (int l = 0; l < NLAYER; ++l) {
#else
    for (int l = a.l_lo; l < a.l_hi; ++l) {
#endif
        if (IN(0) && (l == 0 || REP0 > 1)) {
            REPEAT(l == 0 ? REP0 : REP0 - 1) { FRAME(); KArgP k = KA(); conv_phase(F, l, k->in[4], k->in[12], k->in[16], k->in[17], k->in[18], k->in[8], k->ws); }
            if (l == 0) REPEAT(REPP) { FRAME(); KArgP k = KA(); prologue_phase(F, k->in[0], k->in[1], k->in[2], k->in[3], k->out, k->ws); }
            SEAM();
        }
        if (IN(1)) REPEAT(REP1) {
            FRAME(); KArgP k = KA(); unsigned char* ws = k->ws;
            pg8::Gemm g{(const bf16*)(ws + WS_XB), (const bf16*)(ws + WS_WIN), TT, DIN, DM, 0};
            pg8::RotOrder S; S.init(TT, DIN, F.G, (int)blockIdx.x);
            EpiIn E{(bf16*)(ws + WS_H), k->in[6] + l * 64, k->in[7] + l * 64, k->in[10] + l * 256, k->in[11] + l * 256, (const float*)(ws + WS_ROPE), (bf16*)(ws + WS_VT)};
            pg8::gemm_phase<EpiIn, pg8::RotOrder, true, true, false, false, false, true>(F.lds, g, S, E);
            SEAM();
        }
        if (IN(2)) REPEAT(REP2) {
            REPEAT(REP2A) { FRAME(); KArgP k = KA(); sgu_part(F, l, k->in[9], k->ws); }
            REPEAT(REP2B) { FRAME(); KArgP k = KA(); gqa_part(F.vcu, F.G, (char*)lds, k->ws, k->in[6] + l * 64, k->in[7] + l * 64); }
            REPEAT(REP2C) { FRAME(); KArgP k = KA(); na_part(F, l, k->in[5], k->ws); }
            SEAM();
        }
        if (IN(3)) {
            REPEAT(REP3 - 1) {
                FRAME(); KArgP k = KA(); unsigned char* ws = k->ws;
                pg8::Gemm g{(const bf16*)(ws + WS_HID), (const bf16*)(ws + WS_WOUT), TT, DM, DM, 0};
                pg8::StaticOrder S; S.init(TT, DM, F.G, (int)blockIdx.x);
                EpiRes E{(const bf16*)(ws + WS_XB), (float*)(ws + WS_DUMMY)};
                pg8::gemm_phase<EpiRes, pg8::StaticOrder, true, true, false, false, false, true>(F.lds, g, S, E);
                SEAM();
            }
            FRAME(); KArgP k = KA(); unsigned char* ws = k->ws;
            pg8::Gemm g{(const bf16*)(ws + WS_HID), (const bf16*)(ws + WS_WOUT), TT, DM, DM, 0};
            pg8::StaticOrder S; S.init(TT, DM, F.G, (int)blockIdx.x);
            EpiRes E{(const bf16*)(ws + WS_XB), k->out};
            pg8::gemm_phase<EpiRes, pg8::StaticOrder, true, true, false, false, false, true>(F.lds, g, S, E);
            SEAM();
        }
        if (IN(4)) { REPEAT(REP4 - 1) { FRAME(); KArgP k = KA(); ln1_router_phase<true>(F, k->out, k->in[13] + l * DM, k->in[14] + l * DM, k->in[15] + (size_t)l * DM * NEXP, k->ws); SEAM(); }
            FRAME(); KArgP k = KA(); ln1_router_phase<false>(F, k->out, k->in[13] + l * DM, k->in[14] + l * DM, k->in[15] + (size_t)l * DM * NEXP, k->ws); SEAM(); }
        if (IN(5)) REPEAT(REP5) { FRAME(); KArgP k = KA(); topk_phase(F, k->ws); SEAM(); }
        if (IN(7)) REPEAT(REP7) {
            FRAME(); KArgP k = KA(); unsigned char* ws = k->ws;
            pg8::Gemm g{(const bf16*)(ws + WS_XB8), (const bf16*)(ws + WS_WGU), ROWS_E, 4096, DM / 2, (size_t)4096 * DM, (const int*)(ws + WS_IDX)};
            pg8::StaticOrder S; S.init(ROWS_E, 4096, F.G, (int)blockIdx.x);
            EpiSwiglu E{ws + WS_HID};
            pg8::gemm_phase<EpiSwiglu, pg8::StaticOrder, true, true, true, true, true, true>(F.lds, g, S, E);
            SEAM();
        }
        if (IN(8)) REPEAT(REP8) {
            FRAME(); KArgP k = KA(); unsigned char* ws = k->ws;
            pg8::Gemm g{(const bf16*)(ws + WS_HID), (const bf16*)(ws + WS_WD), ROWS_E, DM, DEXP / 2, (size_t)DM * DEXP};
            pg8::StaticOrder S; S.init(ROWS_E, DM, F.G, (int)blockIdx.x);
            EpiDown E{ws + WS_H, (const float*)(ws + WS_GATE)};
            pg8::gemm_phase<EpiDown, pg8::StaticOrder, true, true, true, true, false, true>(F.lds, g, S, E);
            SEAM();
        }
#if BAL_PROBE_N
        if (IN(8)) REPEAT(BAL_PROBE_N) {
            FRAME(); KArgP k = KA(); unsigned char* ws = k->ws;
            pg8::Gemm g{(const bf16*)(ws + WS_HID), (const bf16*)(ws + WS_WD), ROWS_E, DM, DEXP / 2, (size_t)DM * DEXP};
            pg8::StaticOrder S; S.init(ROWS_E, DM, F.G, (int)blockIdx.x);
            EpiDown E{ws + WS_DUMMY, (const float*)(ws + WS_GATE)};
            pg8::gemm_phase<EpiDown, pg8::StaticOrder, true, true, true, true, false, (BAL_PROBE != 0)>(F.lds, g, S, E);
            SEAM();
        }
#endif
        if (IN(9)) { REPEAT(REP9 - 1) { FRAME(); KArgP k = KA(); combine_phase<true>(F, k->out, k->in[13] + l * DM, k->in[14] + l * DM, k->in[19] + l * DM, k->in[20] + l * DM, k->ws, l + 1 == NLAYER); SEAM(); }
            FRAME(); KArgP k = KA(); combine_phase<false>(F, k->out, k->in[13] + l * DM, k->in[14] + l * DM, k->in[19] + l * DM, k->in[20] + l * DM, k->ws, l + 1 == NLAYER);
            if (l + 1 < NLAYER) { FRAME(); KArgP k = KA(); conv_phase(F, l + 1, k->in[4], k->in[12], k->in[16], k->in[17], k->in[18], k->in[8], k->ws); }
            SEAM(); }
    }
#undef IN
#undef SEAM
}

extern "C" void kernel_launch(void* const* d_in, const int* in_sizes, int n_in, void* d_out, int out_size, void* d_ws, size_t ws_size, hipStream_t stream) {
    static int grid = 0;
    if (grid == 0) {
        if (n_in != 21 || out_size != TT * DM || ws_size < WS_END) { fprintf(stderr, "kernel_launch: unexpected shapes (n_in %d, out %d, ws %zu)\n", n_in, out_size, ws_size); grid = -1; return; }
        int dev = 0, cus = 0, per_cu = 0;
        if (hipGetDevice(&dev) != hipSuccess || hipDeviceGetAttribute(&cus, hipDeviceAttributeMultiprocessorCount, dev) != hipSuccess) { grid = -1; return; }
        if (hipFuncSetAttribute((const void*)enc_fwd, hipFuncAttributeMaxDynamicSharedMemorySize, LDS_BYTES) != hipSuccess) { fprintf(stderr, "kernel_launch: hipFuncSetAttribute failed\n"); grid = -1; return; }
        if (hipOccupancyMaxActiveBlocksPerMultiprocessor(&per_cu, (const void*)enc_fwd, NWAVES * 64, LDS_BYTES) != hipSuccess || per_cu < 1) fprintf(stderr, "kernel_launch: occupancy query reports %d\n", per_cu);
        (void)hipGetLastError();
        grid = cus;
    }
    if (grid < 0) return;
    if (hipMemsetAsync((char*)d_ws + WS_CTL, 0, CTL_ZERO_BYTES, stream) != hipSuccess) return;
    Args a{};
    for (int i = 0; i < 21; ++i) a.in[i] = (const float*)d_in[i];
    a.out = (float*)d_out; a.ws = (unsigned char*)d_ws; a.pad = 0;
#if MK_FUSED
    a.l_lo = 0; a.l_hi = NLAYER; a.ph_lo = 0; a.ph_hi = NPH; a.use_bar = 1;
    hipLaunchKernelGGL(enc_fwd, dim3(grid), dim3(NWAVES * 64), LDS_BYTES, stream, a);
#else
    a.use_bar = 0;
    for (int l = 0; l < NLAYER; ++l)
        for (int ph = 0; ph < NPH; ++ph) { a.l_lo = l; a.l_hi = l + 1; a.ph_lo = ph; a.ph_hi = ph + 1; hipLaunchKernelGGL(enc_fwd, dim3(grid), dim3(NWAVES * 64), LDS_BYTES, stream, a); }
#endif
}
```

```cpp
#include <hip/hip_runtime.h>
#include <hip/hip_bf16.h>
#include <cstdio>
#include <cstdint>
#ifndef BAL_PROBE
#define BAL_PROBE 0
#endif
#ifndef BAL_PROBE_N
#define BAL_PROBE_N 0
#endif
#ifndef LN1_ROWS
#define LN1_ROWS 4
#endif
#ifndef GQA_MSUM
#define GQA_MSUM false
#endif
namespace pg8 {
#define PG8_LAS __attribute__((address_space(3)))
typedef unsigned short bf16_t;
typedef short bf16x8 __attribute__((ext_vector_type(8)));
typedef float f32x4 __attribute__((ext_vector_type(4)));
typedef unsigned u32x4 __attribute__((ext_vector_type(4)));
typedef int v4i_t __attribute__((ext_vector_type(4)));
typedef int v8i_t __attribute__((ext_vector_type(8)));
constexpr int BM = 256, BK = 64, HALF = 128, HTB = HALF * BK * 2  , STAGE_BYTES = 8 * HTB, NXCD = 8, WGM = 8;

__host__ __device__ __forceinline__ int lds_byte(int r, int c) { const int st = (r >> 4) * 2 + (c >> 5), rr = r & 15, cc = c & 31, ob = rr * 64 + cc * 2; return st * 1024 + (ob ^ (((ob >> 9) & 1) << 5)); }
__host__ __device__ __forceinline__ void stage_rc(int b, int& R, int& C) { const int st = b / 1024, sb = b % 1024, swz = sb ^ (((sb >> 9) & 1) << 5); R = (st >> 1) * 16 + swz / 64; C = (st & 1) * 32 + (swz % 64) / 2; }
__host__ __device__ __forceinline__ int perm32(int rho) { const int n = rho >> 4, i = rho & 15; return 8 * (i >> 2) + 4 * n + (i & 3); }

struct Unit { int pm, pn; };
struct Gemm { const bf16_t* A; const bf16_t* Bt; int M, N, K; size_t estride; const int* idx; };
__host__ __device__ __forceinline__ int expert_of_tile(int pm) { return pm < 128 ? (pm >> 3) : ((pm - 128) >> 5); }

struct StaticOrder {
    int nM, nN, nwg, G, c;
    __host__ __device__ void init(int M, int N, int G_, int c_) { nM = M / BM; nN = N / BM; nwg = nM * nN; G = G_; c = c_; }
    __host__ __device__ bool next(int i, Unit& u) const {
        const long L = (long)i * G + c; if (L >= nwg) return false;
        int wgid = (int)L; { const int q = nwg / NXCD, r = nwg % NXCD, xcd = wgid % NXCD, off = wgid / NXCD; wgid = (xcd < r ? xcd * (q + 1) : r * (q + 1) + (xcd - r) * q) + off; }
        const int nig = WGM * nN, gid = wgid / nig, fm = gid * WGM, gsz = (nM - fm) < WGM ? (nM - fm) : WGM;
        u.pm = fm + ((wgid % nig) % gsz); u.pn = (wgid % nig) / gsz; return true;
    }
    __device__ __forceinline__ void a_ready(const Unit&) const {}
    __device__ __forceinline__ void done(const Unit&) const {}
};

struct RotOrder {
    StaticOrder S;
    __host__ __device__ void init(int M, int N, int G_, int c_) { S.init(M, N, G_, c_); }
    __host__ __device__ bool next(int i, Unit& u) const {
        if (S.G != 256) return S.next(i, u);
        StaticOrder T = S; T.c = (S.c & 63) + 64 * (((S.c >> 6) + (i >> 1)) & 3);
        return T.next(i, u);
    }
    __device__ __forceinline__ void a_ready(const Unit&) const {}
    __device__ __forceinline__ void done(const Unit&) const {}
};

__device__ __forceinline__ unsigned cvt_pk_bf16(float lo, float hi) { unsigned r; asm volatile("v_cvt_pk_bf16_f32 %0, %1, %2" : "=v"(r) : "v"(lo), "v"(hi)); return r; }
typedef float f32x2 __attribute__((ext_vector_type(2)));

__device__ __forceinline__ void mfma_fp8(f32x4& acc, const v8i_t& a, const v8i_t& b, int sc) {
    asm volatile("v_mfma_scale_f32_16x16x128_f8f6f4 %0, %1, %2, %0, %3, %3 op_sel_hi:[0,0,0]" : "+v"(acc) : "v"(a), "v"(b), "v"(sc));
}
template <class Epi, class Sched, bool ALIGN_EPI = false, bool SP2 = false, bool GROUPED = false, bool FP8 = false, bool GATHER = false, bool BAL = false>
__device__ __forceinline__ void gemm_phase(PG8_LAS unsigned char* lds, const Gemm g, const Sched& S, const Epi& E) {
    int tid_ = threadIdx.x; asm volatile("" : "+v"(tid_));
    const int tid = tid_, wid = __builtin_amdgcn_readfirstlane(tid >> 6), lane = tid & 63, wr = wid >> 2, wc = wid & 3, fr = lane & 15, fq = lane >> 4;
    const int K = g.K, nt = K / BK;
    unsigned voffA[2], voffB[2];
#pragma unroll
    for (int i = 0; i < 2; ++i) { int R, C; stage_rc(tid * 16 + i * 8192, R, C); const int Rb = Epi::PERM ? ((R & ~31) + perm32(R & 31)) : R;
        voffA[i] = (unsigned)(R * K + C) * 2u; voffB[i] = (unsigned)(Rb * K + C) * 2u; }
    const size_t kstep = (size_t)(BK * 2);
    const size_t hstep = (size_t)HALF * K * 2;
    const size_t tstep = 2 * hstep;
    const unsigned ldsw = (unsigned)wid * 1024u;
    const int aoff = lds_byte(wr * 64 + fr, fq * 8), boff = lds_byte(wc * 32 + fr, fq * 8);
#define PG8_SA(b, h) (((b) * 2 + (h)) * HTB)
#define PG8_SB(b, h) ((4 + (b) * 2 + (h)) * HTB)
#define PG8_STAGE(bufoff, gbase, voff) do { _Pragma("unroll") for (int _i = 0; _i < 2; ++_i) \
        __builtin_amdgcn_global_load_lds((const unsigned*)((const char*)(gbase) + (voff)[_i]), (PG8_LAS unsigned*)(lds + (bufoff) + ldsw + _i * 8192), 16, 0, 0); } while (0)
    static_assert(!GATHER || SP2, "GATHER is wired into the SP2 loop only");
    unsigned vC[2][2], vN[2][2]; unsigned cC[2];
    PG8_LAS unsigned char* gtab = lds + 131072 + 1024 + wid * 512;
    if constexpr (GATHER) {
#pragma unroll
        for (int i = 0; i < 2; ++i) { int R, C; stage_rc(tid * 16 + i * 8192, R, C); cC[i] = (unsigned)C * 2u; }
    }
    const int grow = ((lane >> 5) & 1) * 128 + ((lane >> 4) & 1) * 64 + (wid >> 1) * 16 + (lane & 15);
#define PG8_GDMA(unit, buf) __builtin_amdgcn_global_load_lds((const unsigned*)(g.idx + (size_t)(unit).pm * BM + grow), (PG8_LAS unsigned*)(gtab + (buf) * 256), 4, 0, 0)
#define PG8_GREAD(dst, buf) do { unsigned r00_, r01_, r10_, r11_; const unsigned ga_ = (unsigned)(size_t)gtab + (unsigned)(buf) * 256u + (unsigned)(lane >> 2) * 4u; \
        asm volatile("ds_read_b32 %0, %4\n\tds_read_b32 %1, %4 offset:64\n\tds_read_b32 %2, %4 offset:128\n\tds_read_b32 %3, %4 offset:192\n\ts_waitcnt lgkmcnt(0)" \
                     : "=&v"(r00_), "=&v"(r01_), "=&v"(r10_), "=&v"(r11_) : "v"(ga_) : "memory"); \
        dst[0][0] = r00_ * (unsigned)(K * 2) + cC[0]; dst[0][1] = r01_ * (unsigned)(K * 2) + cC[1]; dst[1][0] = r10_ * (unsigned)(K * 2) + cC[0]; dst[1][1] = r11_ * (unsigned)(K * 2) + cC[1]; } while (0)
#define PG8_GSTAGE(bufoff, kb, h, nx) do { _Pragma("unroll") for (int _i = 0; _i < 2; ++_i) \
        __builtin_amdgcn_global_load_lds((const unsigned*)((const char*)g.A + (kb) + ((nx) ? vN[h][_i] : vC[h][_i])), (PG8_LAS unsigned*)(lds + (bufoff) + ldsw + _i * 8192), 16, 0, 0); } while (0)
#define PG8_STA(bufoff, ptr, kb, h, nx) do { if constexpr (GATHER) { PG8_GSTAGE(bufoff, kb, h, nx); } else { PG8_STAGE(bufoff, ptr, voffA); } } while (0)
#define PG8_LDA(dst, b, h) do { if constexpr (FP8) { _Pragma("unroll") for (int m = 0; m < 4; ++m) dst##8[m] = PG8_CAT(*(const PG8_LAS bf16x8*)(lds + PG8_SA(b, h) + aoff + m * 2048), *(const PG8_LAS bf16x8*)(lds + PG8_SA(b, h) + aoff + m * 2048 + 1024)); } \
        else { _Pragma("unroll") for (int m = 0; m < 4; ++m) _Pragma("unroll") for (int k = 0; k < 2; ++k) dst[m][k] = *(const PG8_LAS bf16x8*)(lds + PG8_SA(b, h) + aoff + m * 2048 + k * 1024); } } while (0)
#define PG8_LDB(dst, b, h) do { if constexpr (FP8) { _Pragma("unroll") for (int n = 0; n < 2; ++n) dst##8[n] = PG8_CAT(*(const PG8_LAS bf16x8*)(lds + PG8_SB(b, h) + boff + n * 2048), *(const PG8_LAS bf16x8*)(lds + PG8_SB(b, h) + boff + n * 2048 + 1024)); } \
        else { _Pragma("unroll") for (int n = 0; n < 2; ++n) _Pragma("unroll") for (int k = 0; k < 2; ++k) dst[n][k] = *(const PG8_LAS bf16x8*)(lds + PG8_SB(b, h) + boff + n * 2048 + k * 1024); } } while (0)
#define PG8_MMA(ai, bj, At, Bt) do { __builtin_amdgcn_s_setprio(1); if constexpr (FP8) { _Pragma("unroll") for (int m = 0; m < 4; ++m) _Pragma("unroll") for (int n = 0; n < 2; ++n) \
        mfma_fp8(acc[ai][bj][m][n], Bt##8[n], At##8[m], sc8); } \
        else { _Pragma("unroll") for (int m = 0; m < 4; ++m) _Pragma("unroll") for (int n = 0; n < 2; ++n) _Pragma("unroll") for (int k = 0; k < 2; ++k) \
        acc[ai][bj][m][n] = __builtin_amdgcn_mfma_f32_16x16x32_bf16(Bt[n][k], At[m][k], acc[ai][bj][m][n], 0, 0, 0); } __builtin_amdgcn_s_setprio(0); } while (0)
#define PG8_CAT(x, y) __builtin_shufflevector(__builtin_bit_cast(v4i_t, (x)), __builtin_bit_cast(v4i_t, (y)), 0, 1, 2, 3, 4, 5, 6, 7)
#define PG8_WAIT_V(n) asm volatile("s_waitcnt vmcnt(" #n ")" ::: "memory")
#define PG8_WAIT_L(n) asm volatile("s_waitcnt lgkmcnt(" #n ")" ::: "memory")
#define PG8_BAR __builtin_amdgcn_s_barrier()
#define PG8_SCHED __builtin_amdgcn_sched_barrier(0)
    Unit cur, nxt; int ui = 0;
    if (!S.next(0, cur)) return;
    f32x4 acc[2][2][4][2];
#pragma unroll
    for (int a = 0; a < 2; ++a)
#pragma unroll
        for (int b = 0; b < 2; ++b)
#pragma unroll
            for (int m = 0; m < 4; ++m)
#pragma unroll
                for (int n = 0; n < 2; ++n) acc[a][b][m][n] = (f32x4){0.f, 0.f, 0.f, 0.f};
    int sc8 = 0x7f7f7f7f; if constexpr (FP8) asm volatile("" : "+v"(sc8));
    bf16x8 At[4][2], B0[2][2], B1[2][2]; v8i_t At8[4], B08[2], B18[2];
    const char* cA = (const char*)g.A + (size_t)cur.pm * tstep; const char* cB = (const char*)g.Bt + (size_t)cur.pn * tstep + (GROUPED ? (size_t)expert_of_tile(cur.pm) * g.estride : (size_t)0);
    S.a_ready(cur);
    if constexpr (SP2) {
        if constexpr (GATHER) { PG8_GDMA(cur, 0); PG8_WAIT_V(0); PG8_GREAD(vC, 0); }
        PG8_STAGE(PG8_SB(0, 0), cB, voffB); PG8_STAGE(PG8_SB(0, 1), cB + hstep, voffB); PG8_STA(PG8_SA(0, 0), cA, 0, 0, false); PG8_STA(PG8_SA(0, 1), cA + hstep, 0, 1, false);
        if (wr == 1) PG8_BAR;
        PG8_WAIT_V(2); PG8_BAR;
        if constexpr (BAL) { PG8_STAGE(PG8_SB(1, 0), cB + kstep, voffB); PG8_STAGE(PG8_SB(1, 1), cB + hstep + kstep, voffB); PG8_WAIT_V(4); PG8_BAR; }
        else {
        PG8_STAGE(PG8_SB(1, 0), cB + kstep, voffB); PG8_STA(PG8_SA(1, 0), cA + kstep, kstep, 0, false); PG8_STAGE(PG8_SB(1, 1), cB + hstep + kstep, voffB);
        PG8_WAIT_V(6); PG8_BAR;
        }
    } else {
        PG8_STAGE(PG8_SB(0, 0), cB, voffB); PG8_STAGE(PG8_SA(0, 0), cA, voffA); PG8_STAGE(PG8_SB(0, 1), cB + hstep, voffB); PG8_STAGE(PG8_SA(0, 1), cA + hstep, voffA);
        if (wr == 1) PG8_BAR;
        PG8_WAIT_V(4); PG8_BAR;
        PG8_STAGE(PG8_SB(1, 0), cB + kstep, voffB); PG8_STAGE(PG8_SA(1, 0), cA + kstep, voffA); PG8_STAGE(PG8_SB(1, 1), cB + hstep + kstep, voffB);
        PG8_WAIT_V(6); PG8_BAR;
    }
    for (;;) {
        const bool has_next = S.next(ui + 1, nxt);
        if constexpr (GATHER) { if (has_next) PG8_GDMA(nxt, (ui + 1) & 1); }
        const char* nA = has_next ? (const char*)g.A + (size_t)nxt.pm * tstep : cA; const char* nB = has_next ? (const char*)g.Bt + (size_t)nxt.pn * tstep + (GROUPED ? (size_t)expert_of_tile(nxt.pm) * g.estride : (size_t)0) : cB;
        for (int t = 0; t < nt; t += 2) {
            const bool last = (t == nt - 2);
            const char* a1 = cA + (size_t)(t + 1) * kstep;
            const char* a2 = last ? nA : cA + (size_t)(t + 2) * kstep; const char* b2 = last ? nB : cB + (size_t)(t + 2) * kstep;
            const char* a3 = a2 + kstep; const char* b3 = b2 + kstep;
            if (last && has_next) S.a_ready(nxt);
            if constexpr (SP2) {
            const bool nx = last && has_next; const size_t kb2 = last ? (size_t)0 : (size_t)(t + 2) * kstep;
            if constexpr (GATHER) { if (nx) PG8_GREAD(vN, (ui + 1) & 1); }
            if constexpr (BAL) {
            PG8_LDB(B0, 0, 0); PG8_LDB(B1, 0, 1); PG8_SCHED; PG8_LDA(At, 0, 0); PG8_STA(PG8_SA(1, 0), a1, (size_t)(t + 1) * kstep, 0, false); PG8_STA(PG8_SA(1, 1), a1 + hstep, (size_t)(t + 1) * kstep, 1, false);
            PG8_WAIT_V(8); PG8_WAIT_L(0); PG8_BAR; PG8_MMA(0, 0, At, B0); PG8_MMA(0, 1, At, B1); PG8_BAR; PG8_SCHED;
            PG8_LDA(At, 0, 1); PG8_STAGE(PG8_SB(0, 0), b2, voffB); PG8_STAGE(PG8_SB(0, 1), b2 + hstep, voffB);
            PG8_WAIT_V(6); PG8_WAIT_L(0); PG8_BAR; PG8_MMA(1, 0, At, B0); PG8_MMA(1, 1, At, B1); PG8_BAR; PG8_SCHED;
            PG8_LDB(B0, 1, 0); PG8_LDB(B1, 1, 1); PG8_SCHED; PG8_LDA(At, 1, 0); PG8_STA(PG8_SA(0, 0), a2, kb2, 0, nx); PG8_STA(PG8_SA(0, 1), a2 + hstep, kb2, 1, nx);
            PG8_WAIT_V(8); PG8_WAIT_L(0); PG8_BAR; PG8_MMA(0, 0, At, B0); PG8_MMA(0, 1, At, B1); PG8_BAR; PG8_SCHED;
            PG8_LDA(At, 1, 1); PG8_STAGE(PG8_SB(1, 0), b3, voffB); PG8_STAGE(PG8_SB(1, 1), b3 + hstep, voffB);
            PG8_WAIT_V(6); PG8_WAIT_L(0); PG8_BAR; PG8_MMA(1, 0, At, B0); PG8_MMA(1, 1, At, B1); PG8_BAR; PG8_SCHED;
            } else {
            PG8_LDB(B0, 0, 0); PG8_LDB(B1, 0, 1); PG8_SCHED; PG8_LDA(At, 0, 0); PG8_STA(PG8_SA(1, 1), a1 + hstep, (size_t)(t + 1) * kstep, 1, false);
            PG8_WAIT_V(8); PG8_WAIT_L(0); PG8_BAR; PG8_MMA(0, 0, At, B0); PG8_MMA(0, 1, At, B1); PG8_BAR; PG8_SCHED;
            PG8_LDA(At, 0, 1); PG8_STAGE(PG8_SB(0, 0), b2, voffB); PG8_STAGE(PG8_SB(0, 1), b2 + hstep, voffB); PG8_STA(PG8_SA(0, 0), a2, kb2, 0, nx);
            PG8_WAIT_V(8); PG8_WAIT_L(0); PG8_BAR; PG8_MMA(1, 0, At, B0); PG8_MMA(1, 1, At, B1); PG8_BAR; PG8_SCHED;
            PG8_LDB(B0, 1, 0); PG8_LDB(B1, 1, 1); PG8_SCHED; PG8_LDA(At, 1, 0); PG8_STA(PG8_SA(0, 1), a2 + hstep, kb2, 1, nx);
            PG8_WAIT_V(8); PG8_WAIT_L(0); PG8_BAR; PG8_MMA(0, 0, At, B0); PG8_MMA(0, 1, At, B1); PG8_BAR; PG8_SCHED;
            PG8_LDA(At, 1, 1); PG8_STAGE(PG8_SB(1, 0), b3, voffB); PG8_STAGE(PG8_SB(1, 1), b3 + hstep, voffB); PG8_STA(PG8_SA(1, 0), a3, kb2 + kstep, 0, nx);
            PG8_WAIT_V(8); PG8_WAIT_L(0); PG8_BAR; PG8_MMA(1, 0, At, B0); PG8_MMA(1, 1, At, B1); PG8_BAR; PG8_SCHED;
            }
            } else {
            PG8_LDB(B0, 0, 0); PG8_SCHED; PG8_LDA(At, 0, 0); PG8_STAGE(PG8_SA(1, 1), a1 + hstep, voffA);
            PG8_WAIT_L(8); PG8_BAR; PG8_WAIT_L(0); PG8_MMA(0, 0, At, B0); PG8_BAR; PG8_SCHED;
            PG8_LDB(B1, 0, 1); PG8_STAGE(PG8_SB(0, 0), b2, voffB);
            PG8_BAR; PG8_WAIT_L(0); PG8_MMA(0, 1, At, B1); PG8_BAR;
            PG8_LDA(At, 0, 1); PG8_STAGE(PG8_SA(0, 0), a2, voffA);
            PG8_BAR; PG8_WAIT_L(0); PG8_MMA(1, 0, At, B0); PG8_BAR; PG8_SCHED;
            PG8_STAGE(PG8_SB(0, 1), b2 + hstep, voffB);
            PG8_WAIT_V(6); PG8_BAR; PG8_MMA(1, 1, At, B1); PG8_BAR;
            PG8_LDB(B0, 1, 0); PG8_SCHED; PG8_LDA(At, 1, 0); PG8_STAGE(PG8_SA(0, 1), a2 + hstep, voffA);
            PG8_WAIT_L(8); PG8_BAR; PG8_WAIT_L(0); PG8_MMA(0, 0, At, B0); PG8_BAR; PG8_SCHED;
            PG8_LDB(B1, 1, 1); PG8_STAGE(PG8_SB(1, 0), b3, voffB);
            PG8_BAR; PG8_WAIT_L(0); PG8_MMA(0, 1, At, B1); PG8_BAR;
            PG8_LDA(At, 1, 1); PG8_STAGE(PG8_SA(1, 0), a3, voffA);
            PG8_BAR; PG8_WAIT_L(0); PG8_MMA(1, 0, At, B0); PG8_BAR; PG8_SCHED;
            PG8_STAGE(PG8_SB(1, 1), b3 + hstep, voffB);
            PG8_WAIT_V(6); PG8_BAR; PG8_MMA(1, 1, At, B1); PG8_BAR;
            }
        }
        if constexpr (FP8) asm volatile("s_nop 15\n\ts_nop 7" ::: "memory");
        if constexpr (ALIGN_EPI) { if (wr == 0) PG8_BAR; }
        if constexpr (!Epi::AFTER_DRAIN) { int fr_ = fr, fq_ = fq; asm volatile("" : "+v"(fr_), "+v"(fq_));
            E(acc, cur, wr, wc, fr_, fq_); S.done(cur); }
        if (!has_next) break;
#pragma unroll
        for (int a = 0; a < 2; ++a)
#pragma unroll
            for (int b = 0; b < 2; ++b)
#pragma unroll
                for (int m = 0; m < 4; ++m)
#pragma unroll
                    for (int n = 0; n < 2; ++n) acc[a][b][m][n] = (f32x4){0.f, 0.f, 0.f, 0.f};
        cur = nxt; cA = nA; cB = nB; ++ui;
        if constexpr (GATHER) { vC[0][0] = vN[0][0]; vC[0][1] = vN[0][1]; vC[1][0] = vN[1][0]; vC[1][1] = vN[1][1]; }
        if constexpr (ALIGN_EPI) { if (wr == 1) PG8_BAR; }
    }
    PG8_WAIT_V(0);
    if constexpr (!ALIGN_EPI) { if (wr == 0) PG8_BAR; }
    PG8_BAR;
    if constexpr (Epi::AFTER_DRAIN) { E.fused(acc, cur, wr, wc, fr, fq, lds, wid, lane); S.done(cur); }
#undef PG8_SA
#undef PG8_SB
#undef PG8_STAGE
#undef PG8_GDMA
#undef PG8_GREAD
#undef PG8_GSTAGE
#undef PG8_STA
#undef PG8_LDA
#undef PG8_LDB
#undef PG8_MMA
#undef PG8_CAT
#undef PG8_WAIT_V
#undef PG8_WAIT_L
#undef PG8_BAR
#undef PG8_SCHED
}
}

#define GAS __attribute__((address_space(1)))
#define LAS __attribute__((address_space(3)))
typedef unsigned v4u __attribute__((ext_vector_type(4)));
using pg8::f32x4;
typedef GAS unsigned gu32;
typedef GAS unsigned long long gu64;
#define RLX_AGENT __ATOMIC_RELAXED, __HIP_MEMORY_SCOPE_AGENT
#define LDS_WAIT() asm volatile("s_waitcnt lgkmcnt(0)" ::: "memory")
#define VM_WAIT() asm volatile("s_waitcnt vmcnt(0)" ::: "memory")

#define XB_TMO      128
#define XB_XCNT(j)  (256  + 64 * (j))
#define XB_XSUB(j)  (1280 + 64 * (j))
#define XB_XGEN(j)  (2304 + 64 * (j))
#define XB_TOP      3328
#define XB_TOPGEN   3392
#define XCD_BAR_WORDS 3456
#define XB_SPIN_CAP (1u << 18)

__device__ __forceinline__ unsigned xb_ld(unsigned* p)              { return __hip_atomic_load(p, __ATOMIC_RELAXED, __HIP_MEMORY_SCOPE_AGENT); }
__device__ __forceinline__ unsigned xb_add(unsigned* p, unsigned v) { return __hip_atomic_fetch_add(p, v, __ATOMIC_RELAXED, __HIP_MEMORY_SCOPE_AGENT); }
__device__ __forceinline__ unsigned xb_xcc_id() { return (unsigned)__builtin_amdgcn_s_getreg((3 << 11) | 20) & 0xFu; }
#define XB_SPIN(cond, bar) do { unsigned _sp = 0; while (cond) { __builtin_amdgcn_s_sleep(1); \
    if ((++_sp & 255u) == 0u) { if (xb_ld(&(bar)[XB_TMO])) break; if (_sp > XB_SPIN_CAP) { atomicAdd(&(bar)[XB_TMO], 1u); break; } } } } while (0)

struct XcdBarrier {
    unsigned* bar; unsigned x;
    volatile LAS unsigned* st;
};

__device__ __forceinline__ XcdBarrier xcd_barrier_post(unsigned* bar, volatile LAS unsigned* st) {
    XcdBarrier b; b.bar = bar; b.x = xb_xcc_id(); b.st = st;
    if (threadIdx.x == 0) (void)xb_add(&bar[XB_XCNT(b.x)], 1u);
    return b;
}
__device__ __forceinline__ void xcd_barrier_complete(unsigned* bar, unsigned x, unsigned& nloc, unsigned& nx) {
    const unsigned G = gridDim.x * gridDim.y * gridDim.z;
    unsigned sum, cnt, mine, sp = 0u;
    for (;;) {
        sum = 0u; cnt = 0u; mine = 0u;
#pragma unroll
        for (unsigned j = 0; j < 16; ++j) { const unsigned c = xb_ld(&bar[XB_XCNT(j)]); sum += c; cnt += (c > 0u) ? 1u : 0u; mine = (j == x) ? c : mine; }
        if (sum == G) break;
        __builtin_amdgcn_s_sleep(1);
        if ((++sp & 255u) == 0u) { if (xb_ld(&bar[XB_TMO])) break; if (sp > XB_SPIN_CAP) { atomicAdd(&bar[XB_TMO], 1u); break; } }
    }
    nloc = mine > 0u ? mine : 1u; nx = cnt > 0u ? cnt : 1u;
}

__device__ __forceinline__ void xcd_barrier(const XcdBarrier& b) {
    asm volatile("s_waitcnt vmcnt(0)" ::: "memory");
    __syncthreads();
    if (threadIdx.x == 0) {
        unsigned* bar = b.bar;
        __builtin_amdgcn_s_waitcnt(0);
        unsigned nloc = b.st[0], nx = b.st[1];
        if (nloc == 0u) { xcd_barrier_complete(bar, b.x, nloc, nx); b.st[0] = nloc; b.st[1] = nx; }
        const unsigned old = xb_add(&bar[XB_XSUB(b.x)], 1u);
        const unsigned gen = old / nloc;
        if (old + 1u == (gen + 1u) * nloc) {
            __builtin_amdgcn_fence(__ATOMIC_RELEASE, "agent");
            asm volatile("s_waitcnt vmcnt(0)" ::: "memory");
            const unsigned og = xb_add(&bar[XB_TOP], 1u);
            const unsigned tg = og / nx;
            if (og + 1u == (tg + 1u) * nx) xb_add(&bar[XB_TOPGEN], 1u);
            else XB_SPIN(xb_ld(&bar[XB_TOPGEN]) == tg, bar);
            __builtin_amdgcn_fence(__ATOMIC_ACQUIRE, "agent");
            xb_add(&bar[XB_XGEN(b.x)], 1u);
            asm volatile("s_waitcnt vmcnt(0)" ::: "memory");
        } else {
            XB_SPIN(xb_ld(&bar[XB_XGEN(b.x)]) == gen, bar);
            __builtin_amdgcn_fence(__ATOMIC_ACQUIRE, "agent");
            asm volatile("s_waitcnt vmcnt(0)" ::: "memory");
        }
    }
    __syncthreads();
}


namespace attn_body {
using bf16=__hip_bfloat16;
using bf16x8=__attribute__((ext_vector_type(8)))short;
using s16x4=__attribute__((ext_vector_type(4)))short;
using f32x16=__attribute__((ext_vector_type(16)))float;
using u32x4=__attribute__((ext_vector_type(4)))unsigned;
constexpr int SEQ=4096,D=64,KP=2048,OP=1024;
constexpr int NW=8,QBLK=32,QB=QBLK*NW,KVBLK=64,NQB=SEQ/QB;
__device__ __forceinline__ int crow(int r,int hi){return (r&3)+8*(r>>2)+4*hi;}
#define SBAR() __builtin_amdgcn_sched_barrier(0)
constexpr int NSLOT=3, SLOTB=8192;
constexpr int LDS_K=0, LDS_V=NSLOT*SLOTB, LDS_WS=2*NSLOT*SLOTB, LDS_OST=LDS_WS+NW*64*4, LDS_BYTES=LDS_OST+NW*4096;
constexpr float C2=0.125f*1.4426950408889634f;
__device__ __forceinline__ void glds16(const void*gsrc,unsigned lds_dst){unsigned keep;
  asm volatile("s_mov_b32 %0, m0\n\ts_mov_b32 m0, %2\n\ts_nop 0\n\tglobal_load_lds_dwordx4 %1, off\n\ts_mov_b32 m0, %0":"=&s"(keep):"v"(gsrc),"s"(lds_dst):"memory");}
__device__ __forceinline__ float max3f(float a,float b,float c){float r;asm("v_max3_f32 %0, %1, %2, %3":"=v"(r):"v"(a),"v"(b),"v"(c));return r;}
__device__ __forceinline__ float max2f(float a,float b){float r;asm("v_max_f32_e32 %0, %1, %2":"=v"(r):"v"(a),"v"(b));return r;}
__device__ __forceinline__ float fadd_s(float a,float b){float r;asm("v_add_f32_e32 %0, %1, %2":"=v"(r):"v"(a),"v"(b));return r;}
__device__ __forceinline__ float fsub_s(float a,float b){float r;asm("v_sub_f32_e32 %0, %1, %2":"=v"(r):"v"(a),"v"(b));return r;}
typedef float f32x2_t __attribute__((ext_vector_type(2))); typedef __bf16 bf16x2_t __attribute__((ext_vector_type(2)));
__device__ __forceinline__ unsigned cvtpk_s(float lo,float hi){f32x2_t v={lo,hi};bf16x2_t b=__builtin_convertvector(v,bf16x2_t);return __builtin_bit_cast(unsigned,b);}
#define WAIT_BAR(N) asm volatile("s_waitcnt vmcnt(" #N ") lgkmcnt(0)\n\ts_barrier":::"memory")

__device__ __forceinline__ void qkt(f32x16&p0,f32x16&p1,const char*Kslot,const bf16x8*qr,const f32x16&negm,int r32,int hi){
  const char*kb=Kslot+hi*1024+r32*16;
  #pragma unroll
  for(int d0=0;d0<4;++d0){
    const bf16x8 b0=*reinterpret_cast<const bf16x8*>(kb+d0*2048);
    const bf16x8 b1=*reinterpret_cast<const bf16x8*>(kb+d0*2048+512);
    if(d0==0){p0=__builtin_amdgcn_mfma_f32_32x32x16_bf16(b0,qr[0],negm,0,0,0);p1=__builtin_amdgcn_mfma_f32_32x32x16_bf16(b1,qr[0],negm,0,0,0);}
    else{p0=__builtin_amdgcn_mfma_f32_32x32x16_bf16(b0,qr[d0],p0,0,0,0);p1=__builtin_amdgcn_mfma_f32_32x32x16_bf16(b1,qr[d0],p1,0,0,0);}}
}
typedef __attribute__((address_space(3))) const char* lds_cptr;
typedef short v4i16_t __attribute__((ext_vector_type(4)));
__device__ __forceinline__ void kload8(bf16x8*kf,lds_cptr kp){
  kf[0]=*(const __attribute__((address_space(3))) bf16x8*)(kp);      kf[1]=*(const __attribute__((address_space(3))) bf16x8*)(kp+512);
  kf[2]=*(const __attribute__((address_space(3))) bf16x8*)(kp+2048); kf[3]=*(const __attribute__((address_space(3))) bf16x8*)(kp+2560);
  kf[4]=*(const __attribute__((address_space(3))) bf16x8*)(kp+4096); kf[5]=*(const __attribute__((address_space(3))) bf16x8*)(kp+4608);
  kf[6]=*(const __attribute__((address_space(3))) bf16x8*)(kp+6144); kf[7]=*(const __attribute__((address_space(3))) bf16x8*)(kp+6656);
}
__device__ __forceinline__ void kload2(bf16x8*kf,lds_cptr kp,int j){ kf[2*j]=*(const __attribute__((address_space(3))) bf16x8*)(kp+j*2048); kf[2*j+1]=*(const __attribute__((address_space(3))) bf16x8*)(kp+j*2048+512); }
__device__ __forceinline__ s16x4 vtr(lds_cptr p){ return __builtin_bit_cast(s16x4,__builtin_amdgcn_ds_read_tr16_b64_v4i16((__attribute__((address_space(3))) v4i16_t*)p)); }
__device__ __forceinline__ float rowmax(const f32x16&p0,const f32x16&p1){
  float a=max3f(p0[0],p0[1],p1[0]),b=max3f(p0[2],p0[3],p1[1]);a=max3f(a,p1[2],p1[3]);
  #pragma unroll
  for(int r=4;r<16;r+=4){a=max3f(a,p0[r],p0[r+1]);b=max3f(b,p0[r+2],p0[r+3]);a=max3f(a,p1[r],p1[r+1]);b=max3f(b,p1[r+2],p1[r+3]);}
  const float m=max2f(a,b);
  auto rr=__builtin_amdgcn_permlane32_swap(__float_as_uint(m),__float_as_uint(m),false,false);
  return max2f(__uint_as_float(rr[0]),__uint_as_float(rr[1]));
}
__device__ __forceinline__ void pv(f32x16*o,int vb,bf16x8 pa0,bf16x8 pa1,bf16x8 pa2,bf16x8 pa3){
  #pragma unroll
  for(int d0=0;d0<2;++d0){s16x4 lo[4],hi[4];
    #pragma unroll
    for(int ks=0;ks<4;++ks){
      asm volatile("ds_read_b64_tr_b16 %0,%1 offset:%c2":"=&v"(lo[ks]):"v"(vb),"i"(d0*4096+ks*1024):"memory");
      asm volatile("ds_read_b64_tr_b16 %0,%1 offset:%c2":"=&v"(hi[ks]):"v"(vb),"i"(d0*4096+ks*1024+512):"memory");}
    asm volatile("s_waitcnt lgkmcnt(0)":::"memory");SBAR();
    #define PK(k) (bf16x8){lo[k][0],lo[k][1],lo[k][2],lo[k][3],hi[k][0],hi[k][1],hi[k][2],hi[k][3]}
    o[d0]=__builtin_amdgcn_mfma_f32_32x32x16_bf16(pa0,PK(0),o[d0],0,0,0);
    o[d0]=__builtin_amdgcn_mfma_f32_32x32x16_bf16(pa1,PK(1),o[d0],0,0,0);
    o[d0]=__builtin_amdgcn_mfma_f32_32x32x16_bf16(pa2,PK(2),o[d0],0,0,0);
    o[d0]=__builtin_amdgcn_mfma_f32_32x32x16_bf16(pa3,PK(3),o[d0],0,0,0);
    #undef PK
  }
}

#ifndef ATTN_STORE16
#define ATTN_STORE16(p,v) (*(u32x4*)(p)=(v))
#endif
template<int THRL,bool NOMAX=false,bool MSUM=true> __device__ __forceinline__ void attn_unit(const bf16*Qw0,const bf16*__restrict__ Kh,const bf16*__restrict__ Vh,bf16*Ow0,char*shm){
  int tid_=threadIdx.x; asm volatile("":"+v"(tid_));
  const int tid=tid_,lane=tid&63,r32=lane&31,hi=lane>>5; const int wid=__builtin_amdgcn_readfirstlane(tid>>6);
  const bf16*Qw=Qw0+(long)(wid*QBLK)*KP;
  const unsigned lds0=(unsigned)(uintptr_t)shm;
  float*wsf=(float*)(shm+LDS_WS)+wid*64;
  const bf16*ksrc=Kh+(long)lane*KP+wid*8;
  const bf16*vsrc=Vh+(long)(16*(wid&3)+(lane>>2))*KP+(wid>>2)*32+(lane&3)*8;
  const unsigned kdst=lds0+LDS_K+wid*1024, vdst=lds0+LDS_V+wid*1024;
  #define DMA_K(t,slot) glds16(ksrc+(long)(t)*KVBLK*KP,(unsigned)__builtin_amdgcn_readfirstlane(kdst+(slot)))
  #define DMA_V(t,slot) glds16(vsrc+(long)(t)*KVBLK*KP,(unsigned)__builtin_amdgcn_readfirstlane(vdst+(slot)))
  const int vb0=(int)(lds0+LDS_V)+((lane>>4)&1)*32+(lane&3)*8+(4*hi+((lane&15)>>2))*64;
  const char*Kbase=shm+LDS_K; bf16x8 kf[8];
  const lds_cptr shm3=(lds_cptr)shm; const lds_cptr kp0=shm3+LDS_K+hi*1024+r32*16; const lds_cptr vp0=shm3+LDS_V+((lane>>4)&1)*32+(lane&3)*8+(4*hi+((lane&15)>>2))*64;
  constexpr int NT=SEQ/KVBLK;
  DMA_K(0,0);DMA_V(0,0);DMA_K(1,SLOTB);
  bf16x8 qr[4];
  #pragma unroll
  for(int d0=0;d0<4;++d0)qr[d0]=*reinterpret_cast<const bf16x8*>(&Qw[(long)r32*KP+d0*16+hi*8]);
  float mhat=0.f,l_reg=0.f;f32x16 o[2];o[0]=f32x16{};o[1]=f32x16{};f32x16 negm=f32x16{};if constexpr(!NOMAX)asm volatile("":"+v"(negm));
  f32x16 lsum=f32x16{}; const bf16x8 ONESF={(short)0x3F80,(short)0x3F80,(short)0x3F80,(short)0x3F80,(short)0x3F80,(short)0x3F80,(short)0x3F80,(short)0x3F80};
  #define CMASK(P0,P1,t) do{}while(0)
  bool resc=false;
  #define START(P0,P1) do{ if constexpr(!NOMAX){ const float rm=rowmax(P0,P1); resc=false; \
    { const float dl=rm; mhat=fadd_s(mhat,dl); \
      _Pragma("unroll") for(int r=0;r<16;++r){P0[r]=fsub_s(P0[r],dl);P1[r]=fsub_s(P1[r],dl);} \
      _Pragma("unroll") for(int r=0;r<16;++r)negm[r]=-mhat; asm volatile("":"+v"(negm)); } } \
    _Pragma("unroll") for(int r=0;r<16;++r)P0[r]=__builtin_amdgcn_exp2f(P0[r]); }while(0)
  #define RESC() do{ if(resc){ asm volatile("s_waitcnt lgkmcnt(0)":::"memory"); \
      _Pragma("unroll") for(int d_=0;d_<2;++d_) _Pragma("unroll") for(int r=0;r<16;++r)o[d_][r]*=wsf[crow(r,hi)]; } }while(0)
  f32x16 pA0,pA1,pB0,pB1;
  int sl_prev=0,sl_cur=0,sl_next=SLOTB;
  #define ROT() do{sl_prev=sl_cur;sl_cur=sl_next;sl_next=(sl_next==(NSLOT-1)*SLOTB)?0:sl_next+SLOTB;}while(0)
  DMA_K(2,2*SLOTB);
  WAIT_BAR(3);
  qkt(pA0,pA1,Kbase,qr,negm,r32,hi);asm volatile("s_nop 15\n\ts_nop 7":"+v"(pA0),"+v"(pA1));CMASK(pA0,pA1,0);
  START(pA0,pA1);
  _Pragma("unroll") for(int r=0;r<16;++r)pA1[r]=__builtin_amdgcn_exp2f(pA1[r]);
  WAIT_BAR(0);
  DMA_K(3,0);DMA_V(1,SLOTB);
  ROT();
  kload8(kf,kp0+sl_cur);
  WAIT_BAR(2);
  s16x4 vlo[8],vhi[8]; u32x4 pw0,pw1,pw2,pw3;
  #define PKW(P,B) cvtpk_s(P[B],P[B+1])
  #define PAF(k) __builtin_bit_cast(bf16x8,pw##k)
  #define VFR(i) (bf16x8){vlo[i][0],vlo[i][1],vlo[i][2],vlo[i][3],vhi[i][0],vhi[i][1],vhi[i][2],vhi[i][3]}
  #define PIN(x) asm volatile("":"+v"(x))
  #define MX3(a,b,c) __builtin_fmaxf(__builtin_fmaxf((a),(b)),(c))
  #define GAPA(MF,A0,A1,A2,A3,W0,W1,PW) do{ MF; if constexpr(!(NOMAX&&MSUM)){ sacc+=A0; sacc+=A1; sacc+=A2; sacc+=A3; PIN(sacc); } W0; W1; PIN(PW); SBAR(); }while(0)
  #define LSUM(k) do{ if constexpr(NOMAX&&MSUM){ lsum=__builtin_amdgcn_mfma_f32_32x32x16_bf16(PAF(k),ONESF,lsum,0,0,0); SBAR(); } }while(0)
  #define EX(v) __builtin_amdgcn_exp2f(v)
  #define GAPB(MF,X,B) do{ MF; X[B]=EX(X[B]); X[B+1]=EX(X[B+1]); X[B+2]=EX(X[B+2]); X[B+3]=EX(X[B+3]); PIN(X); SBAR(); }while(0)
  #define VRD(i) do{ vlo[i]=vtr(vp_+(((i)>>2)*4096+((i)&3)*1024)); vhi[i]=vtr(vp_+(((i)>>2)*4096+((i)&3)*1024+512)); }while(0)
  #define KRD(G,j) do{ if(G){ kload2(kf,kp0+sl_next,j); SBAR(); } }while(0)
  #define STEP(C0,C1,P0,P1,t,GK,GV,GL) do{ SBAR(); \
    const lds_cptr vp_=vp0+sl_prev; \
    VRD(0); SBAR(); float sacc=0.f; if constexpr(!(NOMAX&&MSUM)) sacc=(P0[0]+P0[1]); \
    GAPA(C0=__builtin_amdgcn_mfma_f32_32x32x16_bf16(kf[0],qr[0],negm,0,0,0), P0[2],P0[3],P0[4],P0[5],     pw0[0]=PKW(P0,0), pw0[1]=PKW(P0,2), pw0); \
    VRD(4); SBAR(); GAPA(C1=__builtin_amdgcn_mfma_f32_32x32x16_bf16(kf[1],qr[0],negm,0,0,0), P0[6],P0[7],P0[8],P0[9],     pw0[2]=PKW(P0,4), pw0[3]=PKW(P0,6), pw0); \
    VRD(1); SBAR(); GAPA(C0=__builtin_amdgcn_mfma_f32_32x32x16_bf16(kf[2],qr[1],C0,0,0,0),   P0[10],P0[11],P0[12],P0[13], pw1[0]=PKW(P0,8), pw1[1]=PKW(P0,10), pw1); \
    VRD(5); SBAR(); GAPA(C1=__builtin_amdgcn_mfma_f32_32x32x16_bf16(kf[3],qr[1],C1,0,0,0),   P0[14],P0[15],P1[0],P1[1],   pw1[2]=PKW(P0,12),pw1[3]=PKW(P0,14), pw1); \
    VRD(2); SBAR(); GAPA(C0=__builtin_amdgcn_mfma_f32_32x32x16_bf16(kf[4],qr[2],C0,0,0,0),   P1[2],P1[3],P1[4],P1[5],     pw2[0]=PKW(P1,0), pw2[1]=PKW(P1,2), pw2); \
    VRD(6); SBAR(); GAPA(C1=__builtin_amdgcn_mfma_f32_32x32x16_bf16(kf[5],qr[2],C1,0,0,0),   P1[6],P1[7],P1[8],P1[9],     pw2[2]=PKW(P1,4), pw2[3]=PKW(P1,6), pw2); \
    VRD(3); SBAR(); GAPA(C0=__builtin_amdgcn_mfma_f32_32x32x16_bf16(kf[6],qr[3],C0,0,0,0),   P1[10],P1[11],P1[12],P1[13], pw3[0]=PKW(P1,8), pw3[1]=PKW(P1,10), pw3); \
    VRD(7); SBAR(); GAPA(C1=__builtin_amdgcn_mfma_f32_32x32x16_bf16(kf[7],qr[3],C1,0,0,0),   P1[14],P1[15],0.f,0.f,       pw3[2]=PKW(P1,12),pw3[3]=PKW(P1,14), pw3); \
    l_reg+=sacc; \
    if(GK){DMA_K((t)+3,sl_cur);} if(GV){DMA_V((t)+1,sl_next);} \
    CMASK(C0,C1,t); \
    if constexpr(!NOMAX){ float a=MX3(C0[0],C0[1],C1[0]),b=MX3(C0[2],C0[3],C1[1]); a=MX3(a,C1[2],C1[3]); \
      _Pragma("unroll") for(int r=4;r<16;r+=4){a=MX3(a,C0[r],C0[r+1]);b=MX3(b,C0[r+2],C0[r+3]);a=MX3(a,C1[r],C1[r+1]);b=MX3(b,C1[r+2],C1[r+3]);} \
      float rm=__builtin_fmaxf(a,b); { auto rr=__builtin_amdgcn_permlane32_swap(__float_as_uint(rm),__float_as_uint(rm),false,false); rm=__builtin_fmaxf(__uint_as_float(rr[0]),__uint_as_float(rr[1])); } \
      resc=false; \
      if(__builtin_expect(__any(rm>(float)THRL),0)){ const float dl=__builtin_fmaxf(rm,0.f); mhat+=dl; \
        _Pragma("unroll") for(int r=0;r<16;++r){C0[r]-=dl;C1[r]-=dl;} \
        _Pragma("unroll") for(int r=0;r<16;++r)negm[r]=-mhat; asm volatile("":"+v"(negm)); \
        const float f=__builtin_amdgcn_exp2f(-dl); l_reg*=f; if(hi==0)wsf[r32]=f; resc=true; } } \
    SBAR(); \
    GAPB(o[0]=__builtin_amdgcn_mfma_f32_32x32x16_bf16(PAF(0),VFR(0),o[0],0,0,0), C0,0); \
    GAPB(o[1]=__builtin_amdgcn_mfma_f32_32x32x16_bf16(PAF(0),VFR(4),o[1],0,0,0), C0,4); LSUM(0); \
    KRD(GL,0); GAPB(o[0]=__builtin_amdgcn_mfma_f32_32x32x16_bf16(PAF(1),VFR(1),o[0],0,0,0), C0,8); \
    KRD(GL,1); GAPB(o[1]=__builtin_amdgcn_mfma_f32_32x32x16_bf16(PAF(1),VFR(5),o[1],0,0,0), C0,12); LSUM(1); \
    KRD(GL,2); GAPB(o[0]=__builtin_amdgcn_mfma_f32_32x32x16_bf16(PAF(2),VFR(2),o[0],0,0,0), C1,0); \
    KRD(GL,3); GAPB(o[1]=__builtin_amdgcn_mfma_f32_32x32x16_bf16(PAF(2),VFR(6),o[1],0,0,0), C1,4); LSUM(2); \
    GAPB(o[0]=__builtin_amdgcn_mfma_f32_32x32x16_bf16(PAF(3),VFR(3),o[0],0,0,0), C1,8); \
    GAPB(o[1]=__builtin_amdgcn_mfma_f32_32x32x16_bf16(PAF(3),VFR(7),o[1],0,0,0), C1,12); LSUM(3); \
    }while(0)
  int t=1;
  for(;t+5<NT;t+=2){
    STEP(pB0,pB1,pA0,pA1,t,true,true,true);     WAIT_BAR(2); RESC(); ROT();
    STEP(pA0,pA1,pB0,pB1,t+1,true,true,true);   WAIT_BAR(2); RESC(); ROT();
  }
  #define ENDW(tt) do{ if((tt)+3<NT){WAIT_BAR(2);} else if((tt)+2<NT){WAIT_BAR(1);} else {WAIT_BAR(0);} }while(0)
  for(;t+1<NT;t+=2){
    STEP(pB0,pB1,pA0,pA1,t,(t+3<NT),(t+1<NT),(t+1<NT));       ENDW(t);   RESC(); ROT();
    STEP(pA0,pA1,pB0,pB1,t+1,(t+4<NT),(t+2<NT),(t+2<NT));     ENDW(t+1); RESC(); ROT();
  }
  STEP(pB0,pB1,pA0,pA1,NT-1,false,false,false); RESC();
  { if constexpr(!(NOMAX&&MSUM)){ float sacc=pB0[0]+pB0[1]; _Pragma("unroll") for(int r=2;r<16;++r)sacc+=pB0[r]; _Pragma("unroll") for(int r=0;r<16;++r)sacc+=pB1[r]; l_reg+=sacc; }
    pw0=(u32x4){PKW(pB0,0),PKW(pB0,2),PKW(pB0,4),PKW(pB0,6)};pw1=(u32x4){PKW(pB0,8),PKW(pB0,10),PKW(pB0,12),PKW(pB0,14)};pw2=(u32x4){PKW(pB1,0),PKW(pB1,2),PKW(pB1,4),PKW(pB1,6)};pw3=(u32x4){PKW(pB1,8),PKW(pB1,10),PKW(pB1,12),PKW(pB1,14)};
    SBAR(); pv(o,vb0+sl_cur,PAF(0),PAF(1),PAF(2),PAF(3)); LSUM(0); LSUM(1); LSUM(2); LSUM(3); }
  #undef PKW
  #undef PAF
  #undef VFR
  #undef PIN
  #undef MX3
  #undef GAPA
  #undef LSUM
  #undef GAPB
  #undef EX
  #undef VRD
  #undef KRD
  #undef STEP
  #undef ENDW
  float rli[16];
  if constexpr(NOMAX&&MSUM){
    #pragma unroll
    for(int r=0;r<16;++r)rli[r]=__builtin_amdgcn_rcpf(lsum[r]);
  } else {
  {auto rr=__builtin_amdgcn_permlane32_swap(__float_as_uint(l_reg),__float_as_uint(l_reg),false,false);l_reg=__uint_as_float(rr[0])+__uint_as_float(rr[1]);}
  if(hi==0)wsf[32+r32]=l_reg;asm volatile("s_waitcnt lgkmcnt(0)":::"memory");
  #pragma unroll
  for(int r=0;r<16;++r)rli[r]=__builtin_amdgcn_rcpf(wsf[32+crow(r,hi)]);
  }
  bf16*Ow=Ow0+(long)(wid*QBLK)*OP;
  { bf16*stg=(bf16*)(shm+LDS_OST)+wid*2048;
    #pragma unroll
    for(int r=0;r<16;++r){const int orow=crow(r,hi);
      #pragma unroll
      for(int d0=0;d0<2;++d0)stg[orow*64+d0*32+r32]=__float2bfloat16(o[d0][r]*rli[r]);}
    asm volatile("s_waitcnt lgkmcnt(0)":::"memory");
    #pragma unroll
    for(int i=0;i<4;++i){const int row=i*8+(lane>>3),ch=lane&7; const u32x4 v=*(const u32x4*)(stg+row*64+ch*8); ATTN_STORE16(Ow+(long)row*OP+ch*8,v);} }
  asm volatile("s_waitcnt lgkmcnt(0)\n\ts_barrier":::"memory");
  #undef DMA_K
  #undef DMA_V
  #undef CMASK
  #undef START
  #undef RESC
  #undef ROT
}
constexpr int ATTN_LDS_BYTES=LDS_BYTES;
#undef SBAR
#undef WAIT_BAR
}

typedef unsigned short bf16;
typedef float f32x16 __attribute__((ext_vector_type(16)));
typedef short s16x4 __attribute__((ext_vector_type(4)));
typedef short v4i16_t __attribute__((ext_vector_type(4)));
typedef unsigned u32x2 __attribute__((ext_vector_type(2)));
typedef float f32x2v __attribute__((ext_vector_type(2)));
using pg8::bf16x8; using pg8::u32x4;

constexpr int DM = 1024, SEQ = 4096, T_P = 4 * 4096, T_S = 16 * 4096, TT = T_P + T_S, NBATCH = 20;
constexpr int DIN = 2048, NLAYER = 4, NEXP = 16, DEXP = 2048;
constexpr int CAP_P = T_P / 8, CAP_S = T_S / 8, ROWS_P = NEXP * CAP_P, ROWS_E = 2 * TT;
constexpr float LN_EPS = 1e-5f, QK_EPS = 1e-6f;
constexpr float DN_ALPHA = 1.6817928305074290861f;
constexpr float LOG2E = 1.4426950408889634f;
constexpr float C2 = 0.125f * LOG2E;
constexpr int H_NAQ = 0, H_NAK = 256, H_NAV = 512, H_GQ = 768, H_GK = 1280, H_GV = 1408, H_UC = 1536, H_VC = 1792;
constexpr int Y_NA = 0, Y_GQA = 256, Y_SG = 768;

constexpr size_t MiB = 1u << 20;
constexpr size_t WS_CTL = 0, CTL_ZERO_BYTES = 1 * MiB;
constexpr size_t WS_ROPE = 1 * MiB;
constexpr size_t WS_WSBF = 2 * MiB;
constexpr size_t WS_WIN = 4 * MiB;
constexpr size_t WS_WOUT = 8 * MiB;
constexpr size_t WS_WGU = 16 * MiB;
constexpr size_t WS_WD = 144 * MiB;
constexpr size_t WS_AFF = 208 * MiB;
constexpr size_t WS_SLOTOF = 214 * MiB;
constexpr size_t WS_IDX = 220 * MiB;
constexpr size_t WS_GATE = 221 * MiB;
constexpr size_t WS_STATS = 222 * MiB;
constexpr size_t WS_XB = 224 * MiB;
constexpr size_t WS_H = 384 * MiB;
constexpr size_t WS_HID = 704 * MiB;
constexpr size_t WS_XB8 = 1344 * MiB;
constexpr size_t WS_VT = 1424 * MiB;
constexpr size_t WS_SET1 = 1468 * MiB;
constexpr size_t WS_DUMMY = 1676 * MiB;
constexpr size_t WS_END = 1676 * MiB;
__device__ __forceinline__ size_t wset(int l) { return (l & 1) ? (WS_SET1 - 2 * MiB) : (size_t)0; }
#ifndef CONV_SPLIT_ITEMS
#define CONV_SPLIT_ITEMS 20480
#endif
constexpr int VTP = SEQ + 64;
constexpr int CW_TMO = 0, CW_BAR = 4096;

constexpr int NWAVES = 8;
constexpr int RING_BYTES = 131072, LDSCTL_OFF = RING_BYTES, MISC_OFF = LDSCTL_OFF + 320, LDS_BYTES = 147456;

__device__ __forceinline__ unsigned f2bf(float f) { unsigned u = __builtin_bit_cast(unsigned, f); return (u + 0x7fffu + ((u >> 16) & 1u)) >> 16; }
__device__ __forceinline__ unsigned pk2(float lo, float hi) { return f2bf(lo) | (f2bf(hi) << 16); }
__device__ __forceinline__ float bf2f(unsigned short b) { return __builtin_bit_cast(float, (unsigned)b << 16); }
template <int O> __device__ __forceinline__ float shx(float v) {
    static_assert(O >= 1 && O < 32, "ds_swizzle bit mode covers xor distances 1..31");
    return __builtin_bit_cast(float, __builtin_amdgcn_ds_swizzle(__builtin_bit_cast(int, v), 0x1f | (O << 10)));
}
__device__ __forceinline__ float sum32(float v) { const auto rr = __builtin_amdgcn_permlane32_swap(__float_as_uint(v), __float_as_uint(v), false, false); return __uint_as_float(rr[0]) + __uint_as_float(rr[1]); }
__device__ __forceinline__ float max32(float v) { const auto rr = __builtin_amdgcn_permlane32_swap(__float_as_uint(v), __float_as_uint(v), false, false); return fmaxf(__uint_as_float(rr[0]), __uint_as_float(rr[1])); }
__device__ __forceinline__ float other32(float v, bool upper) { const auto rr = __builtin_amdgcn_permlane32_swap(__float_as_uint(v), __float_as_uint(v), false, false); return __uint_as_float(upper ? rr[0] : rr[1]); }
__device__ __forceinline__ float wave_sum(float v) {
    v += shx<1>(v); v += shx<2>(v); v += shx<4>(v); v += shx<8>(v); v += shx<16>(v);
    return sum32(v);
}
__device__ __forceinline__ float gelu_tanh(float x) {
    const float u = 0.7978845608028654f * (x + 0.044715f * x * x * x);
    const float e = __builtin_amdgcn_exp2f((2.0f * LOG2E) * u);
    const float th = 1.0f - 2.0f * __builtin_amdgcn_rcpf(e + 1.0f);
    return 0.5f * x * (1.0f + th);
}
__device__ __forceinline__ float clamp8(float v) { return __builtin_amdgcn_fmed3f(v, -440.f, 440.f); }
__device__ __forceinline__ unsigned pk4_fp8(float a, float b, float c, float d) { int w = 0; w = __builtin_amdgcn_cvt_pk_fp8_f32(clamp8(a), clamp8(b), w, false); w = __builtin_amdgcn_cvt_pk_fp8_f32(clamp8(c), clamp8(d), w, true); return (unsigned)w; }
constexpr float WGU_SCALE = 64.f, WD_SCALE = 128.f, HID_SCALE = 8.f, YE_SCALE = 64.f;
__device__ __forceinline__ int crow(int r, int hi) { return (r & 3) + 8 * (r >> 2) + 4 * hi; }
__device__ __forceinline__ s16x4 tr_read(const LAS unsigned char* p) { return __builtin_bit_cast(s16x4, __builtin_amdgcn_ds_read_tr16_b64_v4i16((LAS v4i16_t*)p)); }
#define MFMA32(a, b, c) __builtin_amdgcn_mfma_f32_32x32x16_bf16((a), (b), (c), 0, 0, 0)

using pg8::Unit; using pg8::BM; using pg8::HALF;
__device__ __forceinline__ u32x4 pack8(const f32x4& a, const f32x4& b) { u32x4 w; w.x = pg8::cvt_pk_bf16(a[0], a[1]); w.y = pg8::cvt_pk_bf16(a[2], a[3]); w.z = pg8::cvt_pk_bf16(b[0], b[1]); w.w = pg8::cvt_pk_bf16(b[2], b[3]); return w; }

struct EpiIn {
    static constexpr bool PERM = true, AFTER_DRAIN = false;
    bf16* H; const float* qn; const float* kn; const float* gv; const float* bv; const float* rope; bf16* VT;
    __device__ __forceinline__ void operator()(const f32x4 (&acc)[2][2][4][2], const Unit& u, int wr, int wc, int fr, int fq) const {
        const int pn = u.pn;
        int mode; const float* gain = qn; float osc = 1.f;
        if (pn == 0) { mode = 1; osc = C2; } else if (pn <= 2) mode = 0; else if (pn <= 4) { mode = 2; gain = qn; osc = C2; }
        else if (pn == 5) { if (wc < 2) { mode = 2; gain = kn; osc = 1.f; } else mode = 0; } else if (pn == 6) mode = 3; else mode = 4;
        const int row0 = u.pm * BM + wr * 64 + fr;
        bf16* Hb = H + (size_t)row0 * DIN + pn * 256 + wc * 64 + 8 * fq;
#define EPI_ROWS(BODY) _Pragma("unroll") for (int ai = 0; ai < 2; ++ai) _Pragma("unroll") for (int m = 0; m < 4; ++m) { const int rofs = ai * HALF + m * 16; f32x4 v[2][2]; \
            _Pragma("unroll") for (int bj = 0; bj < 2; ++bj) _Pragma("unroll") for (int n = 0; n < 2; ++n) v[bj][n] = acc[ai][bj][m][n]; \
            BODY \
            bf16* rowp = Hb + (size_t)rofs * DIN; _Pragma("unroll") for (int bj = 0; bj < 2; ++bj) *(u32x4*)(rowp + 32 * bj) = pack8(v[bj][0], v[bj][1]); }
#define EPI_ALL(EXPR) _Pragma("unroll") for (int bj = 0; bj < 2; ++bj) _Pragma("unroll") for (int n = 0; n < 2; ++n) { EXPR }
        if (mode == 5) {
#pragma unroll
            for (int ai = 0; ai < 2; ++ai)
#pragma unroll
                for (int m = 0; m < 4; ++m) { const int t = row0 + ai * HALF + m * 16; bf16* vb = VT + ((size_t)((t >> 12) * 4 + wc) * 64 + 8 * fq) * VTP + (t & (SEQ - 1));
#pragma unroll
                    for (int bj = 0; bj < 2; ++bj)
#pragma unroll
                        for (int n = 0; n < 2; ++n)
#pragma unroll
                            for (int i = 0; i < 4; ++i) vb[(size_t)(32 * bj + 4 * n + i) * VTP] = (bf16)f2bf(acc[ai][bj][m][n][i]); }
        }
        else if (mode == 0) { EPI_ROWS( ; ) }
        else if (mode == 1) { EPI_ROWS( EPI_ALL( v[bj][n] = v[bj][n] * osc; ) ) }
        else if (mode == 2) {
            EPI_ROWS(
                float ss = 0.f;
                EPI_ALL( const f32x4 x = v[bj][n]; ss += (x[0] * x[0] + x[1] * x[1]) + (x[2] * x[2] + x[3] * x[3]); )
                ss += shx<16>(ss); ss = sum32(ss);
                const float rstd = osc * __builtin_amdgcn_rsqf(ss * (1.0f / 64.0f) + QK_EPS);
                const int sp = (row0 + rofs) & (SEQ - 1);
                EPI_ALL(
                    const f32x4 gg = *(const f32x4*)(gain + 32 * bj + 8 * fq + 4 * n);
                    const f32x4 cs = *(const f32x4*)(rope + ((size_t)sp * 32 + 16 * bj + 4 * fq + 2 * n) * 2);
                    const f32x4 x = v[bj][n] * rstd * gg;
                    f32x4 o; o[0] = x[0] * cs[0] - x[1] * cs[1]; o[1] = x[0] * cs[1] + x[1] * cs[0]; o[2] = x[2] * cs[2] - x[3] * cs[3]; o[3] = x[2] * cs[3] + x[3] * cs[2];
                    v[bj][n] = o; )
                asm volatile("" ::: "memory");
            )
        } else if (mode == 3) {
            EPI_ROWS( EPI_ALL( f32x4 x = v[bj][n]; x[0] = gelu_tanh(x[0]); x[1] = gelu_tanh(x[1]); x[2] = gelu_tanh(x[2]); x[3] = gelu_tanh(x[3]); v[bj][n] = x; ) )
        } else {
            EPI_ROWS(
                EPI_ALL( f32x4 x = v[bj][n]; x[0] = gelu_tanh(x[0]); x[1] = gelu_tanh(x[1]); x[2] = gelu_tanh(x[2]); x[3] = gelu_tanh(x[3]); v[bj][n] = x; )
                float sm = 0.f;
                EPI_ALL( const f32x4 x = v[bj][n]; sm += (x[0] + x[1]) + (x[2] + x[3]); )
                sm += shx<16>(sm); sm = sum32(sm);
                const float mean = sm * (1.0f / 64.0f); float q = 0.f;
                EPI_ALL( const f32x4 d = v[bj][n] - mean; v[bj][n] = d; q += (d[0] * d[0] + d[1] * d[1]) + (d[2] * d[2] + d[3] * d[3]); )
                q += shx<16>(q); q = sum32(q);
                const float rstd = __builtin_amdgcn_rsqf(q * (1.0f / 64.0f) + LN_EPS);
                EPI_ALL( const f32x4 gg = *(const f32x4*)(gv + wc * 64 + 32 * bj + 8 * fq + 4 * n); const f32x4 bb = *(const f32x4*)(bv + wc * 64 + 32 * bj + 8 * fq + 4 * n); v[bj][n] = v[bj][n] * rstd * gg + bb; )
                asm volatile("" ::: "memory");
            )
        }
#undef EPI_ROWS
#undef EPI_ALL
    }
};
struct EpiRes {
    static constexpr bool PERM = true, AFTER_DRAIN = false;
    const bf16* XB; float* S;
    __device__ __forceinline__ void operator()(const f32x4 (&acc)[2][2][4][2], const Unit& u, int wr, int wc, int fr, int fq) const {
        const int row0 = u.pm * BM + wr * 64 + fr, col0 = u.pn * BM + wc * 32 + 8 * fq;
#pragma unroll
        for (int ai = 0; ai < 2; ++ai)
#pragma unroll
            for (int m = 0; m < 4; ++m) { const size_t ro = (size_t)(row0 + ai * HALF + m * 16) * DM + col0;
#pragma unroll
                for (int bj = 0; bj < 2; ++bj) { const u32x4 xw = *(const u32x4*)(XB + ro + bj * HALF);
                    f32x4 x0, x1; x0[0] = __builtin_bit_cast(float, xw.x << 16); x0[1] = __builtin_bit_cast(float, xw.x & 0xffff0000u); x0[2] = __builtin_bit_cast(float, xw.y << 16); x0[3] = __builtin_bit_cast(float, xw.y & 0xffff0000u);
                    x1[0] = __builtin_bit_cast(float, xw.z << 16); x1[1] = __builtin_bit_cast(float, xw.z & 0xffff0000u); x1[2] = __builtin_bit_cast(float, xw.w << 16); x1[3] = __builtin_bit_cast(float, xw.w & 0xffff0000u);
                    *(f32x4*)(S + ro + bj * HALF) = x0 * DN_ALPHA + acc[ai][bj][m][0]; *(f32x4*)(S + ro + bj * HALF + 4) = x1 * DN_ALPHA + acc[ai][bj][m][1]; } }
    }
};
struct EpiSwiglu {
    static constexpr bool PERM = true, AFTER_DRAIN = false;
    unsigned char* HID;
    __device__ __forceinline__ void operator()(const f32x4 (&acc)[2][2][4][2], const Unit& u, int wr, int wc, int fr, int fq) const {
        const int row0 = u.pm * BM + wr * 64 + fr, col0 = u.pn * 128 + wc * 32 + 8 * fq;
        constexpr float IS = 1.0f / WGU_SCALE, OS = HID_SCALE / WGU_SCALE;
#pragma unroll
        for (int ai = 0; ai < 2; ++ai)
#pragma unroll
            for (int m = 0; m < 4; ++m) { f32x4 o[2];
#pragma unroll
                for (int n = 0; n < 2; ++n) { const f32x4 g = acc[ai][0][m][n] * IS, up = acc[ai][1][m][n] * OS;
#pragma unroll
                    for (int i = 0; i < 4; ++i) o[n][i] = g[i] * __builtin_amdgcn_rcpf(1.0f + __builtin_amdgcn_exp2f(-LOG2E * g[i])) * up[i]; }
                u32x2 w; w.x = pk4_fp8(o[0][0], o[0][1], o[0][2], o[0][3]); w.y = pk4_fp8(o[1][0], o[1][1], o[1][2], o[1][3]);
                *(u32x2*)(HID + (size_t)(row0 + ai * HALF + m * 16) * DEXP + col0) = w; }
    }
};
struct EpiDown {
    static constexpr bool PERM = true, AFTER_DRAIN = false;
    unsigned char* YE; const float* gate;
    __device__ __forceinline__ void operator()(const f32x4 (&acc)[2][2][4][2], const Unit& u, int wr, int wc, int fr, int fq) const {
        const int row0 = u.pm * BM + wr * 64 + fr, col0 = u.pn * BM + wc * 32 + 8 * fq;
#pragma unroll
        for (int ai = 0; ai < 2; ++ai)
#pragma unroll
            for (int m = 0; m < 4; ++m) { const int row = row0 + ai * HALF + m * 16; const float gt = gate[row] * (YE_SCALE / (WD_SCALE * HID_SCALE));
#pragma unroll
                for (int bj = 0; bj < 2; ++bj) { const f32x4 a = acc[ai][bj][m][0] * gt, c = acc[ai][bj][m][1] * gt; u32x2 w; w.x = pk4_fp8(a[0], a[1], a[2], a[3]); w.y = pk4_fp8(c[0], c[1], c[2], c[3]);
                    *(u32x2*)(YE + (size_t)row * DM + col0 + bj * HALF) = w; } }
    }
};

struct Frame {
    LAS unsigned char* lds;
    int tid, lane, wave, vcu, G, gw, NGW;
};

__device__ __forceinline__ void transpose_item(const float* W, int N, int K, bf16* dst_row0, LAS float* scr, int k0, int n0, int lane) {
    float tv[32];
#pragma unroll
    for (int i = 0; i < 32; ++i) tv[i] = __builtin_nontemporal_load(W + (size_t)(k0 + 2 * i + (lane >> 5)) * N + n0 + (lane & 31));
#pragma unroll
    for (int i = 0; i < 32; ++i) scr[(2 * i + (lane >> 5)) * 33 + (lane & 31)] = tv[i];
    asm volatile("s_waitcnt lgkmcnt(0)" ::: "memory");
    const int c = lane & 7;
#pragma unroll
    for (int j = 0; j < 4; ++j) { const int n = (lane >> 3) + 8 * j; const LAS float* s = scr + (8 * c) * 33 + n;
        u32x4 o; o.x = pk2(s[0 * 33], s[1 * 33]); o.y = pk2(s[2 * 33], s[3 * 33]); o.z = pk2(s[4 * 33], s[5 * 33]); o.w = pk2(s[6 * 33], s[7 * 33]);
        *(u32x4*)(dst_row0 + (size_t)n * K + k0 + 8 * c) = o; }
    asm volatile("s_waitcnt lgkmcnt(0)" ::: "memory");
}
__device__ __forceinline__ void transpose_item_fp8(const float* W, int N, int K, unsigned char* dst_row0, LAS float* scr, int k0, int n0, int lane, float sc) {
    float tv[32];
#pragma unroll
    for (int i = 0; i < 32; ++i) tv[i] = __builtin_nontemporal_load(W + (size_t)(k0 + 2 * i + (lane >> 5)) * N + n0 + (lane & 31));
#pragma unroll
    for (int i = 0; i < 32; ++i) scr[(2 * i + (lane >> 5)) * 33 + (lane & 31)] = tv[i];
    asm volatile("s_waitcnt lgkmcnt(0)" ::: "memory");
    const int c = lane & 7;
#pragma unroll
    for (int j = 0; j < 4; ++j) { const int n = (lane >> 3) + 8 * j; const LAS float* s = scr + (8 * c) * 33 + n;
        u32x2 o; o.x = pk4_fp8(s[0 * 33] * sc, s[1 * 33] * sc, s[2 * 33] * sc, s[3 * 33] * sc); o.y = pk4_fp8(s[4 * 33] * sc, s[5 * 33] * sc, s[6 * 33] * sc, s[7 * 33] * sc);
        *(u32x2*)(dst_row0 + (size_t)n * K + k0 + 8 * c) = o; }
    asm volatile("s_waitcnt lgkmcnt(0)" ::: "memory");
}
__device__ __forceinline__ void conv_phase(Frame& F, int l, const float* w_in, const float* w_out, const float* w_gate, const float* w_up, const float* w_down, const float* sg_w, unsigned char* ws0, int it_lo, int it_hi, int vgw, int vngw, bool tail) {
    unsigned char* ws = ws0 + wset(l);
    LAS float* scr = (LAS float*)(F.lds + F.wave * 16384);
    bf16* WIN = (bf16*)(ws + WS_WIN); bf16* WOUT = (bf16*)(ws + WS_WOUT); unsigned char* WGU = ws + WS_WGU; unsigned char* WD = ws + WS_WD; bf16* WSB = (bf16*)(ws + WS_WSBF);
    constexpr int I_IN = 16 * 64, I_OUT = 16 * 32, I_G = 16 * 1024, I_D = 16 * 1024, NIT = I_IN + I_OUT + 2 * I_G + I_D;
    if (it_hi > NIT) it_hi = NIT;
    for (int it = it_lo + vgw; it < it_hi; it += vngw) {
        int r = it;
        if (r < I_IN) { const int kb = r >> 6, nb = r & 63, n0 = 32 * nb; const int pn = n0 >> 8, c = n0 & 255, wc = c >> 6, bj = (c >> 5) & 1;
            transpose_item(w_in + (size_t)l * DM * DIN, DIN, DM, WIN + (size_t)(256 * pn + 128 * bj + 32 * wc) * DM, scr, 64 * kb, n0, F.lane); continue; }
        r -= I_IN;
        if (r < I_OUT) { const int kb = r >> 5, nb = r & 31, n0 = 32 * nb;
            transpose_item(w_out + (size_t)l * DM * DM, DM, DM, WOUT + (size_t)n0 * DM, scr, 64 * kb, n0, F.lane); continue; }
        r -= I_OUT;
        if (r < 2 * I_G) { const int which = r >= I_G; if (which) r -= I_G; const int e = r >> 10, kb = (r >> 6) & 15, nb = r & 63, n0 = 32 * nb;
            const float* W = (which ? w_up : w_gate) + ((size_t)l * NEXP + e) * DM * DEXP;
            transpose_item_fp8(W, DEXP, DM, WGU + ((size_t)e * 4096 + (n0 >> 7) * 256 + which * 128 + (n0 & 127)) * DM, scr, 64 * kb, n0, F.lane, WGU_SCALE); continue; }
        r -= 2 * I_G;
        { const int e = r >> 10, kb = (r >> 5) & 31, nb = r & 31, n0 = 32 * nb;
            transpose_item_fp8(w_down + ((size_t)l * NEXP + e) * DEXP * DM, DM, DEXP, WD + ((size_t)e * DM + n0) * DEXP, scr, 64 * kb, n0, F.lane, WD_SCALE); }
    }
    if (tail) { const float* sw = sg_w + (size_t)l * 4 * 128 * 128;
        for (int i = vgw * 64 + F.lane; i < 4 * 128 * 128; i += vngw * 64) WSB[i] = (bf16)f2bf(sw[i]); }
}

__device__ __forceinline__ void row_ln(f32x4 (&v)[4], const float* g, const float* b, int lane) {
    float s = 0.f;
#pragma unroll
    for (int j = 0; j < 4; ++j) s += (v[j][0] + v[j][1]) + (v[j][2] + v[j][3]);
    const float mean = wave_sum(s) * (1.f / DM); float s2 = 0.f;
#pragma unroll
    for (int j = 0; j < 4; ++j) { v[j] = v[j] - mean; s2 += (v[j][0] * v[j][0] + v[j][1] * v[j][1]) + (v[j][2] * v[j][2] + v[j][3] * v[j][3]); }
    const float rstd = 1.f / sqrtf(wave_sum(s2) * (1.f / DM) + LN_EPS);
#pragma unroll
    for (int j = 0; j < 4; ++j) { const f32x4 gg = *(const f32x4*)(g + 4 * lane + 256 * j), bb = *(const f32x4*)(b + 4 * lane + 256 * j); v[j] = v[j] * rstd * gg + bb; }
}
__device__ __forceinline__ void row_ln_stats(f32x4 (&v)[4], const float* g, const float* b, int lane, float& mean_o, float& rstd_o) {
    float s = 0.f;
#pragma unroll
    for (int j = 0; j < 4; ++j) s += (v[j][0] + v[j][1]) + (v[j][2] + v[j][3]);
    const float mean = wave_sum(s) * (1.f / DM); float s2 = 0.f;
#pragma unroll
    for (int j = 0; j < 4; ++j) { v[j] = v[j] - mean; s2 += (v[j][0] * v[j][0] + v[j][1] * v[j][1]) + (v[j][2] * v[j][2] + v[j][3] * v[j][3]); }
    const float rstd = 1.f / sqrtf(wave_sum(s2) * (1.f / DM) + LN_EPS);
#pragma unroll
    for (int j = 0; j < 4; ++j) { const f32x4 gg = *(const f32x4*)(g + 4 * lane + 256 * j), bb = *(const f32x4*)(b + 4 * lane + 256 * j); v[j] = v[j] * rstd * gg + bb; }
    mean_o = mean; rstd_o = rstd;
}
__device__ __forceinline__ void store_row(const f32x4 (&v)[4], float* xrow, bf16* xbrow, int lane) {
#pragma unroll
    for (int j = 0; j < 4; ++j) { *(f32x4*)(xrow + 4 * lane + 256 * j) = v[j]; u32x2 w; w.x = pk2(v[j][0], v[j][1]); w.y = pk2(v[j][2], v[j][3]); *(u32x2*)(xbrow + 4 * lane + 256 * j) = w; }
}

__device__ __forceinline__ void store_row_bf(const f32x4 (&v)[4], bf16* xbrow, int lane) {
#pragma unroll
    for (int j = 0; j < 4; ++j) { u32x2 w; w.x = pk2(v[j][0], v[j][1]); w.y = pk2(v[j][2], v[j][3]); *(u32x2*)(xbrow + 4 * lane + 256 * j) = w; }
}
__device__ __forceinline__ void prologue_phase(Frame& F, const float* xp, const float* xs, const float* g, const float* b, float* X, unsigned char* ws) {
    float* rope = (float*)(ws + WS_ROPE);
    for (int i = F.gw * 64 + F.lane; i < SEQ * 32; i += F.NGW * 64) {
        const int s = i >> 5, p = i & 31, fi = p & 15; const float pos = (float)((p < 16) ? (s >> 6) : (s & 63));
        const float inv = powf(10000.0f, -(float)fi / 16.0f); const float ang = pos * inv;
        rope[2 * i] = cosf(ang); rope[2 * i + 1] = sinf(ang);
    }
    bf16* XB = (bf16*)(ws + WS_XB);
    for (int m = F.gw; m < TT; m += F.NGW) {
        const float* src = (m < T_P) ? xp + (size_t)m * DM : xs + (size_t)(m - T_P) * DM;
        f32x4 v[4];
#pragma unroll
        for (int j = 0; j < 4; ++j) v[j] = *(const f32x4*)(src + 4 * F.lane + 256 * j);
        row_ln(v, g, b, F.lane);
        store_row_bf(v, XB + (size_t)m * DM, F.lane);
    }
}

__device__ __forceinline__ float router_reduce(float (&lg)[16], int lane) {
    float r8[8], r4[4], r2[2], r1;
    const bool b5 = lane & 32, b4 = lane & 16, b3 = lane & 8, b2 = lane & 4;
#pragma unroll
    for (int i = 0; i < 8; ++i) { const float snd = b5 ? lg[i] : lg[i + 8], kp = b5 ? lg[i + 8] : lg[i]; r8[i] = kp + other32(snd, b5); }
#pragma unroll
    for (int i = 0; i < 4; ++i) { const float snd = b4 ? r8[i] : r8[i + 4], kp = b4 ? r8[i + 4] : r8[i]; r4[i] = kp + shx<16>(snd); }
#pragma unroll
    for (int i = 0; i < 2; ++i) { const float snd = b3 ? r4[i] : r4[i + 2], kp = b3 ? r4[i + 2] : r4[i]; r2[i] = kp + shx<8>(snd); }
    { const float snd = b2 ? r2[0] : r2[1], kp = b2 ? r2[1] : r2[0]; r1 = kp + shx<4>(snd); }
    r1 += shx<1>(r1); r1 += shx<2>(r1);
    float mx = r1;
    mx = fmaxf(mx, shx<4>(mx)); mx = fmaxf(mx, shx<8>(mx)); mx = fmaxf(mx, shx<16>(mx)); mx = max32(mx);
    const float ex = expf(r1 - mx); float sm = ex;
    sm += shx<4>(sm); sm += shx<8>(sm); sm += shx<16>(sm); sm = sum32(sm);
    return ex / sm;
}
template <bool DRY> __device__ __forceinline__ void ln1_router_phase(Frame& F, float* X, const float* g, const float* b, const float* wr, unsigned char* ws) {
    constexpr int NR = LN1_ROWS;
    LAS float* wl = (LAS float*)F.lds;
    for (int i = F.tid; i < DM * NEXP; i += NWAVES * 64) wl[(i & 15) * DM + (i >> 4)] = wr[i];
    __syncthreads();
    unsigned char* XB8 = ws + (DRY ? WS_DUMMY + 400 * MiB : WS_XB8); float* AFF = (float*)(ws + (DRY ? WS_DUMMY + 500 * MiB : WS_AFF)); float* ST = (float*)(ws + (DRY ? WS_DUMMY : WS_STATS));
    const int lane = F.lane, e_mine = ((lane >> 5) & 1) * 8 + ((lane >> 4) & 1) * 4 + ((lane >> 3) & 1) * 2 + ((lane >> 2) & 1);
    int m = NR * F.gw;
    f32x4 nx[NR][4];
#pragma unroll
    for (int r = 0; r < NR; ++r)
#pragma unroll
        for (int j = 0; j < 4; ++j) nx[r][j] = (f32x4){0.f, 0.f, 0.f, 0.f};
    if (m < TT) {
#pragma unroll
        for (int r = 0; r < NR; ++r)
#pragma unroll
            for (int j = 0; j < 4; ++j) nx[r][j] = *(const f32x4*)(X + (size_t)(m + r) * DM + 4 * lane + 256 * j); }
    for (; m < TT; m += NR * F.NGW) {
        f32x4 v[NR][4];
#pragma unroll
        for (int r = 0; r < NR; ++r)
#pragma unroll
            for (int j = 0; j < 4; ++j) v[r][j] = nx[r][j];
        { const int mn = m + NR * F.NGW;
          if (mn < TT) {
#pragma unroll
            for (int r = 0; r < NR; ++r)
#pragma unroll
                for (int j = 0; j < 4; ++j) nx[r][j] = *(const f32x4*)(X + (size_t)(mn + r) * DM + 4 * lane + 256 * j); } }
        float mu[NR], rs[NR];
#pragma unroll
        for (int r = 0; r < NR; ++r) row_ln_stats(v[r], g, b, lane, mu[r], rs[r]);
        if (lane == 0) {
#pragma unroll
            for (int r = 0; r < NR; r += 2) { f32x4 st; st[0] = mu[r]; st[1] = rs[r]; st[2] = mu[r + 1]; st[3] = rs[r + 1]; *(f32x4*)(ST + (size_t)(m + r) * 2) = st; } }
#pragma unroll
        for (int r = 0; r < NR; ++r)
#pragma unroll
            for (int j = 0; j < 4; ++j) *(unsigned*)(XB8 + (size_t)(m + r) * DM + 4 * lane + 256 * j) = pk4_fp8(v[r][j][0], v[r][j][1], v[r][j][2], v[r][j][3]);
        float lg[NR][16];
#pragma unroll
        for (int e = 0; e < 16; ++e) { f32x4 a[NR];
#pragma unroll
            for (int r = 0; r < NR; ++r) a[r] = (f32x4){0.f, 0.f, 0.f, 0.f};
#pragma unroll
            for (int j = 0; j < 4; ++j) { const f32x4 w = *(const LAS f32x4*)(wl + e * DM + 4 * lane + 256 * j);
#pragma unroll
                for (int r = 0; r < NR; ++r) a[r] += v[r][j] * w; }
#pragma unroll
            for (int r = 0; r < NR; ++r) lg[r][e] = (a[r][0] + a[r][1]) + (a[r][2] + a[r][3]);
            if ((e & 3) == 3) asm volatile("" ::: "memory"); }
        float af[NR];
#pragma unroll
        for (int r = 0; r < NR; ++r) af[r] = router_reduce(lg[r], lane);
        if ((lane & 3) == 0) { const size_t off = (m < T_P) ? (size_t)e_mine * T_P + m : (size_t)16 * T_P + (size_t)e_mine * T_S + (m - T_P);
#pragma unroll
            for (int r = 0; r < NR; ++r) AFF[off + r] = af[r]; }
    }
    __syncthreads();
}

constexpr int TK_COPIES = 8, TK_STRIDE = 2048;
template <int NB>
__device__ __forceinline__ void bin_search(LAS unsigned* hist, LAS unsigned* wtot, LAS unsigned* res, unsigned remaining, int tid, int lane, int wave, unsigned& bin, unsigned& rem_out) {
    constexpr int BPT = NB / 512;
    unsigned hb[BPT]; unsigned own = 0;
#pragma unroll
    for (int k = 0; k < BPT; ++k) { unsigned a = 0;
#pragma unroll
        for (int c = 0; c < TK_COPIES; ++c) a += hist[c * TK_STRIDE + tid * BPT + k];
        hb[k] = a; own += a; }
    unsigned x = own;
#pragma unroll
    for (int o = 1; o < 64; o <<= 1) { const unsigned y = (unsigned)__builtin_amdgcn_ds_bpermute((lane + o) << 2, (int)x); if (lane + o < 64) x += y; }
    if (lane == 0) wtot[wave] = x;
    __syncthreads();
    unsigned above = 0;
#pragma unroll
    for (int w = 0; w < 8; ++w) above += (w > wave) ? wtot[w] : 0u;
    const unsigned suf_incl = x + above, suf_excl = suf_incl - own;
    if (suf_excl < remaining && remaining <= suf_incl) {
        unsigned c = suf_excl; bool done = false;
#pragma unroll
        for (int k = BPT - 1; k >= 0; --k) { if (!done && c + hb[k] >= remaining) { res[0] = (unsigned)(tid * BPT + k); res[1] = remaining - c; done = true; } c += hb[k]; }
    }
    __syncthreads();
    bin = res[0]; rem_out = res[1];
    __syncthreads();
}
template <int NPT>
__device__ __forceinline__ void topk_block(Frame& F, const unsigned* vals, int cap, int slotbase, int tokbase, int e, unsigned char* ws) {
    LAS unsigned* hist = (LAS unsigned*)F.lds; LAS unsigned* wtot = hist + TK_COPIES * TK_STRIDE; LAS unsigned* res = wtot + 16;
    const int base = F.wave * (NPT * 64) + F.lane;
    unsigned v[NPT];
#pragma unroll
    for (int j = 0; j < NPT; ++j) v[j] = vals[base + j * 64];
    LAS unsigned* hc = hist + (F.lane & 7) * TK_STRIDE;
    unsigned remaining = (unsigned)cap, prefix = 0, bin;
#define TK_ZERO() do { for (int i = F.tid; i < TK_COPIES * TK_STRIDE; i += 512) hist[i] = 0u; __syncthreads(); } while (0)
#define TK_ADD(idx) (void)__hip_atomic_fetch_add(&hc[(idx)], 1u, __ATOMIC_RELAXED, __HIP_MEMORY_SCOPE_WORKGROUP)
    TK_ZERO();
#pragma unroll
    for (int j = 0; j < NPT; ++j) { unsigned vv = v[j]; asm volatile("" : "+v"(vv) :: "memory"); TK_ADD(vv >> 21); }
    __syncthreads();
    bin_search<2048>(hist, wtot, res, remaining, F.tid, F.lane, F.wave, bin, remaining); prefix = bin;
    TK_ZERO();
#pragma unroll
    for (int j = 0; j < NPT; ++j) { unsigned vv = v[j]; asm volatile("" : "+v"(vv) :: "memory"); if ((vv >> 21) == prefix) TK_ADD((vv >> 10) & 2047u); }
    __syncthreads();
    bin_search<2048>(hist, wtot, res, remaining, F.tid, F.lane, F.wave, bin, remaining); prefix = (prefix << 11) | bin;
    TK_ZERO();
#pragma unroll
    for (int j = 0; j < NPT; ++j) { unsigned vv = v[j]; asm volatile("" : "+v"(vv) :: "memory"); if ((vv >> 10) == prefix) TK_ADD(vv & 1023u); }
    __syncthreads();
    bin_search<1024>(hist, wtot, res, remaining, F.tid, F.lane, F.wave, bin, remaining);
#undef TK_ZERO
#undef TK_ADD
    const unsigned thr = (prefix << 10) | bin, need_eq = remaining;
    unsigned cg = 0, ce = 0;
#pragma unroll
    for (int j = 0; j < NPT; ++j) { unsigned vv = v[j]; asm volatile("" : "+v"(vv)); cg += (unsigned)__popcll(__ballot(vv > thr)); ce += (unsigned)__popcll(__ballot(vv == thr)); asm volatile("" : "+v"(cg), "+v"(ce)); }
    if (F.lane == 0) { wtot[F.wave] = cg; wtot[8 + F.wave] = ce; }
    __syncthreads();
    unsigned run_gt = 0, run_eq = 0;
#pragma unroll
    for (int w = 0; w < 8; ++w) { run_gt += (w < F.wave) ? wtot[w] : 0u; run_eq += (w < F.wave) ? wtot[8 + w] : 0u; }
    int* IDX = (int*)(ws + WS_IDX); float* GATE = (float*)(ws + WS_GATE); int* SLOTOF = (int*)(ws + WS_SLOTOF);
    const unsigned long long ltmask = (1ull << F.lane) - 1ull;
#pragma unroll
    for (int j = 0; j < NPT; ++j) {
        unsigned vv = v[j]; asm volatile("" : "+v"(vv));
        const bool gt = vv > thr, eq = vv == thr;
        const unsigned long long bg = __ballot(gt), be = __ballot(eq);
        const unsigned gb = (unsigned)__popcll(bg & ltmask), eb = (unsigned)__popcll(be & ltmask);
        const unsigned eq_rank = run_eq + eb;
        const bool sel = gt || (eq && eq_rank < need_eq);
        const unsigned slot = run_gt + gb + (eq_rank < need_eq ? eq_rank : need_eq);
        const int tok = tokbase + base + j * 64;
        if (sel) { IDX[slotbase + slot] = tok; GATE[slotbase + slot] = __builtin_bit_cast(float, vv); }
        SLOTOF[(size_t)e * TT + tok] = sel ? (int)(slotbase + slot) : -1;
        run_gt += (unsigned)__popcll(bg); run_eq += (unsigned)__popcll(be); asm volatile("" : "+v"(run_gt), "+v"(run_eq));
    }
    __syncthreads();
}
__device__ __forceinline__ void topk_phase(Frame& F, unsigned char* ws) {
    if (blockIdx.x >= 32) return;
    const int g = blockIdx.x >> 4, e = blockIdx.x & 15;
    const unsigned* aff = (const unsigned*)(ws + WS_AFF);
    if (g == 0) topk_block<T_P / 512>(F, aff + (size_t)e * T_P, CAP_P, e * CAP_P, 0, e, ws);
    else        topk_block<T_S / 512>(F, aff + (size_t)16 * T_P + (size_t)e * T_S, CAP_S, ROWS_P + e * CAP_S, T_P, e, ws);
}

__device__ __forceinline__ void gather_phase(Frame& F, unsigned char* ws) {
    const int* IDX = (const int*)(ws + WS_IDX); const unsigned char* XB8 = ws + WS_XB8; unsigned char* XE = ws + WS_H;
    for (int r = F.gw; r < ROWS_E; r += F.NGW) { const int tok = IDX[r];
        *(u32x4*)(XE + (size_t)r * DM + 16 * F.lane) = *(const u32x4*)(XB8 + (size_t)tok * DM + 16 * F.lane); }
}

template <bool DRY> __device__ __forceinline__ void combine_phase(Frame& F, float* X, const float* g1, const float* b1, const float* g, const float* b, unsigned char* ws, bool last_layer) {
    const int* SLOTOF = (const int*)(ws + WS_SLOTOF); const unsigned char* YE = ws + WS_H; bf16* XB = (bf16*)(ws + (DRY ? WS_DUMMY + 400 * MiB : WS_XB)); float* Xo = DRY ? (float*)(ws + WS_DUMMY) : X;
    const int lane = F.lane;
    int m = 2 * F.gw;
    int so_n = (m < TT) ? SLOTOF[(size_t)(lane & 15) * TT + m + ((lane >> 4) & 1)] : -1;
    for (; m < TT; m += 2 * F.NGW) {
        const int so = so_n; const int mn = m + 2 * F.NGW;
        so_n = (mn < TT) ? SLOTOF[(size_t)(lane & 15) * TT + mn + ((lane >> 4) & 1)] : -1;
        f32x4 v0[4], v1[4];
#pragma unroll
        for (int j = 0; j < 4; ++j) { v0[j] = *(const f32x4*)(X + (size_t)m * DM + 4 * lane + 256 * j); v1[j] = *(const f32x4*)(X + (size_t)(m + 1) * DM + 4 * lane + 256 * j); }
        { const f32x4 st = *(const f32x4*)((const float*)(ws + WS_STATS) + (size_t)m * 2);
#pragma unroll
          for (int j = 0; j < 4; ++j) { const f32x4 gg = *(const f32x4*)(g1 + 4 * lane + 256 * j) * DN_ALPHA, bb = *(const f32x4*)(b1 + 4 * lane + 256 * j) * DN_ALPHA;
              v0[j] = (v0[j] - st[0]) * st[1] * gg + bb; v1[j] = (v1[j] - st[2]) * st[3] * gg + bb; } }
        constexpr int CK = 4;
        unsigned m0 = (unsigned)__ballot(so >= 0); unsigned m1 = (m0 >> 16) & 0xffffu; m0 &= 0xffffu;
        unsigned w0[CK][4], w1[CK][4]; float f0[CK], f1[CK];
#pragma unroll
        for (int k = 0; k < CK; ++k) {
            const int e0 = m0 ? __builtin_ctz(m0) : 0, e1 = m1 ? __builtin_ctz(m1) : 0;
            const int sl0 = __builtin_amdgcn_readlane(so, e0), sl1 = __builtin_amdgcn_readlane(so, 16 + e1);
            const size_t r0 = (size_t)(m0 ? sl0 : 0) * DM, r1 = (size_t)(m1 ? sl1 : 0) * DM;
            f0[k] = m0 ? (1.0f / YE_SCALE) : 0.f; f1[k] = m1 ? (1.0f / YE_SCALE) : 0.f;
#pragma unroll
            for (int j = 0; j < 4; ++j) { w0[k][j] = *(const unsigned*)(YE + r0 + 4 * lane + 256 * j); w1[k][j] = *(const unsigned*)(YE + r1 + 4 * lane + 256 * j); }
            m0 &= m0 - 1; m1 &= m1 - 1;
        }
#pragma unroll
        for (int k = 0; k < CK; ++k)
#pragma unroll
            for (int j = 0; j < 4; ++j) {
                { const f32x2v lo = __builtin_amdgcn_cvt_pk_f32_fp8((int)w0[k][j], false), hi = __builtin_amdgcn_cvt_pk_f32_fp8((int)w0[k][j], true);
                  v0[j][0] += lo[0] * f0[k]; v0[j][1] += lo[1] * f0[k]; v0[j][2] += hi[0] * f0[k]; v0[j][3] += hi[1] * f0[k]; }
                { const f32x2v lo = __builtin_amdgcn_cvt_pk_f32_fp8((int)w1[k][j], false), hi = __builtin_amdgcn_cvt_pk_f32_fp8((int)w1[k][j], true);
                  v1[j][0] += lo[0] * f1[k]; v1[j][1] += lo[1] * f1[k]; v1[j][2] += hi[0] * f1[k]; v1[j][3] += hi[1] * f1[k]; }
            }
        while (m0) { const int sl = __builtin_amdgcn_readlane(so, __builtin_ctz(m0)); m0 &= m0 - 1;
#pragma unroll
            for (int j = 0; j < 4; ++j) { const unsigned w = *(const unsigned*)(YE + (size_t)sl * DM + 4 * lane + 256 * j);
                const f32x2v lo = __builtin_amdgcn_cvt_pk_f32_fp8((int)w, false), hi = __builtin_amdgcn_cvt_pk_f32_fp8((int)w, true);
                v0[j][0] += lo[0] * (1.0f / YE_SCALE); v0[j][1] += lo[1] * (1.0f / YE_SCALE); v0[j][2] += hi[0] * (1.0f / YE_SCALE); v0[j][3] += hi[1] * (1.0f / YE_SCALE); } }
        while (m1) { const int sl = __builtin_amdgcn_readlane(so, 16 + __builtin_ctz(m1)); m1 &= m1 - 1;
#pragma unroll
            for (int j = 0; j < 4; ++j) { const unsigned w = *(const unsigned*)(YE + (size_t)sl * DM + 4 * lane + 256 * j);
                const f32x2v lo = __builtin_amdgcn_cvt_pk_f32_fp8((int)w, false), hi = __builtin_amdgcn_cvt_pk_f32_fp8((int)w, true);
                v1[j][0] += lo[0] * (1.0f / YE_SCALE); v1[j][1] += lo[1] * (1.0f / YE_SCALE); v1[j][2] += hi[0] * (1.0f / YE_SCALE); v1[j][3] += hi[1] * (1.0f / YE_SCALE); } }
        row_ln(v0, g, b, lane); row_ln(v1, g, b, lane);
        if (last_layer) {
#pragma unroll
            for (int j = 0; j < 4; ++j) { *(f32x4*)(Xo + (size_t)m * DM + 4 * lane + 256 * j) = v0[j]; *(f32x4*)(Xo + (size_t)(m + 1) * DM + 4 * lane + 256 * j) = v1[j]; }
        } else { store_row_bf(v0, XB + (size_t)m * DM, lane); store_row_bf(v1, XB + (size_t)(m + 1) * DM, lane); }
    }
}

template <bool NA>
__device__ __forceinline__ void attn_wave(const bf16* __restrict__ Qb, const bf16* __restrict__ Kb, const bf16* __restrict__ Vb, bf16* __restrict__ Ob, int ntiles,
                                          LAS unsigned char* wl, const LAS float* rpbh, int rr, int rs, int qh, int lane) {
    const int r = lane & 31, h = lane >> 5;
    bf16x8 qf[4];
#pragma unroll
    for (int d0 = 0; d0 < 4; ++d0) qf[d0] = *(const bf16x8*)(Qb + (size_t)r * DIN + 16 * d0 + 8 * h);
    f32x16 o0, o1;
#pragma unroll
    for (int i = 0; i < 16; ++i) { o0[i] = 0.f; o1[i] = 0.f; }
    float m = -1e30f, l = 0.f;
    LAS unsigned char* vl = wl; LAS float* wsf = (LAS float*)(wl + 4608);
    const bf16* vsrc = Vb + (size_t)(lane >> 3) * DIN + 8 * (lane & 7);
    const bf16* ksrc = Kb + (size_t)r * DIN + 8 * h;
    const int vwoff = (lane >> 3) * 144 + (lane & 7) * 16;
    const int i16 = lane & 15, tq = i16 >> 2, tp = i16 & 3, blk = (lane >> 4) & 1;
    const int troff = (4 * h + tq) * 144 + (16 * blk + 4 * tp) * 2;
    const int qc = 32 * qh + r; const int cs = qc - 8 < 0 ? 0 : (qc - 8 > 48 ? 48 : qc - 8);
    for (int t = 0; t < ntiles; ++t) {
        const size_t ko = (size_t)(32 * t) * DIN;
        bf16x8 kf[4];
#pragma unroll
        for (int d0 = 0; d0 < 4; ++d0) kf[d0] = *(const bf16x8*)(ksrc + ko + 16 * d0);
        u32x4 vr[4];
#pragma unroll
        for (int i = 0; i < 4; ++i) vr[i] = *(const u32x4*)(vsrc + ko + (size_t)(8 * i) * DIN);
        f32x16 s;
#pragma unroll
        for (int i = 0; i < 16; ++i) s[i] = 0.f;
#pragma unroll
        for (int d0 = 0; d0 < 4; ++d0) s = MFMA32(kf[d0], qf[d0], s);
        unsigned okm = 0xffffu;
        if (NA) {
            okm = 0u; const int kr = rs + (t >> 1), kh = t & 1, brow = (kr - rr + 7) * 31;
#pragma unroll
            for (int i = 0; i < 16; ++i) { const int kc = 32 * kh + crow(i, h); const bool ok = (kc >= cs) && (kc < cs + 16); const int idx = ok ? brow + kc - qc + 15 : 0;
                const float bia = rpbh[idx]; s[i] = ok ? s[i] + bia : -1e30f; okm |= ok ? (1u << i) : 0u; }
        }
        float mx = s[0];
#pragma unroll
        for (int i = 1; i < 16; ++i) mx = fmaxf(mx, s[i]);
        mx = max32(mx);
        const float mn = fmaxf(m, mx), alpha = __builtin_amdgcn_exp2f(m - mn); m = mn;
        float rsum = 0.f;
#pragma unroll
        for (int i = 0; i < 16; ++i) { float p = __builtin_amdgcn_exp2f(s[i] - mn); if (NA) p = ((okm >> i) & 1u) ? p : 0.f; s[i] = p; rsum += p; }
        l = l * alpha + rsum;
#pragma unroll
        for (int i = 0; i < 4; ++i) *(LAS u32x4*)(vl + vwoff + i * 8 * 144) = vr[i];
        if (h == 0) wsf[r] = alpha;
        asm volatile("s_waitcnt lgkmcnt(0)" ::: "memory");
#pragma unroll
        for (int g4 = 0; g4 < 4; ++g4) { const f32x4 a4 = *(const LAS f32x4*)(wsf + 8 * g4 + 4 * h);
#pragma unroll
            for (int j = 0; j < 4; ++j) { o0[4 * g4 + j] *= a4[j]; o1[4 * g4 + j] *= a4[j]; } }
        u32x4 pw0, pw1;
        pw0.x = pg8::cvt_pk_bf16(s[0], s[1]); pw0.y = pg8::cvt_pk_bf16(s[2], s[3]); pw0.z = pg8::cvt_pk_bf16(s[4], s[5]); pw0.w = pg8::cvt_pk_bf16(s[6], s[7]);
        pw1.x = pg8::cvt_pk_bf16(s[8], s[9]); pw1.y = pg8::cvt_pk_bf16(s[10], s[11]); pw1.z = pg8::cvt_pk_bf16(s[12], s[13]); pw1.w = pg8::cvt_pk_bf16(s[14], s[15]);
        const bf16x8 pa0 = __builtin_bit_cast(bf16x8, pw0), pa1 = __builtin_bit_cast(bf16x8, pw1);
#pragma unroll
        for (int sp = 0; sp < 2; ++sp) {
#pragma unroll
            for (int db = 0; db < 2; ++db) {
                const s16x4 lo = tr_read(vl + troff + (16 * sp) * 144 + 64 * db), hi = tr_read(vl + troff + (16 * sp + 8) * 144 + 64 * db);
                const bf16x8 bfr = __builtin_shufflevector(lo, hi, 0, 1, 2, 3, 4, 5, 6, 7);
                if (db == 0) o0 = MFMA32(sp ? pa1 : pa0, bfr, o0); else o1 = MFMA32(sp ? pa1 : pa0, bfr, o1);
            }
        }
        asm volatile("s_waitcnt lgkmcnt(0)" ::: "memory");
    }
    l = sum32(l);
    if (h == 0) wsf[32 + r] = l;
    asm volatile("s_waitcnt lgkmcnt(0)" ::: "memory");
#pragma unroll
    for (int i = 0; i < 16; ++i) { const int q = crow(i, h); const float rl = 1.0f / wsf[32 + q];
        Ob[(size_t)q * DM + r] = (bf16)f2bf(o0[i] * rl); Ob[(size_t)q * DM + 32 + r] = (bf16)f2bf(o1[i] * rl); }
    asm volatile("s_waitcnt lgkmcnt(0)" ::: "memory");
}

__device__ __forceinline__ void sgu_part(Frame& F, int l, const float* sg_b, unsigned char* ws) {
    const bf16* H = (const bf16*)(ws + WS_H); bf16* Y = (bf16*)(ws + WS_HID); const bf16* WSB = (const bf16*)(ws + wset(l) + WS_WSBF);
    const int lane = F.lane, r = lane & 31, h = lane >> 5;
    LAS unsigned char* vnl = F.lds;
    const int pt = F.wave >> 1, ct = F.wave & 1;
    const int i16 = lane & 15, tq = i16 >> 2, tp = i16 & 3, blk = (lane >> 4) & 1;
    u32x4 stg[2];
    { const int u = F.vcu; if (u < NBATCH * 32 * 4) { const int g = u & 3, ch = (u >> 2) & 31, b = u >> 7; const size_t tok0 = (size_t)b * SEQ + ch * 128;
#pragma unroll
        for (int i = 0; i < 2; ++i) { const int idx = F.tid + 512 * i, row = idx >> 3, chunk = idx & 7; stg[i] = *(const u32x4*)(H + (tok0 + row) * DIN + H_VC + 64 * g + 8 * chunk); } } }
    for (int u = F.vcu; u < NBATCH * 32 * 4; u += F.G) {
        const int g = u & 3, ch = (u >> 2) & 31, b = u >> 7; const size_t tok0 = (size_t)b * SEQ + ch * 128;
#pragma unroll
        for (int i = 0; i < 2; ++i) { const int idx = F.tid + 512 * i, row = idx >> 3, chunk = idx & 7; *(LAS u32x4*)(vnl + row * 144 + chunk * 16) = stg[i]; }
        __syncthreads();
        { const int un = u + F.G; if (un < NBATCH * 32 * 4) { const int gn = un & 3, chn = (un >> 2) & 31, bn = un >> 7; const size_t tokn = (size_t)bn * SEQ + chn * 128;
#pragma unroll
            for (int i = 0; i < 2; ++i) { const int idx = F.tid + 512 * i, row = idx >> 3, chunk = idx & 7; stg[i] = *(const u32x4*)(H + (tokn + row) * DIN + H_VC + 64 * gn + 8 * chunk); } } }
        unsigned short uu[16];
#pragma unroll
        for (int i = 0; i < 16; ++i) uu[i] = H[(tok0 + 32 * pt + crow(i, h)) * DIN + H_UC + 64 * g + 32 * ct + r];
        f32x16 z;
#pragma unroll
        for (int i = 0; i < 16; ++i) z[i] = 0.f;
#pragma unroll
        for (int s = 0; s < 8; ++s) {
            const bf16x8 a = *(const bf16x8*)(WSB + ((size_t)(g * 128 + 32 * pt + r) * 128 + 16 * s + 8 * h));
            const s16x4 lo = tr_read(vnl + (16 * s + 8 * h + tq) * 144 + (32 * ct + 16 * blk + 4 * tp) * 2), hi = tr_read(vnl + (16 * s + 8 * h + 4 + tq) * 144 + (32 * ct + 16 * blk + 4 * tp) * 2);
            z = MFMA32(a, __builtin_shufflevector(lo, hi, 0, 1, 2, 3, 4, 5, 6, 7), z);
        }
        const float* bs = sg_b + ((size_t)l * 4 + g) * 128;
#pragma unroll
        for (int i = 0; i < 16; ++i) { const int pp = 32 * pt + crow(i, h); const size_t tok = tok0 + pp; const int c = 32 * ct + r;
            Y[tok * DM + Y_SG + 64 * g + c] = (bf16)f2bf(bf2f(uu[i]) * (z[i] + bs[pp])); }
        __syncthreads();
    }
}
__device__ __forceinline__ void gqa_part(int vcu, int G, char* lds, unsigned char* ws, const float* qn, const float* kn) {
    const bf16* H = (const bf16*)(ws + WS_H); bf16* Y = (bf16*)(ws + WS_HID);
    float gq = 0.f, gk = 0.f;
    for (int i = 0; i < 64; ++i) { gq = fmaxf(gq, fabsf(qn[i])); gk = fmaxf(gk, fabsf(kn[i])); }
    const bool nomax = (64.0f * C2 * gq * gk) * 1.02f <= 40.0f;
    if (nomax) {
        for (int id = vcu; id < NBATCH * 8 * 16; id += G) {
            const int qb = id & 15, hg = (id >> 4) & 3, kvh = (id >> 6) & 1, b = id >> 7, hq = kvh * 4 + hg;
            const size_t t0 = (size_t)b * SEQ;
            attn_body::attn_unit<8, true, GQA_MSUM>((const attn_body::bf16*)(H + (t0 + 256 * qb) * DIN + H_GQ + 64 * hq), (const attn_body::bf16*)(H + t0 * DIN + H_GK + 64 * kvh),
                                          (const attn_body::bf16*)(H + t0 * DIN + H_GV + 64 * kvh), (attn_body::bf16*)(Y + (t0 + 256 * qb) * DM + Y_GQA + 64 * hq), lds);
        }
    } else {
        for (int id = vcu; id < NBATCH * 8 * 16; id += G) {
            const int qb = id & 15, hg = (id >> 4) & 3, kvh = (id >> 6) & 1, b = id >> 7, hq = kvh * 4 + hg;
            const size_t t0 = (size_t)b * SEQ;
            attn_body::attn_unit<8, false>((const attn_body::bf16*)(H + (t0 + 256 * qb) * DIN + H_GQ + 64 * hq), (const attn_body::bf16*)(H + t0 * DIN + H_GK + 64 * kvh),
                                           (const attn_body::bf16*)(H + t0 * DIN + H_GV + 64 * kvh), (attn_body::bf16*)(Y + (t0 + 256 * qb) * DM + Y_GQA + 64 * hq), lds);
        }
    }
    __syncthreads();
}
typedef float f32x4_t __attribute__((ext_vector_type(4)));
#define MFMA16(a, b, c) __builtin_amdgcn_mfma_f32_16x16x32_bf16((a), (b), (c), 0, 0, 0)
constexpr int NA_VP = 144;
__device__ __forceinline__ void na_wave(const bf16* __restrict__ H, const LAS unsigned char* vl, bf16* __restrict__ Y, const LAS float* rpbh, int b, int hd, int rr, int rs, int qb4, int lane) {
    const int n16 = lane & 15, g = lane >> 4;
    const int c0 = 16 * qb4, w0 = (16 * qb4 - 8 < 0) ? 0 : (16 * qb4 - 8 > 32 ? 32 : 16 * qb4 - 8);
    const size_t t0 = (size_t)b * SEQ, qtok = t0 + rr * 64 + c0 + n16;
    bf16x8 qf[2];
#pragma unroll
    for (int ks = 0; ks < 2; ++ks) qf[ks] = *(const bf16x8*)(H + qtok * DIN + H_NAQ + 64 * hd + 32 * ks + 8 * g);
    f32x4_t s[16];
    const bf16* kb = H + (t0 + rs * 64 + w0 + 8 * (n16 >> 2) + (n16 & 3)) * DIN + H_NAK + 64 * hd + 8 * g;
    {
        bf16x8 kf[16][2];
#pragma unroll
        for (int T = 0; T < 16; ++T) { const bf16* kp = kb + (size_t)((T >> 1) * 64 + 4 * (T & 1)) * DIN; kf[T][0] = *(const bf16x8*)kp; kf[T][1] = *(const bf16x8*)(kp + 32); }
        asm volatile("" ::: "memory");
#pragma unroll
        for (int T = 0; T < 16; ++T) { f32x4_t z = {0.f, 0.f, 0.f, 0.f}; z = MFMA16(kf[T][0], qf[0], z); s[T] = MFMA16(kf[T][1], qf[1], z); }
    }
    const int qc = c0 + n16, cs = qc - 8 < 0 ? 0 : (qc - 8 > 48 ? 48 : qc - 8);
    const LAS float* tb[8];
#pragma unroll
    for (int j = 0; j < 8; ++j) { const int kc = w0 + 8 * g + 4 * (j >> 2) + (j & 3); const bool ok = (unsigned)(kc - cs) < 16u; tb[j] = rpbh + (rs - rr + 7) * 32 + (ok ? kc - qc + 15 : 31); }
    float mx = -1e30f;
#pragma unroll
    for (int T = 0; T < 16; ++T)
#pragma unroll
        for (int i = 0; i < 4; ++i) { const float v = s[T][i] + tb[(T & 1) * 4 + i][(T >> 1) * 32]; s[T][i] = v; mx = fmaxf(mx, v); }
    mx = fmaxf(mx, shx<16>(mx)); mx = max32(mx);
    float sum = 0.f;
#pragma unroll
    for (int T = 0; T < 16; ++T)
#pragma unroll
        for (int i = 0; i < 4; ++i) { const float p = __builtin_amdgcn_exp2f(s[T][i] - mx); s[T][i] = p; sum += p; }
    sum += shx<16>(sum); sum = sum32(sum);
    f32x4_t o[4];
#pragma unroll
    for (int db = 0; db < 4; ++db) o[db] = (f32x4_t){0.f, 0.f, 0.f, 0.f};
    const LAS unsigned char* vb = vl + (w0 + 8 * g + (n16 >> 2)) * NA_VP + (n16 & 3) * 8;
#pragma unroll
    for (int kr = 0; kr < 8; ++kr) {
        u32x4 pw; pw.x = pg8::cvt_pk_bf16(s[2 * kr][0], s[2 * kr][1]); pw.y = pg8::cvt_pk_bf16(s[2 * kr][2], s[2 * kr][3]);
        pw.z = pg8::cvt_pk_bf16(s[2 * kr + 1][0], s[2 * kr + 1][1]); pw.w = pg8::cvt_pk_bf16(s[2 * kr + 1][2], s[2 * kr + 1][3]);
        const bf16x8 pb = __builtin_bit_cast(bf16x8, pw);
#pragma unroll
        for (int db = 0; db < 4; ++db) { const LAS unsigned char* vp = vb + (kr * 64) * NA_VP + db * 32;
            const s16x4 lo = tr_read(vp), hi = tr_read(vp + 4 * NA_VP);
            o[db] = MFMA16(__builtin_shufflevector(lo, hi, 0, 1, 2, 3, 4, 5, 6, 7), pb, o[db]); }
    }
    const float rl = 1.0f / sum;
    bf16* yp = Y + qtok * DM + Y_NA + 64 * hd + 4 * g;
#pragma unroll
    for (int db = 0; db < 4; ++db) { u32x2 w; w.x = pg8::cvt_pk_bf16(o[db][0] * rl, o[db][1] * rl); w.y = pg8::cvt_pk_bf16(o[db][2] * rl, o[db][3] * rl); *(u32x2*)(yp + 16 * db) = w; }
}
__device__ __forceinline__ void na_part(Frame& F, int l, const float* na_rpb, unsigned char* ws) {
    const bf16* H = (const bf16*)(ws + WS_H); bf16* Y = (bf16*)(ws + WS_HID);
    LAS float* rpbl = (LAS float*)(F.lds + 90112);
    for (int i = F.tid; i < 4 * 15 * 32; i += 512) { const int c = i & 31, hr = i >> 5; rpbl[i] = (c < 31) ? na_rpb[(size_t)l * 4 * 15 * 31 + hr * 31 + c] * LOG2E : -1e30f; }
    LAS unsigned char* vl = F.lds;
    u32x4 stg[9];
#define NA_VSRC(id_) (H + ((size_t)((id_) >> 7) * SEQ + (2 * ((id_) & 31) - 4 < 0 ? 0 : (2 * ((id_) & 31) - 4 > 56 ? 56 : 2 * ((id_) & 31) - 4)) * 64) * DIN + H_NAV + 64 * (((id_) >> 5) & 3))
    if (F.vcu < NBATCH * 4 * 32) { const bf16* vsrc = NA_VSRC(F.vcu);
#pragma unroll
        for (int i = 0; i < 9; ++i) { const int idx = F.tid + 512 * i, tok = idx >> 3, ch = idx & 7; stg[i] = *(const u32x4*)(vsrc + (size_t)tok * DIN + ch * 8); } }
    for (int id = F.vcu; id < NBATCH * 4 * 32; id += F.G) {
        const int rp = id & 31, hd = (id >> 5) & 3, b = id >> 7, rr0 = 2 * rp;
        const int sb = rr0 - 4 < 0 ? 0 : (rr0 - 4 > 56 ? 56 : rr0 - 4);
        __syncthreads();
#pragma unroll
        for (int i = 0; i < 9; ++i) { const int idx = F.tid + 512 * i, tok = idx >> 3, ch = idx & 7; *(LAS u32x4*)(vl + tok * NA_VP + ch * 16) = stg[i]; }
        __syncthreads();
        { const int idn = id + F.G; if (idn < NBATCH * 4 * 32) { const bf16* vsrc = NA_VSRC(idn);
#pragma unroll
            for (int i = 0; i < 9; ++i) { const int idx = F.tid + 512 * i, tok = idx >> 3, ch = idx & 7; stg[i] = *(const u32x4*)(vsrc + (size_t)tok * DIN + ch * 8); } } }
        const int rr = rr0 + (F.wave >> 2); const int rs = rr - 4 < 0 ? 0 : (rr - 4 > 56 ? 56 : rr - 4);
        na_wave(H, vl + (rs - sb) * 64 * NA_VP, Y, rpbl + hd * 480, b, hd, rr, rs, F.wave & 3, F.lane);
    }
#undef NA_VSRC
    __syncthreads();
}

__device__ __forceinline__ void frame_init(Frame& F, LAS unsigned char* lds) {
    int t = threadIdx.x; asm volatile("" : "+v"(t));
    F.lds = lds; F.tid = t; F.lane = t & 63; F.wave = __builtin_amdgcn_readfirstlane(t >> 6);
    int G_ = gridDim.x; asm volatile("" : "+s"(G_));
    F.G = G_; { const int bx = blockIdx.x; F.vcu = (F.G % 8 == 0) ? (bx % 8) * (F.G / 8) + bx / 8 : bx; }
    F.gw = F.vcu * NWAVES + F.wave; F.NGW = F.G * NWAVES;
}
#ifndef MK_FUSED
#define MK_FUSED 1
#endif
struct Args { const float* in[21]; float* out; unsigned char* ws; int l_lo, l_hi, ph_lo, ph_hi, use_bar, pad; };
constexpr int NPH = 10;

__global__ void __launch_bounds__(NWAVES * 64, 2) enc_fwd(Args a) {
    extern __shared__ __attribute__((aligned(16))) unsigned char lds[];
    Frame F0; frame_init(F0, (LAS unsigned char*)lds);
#define FRAME() Frame F; frame_init(F, (LAS unsigned char*)lds)
    volatile LAS unsigned* MISC = (volatile LAS unsigned*)(F0.lds + MISC_OFF);
    for (int u = F0.tid; u < (LDS_BYTES - LDSCTL_OFF) / 4; u += NWAVES * 64) ((LAS unsigned*)(F0.lds + LDSCTL_OFF))[u] = 0u;
    __syncthreads();
    unsigned* ctl = (unsigned*)(a.ws + WS_CTL);
    XcdBarrier bar; bar.bar = ctl + CW_BAR; bar.x = 0; bar.st = nullptr;
    if (a.use_bar) bar = xcd_barrier_post(ctl + CW_BAR, MISC + 8);
#if MK_FUSED
#define SEAM() xcd_barrier(bar)
#else
#define SEAM() do { if (a.use_bar) xcd_barrier(bar); } while (0)
#endif
    typedef const __attribute__((address_space(4))) Args* KArgP;
#define KA() ({ KArgP p_ = (KArgP)__builtin_amdgcn_kernarg_segment_ptr(); asm volatile("" : "+s"(p_)); p_; })
#if !MK_FUSED
    const int lo = a.ph_lo, hi = a.ph_hi;
#endif
#ifndef ONLY_PH
#define ONLY_PH -1
#endif
#if MK_FUSED
#define IN(k) (ONLY_PH < 0 || ONLY_PH == (k))
#else
#define IN(k) ((ONLY_PH < 0 || ONLY_PH == (k)) && lo <= (k) && (k) < hi)
#endif
#ifndef REP0
#define REP0 1
#endif
#ifndef REP2
#define REP2 1
#endif
#ifndef REP4
#define REP4 1
#endif
#ifndef REP9
#define REP9 1
#endif
#ifndef REP1
#define REP1 1
#endif
#ifndef REP2A
#define REP2A 1
#endif
#ifndef REP2B
#define REP2B 1
#endif
#ifndef REP2C
#define REP2C 1
#endif
#ifndef NA_VAR
#define NA_VAR 1
#endif
#ifndef REP3
#define REP3 1
#endif
#ifndef REPP
#define REPP 1
#endif
#ifndef REP5
#define REP5 1
#endif
#ifndef REP6
#define REP6 1
#endif
#ifndef REP7
#define REP7 1
#endif
#ifndef REP8
#define REP8 1
#endif
#define REPEAT(n) _Pragma("nounroll") for (int rep_ = 0; rep_ < (n); ++rep_)
#if MK_FUSED
    for (int l = 0; l < NLAYER; ++l) {
#else
    for (int l = a.l_lo; l < a.l_hi; ++l) {
#endif
        if (IN(0) && (l == 0 || REP0 > 1)) {
            REPEAT(l == 0 ? REP0 : REP0 - 1) { FRAME(); KArgP k = KA(); conv_phase(F, l, k->in[4], k->in[12], k->in[16], k->in[17], k->in[18], k->in[8], k->ws, 0, 1 << 30, F.gw, F.NGW, true); }
            if (l == 0) REPEAT(REPP) { FRAME(); KArgP k = KA(); prologue_phase(F, k->in[0], k->in[1], k->in[2], k->in[3], k->out, k->ws); }
            SEAM();
        }
        if (IN(1)) REPEAT(REP1) {
            FRAME(); KArgP k = KA(); unsigned char* ws = k->ws;
            pg8::Gemm g{(const bf16*)(ws + WS_XB), (const bf16*)(ws + wset(l) + WS_WIN), TT, DIN, DM, 0};
            pg8::RotOrder S; S.init(TT, DIN, F.G, (int)blockIdx.x);
            EpiIn E{(bf16*)(ws + WS_H), k->in[6] + l * 64, k->in[7] + l * 64, k->in[10] + l * 256, k->in[11] + l * 256, (const float*)(ws + WS_ROPE), (bf16*)(ws + WS_VT)};
            pg8::gemm_phase<EpiIn, pg8::RotOrder, true, true, false, false, false, true>(F.lds, g, S, E);
            SEAM();
        }
        if (IN(2)) REPEAT(REP2) {
            REPEAT(REP2A) { FRAME(); KArgP k = KA(); sgu_part(F, l, k->in[9], k->ws); }
            REPEAT(REP2B) { FRAME(); KArgP k = KA(); gqa_part(F.vcu, F.G, (char*)lds, k->ws, k->in[6] + l * 64, k->in[7] + l * 64); }
            REPEAT(REP2C) { FRAME(); KArgP k = KA(); na_part(F, l, k->in[5], k->ws); }
            SEAM();
        }
        if (IN(3)) {
            REPEAT(REP3 - 1) {
                FRAME(); KArgP k = KA(); unsigned char* ws = k->ws;
                pg8::Gemm g{(const bf16*)(ws + WS_HID), (const bf16*)(ws + wset(l) + WS_WOUT), TT, DM, DM, 0};
                pg8::StaticOrder S; S.init(TT, DM, F.G, (int)blockIdx.x);
                EpiRes E{(const bf16*)(ws + WS_XB), (float*)(ws + WS_DUMMY)};
                pg8::gemm_phase<EpiRes, pg8::StaticOrder, true, true, false, false, false, true>(F.lds, g, S, E);
                SEAM();
            }
            FRAME(); KArgP k = KA(); unsigned char* ws = k->ws;
            pg8::Gemm g{(const bf16*)(ws + WS_HID), (const bf16*)(ws + wset(l) + WS_WOUT), TT, DM, DM, 0};
            pg8::StaticOrder S; S.init(TT, DM, F.G, (int)blockIdx.x);
            EpiRes E{(const bf16*)(ws + WS_XB), k->out};
            pg8::gemm_phase<EpiRes, pg8::StaticOrder, true, true, false, false, false, true>(F.lds, g, S, E);
            SEAM();
        }
        if (IN(4)) { REPEAT(REP4 - 1) { FRAME(); KArgP k = KA(); ln1_router_phase<true>(F, k->out, k->in[13] + l * DM, k->in[14] + l * DM, k->in[15] + (size_t)l * DM * NEXP, k->ws); SEAM(); }
            FRAME(); KArgP k = KA(); ln1_router_phase<false>(F, k->out, k->in[13] + l * DM, k->in[14] + l * DM, k->in[15] + (size_t)l * DM * NEXP, k->ws); SEAM(); }
        if (IN(5)) REPEAT(REP5) { FRAME(); KArgP k = KA(); topk_phase(F, k->ws);
            if (l + 1 < NLAYER && blockIdx.x >= 32) { FRAME(); KArgP k2 = KA(); conv_phase(F, l + 1, k2->in[4], k2->in[12], k2->in[16], k2->in[17], k2->in[18], k2->in[8], k2->ws, 0, CONV_SPLIT_ITEMS, (blockIdx.x - 32) * NWAVES + F.wave, (gridDim.x - 32) * NWAVES, false); }
            SEAM(); }
        if (IN(7)) REPEAT(REP7) {
            FRAME(); KArgP k = KA(); unsigned char* ws = k->ws;
            pg8::Gemm g{(const bf16*)(ws + WS_XB8), (const bf16*)(ws + wset(l) + WS_WGU), ROWS_E, 4096, DM / 2, (size_t)4096 * DM, (const int*)(ws + WS_IDX)};
            pg8::StaticOrder S; S.init(ROWS_E, 4096, F.G, (int)blockIdx.x);
            EpiSwiglu E{ws + WS_HID};
            pg8::gemm_phase<EpiSwiglu, pg8::StaticOrder, true, true, true, true, true, true>(F.lds, g, S, E);
            SEAM();
        }
        if (IN(8)) REPEAT(REP8) {
            FRAME(); KArgP k = KA(); unsigned char* ws = k->ws;
            pg8::Gemm g{(const bf16*)(ws + WS_HID), (const bf16*)(ws + wset(l) + WS_WD), ROWS_E, DM, DEXP / 2, (size_t)DM * DEXP};
            pg8::StaticOrder S; S.init(ROWS_E, DM, F.G, (int)blockIdx.x);
            EpiDown E{ws + WS_H, (const float*)(ws + WS_GATE)};
            pg8::gemm_phase<EpiDown, pg8::StaticOrder, true, true, true, true, false, true>(F.lds, g, S, E);
            SEAM();
        }
#if BAL_PROBE_N
        if (IN(8)) REPEAT(BAL_PROBE_N) {
            FRAME(); KArgP k = KA(); unsigned char* ws = k->ws;
            pg8::Gemm g{(const bf16*)(ws + WS_HID), (const bf16*)(ws + wset(l) + WS_WD), ROWS_E, DM, DEXP / 2, (size_t)DM * DEXP};
            pg8::StaticOrder S; S.init(ROWS_E, DM, F.G, (int)blockIdx.x);
            EpiDown E{ws + WS_DUMMY, (const float*)(ws + WS_GATE)};
            pg8::gemm_phase<EpiDown, pg8::StaticOrder, true, true, true, true, false, (BAL_PROBE != 0)>(F.lds, g, S, E);
            SEAM();
        }
#endif
        if (IN(9)) { REPEAT(REP9 - 1) { FRAME(); KArgP k = KA(); combine_phase<true>(F, k->out, k->in[13] + l * DM, k->in[14] + l * DM, k->in[19] + l * DM, k->in[20] + l * DM, k->ws, l + 1 == NLAYER); SEAM(); }
            FRAME(); KArgP k = KA(); combine_phase<false>(F, k->out, k->in[13] + l * DM, k->in[14] + l * DM, k->in[19] + l * DM, k->in[20] + l * DM, k->ws, l + 1 == NLAYER);
            if (l + 1 < NLAYER) { FRAME(); KArgP k = KA(); conv_phase(F, l + 1, k->in[4], k->in[12], k->in[16], k->in[17], k->in[18], k->in[8], k->ws, CONV_SPLIT_ITEMS, 1 << 30, F.gw, F.NGW, true); }
            SEAM(); }
    }
#undef IN
#undef SEAM
}

extern "C" void kernel_launch(void* const* d_in, const int* in_sizes, int n_in, void* d_out, int out_size, void* d_ws, size_t ws_size, hipStream_t stream) {
    static int grid = 0;
    if (grid == 0) {
        if (n_in != 21 || out_size != TT * DM || ws_size < WS_END) { fprintf(stderr, "kernel_launch: unexpected shapes (n_in %d, out %d, ws %zu)\n", n_in, out_size, ws_size); grid = -1; return; }
        int dev = 0, cus = 0, per_cu = 0;
        if (hipGetDevice(&dev) != hipSuccess || hipDeviceGetAttribute(&cus, hipDeviceAttributeMultiprocessorCount, dev) != hipSuccess) { grid = -1; return; }
        if (hipFuncSetAttribute((const void*)enc_fwd, hipFuncAttributeMaxDynamicSharedMemorySize, LDS_BYTES) != hipSuccess) { fprintf(stderr, "kernel_launch: hipFuncSetAttribute failed\n"); grid = -1; return; }
        if (hipOccupancyMaxActiveBlocksPerMultiprocessor(&per_cu, (const void*)enc_fwd, NWAVES * 64, LDS_BYTES) != hipSuccess || per_cu < 1) fprintf(stderr, "kernel_launch: occupancy query reports %d\n", per_cu);
        (void)hipGetLastError();
        grid = cus;
    }
    if (grid < 0) return;
    if (hipMemsetAsync((char*)d_ws + WS_CTL, 0, CTL_ZERO_BYTES, stream) != hipSuccess) return;
    Args a{};
    for (int i = 0; i < 21; ++i) a.in[i] = (const float*)d_in[i];
    a.out = (float*)d_out; a.ws = (unsigned char*)d_ws; a.pad = 0;
#if MK_FUSED
    a.l_lo = 0; a.l_hi = NLAYER; a.ph_lo = 0; a.ph_hi = NPH; a.use_bar = 1;
    hipLaunchKernelGGL(enc_fwd, dim3(grid), dim3(NWAVES * 64), LDS_BYTES, stream, a);
#else
    a.use_bar = 0;
    for (int l = 0; l < NLAYER; ++l)
        for (int ph = 0; ph < NPH; ++ph) { a.l_lo = l; a.l_hi = l + 1; a.ph_lo = ph; a.ph_hi = ph + 1; hipLaunchKernelGGL(enc_fwd, dim3(grid), dim3(NWAVES * 64), LDS_BYTES, stream, a); }
#endif
}
```

```cpp
#include <hip/hip_runtime.h>
#include <hip/hip_bf16.h>
#include <cstdio>
#include <cstdint>
#ifndef BAL_PROBE
#define BAL_PROBE 0
#endif
#ifndef BAL_PROBE_N
#define BAL_PROBE_N 0
#endif
#ifndef LN1_ROWS
#define LN1_ROWS 4
#endif
#ifndef GQA_MSUM
#define GQA_MSUM false
#endif
namespace pg8 {
#define PG8_LAS __attribute__((address_space(3)))
typedef unsigned short bf16_t;
typedef short bf16x8 __attribute__((ext_vector_type(8)));
typedef float f32x4 __attribute__((ext_vector_type(4)));
typedef unsigned u32x4 __attribute__((ext_vector_type(4)));
typedef int v4i_t __attribute__((ext_vector_type(4)));
typedef int v8i_t __attribute__((ext_vector_type(8)));
constexpr int BM = 256, BK = 64, HALF = 128, HTB = HALF * BK * 2  , STAGE_BYTES = 8 * HTB, NXCD = 8, WGM = 8;

__host__ __device__ __forceinline__ int lds_byte(int r, int c) { const int st = (r >> 4) * 2 + (c >> 5), rr = r & 15, cc = c & 31, ob = rr * 64 + cc * 2; return st * 1024 + (ob ^ (((ob >> 9) & 1) << 5)); }
__host__ __device__ __forceinline__ void stage_rc(int b, int& R, int& C) { const int st = b / 1024, sb = b % 1024, swz = sb ^ (((sb >> 9) & 1) << 5); R = (st >> 1) * 16 + swz / 64; C = (st & 1) * 32 + (swz % 64) / 2; }
__host__ __device__ __forceinline__ int perm32(int rho) { const int n = rho >> 4, i = rho & 15; return 8 * (i >> 2) + 4 * n + (i & 3); }

struct Unit { int pm, pn; };
struct Gemm { const bf16_t* A; const bf16_t* Bt; int M, N, K; size_t estride; const int* idx; };
__host__ __device__ __forceinline__ int expert_of_tile(int pm) { return pm < 128 ? (pm >> 3) : ((pm - 128) >> 5); }

struct StaticOrder {
    int nM, nN, nwg, G, c;
    __host__ __device__ void init(int M, int N, int G_, int c_) { nM = M / BM; nN = N / BM; nwg = nM * nN; G = G_; c = c_; }
    __host__ __device__ bool next(int i, Unit& u) const {
        const long L = (long)i * G + c; if (L >= nwg) return false;
        int wgid = (int)L; { const int q = nwg / NXCD, r = nwg % NXCD, xcd = wgid % NXCD, off = wgid / NXCD; wgid = (xcd < r ? xcd * (q + 1) : r * (q + 1) + (xcd - r) * q) + off; }
        const int nig = WGM * nN, gid = wgid / nig, fm = gid * WGM, gsz = (nM - fm) < WGM ? (nM - fm) : WGM;
        u.pm = fm + ((wgid % nig) % gsz); u.pn = (wgid % nig) / gsz; return true;
    }
    __device__ __forceinline__ void a_ready(const Unit&) const {}
    __device__ __forceinline__ void done(const Unit&) const {}
};

struct RotOrder {
    StaticOrder S;
    __host__ __device__ void init(int M, int N, int G_, int c_) { S.init(M, N, G_, c_); }
    __host__ __device__ bool next(int i, Unit& u) const {
        if (S.G != 256) return S.next(i, u);
        StaticOrder T = S; T.c = (S.c & 63) + 64 * (((S.c >> 6) + (i >> 1)) & 3);
        return T.next(i, u);
    }
    __device__ __forceinline__ void a_ready(const Unit&) const {}
    __device__ __forceinline__ void done(const Unit&) const {}
};

__device__ __forceinline__ unsigned cvt_pk_bf16(float lo, float hi) { unsigned r; asm volatile("v_cvt_pk_bf16_f32 %0, %1, %2" : "=v"(r) : "v"(lo), "v"(hi)); return r; }
typedef float f32x2 __attribute__((ext_vector_type(2)));

__device__ __forceinline__ void mfma_fp8(f32x4& acc, const v8i_t& a, const v8i_t& b, int sc) {
    asm volatile("v_mfma_scale_f32_16x16x128_f8f6f4 %0, %1, %2, %0, %3, %3 op_sel_hi:[0,0,0]" : "+v"(acc) : "v"(a), "v"(b), "v"(sc));
}
template <class Epi, class Sched, bool ALIGN_EPI = false, bool SP2 = false, bool GROUPED = false, bool FP8 = false, bool GATHER = false, bool BAL = false>
__device__ __forceinline__ void gemm_phase(PG8_LAS unsigned char* lds, const Gemm g, const Sched& S, const Epi& E, int tid_in) {
    int tid_ = tid_in; asm volatile("" : "+v"(tid_));
    const int tid = tid_, wid = __builtin_amdgcn_readfirstlane(tid >> 6), lane = tid & 63, wr = wid >> 2, wc = wid & 3, fr = lane & 15, fq = lane >> 4;
    const int K = g.K, nt = K / BK;
    unsigned voffA[2], voffB[2];
#pragma unroll
    for (int i = 0; i < 2; ++i) { int R, C; stage_rc(tid * 16 + i * 8192, R, C); const int Rb = Epi::PERM ? ((R & ~31) + perm32(R & 31)) : R;
        voffA[i] = (unsigned)(R * K + C) * 2u; voffB[i] = (unsigned)(Rb * K + C) * 2u; }
    const size_t kstep = (size_t)(BK * 2);
    const size_t hstep = (size_t)HALF * K * 2;
    const size_t tstep = 2 * hstep;
    const unsigned ldsw = (unsigned)wid * 1024u;
    const int aoff = lds_byte(wr * 64 + fr, fq * 8), boff = lds_byte(wc * 32 + fr, fq * 8);
#define PG8_SA(b, h) (((b) * 2 + (h)) * HTB)
#define PG8_SB(b, h) ((4 + (b) * 2 + (h)) * HTB)
#define PG8_STAGE(bufoff, gbase, voff) do { _Pragma("unroll") for (int _i = 0; _i < 2; ++_i) \
        __builtin_amdgcn_global_load_lds((const unsigned*)((const char*)(gbase) + (voff)[_i]), (PG8_LAS unsigned*)(lds + (bufoff) + ldsw + _i * 8192), 16, 0, 0); } while (0)
    static_assert(!GATHER || SP2, "GATHER is wired into the SP2 loop only");
    unsigned vC[2][2], vN[2][2]; unsigned cC[2];
    PG8_LAS unsigned char* gtab = lds + 131072 + 1024 + wid * 512;
    if constexpr (GATHER) {
#pragma unroll
        for (int i = 0; i < 2; ++i) { int R, C; stage_rc(tid * 16 + i * 8192, R, C); cC[i] = (unsigned)C * 2u; }
    }
    const int grow = ((lane >> 5) & 1) * 128 + ((lane >> 4) & 1) * 64 + (wid >> 1) * 16 + (lane & 15);
#define PG8_GDMA(unit, buf) __builtin_amdgcn_global_load_lds((const unsigned*)(g.idx + (size_t)(unit).pm * BM + grow), (PG8_LAS unsigned*)(gtab + (buf) * 256), 4, 0, 0)
#define PG8_GREAD(dst, buf) do { unsigned r00_, r01_, r10_, r11_; const unsigned ga_ = (unsigned)(size_t)gtab + (unsigned)(buf) * 256u + (unsigned)(lane >> 2) * 4u; \
        asm volatile("ds_read_b32 %0, %4\n\tds_read_b32 %1, %4 offset:64\n\tds_read_b32 %2, %4 offset:128\n\tds_read_b32 %3, %4 offset:192\n\ts_waitcnt lgkmcnt(0)" \
                     : "=&v"(r00_), "=&v"(r01_), "=&v"(r10_), "=&v"(r11_) : "v"(ga_) : "memory"); \
        dst[0][0] = r00_ * (unsigned)(K * 2) + cC[0]; dst[0][1] = r01_ * (unsigned)(K * 2) + cC[1]; dst[1][0] = r10_ * (unsigned)(K * 2) + cC[0]; dst[1][1] = r11_ * (unsigned)(K * 2) + cC[1]; } while (0)
#define PG8_GSTAGE(bufoff, kb, h, nx) do { _Pragma("unroll") for (int _i = 0; _i < 2; ++_i) \
        __builtin_amdgcn_global_load_lds((const unsigned*)((const char*)g.A + (kb) + ((nx) ? vN[h][_i] : vC[h][_i])), (PG8_LAS unsigned*)(lds + (bufoff) + ldsw + _i * 8192), 16, 0, 0); } while (0)
#define PG8_STA(bufoff, ptr, kb, h, nx) do { if constexpr (GATHER) { PG8_GSTAGE(bufoff, kb, h, nx); } else { PG8_STAGE(bufoff, ptr, voffA); } } while (0)
#define PG8_LDA(dst, b, h) do { if constexpr (FP8) { _Pragma("unroll") for (int m = 0; m < 4; ++m) dst##8[m] = PG8_CAT(*(const PG8_LAS bf16x8*)(lds + PG8_SA(b, h) + aoff + m * 2048), *(const PG8_LAS bf16x8*)(lds + PG8_SA(b, h) + aoff + m * 2048 + 1024)); } \
        else { _Pragma("unroll") for (int m = 0; m < 4; ++m) _Pragma("unroll") for (int k = 0; k < 2; ++k) dst[m][k] = *(const PG8_LAS bf16x8*)(lds + PG8_SA(b, h) + aoff + m * 2048 + k * 1024); } } while (0)
#define PG8_LDB(dst, b, h) do { if constexpr (FP8) { _Pragma("unroll") for (int n = 0; n < 2; ++n) dst##8[n] = PG8_CAT(*(const PG8_LAS bf16x8*)(lds + PG8_SB(b, h) + boff + n * 2048), *(const PG8_LAS bf16x8*)(lds + PG8_SB(b, h) + boff + n * 2048 + 1024)); } \
        else { _Pragma("unroll") for (int n = 0; n < 2; ++n) _Pragma("unroll") for (int k = 0; k < 2; ++k) dst[n][k] = *(const PG8_LAS bf16x8*)(lds + PG8_SB(b, h) + boff + n * 2048 + k * 1024); } } while (0)
#define PG8_MMA(ai, bj, At, Bt) do { __builtin_amdgcn_s_setprio(1); if constexpr (FP8) { _Pragma("unroll") for (int m = 0; m < 4; ++m) _Pragma("unroll") for (int n = 0; n < 2; ++n) \
        mfma_fp8(acc[ai][bj][m][n], Bt##8[n], At##8[m], sc8); } \
        else { _Pragma("unroll") for (int m = 0; m < 4; ++m) _Pragma("unroll") for (int n = 0; n < 2; ++n) _Pragma("unroll") for (int k = 0; k < 2; ++k) \
        acc[ai][bj][m][n] = __builtin_amdgcn_mfma_f32_16x16x32_bf16(Bt[n][k], At[m][k], acc[ai][bj][m][n], 0, 0, 0); } __builtin_amdgcn_s_setprio(0); } while (0)
#define PG8_CAT(x, y) __builtin_shufflevector(__builtin_bit_cast(v4i_t, (x)), __builtin_bit_cast(v4i_t, (y)), 0, 1, 2, 3, 4, 5, 6, 7)
#define PG8_WAIT_V(n) asm volatile("s_waitcnt vmcnt(" #n ")" ::: "memory")
#define PG8_WAIT_L(n) asm volatile("s_waitcnt lgkmcnt(" #n ")" ::: "memory")
#define PG8_BAR __builtin_amdgcn_s_barrier()
#define PG8_SCHED __builtin_amdgcn_sched_barrier(0)
    Unit cur, nxt; int ui = 0;
    if (!S.next(0, cur)) return;
    f32x4 acc[2][2][4][2];
#pragma unroll
    for (int a = 0; a < 2; ++a)
#pragma unroll
        for (int b = 0; b < 2; ++b)
#pragma unroll
            for (int m = 0; m < 4; ++m)
#pragma unroll
                for (int n = 0; n < 2; ++n) acc[a][b][m][n] = (f32x4){0.f, 0.f, 0.f, 0.f};
    int sc8 = 0x7f7f7f7f; if constexpr (FP8) asm volatile("" : "+v"(sc8));
    bf16x8 At[4][2], B0[2][2], B1[2][2]; v8i_t At8[4], B08[2], B18[2];
    const char* cA = (const char*)g.A + (size_t)cur.pm * tstep; const char* cB = (const char*)g.Bt + (size_t)cur.pn * tstep + (GROUPED ? (size_t)expert_of_tile(cur.pm) * g.estride : (size_t)0);
    S.a_ready(cur);
    if constexpr (SP2) {
        if constexpr (GATHER) { PG8_GDMA(cur, 0); PG8_WAIT_V(0); PG8_GREAD(vC, 0); }
        PG8_STAGE(PG8_SB(0, 0), cB, voffB); PG8_STAGE(PG8_SB(0, 1), cB + hstep, voffB); PG8_STA(PG8_SA(0, 0), cA, 0, 0, false); PG8_STA(PG8_SA(0, 1), cA + hstep, 0, 1, false);
        if (wr == 1) PG8_BAR;
        PG8_WAIT_V(2); PG8_BAR;
        if constexpr (BAL) { PG8_STAGE(PG8_SB(1, 0), cB + kstep, voffB); PG8_STAGE(PG8_SB(1, 1), cB + hstep + kstep, voffB); PG8_WAIT_V(4); PG8_BAR; }
        else {
        PG8_STAGE(PG8_SB(1, 0), cB + kstep, voffB); PG8_STA(PG8_SA(1, 0), cA + kstep, kstep, 0, false); PG8_STAGE(PG8_SB(1, 1), cB + hstep + kstep, voffB);
        PG8_WAIT_V(6); PG8_BAR;
        }
    } else {
        PG8_STAGE(PG8_SB(0, 0), cB, voffB); PG8_STAGE(PG8_SA(0, 0), cA, voffA); PG8_STAGE(PG8_SB(0, 1), cB + hstep, voffB); PG8_STAGE(PG8_SA(0, 1), cA + hstep, voffA);
        if (wr == 1) PG8_BAR;
        PG8_WAIT_V(4); PG8_BAR;
        PG8_STAGE(PG8_SB(1, 0), cB + kstep, voffB); PG8_STAGE(PG8_SA(1, 0), cA + kstep, voffA); PG8_STAGE(PG8_SB(1, 1), cB + hstep + kstep, voffB);
        PG8_WAIT_V(6); PG8_BAR;
    }
    for (;;) {
        const bool has_next = S.next(ui + 1, nxt);
        if constexpr (GATHER) { if (has_next) PG8_GDMA(nxt, (ui + 1) & 1); }
        const char* nA = has_next ? (const char*)g.A + (size_t)nxt.pm * tstep : cA; const char* nB = has_next ? (const char*)g.Bt + (size_t)nxt.pn * tstep + (GROUPED ? (size_t)expert_of_tile(nxt.pm) * g.estride : (size_t)0) : cB;
        for (int t = 0; t < nt; t += 2) {
            const bool last = (t == nt - 2);
            const char* a1 = cA + (size_t)(t + 1) * kstep;
            const char* a2 = last ? nA : cA + (size_t)(t + 2) * kstep; const char* b2 = last ? nB : cB + (size_t)(t + 2) * kstep;
            const char* a3 = a2 + kstep; const char* b3 = b2 + kstep;
            if (last && has_next) S.a_ready(nxt);
            if constexpr (SP2) {
            const bool nx = last && has_next; const size_t kb2 = last ? (size_t)0 : (size_t)(t + 2) * kstep;
            if constexpr (GATHER) { if (nx) PG8_GREAD(vN, (ui + 1) & 1); }
            if constexpr (BAL) {
            PG8_LDB(B0, 0, 0); PG8_LDB(B1, 0, 1); PG8_SCHED; PG8_LDA(At, 0, 0); PG8_STA(PG8_SA(1, 0), a1, (size_t)(t + 1) * kstep, 0, false); PG8_STA(PG8_SA(1, 1), a1 + hstep, (size_t)(t + 1) * kstep, 1, false);
            PG8_WAIT_V(8); PG8_WAIT_L(0); PG8_BAR; PG8_MMA(0, 0, At, B0); PG8_MMA(0, 1, At, B1); PG8_BAR; PG8_SCHED;
            PG8_LDA(At, 0, 1); PG8_STAGE(PG8_SB(0, 0), b2, voffB); PG8_STAGE(PG8_SB(0, 1), b2 + hstep, voffB);
            PG8_WAIT_V(6); PG8_WAIT_L(0); PG8_BAR; PG8_MMA(1, 0, At, B0); PG8_MMA(1, 1, At, B1); PG8_BAR; PG8_SCHED;
            PG8_LDB(B0, 1, 0); PG8_LDB(B1, 1, 1); PG8_SCHED; PG8_LDA(At, 1, 0); PG8_STA(PG8_SA(0, 0), a2, kb2, 0, nx); PG8_STA(PG8_SA(0, 1), a2 + hstep, kb2, 1, nx);
            PG8_WAIT_V(8); PG8_WAIT_L(0); PG8_BAR; PG8_MMA(0, 0, At, B0); PG8_MMA(0, 1, At, B1); PG8_BAR; PG8_SCHED;
            PG8_LDA(At, 1, 1); PG8_STAGE(PG8_SB(1, 0), b3, voffB); PG8_STAGE(PG8_SB(1, 1), b3 + hstep, voffB);
            PG8_WAIT_V(6); PG8_WAIT_L(0); PG8_BAR; PG8_MMA(1, 0, At, B0); PG8_MMA(1, 1, At, B1); PG8_BAR; PG8_SCHED;
            } else {
            PG8_LDB(B0, 0, 0); PG8_LDB(B1, 0, 1); PG8_SCHED; PG8_LDA(At, 0, 0); PG8_STA(PG8_SA(1, 1), a1 + hstep, (size_t)(t + 1) * kstep, 1, false);
            PG8_WAIT_V(8); PG8_WAIT_L(0); PG8_BAR; PG8_MMA(0, 0, At, B0); PG8_MMA(0, 1, At, B1); PG8_BAR; PG8_SCHED;
            PG8_LDA(At, 0, 1); PG8_STAGE(PG8_SB(0, 0), b2, voffB); PG8_STAGE(PG8_SB(0, 1), b2 + hstep, voffB); PG8_STA(PG8_SA(0, 0), a2, kb2, 0, nx);
            PG8_WAIT_V(8); PG8_WAIT_L(0); PG8_BAR; PG8_MMA(1, 0, At, B0); PG8_MMA(1, 1, At, B1); PG8_BAR; PG8_SCHED;
            PG8_LDB(B0, 1, 0); PG8_LDB(B1, 1, 1); PG8_SCHED; PG8_LDA(At, 1, 0); PG8_STA(PG8_SA(0, 1), a2 + hstep, kb2, 1, nx);
            PG8_WAIT_V(8); PG8_WAIT_L(0); PG8_BAR; PG8_MMA(0, 0, At, B0); PG8_MMA(0, 1, At, B1); PG8_BAR; PG8_SCHED;
            PG8_LDA(At, 1, 1); PG8_STAGE(PG8_SB(1, 0), b3, voffB); PG8_STAGE(PG8_SB(1, 1), b3 + hstep, voffB); PG8_STA(PG8_SA(1, 0), a3, kb2 + kstep, 0, nx);
            PG8_WAIT_V(8); PG8_WAIT_L(0); PG8_BAR; PG8_MMA(1, 0, At, B0); PG8_MMA(1, 1, At, B1); PG8_BAR; PG8_SCHED;
            }
            } else {
            PG8_LDB(B0, 0, 0); PG8_SCHED; PG8_LDA(At, 0, 0); PG8_STAGE(PG8_SA(1, 1), a1 + hstep, voffA);
            PG8_WAIT_L(8); PG8_BAR; PG8_WAIT_L(0); PG8_MMA(0, 0, At, B0); PG8_BAR; PG8_SCHED;
            PG8_LDB(B1, 0, 1); PG8_STAGE(PG8_SB(0, 0), b2, voffB);
            PG8_BAR; PG8_WAIT_L(0); PG8_MMA(0, 1, At, B1); PG8_BAR;
            PG8_LDA(At, 0, 1); PG8_STAGE(PG8_SA(0, 0), a2, voffA);
            PG8_BAR; PG8_WAIT_L(0); PG8_MMA(1, 0, At, B0); PG8_BAR; PG8_SCHED;
            PG8_STAGE(PG8_SB(0, 1), b2 + hstep, voffB);
            PG8_WAIT_V(6); PG8_BAR; PG8_MMA(1, 1, At, B1); PG8_BAR;
            PG8_LDB(B0, 1, 0); PG8_SCHED; PG8_LDA(At, 1, 0); PG8_STAGE(PG8_SA(0, 1), a2 + hstep, voffA);
            PG8_WAIT_L(8); PG8_BAR; PG8_WAIT_L(0); PG8_MMA(0, 0, At, B0); PG8_BAR; PG8_SCHED;
            PG8_LDB(B1, 1, 1); PG8_STAGE(PG8_SB(1, 0), b3, voffB);
            PG8_BAR; PG8_WAIT_L(0); PG8_MMA(0, 1, At, B1); PG8_BAR;
            PG8_LDA(At, 1, 1); PG8_STAGE(PG8_SA(1, 0), a3, voffA);
            PG8_BAR; PG8_WAIT_L(0); PG8_MMA(1, 0, At, B0); PG8_BAR; PG8_SCHED;
            PG8_STAGE(PG8_SB(1, 1), b3 + hstep, voffB);
            PG8_WAIT_V(6); PG8_BAR; PG8_MMA(1, 1, At, B1); PG8_BAR;
            }
        }
        if constexpr (FP8) asm volatile("s_nop 15\n\ts_nop 7" ::: "memory");
        if constexpr (ALIGN_EPI) { if (wr == 0) PG8_BAR; }
        if constexpr (!Epi::AFTER_DRAIN) { int fr_ = fr, fq_ = fq; asm volatile("" : "+v"(fr_), "+v"(fq_));
            E(acc, cur, wr, wc, fr_, fq_); S.done(cur); }
        if (!has_next) break;
#pragma unroll
        for (int a = 0; a < 2; ++a)
#pragma unroll
            for (int b = 0; b < 2; ++b)
#pragma unroll
                for (int m = 0; m < 4; ++m)
#pragma unroll
                    for (int n = 0; n < 2; ++n) acc[a][b][m][n] = (f32x4){0.f, 0.f, 0.f, 0.f};
        cur = nxt; cA = nA; cB = nB; ++ui;
        if constexpr (GATHER) { vC[0][0] = vN[0][0]; vC[0][1] = vN[0][1]; vC[1][0] = vN[1][0]; vC[1][1] = vN[1][1]; }
        if constexpr (ALIGN_EPI) { if (wr == 1) PG8_BAR; }
    }
    PG8_WAIT_V(0);
    if constexpr (!ALIGN_EPI) { if (wr == 0) PG8_BAR; }
    PG8_BAR;
    if constexpr (Epi::AFTER_DRAIN) { E.fused(acc, cur, wr, wc, fr, fq, lds, wid, lane); S.done(cur); }
#undef PG8_SA
#undef PG8_SB
#undef PG8_STAGE
#undef PG8_GDMA
#undef PG8_GREAD
#undef PG8_GSTAGE
#undef PG8_STA
#undef PG8_LDA
#undef PG8_LDB
#undef PG8_MMA
#undef PG8_CAT
#undef PG8_WAIT_V
#undef PG8_WAIT_L
#undef PG8_BAR
#undef PG8_SCHED
}
}

#define GAS __attribute__((address_space(1)))
#define LAS __attribute__((address_space(3)))
typedef unsigned v4u __attribute__((ext_vector_type(4)));
using pg8::f32x4;
typedef GAS unsigned gu32;
typedef GAS unsigned long long gu64;
#define RLX_AGENT __ATOMIC_RELAXED, __HIP_MEMORY_SCOPE_AGENT
#define LDS_WAIT() asm volatile("s_waitcnt lgkmcnt(0)" ::: "memory")
#define VM_WAIT() asm volatile("s_waitcnt vmcnt(0)" ::: "memory")

#define XB_TMO      128
#define XB_XCNT(j)  (256  + 64 * (j))
#define XB_XSUB(j)  (1280 + 64 * (j))
#define XB_XGEN(j)  (2304 + 64 * (j))
#define XB_TOP      3328
#define XB_TOPGEN   3392
#define XCD_BAR_WORDS 3456
#define XB_SPIN_CAP (1u << 18)

__device__ __forceinline__ unsigned xb_ld(unsigned* p)              { return __hip_atomic_load(p, __ATOMIC_RELAXED, __HIP_MEMORY_SCOPE_AGENT); }
__device__ __forceinline__ unsigned xb_add(unsigned* p, unsigned v) { return __hip_atomic_fetch_add(p, v, __ATOMIC_RELAXED, __HIP_MEMORY_SCOPE_AGENT); }
__device__ __forceinline__ unsigned xb_xcc_id() { return (unsigned)__builtin_amdgcn_s_getreg((3 << 11) | 20) & 0xFu; }
#define XB_SPIN(cond, bar) do { unsigned _sp = 0; while (cond) { __builtin_amdgcn_s_sleep(1); \
    if ((++_sp & 255u) == 0u) { if (xb_ld(&(bar)[XB_TMO])) break; if (_sp > XB_SPIN_CAP) { atomicAdd(&(bar)[XB_TMO], 1u); break; } } } } while (0)

struct XcdBarrier {
    unsigned* bar; unsigned x;
    volatile LAS unsigned* st;
};

__device__ __forceinline__ XcdBarrier xcd_barrier_post(unsigned* bar, volatile LAS unsigned* st) {
    XcdBarrier b; b.bar = bar; b.x = xb_xcc_id(); b.st = st;
    if (threadIdx.x == 0) (void)xb_add(&bar[XB_XCNT(b.x)], 1u);
    return b;
}
__device__ __forceinline__ void xcd_barrier_complete(unsigned* bar, unsigned x, unsigned& nloc, unsigned& nx) {
    const unsigned G = gridDim.x * gridDim.y * gridDim.z;
    unsigned sum, cnt, mine, sp = 0u;
    for (;;) {
        sum = 0u; cnt = 0u; mine = 0u;
#pragma unroll
        for (unsigned j = 0; j < 16; ++j) { const unsigned c = xb_ld(&bar[XB_XCNT(j)]); sum += c; cnt += (c > 0u) ? 1u : 0u; mine = (j == x) ? c : mine; }
        if (sum == G) break;
        __builtin_amdgcn_s_sleep(1);
        if ((++sp & 255u) == 0u) { if (xb_ld(&bar[XB_TMO])) break; if (sp > XB_SPIN_CAP) { atomicAdd(&bar[XB_TMO], 1u); break; } }
    }
    nloc = mine > 0u ? mine : 1u; nx = cnt > 0u ? cnt : 1u;
}

__device__ __forceinline__ void xcd_barrier(const XcdBarrier& b) {
    asm volatile("s_waitcnt vmcnt(0)" ::: "memory");
    __syncthreads();
    if (threadIdx.x == 0) {
        unsigned* bar = b.bar;
        __builtin_amdgcn_s_waitcnt(0);
        unsigned nloc = b.st[0], nx = b.st[1];
        if (nloc == 0u) { xcd_barrier_complete(bar, b.x, nloc, nx); b.st[0] = nloc; b.st[1] = nx; }
        const unsigned old = xb_add(&bar[XB_XSUB(b.x)], 1u);
        const unsigned gen = old / nloc;
        if (old + 1u == (gen + 1u) * nloc) {
            __builtin_amdgcn_fence(__ATOMIC_RELEASE, "agent");
            asm volatile("s_waitcnt vmcnt(0)" ::: "memory");
            const unsigned og = xb_add(&bar[XB_TOP], 1u);
            const unsigned tg = og / nx;
            if (og + 1u == (tg + 1u) * nx) xb_add(&bar[XB_TOPGEN], 1u);
            else XB_SPIN(xb_ld(&bar[XB_TOPGEN]) == tg, bar);
            __builtin_amdgcn_fence(__ATOMIC_ACQUIRE, "agent");
            xb_add(&bar[XB_XGEN(b.x)], 1u);
            asm volatile("s_waitcnt vmcnt(0)" ::: "memory");
        } else {
            XB_SPIN(xb_ld(&bar[XB_XGEN(b.x)]) == gen, bar);
            __builtin_amdgcn_fence(__ATOMIC_ACQUIRE, "agent");
            asm volatile("s_waitcnt vmcnt(0)" ::: "memory");
        }
    }
    __syncthreads();
}


namespace attn_body {
using bf16=__hip_bfloat16;
using bf16x8=__attribute__((ext_vector_type(8)))short;
using s16x4=__attribute__((ext_vector_type(4)))short;
using f32x16=__attribute__((ext_vector_type(16)))float;
using u32x4=__attribute__((ext_vector_type(4)))unsigned;
constexpr int SEQ=4096,D=64,KP=2048,OP=1024;
constexpr int NW=8,QBLK=32,QB=QBLK*NW,KVBLK=64,NQB=SEQ/QB;
__device__ __forceinline__ int crow(int r,int hi){return (r&3)+8*(r>>2)+4*hi;}
#define SBAR() __builtin_amdgcn_sched_barrier(0)
constexpr int NSLOT=3, SLOTB=8192;
constexpr int LDS_K=0, LDS_V=NSLOT*SLOTB, LDS_WS=2*NSLOT*SLOTB, LDS_OST=LDS_WS+NW*64*4, LDS_BYTES=LDS_OST+NW*4096;
constexpr float C2=0.125f*1.4426950408889634f;
__device__ __forceinline__ void glds16(const void*gsrc,unsigned lds_dst){unsigned keep;
  asm volatile("s_mov_b32 %0, m0\n\ts_mov_b32 m0, %2\n\ts_nop 0\n\tglobal_load_lds_dwordx4 %1, off\n\ts_mov_b32 m0, %0":"=&s"(keep):"v"(gsrc),"s"(lds_dst):"memory");}
__device__ __forceinline__ float max3f(float a,float b,float c){float r;asm("v_max3_f32 %0, %1, %2, %3":"=v"(r):"v"(a),"v"(b),"v"(c));return r;}
__device__ __forceinline__ float max2f(float a,float b){float r;asm("v_max_f32_e32 %0, %1, %2":"=v"(r):"v"(a),"v"(b));return r;}
__device__ __forceinline__ float fadd_s(float a,float b){float r;asm("v_add_f32_e32 %0, %1, %2":"=v"(r):"v"(a),"v"(b));return r;}
__device__ __forceinline__ float fsub_s(float a,float b){float r;asm("v_sub_f32_e32 %0, %1, %2":"=v"(r):"v"(a),"v"(b));return r;}
typedef float f32x2_t __attribute__((ext_vector_type(2))); typedef __bf16 bf16x2_t __attribute__((ext_vector_type(2)));
__device__ __forceinline__ unsigned cvtpk_s(float lo,float hi){f32x2_t v={lo,hi};bf16x2_t b=__builtin_convertvector(v,bf16x2_t);return __builtin_bit_cast(unsigned,b);}
#define WAIT_BAR(N) asm volatile("s_waitcnt vmcnt(" #N ") lgkmcnt(0)\n\ts_barrier":::"memory")

__device__ __forceinline__ void qkt(f32x16&p0,f32x16&p1,const char*Kslot,const bf16x8*qr,const f32x16&negm,int r32,int hi){
  const char*kb=Kslot+hi*1024+r32*16;
  #pragma unroll
  for(int d0=0;d0<4;++d0){
    const bf16x8 b0=*reinterpret_cast<const bf16x8*>(kb+d0*2048);
    const bf16x8 b1=*reinterpret_cast<const bf16x8*>(kb+d0*2048+512);
    if(d0==0){p0=__builtin_amdgcn_mfma_f32_32x32x16_bf16(b0,qr[0],negm,0,0,0);p1=__builtin_amdgcn_mfma_f32_32x32x16_bf16(b1,qr[0],negm,0,0,0);}
    else{p0=__builtin_amdgcn_mfma_f32_32x32x16_bf16(b0,qr[d0],p0,0,0,0);p1=__builtin_amdgcn_mfma_f32_32x32x16_bf16(b1,qr[d0],p1,0,0,0);}}
}
typedef __attribute__((address_space(3))) const char* lds_cptr;
typedef short v4i16_t __attribute__((ext_vector_type(4)));
__device__ __forceinline__ void kload8(bf16x8*kf,lds_cptr kp){
  kf[0]=*(const __attribute__((address_space(3))) bf16x8*)(kp);      kf[1]=*(const __attribute__((address_space(3))) bf16x8*)(kp+512);
  kf[2]=*(const __attribute__((address_space(3))) bf16x8*)(kp+2048); kf[3]=*(const __attribute__((address_space(3))) bf16x8*)(kp+2560);
  kf[4]=*(const __attribute__((address_space(3))) bf16x8*)(kp+4096); kf[5]=*(const __attribute__((address_space(3))) bf16x8*)(kp+4608);
  kf[6]=*(const __attribute__((address_space(3))) bf16x8*)(kp+6144); kf[7]=*(const __attribute__((address_space(3))) bf16x8*)(kp+6656);
}
__device__ __forceinline__ void kload2(bf16x8*kf,lds_cptr kp,int j){ kf[2*j]=*(const __attribute__((address_space(3))) bf16x8*)(kp+j*2048); kf[2*j+1]=*(const __attribute__((address_space(3))) bf16x8*)(kp+j*2048+512); }
__device__ __forceinline__ s16x4 vtr(lds_cptr p){ return __builtin_bit_cast(s16x4,__builtin_amdgcn_ds_read_tr16_b64_v4i16((__attribute__((address_space(3))) v4i16_t*)p)); }
__device__ __forceinline__ float rowmax(const f32x16&p0,const f32x16&p1){
  float a=max3f(p0[0],p0[1],p1[0]),b=max3f(p0[2],p0[3],p1[1]);a=max3f(a,p1[2],p1[3]);
  #pragma unroll
  for(int r=4;r<16;r+=4){a=max3f(a,p0[r],p0[r+1]);b=max3f(b,p0[r+2],p0[r+3]);a=max3f(a,p1[r],p1[r+1]);b=max3f(b,p1[r+2],p1[r+3]);}
  const float m=max2f(a,b);
  auto rr=__builtin_amdgcn_permlane32_swap(__float_as_uint(m),__float_as_uint(m),false,false);
  return max2f(__uint_as_float(rr[0]),__uint_as_float(rr[1]));
}
__device__ __forceinline__ void pv(f32x16*o,int vb,bf16x8 pa0,bf16x8 pa1,bf16x8 pa2,bf16x8 pa3){
  #pragma unroll
  for(int d0=0;d0<2;++d0){s16x4 lo[4],hi[4];
    #pragma unroll
    for(int ks=0;ks<4;++ks){
      asm volatile("ds_read_b64_tr_b16 %0,%1 offset:%c2":"=&v"(lo[ks]):"v"(vb),"i"(d0*4096+ks*1024):"memory");
      asm volatile("ds_read_b64_tr_b16 %0,%1 offset:%c2":"=&v"(hi[ks]):"v"(vb),"i"(d0*4096+ks*1024+512):"memory");}
    asm volatile("s_waitcnt lgkmcnt(0)":::"memory");SBAR();
    #define PK(k) (bf16x8){lo[k][0],lo[k][1],lo[k][2],lo[k][3],hi[k][0],hi[k][1],hi[k][2],hi[k][3]}
    o[d0]=__builtin_amdgcn_mfma_f32_32x32x16_bf16(pa0,PK(0),o[d0],0,0,0);
    o[d0]=__builtin_amdgcn_mfma_f32_32x32x16_bf16(pa1,PK(1),o[d0],0,0,0);
    o[d0]=__builtin_amdgcn_mfma_f32_32x32x16_bf16(pa2,PK(2),o[d0],0,0,0);
    o[d0]=__builtin_amdgcn_mfma_f32_32x32x16_bf16(pa3,PK(3),o[d0],0,0,0);
    #undef PK
  }
}

#ifndef ATTN_STORE16
#define ATTN_STORE16(p,v) (*(u32x4*)(p)=(v))
#endif
template<int THRL,bool NOMAX=false,bool MSUM=true> __device__ __forceinline__ void attn_unit(const bf16*Qw0,const bf16*__restrict__ Kh,const bf16*__restrict__ Vh,bf16*Ow0,char*shm,int tid_in){
  int tid_=tid_in; asm volatile("":"+v"(tid_));
  const int tid=tid_,lane=tid&63,r32=lane&31,hi=lane>>5; const int wid=__builtin_amdgcn_readfirstlane(tid>>6);
  const bf16*Qw=Qw0+(long)(wid*QBLK)*KP;
  const unsigned lds0=(unsigned)(uintptr_t)shm;
  float*wsf=(float*)(shm+LDS_WS)+wid*64;
  const bf16*ksrc=Kh+(long)lane*KP+wid*8;
  const bf16*vsrc=Vh+(long)(16*(wid&3)+(lane>>2))*KP+(wid>>2)*32+(lane&3)*8;
  const unsigned kdst=lds0+LDS_K+wid*1024, vdst=lds0+LDS_V+wid*1024;
  #define DMA_K(t,slot) glds16(ksrc+(long)(t)*KVBLK*KP,(unsigned)__builtin_amdgcn_readfirstlane(kdst+(slot)))
  #define DMA_V(t,slot) glds16(vsrc+(long)(t)*KVBLK*KP,(unsigned)__builtin_amdgcn_readfirstlane(vdst+(slot)))
  const int vb0=(int)(lds0+LDS_V)+((lane>>4)&1)*32+(lane&3)*8+(4*hi+((lane&15)>>2))*64;
  const char*Kbase=shm+LDS_K; bf16x8 kf[8];
  const lds_cptr shm3=(lds_cptr)shm; const lds_cptr kp0=shm3+LDS_K+hi*1024+r32*16; const lds_cptr vp0=shm3+LDS_V+((lane>>4)&1)*32+(lane&3)*8+(4*hi+((lane&15)>>2))*64;
  constexpr int NT=SEQ/KVBLK;
  DMA_K(0,0);DMA_V(0,0);DMA_K(1,SLOTB);
  bf16x8 qr[4];
  #pragma unroll
  for(int d0=0;d0<4;++d0)qr[d0]=*reinterpret_cast<const bf16x8*>(&Qw[(long)r32*KP+d0*16+hi*8]);
  float mhat=0.f,l_reg=0.f;f32x16 o[2];o[0]=f32x16{};o[1]=f32x16{};f32x16 negm=f32x16{};if constexpr(!NOMAX)asm volatile("":"+v"(negm));
  f32x16 lsum=f32x16{}; const bf16x8 ONESF={(short)0x3F80,(short)0x3F80,(short)0x3F80,(short)0x3F80,(short)0x3F80,(short)0x3F80,(short)0x3F80,(short)0x3F80};
  #define CMASK(P0,P1,t) do{}while(0)
  bool resc=false;
  #define START(P0,P1) do{ if constexpr(!NOMAX){ const float rm=rowmax(P0,P1); resc=false; \
    { const float dl=rm; mhat=fadd_s(mhat,dl); \
      _Pragma("unroll") for(int r=0;r<16;++r){P0[r]=fsub_s(P0[r],dl);P1[r]=fsub_s(P1[r],dl);} \
      _Pragma("unroll") for(int r=0;r<16;++r)negm[r]=-mhat; asm volatile("":"+v"(negm)); } } \
    _Pragma("unroll") for(int r=0;r<16;++r)P0[r]=__builtin_amdgcn_exp2f(P0[r]); }while(0)
  #define RESC() do{ if(resc){ asm volatile("s_waitcnt lgkmcnt(0)":::"memory"); \
      _Pragma("unroll") for(int d_=0;d_<2;++d_) _Pragma("unroll") for(int r=0;r<16;++r)o[d_][r]*=wsf[crow(r,hi)]; } }while(0)
  f32x16 pA0,pA1,pB0,pB1;
  int sl_prev=0,sl_cur=0,sl_next=SLOTB;
  #define ROT() do{sl_prev=sl_cur;sl_cur=sl_next;sl_next=(sl_next==(NSLOT-1)*SLOTB)?0:sl_next+SLOTB;}while(0)
  DMA_K(2,2*SLOTB);
  WAIT_BAR(3);
  qkt(pA0,pA1,Kbase,qr,negm,r32,hi);asm volatile("s_nop 15\n\ts_nop 7":"+v"(pA0),"+v"(pA1));CMASK(pA0,pA1,0);
  START(pA0,pA1);
  _Pragma("unroll") for(int r=0;r<16;++r)pA1[r]=__builtin_amdgcn_exp2f(pA1[r]);
  WAIT_BAR(0);
  DMA_K(3,0);DMA_V(1,SLOTB);
  ROT();
  kload8(kf,kp0+sl_cur);
  WAIT_BAR(2);
  s16x4 vlo[8],vhi[8]; u32x4 pw0,pw1,pw2,pw3;
  #define PKW(P,B) cvtpk_s(P[B],P[B+1])
  #define PAF(k) __builtin_bit_cast(bf16x8,pw##k)
  #define VFR(i) (bf16x8){vlo[i][0],vlo[i][1],vlo[i][2],vlo[i][3],vhi[i][0],vhi[i][1],vhi[i][2],vhi[i][3]}
  #define PIN(x) asm volatile("":"+v"(x))
  #define MX3(a,b,c) __builtin_fmaxf(__builtin_fmaxf((a),(b)),(c))
  #define GAPA(MF,A0,A1,A2,A3,W0,W1,PW) do{ MF; if constexpr(!(NOMAX&&MSUM)){ sacc+=A0; sacc+=A1; sacc+=A2; sacc+=A3; PIN(sacc); } W0; W1; PIN(PW); SBAR(); }while(0)
  #define LSUM(k) do{ if constexpr(NOMAX&&MSUM){ lsum=__builtin_amdgcn_mfma_f32_32x32x16_bf16(PAF(k),ONESF,lsum,0,0,0); SBAR(); } }while(0)
  #define EX(v) __builtin_amdgcn_exp2f(v)
  #define GAPB(MF,X,B) do{ MF; X[B]=EX(X[B]); X[B+1]=EX(X[B+1]); X[B+2]=EX(X[B+2]); X[B+3]=EX(X[B+3]); PIN(X); SBAR(); }while(0)
  #define VRD(i) do{ vlo[i]=vtr(vp_+(((i)>>2)*4096+((i)&3)*1024)); vhi[i]=vtr(vp_+(((i)>>2)*4096+((i)&3)*1024+512)); }while(0)
  #define KRD(G,j) do{ if(G){ kload2(kf,kp0+sl_next,j); SBAR(); } }while(0)
  #define STEP(C0,C1,P0,P1,t,GK,GV,GL) do{ SBAR(); \
    const lds_cptr vp_=vp0+sl_prev; \
    VRD(0); SBAR(); float sacc=0.f; if constexpr(!(NOMAX&&MSUM)) sacc=(P0[0]+P0[1]); \
    GAPA(C0=__builtin_amdgcn_mfma_f32_32x32x16_bf16(kf[0],qr[0],negm,0,0,0), P0[2],P0[3],P0[4],P0[5],     pw0[0]=PKW(P0,0), pw0[1]=PKW(P0,2), pw0); \
    VRD(4); SBAR(); GAPA(C1=__builtin_amdgcn_mfma_f32_32x32x16_bf16(kf[1],qr[0],negm,0,0,0), P0[6],P0[7],P0[8],P0[9],     pw0[2]=PKW(P0,4), pw0[3]=PKW(P0,6), pw0); \
    VRD(1); SBAR(); GAPA(C0=__builtin_amdgcn_mfma_f32_32x32x16_bf16(kf[2],qr[1],C0,0,0,0),   P0[10],P0[11],P0[12],P0[13], pw1[0]=PKW(P0,8), pw1[1]=PKW(P0,10), pw1); \
    VRD(5); SBAR(); GAPA(C1=__builtin_amdgcn_mfma_f32_32x32x16_bf16(kf[3],qr[1],C1,0,0,0),   P0[14],P0[15],P1[0],P1[1],   pw1[2]=PKW(P0,12),pw1[3]=PKW(P0,14), pw1); \
    VRD(2); SBAR(); GAPA(C0=__builtin_amdgcn_mfma_f32_32x32x16_bf16(kf[4],qr[2],C0,0,0,0),   P1[2],P1[3],P1[4],P1[5],     pw2[0]=PKW(P1,0), pw2[1]=PKW(P1,2), pw2); \
    VRD(6); SBAR(); GAPA(C1=__builtin_amdgcn_mfma_f32_32x32x16_bf16(kf[5],qr[2],C1,0,0,0),   P1[6],P1[7],P1[8],P1[9],     pw2[2]=PKW(P1,4), pw2[3]=PKW(P1,6), pw2); \
    VRD(3); SBAR(); GAPA(C0=__builtin_amdgcn_mfma_f32_32x32x16_bf16(kf[6],qr[3],C0,0,0,0),   P1[10],P1[11],P1[12],P1[13], pw3[0]=PKW(P1,8), pw3[1]=PKW(P1,10), pw3); \
    VRD(7); SBAR(); GAPA(C1=__builtin_amdgcn_mfma_f32_32x32x16_bf16(kf[7],qr[3],C1,0,0,0),   P1[14],P1[15],0.f,0.f,       pw3[2]=PKW(P1,12),pw3[3]=PKW(P1,14), pw3); \
    l_reg+=sacc; \
    if(GK){DMA_K((t)+3,sl_cur);} if(GV){DMA_V((t)+1,sl_next);} \
    CMASK(C0,C1,t); \
    if constexpr(!NOMAX){ float a=MX3(C0[0],C0[1],C1[0]),b=MX3(C0[2],C0[3],C1[1]); a=MX3(a,C1[2],C1[3]); \
      _Pragma("unroll") for(int r=4;r<16;r+=4){a=MX3(a,C0[r],C0[r+1]);b=MX3(b,C0[r+2],C0[r+3]);a=MX3(a,C1[r],C1[r+1]);b=MX3(b,C1[r+2],C1[r+3]);} \
      float rm=__builtin_fmaxf(a,b); { auto rr=__builtin_amdgcn_permlane32_swap(__float_as_uint(rm),__float_as_uint(rm),false,false); rm=__builtin_fmaxf(__uint_as_float(rr[0]),__uint_as_float(rr[1])); } \
      resc=false; \
      if(__builtin_expect(__any(rm>(float)THRL),0)){ const float dl=__builtin_fmaxf(rm,0.f); mhat+=dl; \
        _Pragma("unroll") for(int r=0;r<16;++r){C0[r]-=dl;C1[r]-=dl;} \
        _Pragma("unroll") for(int r=0;r<16;++r)negm[r]=-mhat; asm volatile("":"+v"(negm)); \
        const float f=__builtin_amdgcn_exp2f(-dl); l_reg*=f; if(hi==0)wsf[r32]=f; resc=true; } } \
    SBAR(); \
    GAPB(o[0]=__builtin_amdgcn_mfma_f32_32x32x16_bf16(PAF(0),VFR(0),o[0],0,0,0), C0,0); \
    GAPB(o[1]=__builtin_amdgcn_mfma_f32_32x32x16_bf16(PAF(0),VFR(4),o[1],0,0,0), C0,4); LSUM(0); \
    KRD(GL,0); GAPB(o[0]=__builtin_amdgcn_mfma_f32_32x32x16_bf16(PAF(1),VFR(1),o[0],0,0,0), C0,8); \
    KRD(GL,1); GAPB(o[1]=__builtin_amdgcn_mfma_f32_32x32x16_bf16(PAF(1),VFR(5),o[1],0,0,0), C0,12); LSUM(1); \
    KRD(GL,2); GAPB(o[0]=__builtin_amdgcn_mfma_f32_32x32x16_bf16(PAF(2),VFR(2),o[0],0,0,0), C1,0); \
    KRD(GL,3); GAPB(o[1]=__builtin_amdgcn_mfma_f32_32x32x16_bf16(PAF(2),VFR(6),o[1],0,0,0), C1,4); LSUM(2); \
    GAPB(o[0]=__builtin_amdgcn_mfma_f32_32x32x16_bf16(PAF(3),VFR(3),o[0],0,0,0), C1,8); \
    GAPB(o[1]=__builtin_amdgcn_mfma_f32_32x32x16_bf16(PAF(3),VFR(7),o[1],0,0,0), C1,12); LSUM(3); \
    }while(0)
  int t=1;
  for(;t+5<NT;t+=2){
    STEP(pB0,pB1,pA0,pA1,t,true,true,true);     WAIT_BAR(2); RESC(); ROT();
    STEP(pA0,pA1,pB0,pB1,t+1,true,true,true);   WAIT_BAR(2); RESC(); ROT();
  }
  #define ENDW(tt) do{ if((tt)+3<NT){WAIT_BAR(2);} else if((tt)+2<NT){WAIT_BAR(1);} else {WAIT_BAR(0);} }while(0)
  for(;t+1<NT;t+=2){
    STEP(pB0,pB1,pA0,pA1,t,(t+3<NT),(t+1<NT),(t+1<NT));       ENDW(t);   RESC(); ROT();
    STEP(pA0,pA1,pB0,pB1,t+1,(t+4<NT),(t+2<NT),(t+2<NT));     ENDW(t+1); RESC(); ROT();
  }
  STEP(pB0,pB1,pA0,pA1,NT-1,false,false,false); RESC();
  { if constexpr(!(NOMAX&&MSUM)){ float sacc=pB0[0]+pB0[1]; _Pragma("unroll") for(int r=2;r<16;++r)sacc+=pB0[r]; _Pragma("unroll") for(int r=0;r<16;++r)sacc+=pB1[r]; l_reg+=sacc; }
    pw0=(u32x4){PKW(pB0,0),PKW(pB0,2),PKW(pB0,4),PKW(pB0,6)};pw1=(u32x4){PKW(pB0,8),PKW(pB0,10),PKW(pB0,12),PKW(pB0,14)};pw2=(u32x4){PKW(pB1,0),PKW(pB1,2),PKW(pB1,4),PKW(pB1,6)};pw3=(u32x4){PKW(pB1,8),PKW(pB1,10),PKW(pB1,12),PKW(pB1,14)};
    SBAR(); pv(o,vb0+sl_cur,PAF(0),PAF(1),PAF(2),PAF(3)); LSUM(0); LSUM(1); LSUM(2); LSUM(3); }
  #undef PKW
  #undef PAF
  #undef VFR
  #undef PIN
  #undef MX3
  #undef GAPA
  #undef LSUM
  #undef GAPB
  #undef EX
  #undef VRD
  #undef KRD
  #undef STEP
  #undef ENDW
  float rli[16];
  if constexpr(NOMAX&&MSUM){
    #pragma unroll
    for(int r=0;r<16;++r)rli[r]=__builtin_amdgcn_rcpf(lsum[r]);
  } else {
  {auto rr=__builtin_amdgcn_permlane32_swap(__float_as_uint(l_reg),__float_as_uint(l_reg),false,false);l_reg=__uint_as_float(rr[0])+__uint_as_float(rr[1]);}
  if(hi==0)wsf[32+r32]=l_reg;asm volatile("s_waitcnt lgkmcnt(0)":::"memory");
  #pragma unroll
  for(int r=0;r<16;++r)rli[r]=__builtin_amdgcn_rcpf(wsf[32+crow(r,hi)]);
  }
  bf16*Ow=Ow0+(long)(wid*QBLK)*OP;
  { bf16*stg=(bf16*)(shm+LDS_OST)+wid*2048;
    #pragma unroll
    for(int r=0;r<16;++r){const int orow=crow(r,hi);
      #pragma unroll
      for(int d0=0;d0<2;++d0)stg[orow*64+d0*32+r32]=__float2bfloat16(o[d0][r]*rli[r]);}
    asm volatile("s_waitcnt lgkmcnt(0)":::"memory");
    #pragma unroll
    for(int i=0;i<4;++i){const int row=i*8+(lane>>3),ch=lane&7; const u32x4 v=*(const u32x4*)(stg+row*64+ch*8); ATTN_STORE16(Ow+(long)row*OP+ch*8,v);} }
  asm volatile("s_waitcnt lgkmcnt(0)\n\ts_barrier":::"memory");
  #undef DMA_K
  #undef DMA_V
  #undef CMASK
  #undef START
  #undef RESC
  #undef ROT
}
constexpr int ATTN_LDS_BYTES=LDS_BYTES;
#undef SBAR
#undef WAIT_BAR
}

typedef unsigned short bf16;
typedef float f32x16 __attribute__((ext_vector_type(16)));
typedef short s16x4 __attribute__((ext_vector_type(4)));
typedef short v4i16_t __attribute__((ext_vector_type(4)));
typedef unsigned u32x2 __attribute__((ext_vector_type(2)));
typedef float f32x2v __attribute__((ext_vector_type(2)));
using pg8::bf16x8; using pg8::u32x4;

constexpr int DM = 1024, SEQ = 4096, T_P = 4 * 4096, T_S = 16 * 4096, TT = T_P + T_S, NBATCH = 20;
constexpr int DIN = 2048, NLAYER = 4, NEXP = 16, DEXP = 2048;
constexpr int CAP_P = T_P / 8, CAP_S = T_S / 8, ROWS_P = NEXP * CAP_P, ROWS_E = 2 * TT;
constexpr float LN_EPS = 1e-5f, QK_EPS = 1e-6f;
constexpr float DN_ALPHA = 1.6817928305074290861f;
constexpr float LOG2E = 1.4426950408889634f;
constexpr float C2 = 0.125f * LOG2E;
constexpr int H_NAQ = 0, H_NAK = 256, H_NAV = 512, H_GQ = 768, H_GK = 1280, H_GV = 1408, H_UC = 1536, H_VC = 1792;
constexpr int Y_NA = 0, Y_GQA = 256, Y_SG = 768;

constexpr size_t MiB = 1u << 20;
constexpr size_t WS_CTL = 0, CTL_ZERO_BYTES = 1 * MiB;
constexpr size_t WS_ROPE = 1 * MiB;
constexpr size_t WS_WSBF = 2 * MiB;
constexpr size_t WS_WIN = 4 * MiB;
constexpr size_t WS_WOUT = 8 * MiB;
constexpr size_t WS_WGU = 16 * MiB;
constexpr size_t WS_WD = 144 * MiB;
constexpr size_t WS_AFF = 208 * MiB;
constexpr size_t WS_SLOTOF = 214 * MiB;
constexpr size_t WS_IDX = 220 * MiB;
constexpr size_t WS_GATE = 221 * MiB;
constexpr size_t WS_STATS = 222 * MiB;
constexpr size_t WS_XB = 224 * MiB;
constexpr size_t WS_H = 384 * MiB;
constexpr size_t WS_SB = 544 * MiB;
constexpr size_t WS_HID = 704 * MiB;
constexpr size_t WS_XB8 = 1344 * MiB;
constexpr size_t WS_VT = 1424 * MiB;
constexpr size_t WS_SET1 = 1468 * MiB;
constexpr size_t WS_DUMMY = 1676 * MiB;
constexpr size_t WS_END = 1676 * MiB;
__device__ __forceinline__ size_t wset(int l) { return (l & 1) ? (WS_SET1 - 2 * MiB) : (size_t)0; }
#ifndef CONV_SPLIT_ITEMS
#define CONV_SPLIT_ITEMS 20480
#endif
constexpr int VTP = SEQ + 64;
constexpr int CW_TMO = 0, CW_BAR = 4096;

constexpr int NWAVES = 8;
constexpr int RING_BYTES = 131072, LDSCTL_OFF = RING_BYTES, MISC_OFF = LDSCTL_OFF + 320, LDS_BYTES = 147456;

__device__ __forceinline__ unsigned f2bf(float f) { unsigned u = __builtin_bit_cast(unsigned, f); return (u + 0x7fffu + ((u >> 16) & 1u)) >> 16; }
__device__ __forceinline__ unsigned pk2(float lo, float hi) { return f2bf(lo) | (f2bf(hi) << 16); }
__device__ __forceinline__ float bf2f(unsigned short b) { return __builtin_bit_cast(float, (unsigned)b << 16); }
template <int O> __device__ __forceinline__ float shx(float v) {
    static_assert(O >= 1 && O < 32, "ds_swizzle bit mode covers xor distances 1..31");
    return __builtin_bit_cast(float, __builtin_amdgcn_ds_swizzle(__builtin_bit_cast(int, v), 0x1f | (O << 10)));
}
__device__ __forceinline__ float sum32(float v) { const auto rr = __builtin_amdgcn_permlane32_swap(__float_as_uint(v), __float_as_uint(v), false, false); return __uint_as_float(rr[0]) + __uint_as_float(rr[1]); }
__device__ __forceinline__ float max32(float v) { const auto rr = __builtin_amdgcn_permlane32_swap(__float_as_uint(v), __float_as_uint(v), false, false); return fmaxf(__uint_as_float(rr[0]), __uint_as_float(rr[1])); }
__device__ __forceinline__ float other32(float v, bool upper) { const auto rr = __builtin_amdgcn_permlane32_swap(__float_as_uint(v), __float_as_uint(v), false, false); return __uint_as_float(upper ? rr[0] : rr[1]); }
__device__ __forceinline__ float wave_sum(float v) {
    v += shx<1>(v); v += shx<2>(v); v += shx<4>(v); v += shx<8>(v); v += shx<16>(v);
    return sum32(v);
}
__device__ __forceinline__ float gelu_tanh(float x) {
    const float u = 0.7978845608028654f * (x + 0.044715f * x * x * x);
    const float e = __builtin_amdgcn_exp2f((2.0f * LOG2E) * u);
    const float th = 1.0f - 2.0f * __builtin_amdgcn_rcpf(e + 1.0f);
    return 0.5f * x * (1.0f + th);
}
__device__ __forceinline__ float clamp8(float v) { return __builtin_amdgcn_fmed3f(v, -440.f, 440.f); }
__device__ __forceinline__ unsigned pk4_fp8(float a, float b, float c, float d) { int w = 0; w = __builtin_amdgcn_cvt_pk_fp8_f32(clamp8(a), clamp8(b), w, false); w = __builtin_amdgcn_cvt_pk_fp8_f32(clamp8(c), clamp8(d), w, true); return (unsigned)w; }
constexpr float WGU_SCALE = 64.f, WD_SCALE = 128.f, HID_SCALE = 8.f, YE_SCALE = 64.f;
__device__ __forceinline__ int crow(int r, int hi) { return (r & 3) + 8 * (r >> 2) + 4 * hi; }
__device__ __forceinline__ s16x4 tr_read(const LAS unsigned char* p) { return __builtin_bit_cast(s16x4, __builtin_amdgcn_ds_read_tr16_b64_v4i16((LAS v4i16_t*)p)); }
#define MFMA32(a, b, c) __builtin_amdgcn_mfma_f32_32x32x16_bf16((a), (b), (c), 0, 0, 0)

using pg8::Unit; using pg8::BM; using pg8::HALF;
__device__ __forceinline__ u32x4 pack8(const f32x4& a, const f32x4& b) { u32x4 w; w.x = pg8::cvt_pk_bf16(a[0], a[1]); w.y = pg8::cvt_pk_bf16(a[2], a[3]); w.z = pg8::cvt_pk_bf16(b[0], b[1]); w.w = pg8::cvt_pk_bf16(b[2], b[3]); return w; }

struct EpiIn {
    static constexpr bool PERM = true, AFTER_DRAIN = false;
    bf16* H; const float* qn; const float* kn; const float* gv; const float* bv; const float* rope; bf16* VT;
    __device__ __forceinline__ void operator()(const f32x4 (&acc)[2][2][4][2], const Unit& u, int wr, int wc, int fr, int fq) const {
        const int pn = u.pn;
        int mode; const float* gain = qn; float osc = 1.f;
        if (pn == 0) { mode = 1; osc = C2; } else if (pn <= 2) mode = 0; else if (pn <= 4) { mode = 2; gain = qn; osc = C2; }
        else if (pn == 5) { if (wc < 2) { mode = 2; gain = kn; osc = 1.f; } else mode = 0; } else if (pn == 6) mode = 3; else mode = 4;
        const int row0 = u.pm * BM + wr * 64 + fr;
        bf16* Hb = H + (size_t)row0 * DIN + pn * 256 + wc * 64 + 8 * fq;
#define EPI_ROWS(BODY) _Pragma("unroll") for (int ai = 0; ai < 2; ++ai) _Pragma("unroll") for (int m = 0; m < 4; ++m) { const int rofs = ai * HALF + m * 16; f32x4 v[2][2]; \
            _Pragma("unroll") for (int bj = 0; bj < 2; ++bj) _Pragma("unroll") for (int n = 0; n < 2; ++n) v[bj][n] = acc[ai][bj][m][n]; \
            BODY \
            bf16* rowp = Hb + (size_t)rofs * DIN; _Pragma("unroll") for (int bj = 0; bj < 2; ++bj) *(u32x4*)(rowp + 32 * bj) = pack8(v[bj][0], v[bj][1]); }
#define EPI_ALL(EXPR) _Pragma("unroll") for (int bj = 0; bj < 2; ++bj) _Pragma("unroll") for (int n = 0; n < 2; ++n) { EXPR }
        if (mode == 5) {
#pragma unroll
            for (int ai = 0; ai < 2; ++ai)
#pragma unroll
                for (int m = 0; m < 4; ++m) { const int t = row0 + ai * HALF + m * 16; bf16* vb = VT + ((size_t)((t >> 12) * 4 + wc) * 64 + 8 * fq) * VTP + (t & (SEQ - 1));
#pragma unroll
                    for (int bj = 0; bj < 2; ++bj)
#pragma unroll
                        for (int n = 0; n < 2; ++n)
#pragma unroll
                            for (int i = 0; i < 4; ++i) vb[(size_t)(32 * bj + 4 * n + i) * VTP] = (bf16)f2bf(acc[ai][bj][m][n][i]); }
        }
        else if (mode == 0) { EPI_ROWS( ; ) }
        else if (mode == 1) { EPI_ROWS( EPI_ALL( v[bj][n] = v[bj][n] * osc; ) ) }
        else if (mode == 2) {
            EPI_ROWS(
                float ss = 0.f;
                EPI_ALL( const f32x4 x = v[bj][n]; ss += (x[0] * x[0] + x[1] * x[1]) + (x[2] * x[2] + x[3] * x[3]); )
                ss += shx<16>(ss); ss = sum32(ss);
                const float rstd = osc * __builtin_amdgcn_rsqf(ss * (1.0f / 64.0f) + QK_EPS);
                const int sp = (row0 + rofs) & (SEQ - 1);
                EPI_ALL(
                    const f32x4 gg = *(const f32x4*)(gain + 32 * bj + 8 * fq + 4 * n);
                    const f32x4 cs = *(const f32x4*)(rope + ((size_t)sp * 32 + 16 * bj + 4 * fq + 2 * n) * 2);
                    const f32x4 x = v[bj][n] * rstd * gg;
                    f32x4 o; o[0] = x[0] * cs[0] - x[1] * cs[1]; o[1] = x[0] * cs[1] + x[1] * cs[0]; o[2] = x[2] * cs[2] - x[3] * cs[3]; o[3] = x[2] * cs[3] + x[3] * cs[2];
                    v[bj][n] = o; )
                asm volatile("" ::: "memory");
            )
        } else if (mode == 3) {
            EPI_ROWS( EPI_ALL( f32x4 x = v[bj][n]; x[0] = gelu_tanh(x[0]); x[1] = gelu_tanh(x[1]); x[2] = gelu_tanh(x[2]); x[3] = gelu_tanh(x[3]); v[bj][n] = x; ) )
        } else {
            EPI_ROWS(
                EPI_ALL( f32x4 x = v[bj][n]; x[0] = gelu_tanh(x[0]); x[1] = gelu_tanh(x[1]); x[2] = gelu_tanh(x[2]); x[3] = gelu_tanh(x[3]); v[bj][n] = x; )
                float sm = 0.f;
                EPI_ALL( const f32x4 x = v[bj][n]; sm += (x[0] + x[1]) + (x[2] + x[3]); )
                sm += shx<16>(sm); sm = sum32(sm);
                const float mean = sm * (1.0f / 64.0f); float q = 0.f;
                EPI_ALL( const f32x4 d = v[bj][n] - mean; v[bj][n] = d; q += (d[0] * d[0] + d[1] * d[1]) + (d[2] * d[2] + d[3] * d[3]); )
                q += shx<16>(q); q = sum32(q);
                const float rstd = __builtin_amdgcn_rsqf(q * (1.0f / 64.0f) + LN_EPS);
                EPI_ALL( const f32x4 gg = *(const f32x4*)(gv + wc * 64 + 32 * bj + 8 * fq + 4 * n); const f32x4 bb = *(const f32x4*)(bv + wc * 64 + 32 * bj + 8 * fq + 4 * n); v[bj][n] = v[bj][n] * rstd * gg + bb; )
                asm volatile("" ::: "memory");
            )
        }
#undef EPI_ROWS
#undef EPI_ALL
    }
};
struct EpiRes {
    static constexpr bool PERM = true, AFTER_DRAIN = false;
    const bf16* XB; bf16* S;
    __device__ __forceinline__ void operator()(const f32x4 (&acc)[2][2][4][2], const Unit& u, int wr, int wc, int fr, int fq) const {
        const int row0 = u.pm * BM + wr * 64 + fr, col0 = u.pn * BM + wc * 32 + 8 * fq;
#pragma unroll
        for (int ai = 0; ai < 2; ++ai)
#pragma unroll
            for (int m = 0; m < 4; ++m) { const size_t ro = (size_t)(row0 + ai * HALF + m * 16) * DM + col0;
#pragma unroll
                for (int bj = 0; bj < 2; ++bj) { const u32x4 xw = *(const u32x4*)(XB + ro + bj * HALF);
                    f32x4 x0, x1; x0[0] = __builtin_bit_cast(float, xw.x << 16); x0[1] = __builtin_bit_cast(float, xw.x & 0xffff0000u); x0[2] = __builtin_bit_cast(float, xw.y << 16); x0[3] = __builtin_bit_cast(float, xw.y & 0xffff0000u);
                    x1[0] = __builtin_bit_cast(float, xw.z << 16); x1[1] = __builtin_bit_cast(float, xw.z & 0xffff0000u); x1[2] = __builtin_bit_cast(float, xw.w << 16); x1[3] = __builtin_bit_cast(float, xw.w & 0xffff0000u);
                    const f32x4 s0 = x0 * DN_ALPHA + acc[ai][bj][m][0], s1 = x1 * DN_ALPHA + acc[ai][bj][m][1];
                    u32x4 o; o.x = pk2(s0[0], s0[1]); o.y = pk2(s0[2], s0[3]); o.z = pk2(s1[0], s1[1]); o.w = pk2(s1[2], s1[3]); *(u32x4*)(S + ro + bj * HALF) = o; } }
    }
};
struct EpiSwiglu {
    static constexpr bool PERM = true, AFTER_DRAIN = false;
    unsigned char* HID;
    __device__ __forceinline__ void operator()(const f32x4 (&acc)[2][2][4][2], const Unit& u, int wr, int wc, int fr, int fq) const {
        const int row0 = u.pm * BM + wr * 64 + fr, col0 = u.pn * 128 + wc * 32 + 8 * fq;
        constexpr float IS = 1.0f / WGU_SCALE, OS = HID_SCALE / WGU_SCALE;
#pragma unroll
        for (int ai = 0; ai < 2; ++ai)
#pragma unroll
            for (int m = 0; m < 4; ++m) { f32x4 o[2];
#pragma unroll
                for (int n = 0; n < 2; ++n) { const f32x4 g = acc[ai][0][m][n] * IS, up = acc[ai][1][m][n] * OS;
#pragma unroll
                    for (int i = 0; i < 4; ++i) o[n][i] = g[i] * __builtin_amdgcn_rcpf(1.0f + __builtin_amdgcn_exp2f(-LOG2E * g[i])) * up[i]; }
                u32x2 w; w.x = pk4_fp8(o[0][0], o[0][1], o[0][2], o[0][3]); w.y = pk4_fp8(o[1][0], o[1][1], o[1][2], o[1][3]);
                *(u32x2*)(HID + (size_t)(row0 + ai * HALF + m * 16) * DEXP + col0) = w; }
    }
};
struct EpiDown {
    static constexpr bool PERM = true, AFTER_DRAIN = false;
    unsigned char* YE; const float* gate;
    __device__ __forceinline__ void operator()(const f32x4 (&acc)[2][2][4][2], const Unit& u, int wr, int wc, int fr, int fq) const {
        const int row0 = u.pm * BM + wr * 64 + fr, col0 = u.pn * BM + wc * 32 + 8 * fq;
#pragma unroll
        for (int ai = 0; ai < 2; ++ai)
#pragma unroll
            for (int m = 0; m < 4; ++m) { const int row = row0 + ai * HALF + m * 16; const float gt = gate[row] * (YE_SCALE / (WD_SCALE * HID_SCALE));
#pragma unroll
                for (int bj = 0; bj < 2; ++bj) { const f32x4 a = acc[ai][bj][m][0] * gt, c = acc[ai][bj][m][1] * gt; u32x2 w; w.x = pk4_fp8(a[0], a[1], a[2], a[3]); w.y = pk4_fp8(c[0], c[1], c[2], c[3]);
                    *(u32x2*)(YE + (size_t)row * DM + col0 + bj * HALF) = w; } }
    }
};

struct Frame {
    LAS unsigned char* lds;
    int tid, lane, wave, vcu, G, gw, NGW;
};

__device__ __forceinline__ void transpose_item(const float* W, int N, int K, bf16* dst_row0, LAS float* scr, int k0, int n0, int lane) {
    float tv[32];
#pragma unroll
    for (int i = 0; i < 32; ++i) tv[i] = __builtin_nontemporal_load(W + (size_t)(k0 + 2 * i + (lane >> 5)) * N + n0 + (lane & 31));
#pragma unroll
    for (int i = 0; i < 32; ++i) scr[(2 * i + (lane >> 5)) * 33 + (lane & 31)] = tv[i];
    asm volatile("s_waitcnt lgkmcnt(0)" ::: "memory");
    const int c = lane & 7;
#pragma unroll
    for (int j = 0; j < 4; ++j) { const int n = (lane >> 3) + 8 * j; const LAS float* s = scr + (8 * c) * 33 + n;
        u32x4 o; o.x = pk2(s[0 * 33], s[1 * 33]); o.y = pk2(s[2 * 33], s[3 * 33]); o.z = pk2(s[4 * 33], s[5 * 33]); o.w = pk2(s[6 * 33], s[7 * 33]);
        *(u32x4*)(dst_row0 + (size_t)n * K + k0 + 8 * c) = o; }
    asm volatile("s_waitcnt lgkmcnt(0)" ::: "memory");
}
__device__ __forceinline__ void transpose_item_fp8(const float* W, int N, int K, unsigned char* dst_row0, LAS float* scr, int k0, int n0, int lane, float sc) {
    float tv[32];
#pragma unroll
    for (int i = 0; i < 32; ++i) tv[i] = __builtin_nontemporal_load(W + (size_t)(k0 + 2 * i + (lane >> 5)) * N + n0 + (lane & 31));
#pragma unroll
    for (int i = 0; i < 32; ++i) scr[(2 * i + (lane >> 5)) * 33 + (lane & 31)] = tv[i];
    asm volatile("s_waitcnt lgkmcnt(0)" ::: "memory");
    const int c = lane & 7;
#pragma unroll
    for (int j = 0; j < 4; ++j) { const int n = (lane >> 3) + 8 * j; const LAS float* s = scr + (8 * c) * 33 + n;
        u32x2 o; o.x = pk4_fp8(s[0 * 33] * sc, s[1 * 33] * sc, s[2 * 33] * sc, s[3 * 33] * sc); o.y = pk4_fp8(s[4 * 33] * sc, s[5 * 33] * sc, s[6 * 33] * sc, s[7 * 33] * sc);
        *(u32x2*)(dst_row0 + (size_t)n * K + k0 + 8 * c) = o; }
    asm volatile("s_waitcnt lgkmcnt(0)" ::: "memory");
}
__device__ __forceinline__ void conv_phase(Frame& F, int l, const float* w_in, const float* w_out, const float* w_gate, const float* w_up, const float* w_down, const float* sg_w, unsigned char* ws0, int it_lo, int it_hi, int vgw, int vngw, bool tail) {
    unsigned char* ws = ws0 + wset(l);
    LAS float* scr = (LAS float*)(F.lds + F.wave * 16384);
    bf16* WIN = (bf16*)(ws + WS_WIN); bf16* WOUT = (bf16*)(ws + WS_WOUT); unsigned char* WGU = ws + WS_WGU; unsigned char* WD = ws + WS_WD; bf16* WSB = (bf16*)(ws + WS_WSBF);
    constexpr int I_IN = 16 * 64, I_OUT = 16 * 32, I_G = 16 * 1024, I_D = 16 * 1024, NIT = I_IN + I_OUT + 2 * I_G + I_D;
    if (it_hi > NIT) it_hi = NIT;
    for (int it = it_lo + vgw; it < it_hi; it += vngw) {
        int r = it;
        if (r < I_IN) { const int kb = r >> 6, nb = r & 63, n0 = 32 * nb; const int pn = n0 >> 8, c = n0 & 255, wc = c >> 6, bj = (c >> 5) & 1;
            transpose_item(w_in + (size_t)l * DM * DIN, DIN, DM, WIN + (size_t)(256 * pn + 128 * bj + 32 * wc) * DM, scr, 64 * kb, n0, F.lane); continue; }
        r -= I_IN;
        if (r < I_OUT) { const int kb = r >> 5, nb = r & 31, n0 = 32 * nb;
            transpose_item(w_out + (size_t)l * DM * DM, DM, DM, WOUT + (size_t)n0 * DM, scr, 64 * kb, n0, F.lane); continue; }
        r -= I_OUT;
        if (r < 2 * I_G) { const int which = r >= I_G; if (which) r -= I_G; const int e = r >> 10, kb = (r >> 6) & 15, nb = r & 63, n0 = 32 * nb;
            const float* W = (which ? w_up : w_gate) + ((size_t)l * NEXP + e) * DM * DEXP;
            transpose_item_fp8(W, DEXP, DM, WGU + ((size_t)e * 4096 + (n0 >> 7) * 256 + which * 128 + (n0 & 127)) * DM, scr, 64 * kb, n0, F.lane, WGU_SCALE); continue; }
        r -= 2 * I_G;
        { const int e = r >> 10, kb = (r >> 5) & 31, nb = r & 31, n0 = 32 * nb;
            transpose_item_fp8(w_down + ((size_t)l * NEXP + e) * DEXP * DM, DM, DEXP, WD + ((size_t)e * DM + n0) * DEXP, scr, 64 * kb, n0, F.lane, WD_SCALE); }
    }
    if (tail) { const float* sw = sg_w + (size_t)l * 4 * 128 * 128;
        for (int i = vgw * 64 + F.lane; i < 4 * 128 * 128; i += vngw * 64) WSB[i] = (bf16)f2bf(sw[i]); }
}

__device__ __forceinline__ f32x4 bf4(u32x2 w) { f32x4 r; r[0] = __builtin_bit_cast(float, w.x << 16); r[1] = __builtin_bit_cast(float, w.x & 0xffff0000u); r[2] = __builtin_bit_cast(float, w.y << 16); r[3] = __builtin_bit_cast(float, w.y & 0xffff0000u); return r; }
__device__ __forceinline__ void row_ln(f32x4 (&v)[4], const float* g, const float* b, int lane) {
    float s = 0.f;
#pragma unroll
    for (int j = 0; j < 4; ++j) s += (v[j][0] + v[j][1]) + (v[j][2] + v[j][3]);
    const float mean = wave_sum(s) * (1.f / DM); float s2 = 0.f;
#pragma unroll
    for (int j = 0; j < 4; ++j) { v[j] = v[j] - mean; s2 += (v[j][0] * v[j][0] + v[j][1] * v[j][1]) + (v[j][2] * v[j][2] + v[j][3] * v[j][3]); }
    const float rstd = 1.f / sqrtf(wave_sum(s2) * (1.f / DM) + LN_EPS);
#pragma unroll
    for (int j = 0; j < 4; ++j) { const f32x4 gg = *(const f32x4*)(g + 4 * lane + 256 * j), bb = *(const f32x4*)(b + 4 * lane + 256 * j); v[j] = v[j] * rstd * gg + bb; }
}
__device__ __forceinline__ void row_ln_stats(f32x4 (&v)[4], const float* g, const float* b, int lane, float& mean_o, float& rstd_o) {
    float s = 0.f;
#pragma unroll
    for (int j = 0; j < 4; ++j) s += (v[j][0] + v[j][1]) + (v[j][2] + v[j][3]);
    const float mean = wave_sum(s) * (1.f / DM); float s2 = 0.f;
#pragma unroll
    for (int j = 0; j < 4; ++j) { v[j] = v[j] - mean; s2 += (v[j][0] * v[j][0] + v[j][1] * v[j][1]) + (v[j][2] * v[j][2] + v[j][3] * v[j][3]); }
    const float rstd = 1.f / sqrtf(wave_sum(s2) * (1.f / DM) + LN_EPS);
#pragma unroll
    for (int j = 0; j < 4; ++j) { const f32x4 gg = *(const f32x4*)(g + 4 * lane + 256 * j), bb = *(const f32x4*)(b + 4 * lane + 256 * j); v[j] = v[j] * rstd * gg + bb; }
    mean_o = mean; rstd_o = rstd;
}
__device__ __forceinline__ void store_row(const f32x4 (&v)[4], float* xrow, bf16* xbrow, int lane) {
#pragma unroll
    for (int j = 0; j < 4; ++j) { *(f32x4*)(xrow + 4 * lane + 256 * j) = v[j]; u32x2 w; w.x = pk2(v[j][0], v[j][1]); w.y = pk2(v[j][2], v[j][3]); *(u32x2*)(xbrow + 4 * lane + 256 * j) = w; }
}

__device__ __forceinline__ void store_row_bf(const f32x4 (&v)[4], bf16* xbrow, int lane) {
#pragma unroll
    for (int j = 0; j < 4; ++j) { u32x2 w; w.x = pk2(v[j][0], v[j][1]); w.y = pk2(v[j][2], v[j][3]); *(u32x2*)(xbrow + 4 * lane + 256 * j) = w; }
}
__device__ __forceinline__ void prologue_phase(Frame& F, const float* xp, const float* xs, const float* g, const float* b, float* X, unsigned char* ws) {
    float* rope = (float*)(ws + WS_ROPE);
    for (int i = F.gw * 64 + F.lane; i < SEQ * 32; i += F.NGW * 64) {
        const int s = i >> 5, p = i & 31, fi = p & 15; const float pos = (float)((p < 16) ? (s >> 6) : (s & 63));
        const float inv = powf(10000.0f, -(float)fi / 16.0f); const float ang = pos * inv;
        rope[2 * i] = cosf(ang); rope[2 * i + 1] = sinf(ang);
    }
    bf16* XB = (bf16*)(ws + WS_XB);
    for (int m = F.gw; m < TT; m += F.NGW) {
        const float* src = (m < T_P) ? xp + (size_t)m * DM : xs + (size_t)(m - T_P) * DM;
        f32x4 v[4];
#pragma unroll
        for (int j = 0; j < 4; ++j) v[j] = *(const f32x4*)(src + 4 * F.lane + 256 * j);
        row_ln(v, g, b, F.lane);
        store_row_bf(v, XB + (size_t)m * DM, F.lane);
    }
}

__device__ __forceinline__ float router_reduce(float (&lg)[16], int lane) {
    float r8[8], r4[4], r2[2], r1;
    const bool b5 = lane & 32, b4 = lane & 16, b3 = lane & 8, b2 = lane & 4;
#pragma unroll
    for (int i = 0; i < 8; ++i) { const float snd = b5 ? lg[i] : lg[i + 8], kp = b5 ? lg[i + 8] : lg[i]; r8[i] = kp + other32(snd, b5); }
#pragma unroll
    for (int i = 0; i < 4; ++i) { const float snd = b4 ? r8[i] : r8[i + 4], kp = b4 ? r8[i + 4] : r8[i]; r4[i] = kp + shx<16>(snd); }
#pragma unroll
    for (int i = 0; i < 2; ++i) { const float snd = b3 ? r4[i] : r4[i + 2], kp = b3 ? r4[i + 2] : r4[i]; r2[i] = kp + shx<8>(snd); }
    { const float snd = b2 ? r2[0] : r2[1], kp = b2 ? r2[1] : r2[0]; r1 = kp + shx<4>(snd); }
    r1 += shx<1>(r1); r1 += shx<2>(r1);
    float mx = r1;
    mx = fmaxf(mx, shx<4>(mx)); mx = fmaxf(mx, shx<8>(mx)); mx = fmaxf(mx, shx<16>(mx)); mx = max32(mx);
    const float ex = expf(r1 - mx); float sm = ex;
    sm += shx<4>(sm); sm += shx<8>(sm); sm += shx<16>(sm); sm = sum32(sm);
    return ex / sm;
}
template <bool DRY> __device__ __forceinline__ void ln1_router_phase(Frame& F, const bf16* X, const float* g, const float* b, const float* wr, unsigned char* ws) {
    constexpr int NR = LN1_ROWS;
    LAS float* wl = (LAS float*)F.lds;
    for (int i = F.tid; i < DM * NEXP; i += NWAVES * 64) wl[(i & 15) * DM + (i >> 4)] = wr[i];
    __syncthreads();
    unsigned char* XB8 = ws + (DRY ? WS_DUMMY + 400 * MiB : WS_XB8); float* AFF = (float*)(ws + (DRY ? WS_DUMMY + 500 * MiB : WS_AFF)); float* ST = (float*)(ws + (DRY ? WS_DUMMY : WS_STATS));
    const int lane = F.lane, e_mine = ((lane >> 5) & 1) * 8 + ((lane >> 4) & 1) * 4 + ((lane >> 3) & 1) * 2 + ((lane >> 2) & 1);
    int m = NR * F.gw;
    u32x2 nx[NR][4];
#pragma unroll
    for (int r = 0; r < NR; ++r)
#pragma unroll
        for (int j = 0; j < 4; ++j) nx[r][j] = (u32x2){0u, 0u};
    if (m < TT) {
#pragma unroll
        for (int r = 0; r < NR; ++r)
#pragma unroll
            for (int j = 0; j < 4; ++j) nx[r][j] = *(const u32x2*)(X + (size_t)(m + r) * DM + 4 * lane + 256 * j); }
    for (; m < TT; m += NR * F.NGW) {
        f32x4 v[NR][4];
#pragma unroll
        for (int r = 0; r < NR; ++r)
#pragma unroll
            for (int j = 0; j < 4; ++j) v[r][j] = bf4(nx[r][j]);
        { const int mn = m + NR * F.NGW;
          if (mn < TT) {
#pragma unroll
            for (int r = 0; r < NR; ++r)
#pragma unroll
                for (int j = 0; j < 4; ++j) nx[r][j] = *(const u32x2*)(X + (size_t)(mn + r) * DM + 4 * lane + 256 * j); } }
        float mu[NR], rs[NR];
#pragma unroll
        for (int r = 0; r < NR; ++r) row_ln_stats(v[r], g, b, lane, mu[r], rs[r]);
        if (lane == 0) {
#pragma unroll
            for (int r = 0; r < NR; r += 2) { f32x4 st; st[0] = mu[r]; st[1] = rs[r]; st[2] = mu[r + 1]; st[3] = rs[r + 1]; *(f32x4*)(ST + (size_t)(m + r) * 2) = st; } }
#pragma unroll
        for (int r = 0; r < NR; ++r)
#pragma unroll
            for (int j = 0; j < 4; ++j) *(unsigned*)(XB8 + (size_t)(m + r) * DM + 4 * lane + 256 * j) = pk4_fp8(v[r][j][0], v[r][j][1], v[r][j][2], v[r][j][3]);
        float lg[NR][16];
#pragma unroll
        for (int e = 0; e < 16; ++e) { f32x4 a[NR];
#pragma unroll
            for (int r = 0; r < NR; ++r) a[r] = (f32x4){0.f, 0.f, 0.f, 0.f};
#pragma unroll
            for (int j = 0; j < 4; ++j) { const f32x4 w = *(const LAS f32x4*)(wl + e * DM + 4 * lane + 256 * j);
#pragma unroll
                for (int r = 0; r < NR; ++r) a[r] += v[r][j] * w; }
#pragma unroll
            for (int r = 0; r < NR; ++r) lg[r][e] = (a[r][0] + a[r][1]) + (a[r][2] + a[r][3]);
            if ((e & 3) == 3) asm volatile("" ::: "memory"); }
        float af[NR];
#pragma unroll
        for (int r = 0; r < NR; ++r) af[r] = router_reduce(lg[r], lane);
        if ((lane & 3) == 0) { const size_t off = (m < T_P) ? (size_t)e_mine * T_P + m : (size_t)16 * T_P + (size_t)e_mine * T_S + (m - T_P);
#pragma unroll
            for (int r = 0; r < NR; ++r) AFF[off + r] = af[r]; }
    }
    __syncthreads();
}

constexpr int TK_COPIES = 8, TK_STRIDE = 2048;
template <int NB>
__device__ __forceinline__ void bin_search(LAS unsigned* hist, LAS unsigned* wtot, LAS unsigned* res, unsigned remaining, int tid, int lane, int wave, unsigned& bin, unsigned& rem_out) {
    constexpr int BPT = NB / 512;
    unsigned hb[BPT]; unsigned own = 0;
#pragma unroll
    for (int k = 0; k < BPT; ++k) { unsigned a = 0;
#pragma unroll
        for (int c = 0; c < TK_COPIES; ++c) a += hist[c * TK_STRIDE + tid * BPT + k];
        hb[k] = a; own += a; }
    unsigned x = own;
#pragma unroll
    for (int o = 1; o < 64; o <<= 1) { const unsigned y = (unsigned)__builtin_amdgcn_ds_bpermute((lane + o) << 2, (int)x); if (lane + o < 64) x += y; }
    if (lane == 0) wtot[wave] = x;
    __syncthreads();
    unsigned above = 0;
#pragma unroll
    for (int w = 0; w < 8; ++w) above += (w > wave) ? wtot[w] : 0u;
    const unsigned suf_incl = x + above, suf_excl = suf_incl - own;
    if (suf_excl < remaining && remaining <= suf_incl) {
        unsigned c = suf_excl; bool done = false;
#pragma unroll
        for (int k = BPT - 1; k >= 0; --k) { if (!done && c + hb[k] >= remaining) { res[0] = (unsigned)(tid * BPT + k); res[1] = remaining - c; done = true; } c += hb[k]; }
    }
    __syncthreads();
    bin = res[0]; rem_out = res[1];
    __syncthreads();
}
template <int NPT>
__device__ __forceinline__ void topk_block(Frame& F, const unsigned* vals, int cap, int slotbase, int tokbase, int e, unsigned char* ws) {
    LAS unsigned* hist = (LAS unsigned*)F.lds; LAS unsigned* wtot = hist + TK_COPIES * TK_STRIDE; LAS unsigned* res = wtot + 16;
    const int base = F.wave * (NPT * 64) + F.lane;
    unsigned v[NPT];
#pragma unroll
    for (int j = 0; j < NPT; ++j) v[j] = vals[base + j * 64];
    LAS unsigned* hc = hist + (F.lane & 7) * TK_STRIDE;
    unsigned remaining = (unsigned)cap, prefix = 0, bin;
#define TK_ZERO() do { for (int i = F.tid; i < TK_COPIES * TK_STRIDE; i += 512) hist[i] = 0u; __syncthreads(); } while (0)
#define TK_ADD(idx) (void)__hip_atomic_fetch_add(&hc[(idx)], 1u, __ATOMIC_RELAXED, __HIP_MEMORY_SCOPE_WORKGROUP)
    TK_ZERO();
#pragma unroll
    for (int j = 0; j < NPT; ++j) { unsigned vv = v[j]; asm volatile("" : "+v"(vv) :: "memory"); TK_ADD(vv >> 21); }
    __syncthreads();
    bin_search<2048>(hist, wtot, res, remaining, F.tid, F.lane, F.wave, bin, remaining); prefix = bin;
    TK_ZERO();
#pragma unroll
    for (int j = 0; j < NPT; ++j) { unsigned vv = v[j]; asm volatile("" : "+v"(vv) :: "memory"); if ((vv >> 21) == prefix) TK_ADD((vv >> 10) & 2047u); }
    __syncthreads();
    bin_search<2048>(hist, wtot, res, remaining, F.tid, F.lane, F.wave, bin, remaining); prefix = (prefix << 11) | bin;
    TK_ZERO();
#pragma unroll
    for (int j = 0; j < NPT; ++j) { unsigned vv = v[j]; asm volatile("" : "+v"(vv) :: "memory"); if ((vv >> 10) == prefix) TK_ADD(vv & 1023u); }
    __syncthreads();
    bin_search<1024>(hist, wtot, res, remaining, F.tid, F.lane, F.wave, bin, remaining);
#undef TK_ZERO
#undef TK_ADD
    const unsigned thr = (prefix << 10) | bin, need_eq = remaining;
    unsigned cg = 0, ce = 0;
#pragma unroll
    for (int j = 0; j < NPT; ++j) { unsigned vv = v[j]; asm volatile("" : "+v"(vv)); cg += (unsigned)__popcll(__ballot(vv > thr)); ce += (unsigned)__popcll(__ballot(vv == thr)); asm volatile("" : "+v"(cg), "+v"(ce)); }
    if (F.lane == 0) { wtot[F.wave] = cg; wtot[8 + F.wave] = ce; }
    __syncthreads();
    unsigned run_gt = 0, run_eq = 0;
#pragma unroll
    for (int w = 0; w < 8; ++w) { run_gt += (w < F.wave) ? wtot[w] : 0u; run_eq += (w < F.wave) ? wtot[8 + w] : 0u; }
    int* IDX = (int*)(ws + WS_IDX); float* GATE = (float*)(ws + WS_GATE); int* SLOTOF = (int*)(ws + WS_SLOTOF);
    const unsigned long long ltmask = (1ull << F.lane) - 1ull;
#pragma unroll
    for (int j = 0; j < NPT; ++j) {
        unsigned vv = v[j]; asm volatile("" : "+v"(vv));
        const bool gt = vv > thr, eq = vv == thr;
        const unsigned long long bg = __ballot(gt), be = __ballot(eq);
        const unsigned gb = (unsigned)__popcll(bg & ltmask), eb = (unsigned)__popcll(be & ltmask);
        const unsigned eq_rank = run_eq + eb;
        const bool sel = gt || (eq && eq_rank < need_eq);
        const unsigned slot = run_gt + gb + (eq_rank < need_eq ? eq_rank : need_eq);
        const int tok = tokbase + base + j * 64;
        if (sel) { IDX[slotbase + slot] = tok; GATE[slotbase + slot] = __builtin_bit_cast(float, vv); }
        SLOTOF[(size_t)e * TT + tok] = sel ? (int)(slotbase + slot) : -1;
        run_gt += (unsigned)__popcll(bg); run_eq += (unsigned)__popcll(be); asm volatile("" : "+v"(run_gt), "+v"(run_eq));
    }
    __syncthreads();
}
__device__ __forceinline__ void topk_phase(Frame& F, unsigned char* ws) {
    if (blockIdx.x >= 32) return;
    const int g = blockIdx.x >> 4, e = blockIdx.x & 15;
    const unsigned* aff = (const unsigned*)(ws + WS_AFF);
    if (g == 0) topk_block<T_P / 512>(F, aff + (size_t)e * T_P, CAP_P, e * CAP_P, 0, e, ws);
    else        topk_block<T_S / 512>(F, aff + (size_t)16 * T_P + (size_t)e * T_S, CAP_S, ROWS_P + e * CAP_S, T_P, e, ws);
}

__device__ __forceinline__ void gather_phase(Frame& F, unsigned char* ws) {
    const int* IDX = (const int*)(ws + WS_IDX); const unsigned char* XB8 = ws + WS_XB8; unsigned char* XE = ws + WS_H;
    for (int r = F.gw; r < ROWS_E; r += F.NGW) { const int tok = IDX[r];
        *(u32x4*)(XE + (size_t)r * DM + 16 * F.lane) = *(const u32x4*)(XB8 + (size_t)tok * DM + 16 * F.lane); }
}

template <bool DRY> __device__ __forceinline__ void combine_phase(Frame& F, float* X, const bf16* SB, const float* g1, const float* b1, const float* g, const float* b, unsigned char* ws, bool last_layer) {
    const int* SLOTOF = (const int*)(ws + WS_SLOTOF); const unsigned char* YE = ws + WS_H; bf16* XB = (bf16*)(ws + (DRY ? WS_DUMMY + 400 * MiB : WS_XB)); float* Xo = DRY ? (float*)(ws + WS_DUMMY) : X;
    const int lane = F.lane;
    int m = 2 * F.gw;
    int so_n = (m < TT) ? SLOTOF[(size_t)(lane & 15) * TT + m + ((lane >> 4) & 1)] : -1;
    for (; m < TT; m += 2 * F.NGW) {
        const int so = so_n; const int mn = m + 2 * F.NGW;
        so_n = (mn < TT) ? SLOTOF[(size_t)(lane & 15) * TT + mn + ((lane >> 4) & 1)] : -1;
        f32x4 v0[4], v1[4];
#pragma unroll
        for (int j = 0; j < 4; ++j) { v0[j] = bf4(*(const u32x2*)(SB + (size_t)m * DM + 4 * lane + 256 * j)); v1[j] = bf4(*(const u32x2*)(SB + (size_t)(m + 1) * DM + 4 * lane + 256 * j)); }
        { const f32x4 st = *(const f32x4*)((const float*)(ws + WS_STATS) + (size_t)m * 2);
#pragma unroll
          for (int j = 0; j < 4; ++j) { const f32x4 gg = *(const f32x4*)(g1 + 4 * lane + 256 * j) * DN_ALPHA, bb = *(const f32x4*)(b1 + 4 * lane + 256 * j) * DN_ALPHA;
              v0[j] = (v0[j] - st[0]) * st[1] * gg + bb; v1[j] = (v1[j] - st[2]) * st[3] * gg + bb; } }
        constexpr int CK = 4;
        unsigned m0 = (unsigned)__ballot(so >= 0); unsigned m1 = (m0 >> 16) & 0xffffu; m0 &= 0xffffu;
        unsigned w0[CK][4], w1[CK][4]; float f0[CK], f1[CK];
#pragma unroll
        for (int k = 0; k < CK; ++k) {
            const int e0 = m0 ? __builtin_ctz(m0) : 0, e1 = m1 ? __builtin_ctz(m1) : 0;
            const int sl0 = __builtin_amdgcn_readlane(so, e0), sl1 = __builtin_amdgcn_readlane(so, 16 + e1);
            const size_t r0 = (size_t)(m0 ? sl0 : 0) * DM, r1 = (size_t)(m1 ? sl1 : 0) * DM;
            f0[k] = m0 ? (1.0f / YE_SCALE) : 0.f; f1[k] = m1 ? (1.0f / YE_SCALE) : 0.f;
#pragma unroll
            for (int j = 0; j < 4; ++j) { w0[k][j] = *(const unsigned*)(YE + r0 + 4 * lane + 256 * j); w1[k][j] = *(const unsigned*)(YE + r1 + 4 * lane + 256 * j); }
            m0 &= m0 - 1; m1 &= m1 - 1;
        }
#pragma unroll
        for (int k = 0; k < CK; ++k)
#pragma unroll
            for (int j = 0; j < 4; ++j) {
                { const f32x2v lo = __builtin_amdgcn_cvt_pk_f32_fp8((int)w0[k][j], false), hi = __builtin_amdgcn_cvt_pk_f32_fp8((int)w0[k][j], true);
                  v0[j][0] += lo[0] * f0[k]; v0[j][1] += lo[1] * f0[k]; v0[j][2] += hi[0] * f0[k]; v0[j][3] += hi[1] * f0[k]; }
                { const f32x2v lo = __builtin_amdgcn_cvt_pk_f32_fp8((int)w1[k][j], false), hi = __builtin_amdgcn_cvt_pk_f32_fp8((int)w1[k][j], true);
                  v1[j][0] += lo[0] * f1[k]; v1[j][1] += lo[1] * f1[k]; v1[j][2] += hi[0] * f1[k]; v1[j][3] += hi[1] * f1[k]; }
            }
        while (m0) { const int sl = __builtin_amdgcn_readlane(so, __builtin_ctz(m0)); m0 &= m0 - 1;
#pragma unroll
            for (int j = 0; j < 4; ++j) { const unsigned w = *(const unsigned*)(YE + (size_t)sl * DM + 4 * lane + 256 * j);
                const f32x2v lo = __builtin_amdgcn_cvt_pk_f32_fp8((int)w, false), hi = __builtin_amdgcn_cvt_pk_f32_fp8((int)w, true);
                v0[j][0] += lo[0] * (1.0f / YE_SCALE); v0[j][1] += lo[1] * (1.0f / YE_SCALE); v0[j][2] += hi[0] * (1.0f / YE_SCALE); v0[j][3] += hi[1] * (1.0f / YE_SCALE); } }
        while (m1) { const int sl = __builtin_amdgcn_readlane(so, 16 + __builtin_ctz(m1)); m1 &= m1 - 1;
#pragma unroll
            for (int j = 0; j < 4; ++j) { const unsigned w = *(const unsigned*)(YE + (size_t)sl * DM + 4 * lane + 256 * j);
                const f32x2v lo = __builtin_amdgcn_cvt_pk_f32_fp8((int)w, false), hi = __builtin_amdgcn_cvt_pk_f32_fp8((int)w, true);
                v1[j][0] += lo[0] * (1.0f / YE_SCALE); v1[j][1] += lo[1] * (1.0f / YE_SCALE); v1[j][2] += hi[0] * (1.0f / YE_SCALE); v1[j][3] += hi[1] * (1.0f / YE_SCALE); } }
        row_ln(v0, g, b, lane); row_ln(v1, g, b, lane);
        if (last_layer) {
#pragma unroll
            for (int j = 0; j < 4; ++j) { *(f32x4*)(Xo + (size_t)m * DM + 4 * lane + 256 * j) = v0[j]; *(f32x4*)(Xo + (size_t)(m + 1) * DM + 4 * lane + 256 * j) = v1[j]; }
        } else { store_row_bf(v0, XB + (size_t)m * DM, lane); store_row_bf(v1, XB + (size_t)(m + 1) * DM, lane); }
    }
}

template <bool NA>
__device__ __forceinline__ void attn_wave(const bf16* __restrict__ Qb, const bf16* __restrict__ Kb, const bf16* __restrict__ Vb, bf16* __restrict__ Ob, int ntiles,
                                          LAS unsigned char* wl, const LAS float* rpbh, int rr, int rs, int qh, int lane) {
    const int r = lane & 31, h = lane >> 5;
    bf16x8 qf[4];
#pragma unroll
    for (int d0 = 0; d0 < 4; ++d0) qf[d0] = *(const bf16x8*)(Qb + (size_t)r * DIN + 16 * d0 + 8 * h);
    f32x16 o0, o1;
#pragma unroll
    for (int i = 0; i < 16; ++i) { o0[i] = 0.f; o1[i] = 0.f; }
    float m = -1e30f, l = 0.f;
    LAS unsigned char* vl = wl; LAS float* wsf = (LAS float*)(wl + 4608);
    const bf16* vsrc = Vb + (size_t)(lane >> 3) * DIN + 8 * (lane & 7);
    const bf16* ksrc = Kb + (size_t)r * DIN + 8 * h;
    const int vwoff = (lane >> 3) * 144 + (lane & 7) * 16;
    const int i16 = lane & 15, tq = i16 >> 2, tp = i16 & 3, blk = (lane >> 4) & 1;
    const int troff = (4 * h + tq) * 144 + (16 * blk + 4 * tp) * 2;
    const int qc = 32 * qh + r; const int cs = qc - 8 < 0 ? 0 : (qc - 8 > 48 ? 48 : qc - 8);
    for (int t = 0; t < ntiles; ++t) {
        const size_t ko = (size_t)(32 * t) * DIN;
        bf16x8 kf[4];
#pragma unroll
        for (int d0 = 0; d0 < 4; ++d0) kf[d0] = *(const bf16x8*)(ksrc + ko + 16 * d0);
        u32x4 vr[4];
#pragma unroll
        for (int i = 0; i < 4; ++i) vr[i] = *(const u32x4*)(vsrc + ko + (size_t)(8 * i) * DIN);
        f32x16 s;
#pragma unroll
        for (int i = 0; i < 16; ++i) s[i] = 0.f;
#pragma unroll
        for (int d0 = 0; d0 < 4; ++d0) s = MFMA32(kf[d0], qf[d0], s);
        unsigned okm = 0xffffu;
        if (NA) {
            okm = 0u; const int kr = rs + (t >> 1), kh = t & 1, brow = (kr - rr + 7) * 31;
#pragma unroll
            for (int i = 0; i < 16; ++i) { const int kc = 32 * kh + crow(i, h); const bool ok = (kc >= cs) && (kc < cs + 16); const int idx = ok ? brow + kc - qc + 15 : 0;
                const float bia = rpbh[idx]; s[i] = ok ? s[i] + bia : -1e30f; okm |= ok ? (1u << i) : 0u; }
        }
        float mx = s[0];
#pragma unroll
        for (int i = 1; i < 16; ++i) mx = fmaxf(mx, s[i]);
        mx = max32(mx);
        const float mn = fmaxf(m, mx), alpha = __builtin_amdgcn_exp2f(m - mn); m = mn;
        float rsum = 0.f;
#pragma unroll
        for (int i = 0; i < 16; ++i) { float p = __builtin_amdgcn_exp2f(s[i] - mn); if (NA) p = ((okm >> i) & 1u) ? p : 0.f; s[i] = p; rsum += p; }
        l = l * alpha + rsum;
#pragma unroll
        for (int i = 0; i < 4; ++i) *(LAS u32x4*)(vl + vwoff + i * 8 * 144) = vr[i];
        if (h == 0) wsf[r] = alpha;
        asm volatile("s_waitcnt lgkmcnt(0)" ::: "memory");
#pragma unroll
        for (int g4 = 0; g4 < 4; ++g4) { const f32x4 a4 = *(const LAS f32x4*)(wsf + 8 * g4 + 4 * h);
#pragma unroll
            for (int j = 0; j < 4; ++j) { o0[4 * g4 + j] *= a4[j]; o1[4 * g4 + j] *= a4[j]; } }
        u32x4 pw0, pw1;
        pw0.x = pg8::cvt_pk_bf16(s[0], s[1]); pw0.y = pg8::cvt_pk_bf16(s[2], s[3]); pw0.z = pg8::cvt_pk_bf16(s[4], s[5]); pw0.w = pg8::cvt_pk_bf16(s[6], s[7]);
        pw1.x = pg8::cvt_pk_bf16(s[8], s[9]); pw1.y = pg8::cvt_pk_bf16(s[10], s[11]); pw1.z = pg8::cvt_pk_bf16(s[12], s[13]); pw1.w = pg8::cvt_pk_bf16(s[14], s[15]);
        const bf16x8 pa0 = __builtin_bit_cast(bf16x8, pw0), pa1 = __builtin_bit_cast(bf16x8, pw1);
#pragma unroll
        for (int sp = 0; sp < 2; ++sp) {
#pragma unroll
            for (int db = 0; db < 2; ++db) {
                const s16x4 lo = tr_read(vl + troff + (16 * sp) * 144 + 64 * db), hi = tr_read(vl + troff + (16 * sp + 8) * 144 + 64 * db);
                const bf16x8 bfr = __builtin_shufflevector(lo, hi, 0, 1, 2, 3, 4, 5, 6, 7);
                if (db == 0) o0 = MFMA32(sp ? pa1 : pa0, bfr, o0); else o1 = MFMA32(sp ? pa1 : pa0, bfr, o1);
            }
        }
        asm volatile("s_waitcnt lgkmcnt(0)" ::: "memory");
    }
    l = sum32(l);
    if (h == 0) wsf[32 + r] = l;
    asm volatile("s_waitcnt lgkmcnt(0)" ::: "memory");
#pragma unroll
    for (int i = 0; i < 16; ++i) { const int q = crow(i, h); const float rl = 1.0f / wsf[32 + q];
        Ob[(size_t)q * DM + r] = (bf16)f2bf(o0[i] * rl); Ob[(size_t)q * DM + 32 + r] = (bf16)f2bf(o1[i] * rl); }
    asm volatile("s_waitcnt lgkmcnt(0)" ::: "memory");
}

__device__ __forceinline__ void sgu_part(Frame& F, int l, const float* sg_b, unsigned char* ws) {
    const bf16* H = (const bf16*)(ws + WS_H); bf16* Y = (bf16*)(ws + WS_HID); const bf16* WSB = (const bf16*)(ws + wset(l) + WS_WSBF);
    const int lane = F.lane, r = lane & 31, h = lane >> 5;
    LAS unsigned char* vnl = F.lds;
    const int pt = F.wave >> 1, ct = F.wave & 1;
    const int i16 = lane & 15, tq = i16 >> 2, tp = i16 & 3, blk = (lane >> 4) & 1;
    u32x4 stg[2];
    { const int u = F.vcu; if (u < NBATCH * 32 * 4) { const int g = u & 3, ch = (u >> 2) & 31, b = u >> 7; const size_t tok0 = (size_t)b * SEQ + ch * 128;
#pragma unroll
        for (int i = 0; i < 2; ++i) { const int idx = F.tid + 512 * i, row = idx >> 3, chunk = idx & 7; stg[i] = *(const u32x4*)(H + (tok0 + row) * DIN + H_VC + 64 * g + 8 * chunk); } } }
    for (int u = F.vcu; u < NBATCH * 32 * 4; u += F.G) {
        const int g = u & 3, ch = (u >> 2) & 31, b = u >> 7; const size_t tok0 = (size_t)b * SEQ + ch * 128;
#pragma unroll
        for (int i = 0; i < 2; ++i) { const int idx = F.tid + 512 * i, row = idx >> 3, chunk = idx & 7; *(LAS u32x4*)(vnl + row * 144 + chunk * 16) = stg[i]; }
        __syncthreads();
        { const int un = u + F.G; if (un < NBATCH * 32 * 4) { const int gn = un & 3, chn = (un >> 2) & 31, bn = un >> 7; const size_t tokn = (size_t)bn * SEQ + chn * 128;
#pragma unroll
            for (int i = 0; i < 2; ++i) { const int idx = F.tid + 512 * i, row = idx >> 3, chunk = idx & 7; stg[i] = *(const u32x4*)(H + (tokn + row) * DIN + H_VC + 64 * gn + 8 * chunk); } } }
        unsigned short uu[16];
#pragma unroll
        for (int i = 0; i < 16; ++i) uu[i] = H[(tok0 + 32 * pt + crow(i, h)) * DIN + H_UC + 64 * g + 32 * ct + r];
        f32x16 z;
#pragma unroll
        for (int i = 0; i < 16; ++i) z[i] = 0.f;
#pragma unroll
        for (int s = 0; s < 8; ++s) {
            const bf16x8 a = *(const bf16x8*)(WSB + ((size_t)(g * 128 + 32 * pt + r) * 128 + 16 * s + 8 * h));
            const s16x4 lo = tr_read(vnl + (16 * s + 8 * h + tq) * 144 + (32 * ct + 16 * blk + 4 * tp) * 2), hi = tr_read(vnl + (16 * s + 8 * h + 4 + tq) * 144 + (32 * ct + 16 * blk + 4 * tp) * 2);
            z = MFMA32(a, __builtin_shufflevector(lo, hi, 0, 1, 2, 3, 4, 5, 6, 7), z);
        }
        const float* bs = sg_b + ((size_t)l * 4 + g) * 128;
#pragma unroll
        for (int i = 0; i < 16; ++i) { const int pp = 32 * pt + crow(i, h); const size_t tok = tok0 + pp; const int c = 32 * ct + r;
            Y[tok * DM + Y_SG + 64 * g + c] = (bf16)f2bf(bf2f(uu[i]) * (z[i] + bs[pp])); }
        __syncthreads();
    }
}
__device__ __forceinline__ void gqa_part(int vcu, int G, int tid, char* lds, unsigned char* ws, const float* qn, const float* kn) {
    const bf16* H = (const bf16*)(ws + WS_H); bf16* Y = (bf16*)(ws + WS_HID);
    float gq = 0.f, gk = 0.f;
    for (int i = 0; i < 64; ++i) { gq = fmaxf(gq, fabsf(qn[i])); gk = fmaxf(gk, fabsf(kn[i])); }
    const bool nomax = (64.0f * C2 * gq * gk) * 1.02f <= 40.0f;
    if (nomax) {
        for (int id = vcu; id < NBATCH * 8 * 16; id += G) {
            const int qb = id & 15, hg = (id >> 4) & 3, kvh = (id >> 6) & 1, b = id >> 7, hq = kvh * 4 + hg;
            const size_t t0 = (size_t)b * SEQ;
            attn_body::attn_unit<8, true, GQA_MSUM>((const attn_body::bf16*)(H + (t0 + 256 * qb) * DIN + H_GQ + 64 * hq), (const attn_body::bf16*)(H + t0 * DIN + H_GK + 64 * kvh),
                                          (const attn_body::bf16*)(H + t0 * DIN + H_GV + 64 * kvh), (attn_body::bf16*)(Y + (t0 + 256 * qb) * DM + Y_GQA + 64 * hq), lds, tid);
        }
    } else {
        for (int id = vcu; id < NBATCH * 8 * 16; id += G) {
            const int qb = id & 15, hg = (id >> 4) & 3, kvh = (id >> 6) & 1, b = id >> 7, hq = kvh * 4 + hg;
            const size_t t0 = (size_t)b * SEQ;
            attn_body::attn_unit<8, false>((const attn_body::bf16*)(H + (t0 + 256 * qb) * DIN + H_GQ + 64 * hq), (const attn_body::bf16*)(H + t0 * DIN + H_GK + 64 * kvh),
                                           (const attn_body::bf16*)(H + t0 * DIN + H_GV + 64 * kvh), (attn_body::bf16*)(Y + (t0 + 256 * qb) * DM + Y_GQA + 64 * hq), lds, tid);
        }
    }
    __syncthreads();
}
typedef float f32x4_t __attribute__((ext_vector_type(4)));
#define MFMA16(a, b, c) __builtin_amdgcn_mfma_f32_16x16x32_bf16((a), (b), (c), 0, 0, 0)
constexpr int NA_VP = 144;
__device__ __forceinline__ void na_wave(const bf16* __restrict__ H, const LAS unsigned char* vl, bf16* __restrict__ Y, const LAS float* rpbh, int b, int hd, int rr, int rs, int qb4, int lane) {
    const int n16 = lane & 15, g = lane >> 4;
    const int c0 = 16 * qb4, w0 = (16 * qb4 - 8 < 0) ? 0 : (16 * qb4 - 8 > 32 ? 32 : 16 * qb4 - 8);
    const size_t t0 = (size_t)b * SEQ, qtok = t0 + rr * 64 + c0 + n16;
    bf16x8 qf[2];
#pragma unroll
    for (int ks = 0; ks < 2; ++ks) qf[ks] = *(const bf16x8*)(H + qtok * DIN + H_NAQ + 64 * hd + 32 * ks + 8 * g);
    f32x4_t s[16];
    const bf16* kb = H + (t0 + rs * 64 + w0 + 8 * (n16 >> 2) + (n16 & 3)) * DIN + H_NAK + 64 * hd + 8 * g;
    {
        bf16x8 kf[16][2];
#pragma unroll
        for (int T = 0; T < 16; ++T) { const bf16* kp = kb + (size_t)((T >> 1) * 64 + 4 * (T & 1)) * DIN; kf[T][0] = *(const bf16x8*)kp; kf[T][1] = *(const bf16x8*)(kp + 32); }
        asm volatile("" ::: "memory");
#pragma unroll
        for (int T = 0; T < 16; ++T) { f32x4_t z = {0.f, 0.f, 0.f, 0.f}; z = MFMA16(kf[T][0], qf[0], z); s[T] = MFMA16(kf[T][1], qf[1], z); }
    }
    const int qc = c0 + n16, cs = qc - 8 < 0 ? 0 : (qc - 8 > 48 ? 48 : qc - 8);
    const LAS float* tb[8];
#pragma unroll
    for (int j = 0; j < 8; ++j) { const int kc = w0 + 8 * g + 4 * (j >> 2) + (j & 3); const bool ok = (unsigned)(kc - cs) < 16u; tb[j] = rpbh + (rs - rr + 7) * 32 + (ok ? kc - qc + 15 : 31); }
    float mx = -1e30f;
#pragma unroll
    for (int T = 0; T < 16; ++T)
#pragma unroll
        for (int i = 0; i < 4; ++i) { const float v = s[T][i] + tb[(T & 1) * 4 + i][(T >> 1) * 32]; s[T][i] = v; mx = fmaxf(mx, v); }
    mx = fmaxf(mx, shx<16>(mx)); mx = max32(mx);
    float sum = 0.f;
#pragma unroll
    for (int T = 0; T < 16; ++T)
#pragma unroll
        for (int i = 0; i < 4; ++i) { const float p = __builtin_amdgcn_exp2f(s[T][i] - mx); s[T][i] = p; sum += p; }
    sum += shx<16>(sum); sum = sum32(sum);
    f32x4_t o[4];
#pragma unroll
    for (int db = 0; db < 4; ++db) o[db] = (f32x4_t){0.f, 0.f, 0.f, 0.f};
    const LAS unsigned char* vb = vl + (w0 + 8 * g + (n16 >> 2)) * NA_VP + (n16 & 3) * 8;
#pragma unroll
    for (int kr = 0; kr < 8; ++kr) {
        u32x4 pw; pw.x = pg8::cvt_pk_bf16(s[2 * kr][0], s[2 * kr][1]); pw.y = pg8::cvt_pk_bf16(s[2 * kr][2], s[2 * kr][3]);
        pw.z = pg8::cvt_pk_bf16(s[2 * kr + 1][0], s[2 * kr + 1][1]); pw.w = pg8::cvt_pk_bf16(s[2 * kr + 1][2], s[2 * kr + 1][3]);
        const bf16x8 pb = __builtin_bit_cast(bf16x8, pw);
#pragma unroll
        for (int db = 0; db < 4; ++db) { const LAS unsigned char* vp = vb + (kr * 64) * NA_VP + db * 32;
            const s16x4 lo = tr_read(vp), hi = tr_read(vp + 4 * NA_VP);
            o[db] = MFMA16(__builtin_shufflevector(lo, hi, 0, 1, 2, 3, 4, 5, 6, 7), pb, o[db]); }
    }
    const float rl = 1.0f / sum;
    bf16* yp = Y + qtok * DM + Y_NA + 64 * hd + 4 * g;
#pragma unroll
    for (int db = 0; db < 4; ++db) { u32x2 w; w.x = pg8::cvt_pk_bf16(o[db][0] * rl, o[db][1] * rl); w.y = pg8::cvt_pk_bf16(o[db][2] * rl, o[db][3] * rl); *(u32x2*)(yp + 16 * db) = w; }
}
__device__ __forceinline__ void na_part(Frame& F, int l, const float* na_rpb, unsigned char* ws) {
    const bf16* H = (const bf16*)(ws + WS_H); bf16* Y = (bf16*)(ws + WS_HID);
    LAS float* rpbl = (LAS float*)(F.lds + 90112);
    for (int i = F.tid; i < 4 * 15 * 32; i += 512) { const int c = i & 31, hr = i >> 5; rpbl[i] = (c < 31) ? na_rpb[(size_t)l * 4 * 15 * 31 + hr * 31 + c] * LOG2E : -1e30f; }
    LAS unsigned char* vl = F.lds;
    u32x4 stg[9];
#define NA_VSRC(id_) (H + ((size_t)((id_) >> 7) * SEQ + (2 * ((id_) & 31) - 4 < 0 ? 0 : (2 * ((id_) & 31) - 4 > 56 ? 56 : 2 * ((id_) & 31) - 4)) * 64) * DIN + H_NAV + 64 * (((id_) >> 5) & 3))
    if (F.vcu < NBATCH * 4 * 32) { const bf16* vsrc = NA_VSRC(F.vcu);
#pragma unroll
        for (int i = 0; i < 9; ++i) { const int idx = F.tid + 512 * i, tok = idx >> 3, ch = idx & 7; stg[i] = *(const u32x4*)(vsrc + (size_t)tok * DIN + ch * 8); } }
    for (int id = F.vcu; id < NBATCH * 4 * 32; id += F.G) {
        const int rp = id & 31, hd = (id >> 5) & 3, b = id >> 7, rr0 = 2 * rp;
        const int sb = rr0 - 4 < 0 ? 0 : (rr0 - 4 > 56 ? 56 : rr0 - 4);
        __syncthreads();
#pragma unroll
        for (int i = 0; i < 9; ++i) { const int idx = F.tid + 512 * i, tok = idx >> 3, ch = idx & 7; *(LAS u32x4*)(vl + tok * NA_VP + ch * 16) = stg[i]; }
        __syncthreads();
        { const int idn = id + F.G; if (idn < NBATCH * 4 * 32) { const bf16* vsrc = NA_VSRC(idn);
#pragma unroll
            for (int i = 0; i < 9; ++i) { const int idx = F.tid + 512 * i, tok = idx >> 3, ch = idx & 7; stg[i] = *(const u32x4*)(vsrc + (size_t)tok * DIN + ch * 8); } } }
        const int rr = rr0 + (F.wave >> 2); const int rs = rr - 4 < 0 ? 0 : (rr - 4 > 56 ? 56 : rr - 4);
        na_wave(H, vl + (rs - sb) * 64 * NA_VP, Y, rpbl + hd * 480, b, hd, rr, rs, F.wave & 3, F.lane);
    }
#undef NA_VSRC
    __syncthreads();
}

__device__ __forceinline__ void frame_init(Frame& F, LAS unsigned char* lds, int wave_s) {
    int t = wave_s * 64 + (int)__builtin_amdgcn_mbcnt_hi(~0u, __builtin_amdgcn_mbcnt_lo(~0u, 0u)); asm volatile("" : "+v"(t));
    F.lds = lds; F.tid = t; F.lane = t & 63; F.wave = __builtin_amdgcn_readfirstlane(t >> 6);
    int G_ = gridDim.x; asm volatile("" : "+s"(G_));
    F.G = G_; { const int bx = blockIdx.x; F.vcu = (F.G % 8 == 0) ? (bx % 8) * (F.G / 8) + bx / 8 : bx; }
    F.gw = F.vcu * NWAVES + F.wave; F.NGW = F.G * NWAVES;
}
#ifndef MK_FUSED
#define MK_FUSED 1
#endif
struct Args { const float* in[21]; float* out; unsigned char* ws; int l_lo, l_hi, ph_lo, ph_hi, use_bar, pad; };
constexpr int NPH = 10;

__global__ void __launch_bounds__(NWAVES * 64, 2) enc_fwd(Args a) {
    extern __shared__ __attribute__((aligned(16))) unsigned char lds[];
    int wave_s_ = __builtin_amdgcn_readfirstlane((int)threadIdx.x >> 6); asm volatile("" : "+s"(wave_s_));
    Frame F0; frame_init(F0, (LAS unsigned char*)lds, wave_s_);
#define FRAME() Frame F; frame_init(F, (LAS unsigned char*)lds, wave_s_)
    volatile LAS unsigned* MISC = (volatile LAS unsigned*)(F0.lds + MISC_OFF);
    for (int u = F0.tid; u < (LDS_BYTES - LDSCTL_OFF) / 4; u += NWAVES * 64) ((LAS unsigned*)(F0.lds + LDSCTL_OFF))[u] = 0u;
    __syncthreads();
    unsigned* ctl = (unsigned*)(a.ws + WS_CTL);
    XcdBarrier bar; bar.bar = ctl + CW_BAR; bar.x = 0; bar.st = nullptr;
    if (a.use_bar) bar = xcd_barrier_post(ctl + CW_BAR, MISC + 8);
#if MK_FUSED
#define SEAM() xcd_barrier(bar)
#else
#define SEAM() do { if (a.use_bar) xcd_barrier(bar); } while (0)
#endif
    typedef const __attribute__((address_space(4))) Args* KArgP;
#define KA() ({ KArgP p_ = (KArgP)__builtin_amdgcn_kernarg_segment_ptr(); asm volatile("" : "+s"(p_)); p_; })
#if !MK_FUSED
    const int lo = a.ph_lo, hi = a.ph_hi;
#endif
#ifndef ONLY_PH
#define ONLY_PH -1
#endif
#if MK_FUSED
#define IN(k) (ONLY_PH < 0 || ONLY_PH == (k))
#else
#define IN(k) ((ONLY_PH < 0 || ONLY_PH == (k)) && lo <= (k) && (k) < hi)
#endif
#ifndef REP0
#define REP0 1
#endif
#ifndef REP2
#define REP2 1
#endif
#ifndef REP4
#define REP4 1
#endif
#ifndef REP9
#define REP9 1
#endif
#ifndef REP1
#define REP1 1
#endif
#ifndef REP2A
#define REP2A 1
#endif
#ifndef REP2B
#define REP2B 1
#endif
#ifndef REP2C
#define REP2C 1
#endif
#ifndef NA_VAR
#define NA_VAR 1
#endif
#ifndef REP3
#define REP3 1
#endif
#ifndef REPP
#define REPP 1
#endif
#ifndef REP5
#define REP5 1
#endif
#ifndef REP6
#define REP6 1
#endif
#ifndef REP7
#define REP7 1
#endif
#ifndef REP8
#define REP8 1
#endif
#define REPEAT(n) _Pragma("nounroll") for (int rep_ = 0; rep_ < (n); ++rep_)
#if MK_FUSED
    for (int l = 0; l < NLAYER; ++l) {
#else
    for (int l = a.l_lo; l < a.l_hi; ++l) {
#endif
        if (IN(0) && (l == 0 || REP0 > 1)) {
            REPEAT(l == 0 ? REP0 : REP0 - 1) { FRAME(); KArgP k = KA(); conv_phase(F, l, k->in[4], k->in[12], k->in[16], k->in[17], k->in[18], k->in[8], k->ws, 0, 1 << 30, F.gw, F.NGW, true); }
            if (l == 0) REPEAT(REPP) { FRAME(); KArgP k = KA(); prologue_phase(F, k->in[0], k->in[1], k->in[2], k->in[3], k->out, k->ws); }
            SEAM();
        }
        if (IN(1)) REPEAT(REP1) {
            FRAME(); KArgP k = KA(); unsigned char* ws = k->ws;
            pg8::Gemm g{(const bf16*)(ws + WS_XB), (const bf16*)(ws + wset(l) + WS_WIN), TT, DIN, DM, 0};
            pg8::RotOrder S; S.init(TT, DIN, F.G, (int)blockIdx.x);
            EpiIn E{(bf16*)(ws + WS_H), k->in[6] + l * 64, k->in[7] + l * 64, k->in[10] + l * 256, k->in[11] + l * 256, (const float*)(ws + WS_ROPE), (bf16*)(ws + WS_VT)};
            pg8::gemm_phase<EpiIn, pg8::RotOrder, true, true, false, false, false, true>(F.lds, g, S, E, F.tid);
            SEAM();
        }
        if (IN(2)) REPEAT(REP2) {
            REPEAT(REP2A) { FRAME(); KArgP k = KA(); sgu_part(F, l, k->in[9], k->ws); }
            REPEAT(REP2B) { FRAME(); KArgP k = KA(); gqa_part(F.vcu, F.G, F.tid, (char*)lds, k->ws, k->in[6] + l * 64, k->in[7] + l * 64); }
            REPEAT(REP2C) { FRAME(); KArgP k = KA(); na_part(F, l, k->in[5], k->ws); }
            SEAM();
        }
        if (IN(3)) {
            REPEAT(REP3 - 1) {
                FRAME(); KArgP k = KA(); unsigned char* ws = k->ws;
                pg8::Gemm g{(const bf16*)(ws + WS_HID), (const bf16*)(ws + wset(l) + WS_WOUT), TT, DM, DM, 0};
                pg8::StaticOrder S; S.init(TT, DM, F.G, (int)blockIdx.x);
                EpiRes E{(const bf16*)(ws + WS_XB), (bf16*)(ws + WS_DUMMY)};
                pg8::gemm_phase<EpiRes, pg8::StaticOrder, true, true, false, false, false, true>(F.lds, g, S, E, F.tid);
                SEAM();
            }
            FRAME(); KArgP k = KA(); unsigned char* ws = k->ws;
            pg8::Gemm g{(const bf16*)(ws + WS_HID), (const bf16*)(ws + wset(l) + WS_WOUT), TT, DM, DM, 0};
            pg8::StaticOrder S; S.init(TT, DM, F.G, (int)blockIdx.x);
            EpiRes E{(const bf16*)(ws + WS_XB), (bf16*)(ws + WS_SB)};
            pg8::gemm_phase<EpiRes, pg8::StaticOrder, true, true, false, false, false, true>(F.lds, g, S, E, F.tid);
            SEAM();
        }
        if (IN(4)) { REPEAT(REP4 - 1) { FRAME(); KArgP k = KA(); ln1_router_phase<true>(F, (const bf16*)(k->ws + WS_SB), k->in[13] + l * DM, k->in[14] + l * DM, k->in[15] + (size_t)l * DM * NEXP, k->ws); SEAM(); }
            FRAME(); KArgP k = KA(); ln1_router_phase<false>(F, (const bf16*)(k->ws + WS_SB), k->in[13] + l * DM, k->in[14] + l * DM, k->in[15] + (size_t)l * DM * NEXP, k->ws); SEAM(); }
        if (IN(5)) REPEAT(REP5) { FRAME(); KArgP k = KA(); topk_phase(F, k->ws);
            if (l + 1 < NLAYER && blockIdx.x >= 32) { FRAME(); KArgP k2 = KA(); conv_phase(F, l + 1, k2->in[4], k2->in[12], k2->in[16], k2->in[17], k2->in[18], k2->in[8], k2->ws, 0, CONV_SPLIT_ITEMS, (blockIdx.x - 32) * NWAVES + F.wave, (gridDim.x - 32) * NWAVES, false); }
            SEAM(); }
        if (IN(7)) REPEAT(REP7) {
            FRAME(); KArgP k = KA(); unsigned char* ws = k->ws;
            pg8::Gemm g{(const bf16*)(ws + WS_XB8), (const bf16*)(ws + wset(l) + WS_WGU), ROWS_E, 4096, DM / 2, (size_t)4096 * DM, (const int*)(ws + WS_IDX)};
            pg8::StaticOrder S; S.init(ROWS_E, 4096, F.G, (int)blockIdx.x);
            EpiSwiglu E{ws + WS_HID};
            pg8::gemm_phase<EpiSwiglu, pg8::StaticOrder, true, true, true, true, true, true>(F.lds, g, S, E, F.tid);
            SEAM();
        }
        if (IN(8)) REPEAT(REP8) {
            FRAME(); KArgP k = KA(); unsigned char* ws = k->ws;
            pg8::Gemm g{(const bf16*)(ws + WS_HID), (const bf16*)(ws + wset(l) + WS_WD), ROWS_E, DM, DEXP / 2, (size_t)DM * DEXP};
            pg8::StaticOrder S; S.init(ROWS_E, DM, F.G, (int)blockIdx.x);
            EpiDown E{ws + WS_H, (const float*)(ws + WS_GATE)};
            pg8::gemm_phase<EpiDown, pg8::StaticOrder, true, true, true, true, false, true>(F.lds, g, S, E, F.tid);
            SEAM();
        }
#if BAL_PROBE_N
        if (IN(8)) REPEAT(BAL_PROBE_N) {
            FRAME(); KArgP k = KA(); unsigned char* ws = k->ws;
            pg8::Gemm g{(const bf16*)(ws + WS_HID), (const bf16*)(ws + wset(l) + WS_WD), ROWS_E, DM, DEXP / 2, (size_t)DM * DEXP};
            pg8::StaticOrder S; S.init(ROWS_E, DM, F.G, (int)blockIdx.x);
            EpiDown E{ws + WS_DUMMY, (const float*)(ws + WS_GATE)};
            pg8::gemm_phase<EpiDown, pg8::StaticOrder, true, true, true, true, false, (BAL_PROBE != 0)>(F.lds, g, S, E, F.tid);
            SEAM();
        }
#endif
        if (IN(9)) { REPEAT(REP9 - 1) { FRAME(); KArgP k = KA(); combine_phase<true>(F, k->out, (const bf16*)(k->ws + WS_SB), k->in[13] + l * DM, k->in[14] + l * DM, k->in[19] + l * DM, k->in[20] + l * DM, k->ws, l + 1 == NLAYER); SEAM(); }
            FRAME(); KArgP k = KA(); combine_phase<false>(F, k->out, (const bf16*)(k->ws + WS_SB), k->in[13] + l * DM, k->in[14] + l * DM, k->in[19] + l * DM, k->in[20] + l * DM, k->ws, l + 1 == NLAYER);
            if (l + 1 < NLAYER) { FRAME(); KArgP k = KA(); conv_phase(F, l + 1, k->in[4], k->in[12], k->in[16], k->in[17], k->in[18], k->in[8], k->ws, CONV_SPLIT_ITEMS, 1 << 30, F.gw, F.NGW, true); }
            SEAM(); }
    }
#undef IN
#undef SEAM
}

extern "C" void kernel_launch(void* const* d_in, const int* in_sizes, int n_in, void* d_out, int out_size, void* d_ws, size_t ws_size, hipStream_t stream) {
    static int grid = 0;
    if (grid == 0) {
        if (n_in != 21 || out_size != TT * DM || ws_size < WS_END) { fprintf(stderr, "kernel_launch: unexpected shapes (n_in %d, out %d, ws %zu)\n", n_in, out_size, ws_size); grid = -1; return; }
        int dev = 0, cus = 0, per_cu = 0;
        if (hipGetDevice(&dev) != hipSuccess || hipDeviceGetAttribute(&cus, hipDeviceAttributeMultiprocessorCount, dev) != hipSuccess) { grid = -1; return; }
        if (hipFuncSetAttribute((const void*)enc_fwd, hipFuncAttributeMaxDynamicSharedMemorySize, LDS_BYTES) != hipSuccess) { fprintf(stderr, "kernel_launch: hipFuncSetAttribute failed\n"); grid = -1; return; }
        if (hipOccupancyMaxActiveBlocksPerMultiprocessor(&per_cu, (const void*)enc_fwd, NWAVES * 64, LDS_BYTES) != hipSuccess || per_cu < 1) fprintf(stderr, "kernel_launch: occupancy query reports %d\n", per_cu);
        (void)hipGetLastError();
        grid = cus;
    }
    if (grid < 0) return;
    if (hipMemsetAsync((char*)d_ws + WS_CTL, 0, CTL_ZERO_BYTES, stream) != hipSuccess) return;
    Args a{};
    for (int i = 0; i < 21; ++i) a.in[i] = (const float*)d_in[i];
    a.out = (float*)d_out; a.ws = (unsigned char*)d_ws; a.pad = 0;
#if MK_FUSED
    a.l_lo = 0; a.l_hi = NLAYER; a.ph_lo = 0; a.ph_hi = NPH; a.use_bar = 1;
    hipLaunchKernelGGL(enc_fwd, dim3(grid), dim3(NWAVES * 64), LDS_BYTES, stream, a);
#else
    a.use_bar = 0;
    for (int l = 0; l < NLAYER; ++l)
        for (int ph = 0; ph < NPH; ++ph) { a.l_lo = l; a.l_hi = l + 1; a.ph_lo = ph; a.ph_hi = ph + 1; hipLaunchKernelGGL(enc_fwd, dim3(grid), dim3(NWAVES * 64), LDS_BYTES, stream, a); }
#endif
}
```

```cpp
#include <hip/hip_runtime.h>
#include <hip/hip_bf16.h>
#include <cstdio>
#include <cstdint>
#ifndef BAL_PROBE
#define BAL_PROBE 0
#endif
#ifndef BAL_PROBE_N
#define BAL_PROBE_N 0
#endif
#ifndef LN1_ROWS
#define LN1_ROWS 4
#endif
#ifndef GQA_MSUM
#define GQA_MSUM false
#endif
namespace pg8 {
#define PG8_LAS __attribute__((address_space(3)))
typedef unsigned short bf16_t;
typedef short bf16x8 __attribute__((ext_vector_type(8)));
typedef float f32x4 __attribute__((ext_vector_type(4)));
typedef unsigned u32x4 __attribute__((ext_vector_type(4)));
typedef int v4i_t __attribute__((ext_vector_type(4)));
typedef int v8i_t __attribute__((ext_vector_type(8)));
constexpr int BM = 256, BK = 64, HALF = 128, HTB = HALF * BK * 2  , STAGE_BYTES = 8 * HTB, NXCD = 8, WGM = 8;

__host__ __device__ __forceinline__ int lds_byte(int r, int c) { const int st = (r >> 4) * 2 + (c >> 5), rr = r & 15, cc = c & 31, ob = rr * 64 + cc * 2; return st * 1024 + (ob ^ (((ob >> 9) & 1) << 5)); }
__host__ __device__ __forceinline__ void stage_rc(int b, int& R, int& C) { const int st = b / 1024, sb = b % 1024, swz = sb ^ (((sb >> 9) & 1) << 5); R = (st >> 1) * 16 + swz / 64; C = (st & 1) * 32 + (swz % 64) / 2; }
__host__ __device__ __forceinline__ int perm32(int rho) { const int n = rho >> 4, i = rho & 15; return 8 * (i >> 2) + 4 * n + (i & 3); }

struct Unit { int pm, pn; };
struct Gemm { const bf16_t* A; const bf16_t* Bt; int M, N, K; size_t estride; const int* idx; };
__host__ __device__ __forceinline__ int expert_of_tile(int pm) { return pm < 128 ? (pm >> 3) : ((pm - 128) >> 5); }

struct StaticOrder {
    int nM, nN, nwg, G, c;
    __host__ __device__ void init(int M, int N, int G_, int c_) { nM = M / BM; nN = N / BM; nwg = nM * nN; G = G_; c = c_; }
    __host__ __device__ bool next(int i, Unit& u) const {
        const long L = (long)i * G + c; if (L >= nwg) return false;
        int wgid = (int)L; { const int q = nwg / NXCD, r = nwg % NXCD, xcd = wgid % NXCD, off = wgid / NXCD; wgid = (xcd < r ? xcd * (q + 1) : r * (q + 1) + (xcd - r) * q) + off; }
        const int nig = WGM * nN, gid = wgid / nig, fm = gid * WGM, gsz = (nM - fm) < WGM ? (nM - fm) : WGM;
        u.pm = fm + ((wgid % nig) % gsz); u.pn = (wgid % nig) / gsz; return true;
    }
    __device__ __forceinline__ void a_ready(const Unit&) const {}
    __device__ __forceinline__ void done(const Unit&) const {}
};

struct RotOrder {
    StaticOrder S;
    __host__ __device__ void init(int M, int N, int G_, int c_) { S.init(M, N, G_, c_); }
    __host__ __device__ bool next(int i, Unit& u) const {
        if (S.G != 256) return S.next(i, u);
        StaticOrder T = S; T.c = (S.c & 63) + 64 * (((S.c >> 6) + (i >> 1)) & 3);
        return T.next(i, u);
    }
    __device__ __forceinline__ void a_ready(const Unit&) const {}
    __device__ __forceinline__ void done(const Unit&) const {}
};

__device__ __forceinline__ unsigned cvt_pk_bf16(float lo, float hi) { unsigned r; asm volatile("v_cvt_pk_bf16_f32 %0, %1, %2" : "=v"(r) : "v"(lo), "v"(hi)); return r; }
typedef float f32x2 __attribute__((ext_vector_type(2)));

__device__ __forceinline__ void mfma_fp8(f32x4& acc, const v8i_t& a, const v8i_t& b, int sc) {
    asm volatile("v_mfma_scale_f32_16x16x128_f8f6f4 %0, %1, %2, %0, %3, %3 op_sel_hi:[0,0,0]" : "+v"(acc) : "v"(a), "v"(b), "v"(sc));
}
template <class Epi, class Sched, bool ALIGN_EPI = false, bool SP2 = false, bool GROUPED = false, bool FP8 = false, bool GATHER = false, bool BAL = false>
__device__ __forceinline__ void gemm_phase(PG8_LAS unsigned char* lds, const Gemm g, const Sched& S, const Epi& E, int tid_in) {
    int tid_ = tid_in; asm volatile("" : "+v"(tid_));
    const int tid = tid_, wid = __builtin_amdgcn_readfirstlane(tid >> 6), lane = tid & 63, wr = wid >> 2, wc = wid & 3, fr = lane & 15, fq = lane >> 4;
    const int K = g.K, nt = K / BK;
    unsigned voffA[2], voffB[2];
#pragma unroll
    for (int i = 0; i < 2; ++i) { int R, C; stage_rc(tid * 16 + i * 8192, R, C); const int Rb = Epi::PERM ? ((R & ~31) + perm32(R & 31)) : R;
        voffA[i] = (unsigned)(R * K + C) * 2u; voffB[i] = (unsigned)(Rb * K + C) * 2u; }
    const size_t kstep = (size_t)(BK * 2);
    const size_t hstep = (size_t)HALF * K * 2;
    const size_t tstep = 2 * hstep;
    const unsigned ldsw = (unsigned)wid * 1024u;
    const int aoff = lds_byte(wr * 64 + fr, fq * 8), boff = lds_byte(wc * 32 + fr, fq * 8);
#define PG8_SA(b, h) (((b) * 2 + (h)) * HTB)
#define PG8_SB(b, h) ((4 + (b) * 2 + (h)) * HTB)
#define PG8_STAGE(bufoff, gbase, voff) do { _Pragma("unroll") for (int _i = 0; _i < 2; ++_i) \
        __builtin_amdgcn_global_load_lds((const unsigned*)((const char*)(gbase) + (voff)[_i]), (PG8_LAS unsigned*)(lds + (bufoff) + ldsw + _i * 8192), 16, 0, 0); } while (0)
    static_assert(!GATHER || SP2, "GATHER is wired into the SP2 loop only");
    unsigned vC[2][2], vN[2][2]; unsigned cC[2];
    PG8_LAS unsigned char* gtab = lds + 131072 + 1024 + wid * 512;
    if constexpr (GATHER) {
#pragma unroll
        for (int i = 0; i < 2; ++i) { int R, C; stage_rc(tid * 16 + i * 8192, R, C); cC[i] = (unsigned)C * 2u; }
    }
    const int grow = ((lane >> 5) & 1) * 128 + ((lane >> 4) & 1) * 64 + (wid >> 1) * 16 + (lane & 15);
#define PG8_GDMA(unit, buf) __builtin_amdgcn_global_load_lds((const unsigned*)(g.idx + (size_t)(unit).pm * BM + grow), (PG8_LAS unsigned*)(gtab + (buf) * 256), 4, 0, 0)
#define PG8_GREAD(dst, buf) do { unsigned r00_, r01_, r10_, r11_; const unsigned ga_ = (unsigned)(size_t)gtab + (unsigned)(buf) * 256u + (unsigned)(lane >> 2) * 4u; \
        asm volatile("ds_read_b32 %0, %4\n\tds_read_b32 %1, %4 offset:64\n\tds_read_b32 %2, %4 offset:128\n\tds_read_b32 %3, %4 offset:192\n\ts_waitcnt lgkmcnt(0)" \
                     : "=&v"(r00_), "=&v"(r01_), "=&v"(r10_), "=&v"(r11_) : "v"(ga_) : "memory"); \
        dst[0][0] = r00_ * (unsigned)(K * 2) + cC[0]; dst[0][1] = r01_ * (unsigned)(K * 2) + cC[1]; dst[1][0] = r10_ * (unsigned)(K * 2) + cC[0]; dst[1][1] = r11_ * (unsigned)(K * 2) + cC[1]; } while (0)
#define PG8_GSTAGE(bufoff, kb, h, nx) do { _Pragma("unroll") for (int _i = 0; _i < 2; ++_i) \
        __builtin_amdgcn_global_load_lds((const unsigned*)((const char*)g.A + (kb) + ((nx) ? vN[h][_i] : vC[h][_i])), (PG8_LAS unsigned*)(lds + (bufoff) + ldsw + _i * 8192), 16, 0, 0); } while (0)
#define PG8_STA(bufoff, ptr, kb, h, nx) do { if constexpr (GATHER) { PG8_GSTAGE(bufoff, kb, h, nx); } else { PG8_STAGE(bufoff, ptr, voffA); } } while (0)
#define PG8_LDA(dst, b, h) do { if constexpr (FP8) { _Pragma("unroll") for (int m = 0; m < 4; ++m) dst##8[m] = PG8_CAT(*(const PG8_LAS bf16x8*)(lds + PG8_SA(b, h) + aoff + m * 2048), *(const PG8_LAS bf16x8*)(lds + PG8_SA(b, h) + aoff + m * 2048 + 1024)); } \
        else { _Pragma("unroll") for (int m = 0; m < 4; ++m) _Pragma("unroll") for (int k = 0; k < 2; ++k) dst[m][k] = *(const PG8_LAS bf16x8*)(lds + PG8_SA(b, h) + aoff + m * 2048 + k * 1024); } } while (0)
#define PG8_LDB(dst, b, h) do { if constexpr (FP8) { _Pragma("unroll") for (int n = 0; n < 2; ++n) dst##8[n] = PG8_CAT(*(const PG8_LAS bf16x8*)(lds + PG8_SB(b, h) + boff + n * 2048), *(const PG8_LAS bf16x8*)(lds + PG8_SB(b, h) + boff + n * 2048 + 1024)); } \
        else { _Pragma("unroll") for (int n = 0; n < 2; ++n) _Pragma("unroll") for (int k = 0; k < 2; ++k) dst[n][k] = *(const PG8_LAS bf16x8*)(lds + PG8_SB(b, h) + boff + n * 2048 + k * 1024); } } while (0)
#define PG8_MMA(ai, bj, At, Bt) do { __builtin_amdgcn_s_setprio(1); if constexpr (FP8) { _Pragma("unroll") for (int m = 0; m < 4; ++m) _Pragma("unroll") for (int n = 0; n < 2; ++n) \
        mfma_fp8(acc[ai][bj][m][n], Bt##8[n], At##8[m], sc8); } \
        else { _Pragma("unroll") for (int m = 0; m < 4; ++m) _Pragma("unroll") for (int n = 0; n < 2; ++n) _Pragma("unroll") for (int k = 0; k < 2; ++k) \
        acc[ai][bj][m][n] = __builtin_amdgcn_mfma_f32_16x16x32_bf16(Bt[n][k], At[m][k], acc[ai][bj][m][n], 0, 0, 0); } __builtin_amdgcn_s_setprio(0); } while (0)
#define PG8_CAT(x, y) __builtin_shufflevector(__builtin_bit_cast(v4i_t, (x)), __builtin_bit_cast(v4i_t, (y)), 0, 1, 2, 3, 4, 5, 6, 7)
#define PG8_WAIT_V(n) asm volatile("s_waitcnt vmcnt(" #n ")" ::: "memory")
#define PG8_WAIT_L(n) asm volatile("s_waitcnt lgkmcnt(" #n ")" ::: "memory")
#define PG8_BAR __builtin_amdgcn_s_barrier()
#define PG8_SCHED __builtin_amdgcn_sched_barrier(0)
    Unit cur, nxt; int ui = 0;
    if (!S.next(0, cur)) return;
    f32x4 acc[2][2][4][2];
#pragma unroll
    for (int a = 0; a < 2; ++a)
#pragma unroll
        for (int b = 0; b < 2; ++b)
#pragma unroll
            for (int m = 0; m < 4; ++m)
#pragma unroll
                for (int n = 0; n < 2; ++n) acc[a][b][m][n] = (f32x4){0.f, 0.f, 0.f, 0.f};
    int sc8 = 0x7f7f7f7f; if constexpr (FP8) asm volatile("" : "+v"(sc8));
    bf16x8 At[4][2], B0[2][2], B1[2][2]; v8i_t At8[4], B08[2], B18[2];
    const char* cA = (const char*)g.A + (size_t)cur.pm * tstep; const char* cB = (const char*)g.Bt + (size_t)cur.pn * tstep + (GROUPED ? (size_t)expert_of_tile(cur.pm) * g.estride : (size_t)0);
    S.a_ready(cur);
    if constexpr (SP2) {
        if constexpr (GATHER) { PG8_GDMA(cur, 0); PG8_WAIT_V(0); PG8_GREAD(vC, 0); }
        PG8_STAGE(PG8_SB(0, 0), cB, voffB); PG8_STAGE(PG8_SB(0, 1), cB + hstep, voffB); PG8_STA(PG8_SA(0, 0), cA, 0, 0, false); PG8_STA(PG8_SA(0, 1), cA + hstep, 0, 1, false);
        if (wr == 1) PG8_BAR;
        PG8_WAIT_V(2); PG8_BAR;
        if constexpr (BAL) { PG8_STAGE(PG8_SB(1, 0), cB + kstep, voffB); PG8_STAGE(PG8_SB(1, 1), cB + hstep + kstep, voffB); PG8_WAIT_V(4); PG8_BAR; }
        else {
        PG8_STAGE(PG8_SB(1, 0), cB + kstep, voffB); PG8_STA(PG8_SA(1, 0), cA + kstep, kstep, 0, false); PG8_STAGE(PG8_SB(1, 1), cB + hstep + kstep, voffB);
        PG8_WAIT_V(6); PG8_BAR;
        }
    } else {
        PG8_STAGE(PG8_SB(0, 0), cB, voffB); PG8_STAGE(PG8_SA(0, 0), cA, voffA); PG8_STAGE(PG8_SB(0, 1), cB + hstep, voffB); PG8_STAGE(PG8_SA(0, 1), cA + hstep, voffA);
        if (wr == 1) PG8_BAR;
        PG8_WAIT_V(4); PG8_BAR;
        PG8_STAGE(PG8_SB(1, 0), cB + kstep, voffB); PG8_STAGE(PG8_SA(1, 0), cA + kstep, voffA); PG8_STAGE(PG8_SB(1, 1), cB + hstep + kstep, voffB);
        PG8_WAIT_V(6); PG8_BAR;
    }
    for (;;) {
        const bool has_next = S.next(ui + 1, nxt);
        if constexpr (GATHER) { if (has_next) PG8_GDMA(nxt, (ui + 1) & 1); }
        const char* nA = has_next ? (const char*)g.A + (size_t)nxt.pm * tstep : cA; const char* nB = has_next ? (const char*)g.Bt + (size_t)nxt.pn * tstep + (GROUPED ? (size_t)expert_of_tile(nxt.pm) * g.estride : (size_t)0) : cB;
        for (int t = 0; t < nt; t += 2) {
            const bool last = (t == nt - 2);
            const char* a1 = cA + (size_t)(t + 1) * kstep;
            const char* a2 = last ? nA : cA + (size_t)(t + 2) * kstep; const char* b2 = last ? nB : cB + (size_t)(t + 2) * kstep;
            const char* a3 = a2 + kstep; const char* b3 = b2 + kstep;
            if (last && has_next) S.a_ready(nxt);
            if constexpr (SP2) {
            const bool nx = last && has_next; const size_t kb2 = last ? (size_t)0 : (size_t)(t + 2) * kstep;
            if constexpr (GATHER) { if (nx) PG8_GREAD(vN, (ui + 1) & 1); }
            if constexpr (BAL) {
            PG8_LDB(B0, 0, 0); PG8_LDB(B1, 0, 1); PG8_SCHED; PG8_LDA(At, 0, 0); PG8_STA(PG8_SA(1, 0), a1, (size_t)(t + 1) * kstep, 0, false); PG8_STA(PG8_SA(1, 1), a1 + hstep, (size_t)(t + 1) * kstep, 1, false);
            PG8_WAIT_V(8); PG8_WAIT_L(0); PG8_BAR; PG8_MMA(0, 0, At, B0); PG8_MMA(0, 1, At, B1); PG8_BAR; PG8_SCHED;
            PG8_LDA(At, 0, 1); PG8_STAGE(PG8_SB(0, 0), b2, voffB); PG8_STAGE(PG8_SB(0, 1), b2 + hstep, voffB);
            PG8_WAIT_V(6); PG8_WAIT_L(0); PG8_BAR; PG8_MMA(1, 0, At, B0); PG8_MMA(1, 1, At, B1); PG8_BAR; PG8_SCHED;
            PG8_LDB(B0, 1, 0); PG8_LDB(B1, 1, 1); PG8_SCHED; PG8_LDA(At, 1, 0); PG8_STA(PG8_SA(0, 0), a2, kb2, 0, nx); PG8_STA(PG8_SA(0, 1), a2 + hstep, kb2, 1, nx);
            PG8_WAIT_V(8); PG8_WAIT_L(0); PG8_BAR; PG8_MMA(0, 0, At, B0); PG8_MMA(0, 1, At, B1); PG8_BAR; PG8_SCHED;
            PG8_LDA(At, 1, 1); PG8_STAGE(PG8_SB(1, 0), b3, voffB); PG8_STAGE(PG8_SB(1, 1), b3 + hstep, voffB);
            PG8_WAIT_V(6); PG8_WAIT_L(0); PG8_BAR; PG8_MMA(1, 0, At, B0); PG8_MMA(1, 1, At, B1); PG8_BAR; PG8_SCHED;
            } else {
            PG8_LDB(B0, 0, 0); PG8_LDB(B1, 0, 1); PG8_SCHED; PG8_LDA(At, 0, 0); PG8_STA(PG8_SA(1, 1), a1 + hstep, (size_t)(t + 1) * kstep, 1, false);
            PG8_WAIT_V(8); PG8_WAIT_L(0); PG8_BAR; PG8_MMA(0, 0, At, B0); PG8_MMA(0, 1, At, B1); PG8_BAR; PG8_SCHED;
            PG8_LDA(At, 0, 1); PG8_STAGE(PG8_SB(0, 0), b2, voffB); PG8_STAGE(PG8_SB(0, 1), b2 + hstep, voffB); PG8_STA(PG8_SA(0, 0), a2, kb2, 0, nx);
            PG8_WAIT_V(8); PG8_WAIT_L(0); PG8_BAR; PG8_MMA(1, 0, At, B0); PG8_MMA(1, 1, At, B1); PG8_BAR; PG8_SCHED;
            PG8_LDB(B0, 1, 0); PG8_LDB(B1, 1, 1); PG8_SCHED; PG8_LDA(At, 1, 0); PG8_STA(PG8_SA(0, 1), a2 + hstep, kb2, 1, nx);
            PG8_WAIT_V(8); PG8_WAIT_L(0); PG8_BAR; PG8_MMA(0, 0, At, B0); PG8_MMA(0, 1, At, B1); PG8_BAR; PG8_SCHED;
            PG8_LDA(At, 1, 1); PG8_STAGE(PG8_SB(1, 0), b3, voffB); PG8_STAGE(PG8_SB(1, 1), b3 + hstep, voffB); PG8_STA(PG8_SA(1, 0), a3, kb2 + kstep, 0, nx);
            PG8_WAIT_V(8); PG8_WAIT_L(0); PG8_BAR; PG8_MMA(1, 0, At, B0); PG8_MMA(1, 1, At, B1); PG8_BAR; PG8_SCHED;
            }
            } else {
            PG8_LDB(B0, 0, 0); PG8_SCHED; PG8_LDA(At, 0, 0); PG8_STAGE(PG8_SA(1, 1), a1 + hstep, voffA);
            PG8_WAIT_L(8); PG8_BAR; PG8_WAIT_L(0); PG8_MMA(0, 0, At, B0); PG8_BAR; PG8_SCHED;
            PG8_LDB(B1, 0, 1); PG8_STAGE(PG8_SB(0, 0), b2, voffB);
            PG8_BAR; PG8_WAIT_L(0); PG8_MMA(0, 1, At, B1); PG8_BAR;
            PG8_LDA(At, 0, 1); PG8_STAGE(PG8_SA(0, 0), a2, voffA);
            PG8_BAR; PG8_WAIT_L(0); PG8_MMA(1, 0, At, B0); PG8_BAR; PG8_SCHED;
            PG8_STAGE(PG8_SB(0, 1), b2 + hstep, voffB);
            PG8_WAIT_V(6); PG8_BAR; PG8_MMA(1, 1, At, B1); PG8_BAR;
            PG8_LDB(B0, 1, 0); PG8_SCHED; PG8_LDA(At, 1, 0); PG8_STAGE(PG8_SA(0, 1), a2 + hstep, voffA);
            PG8_WAIT_L(8); PG8_BAR; PG8_WAIT_L(0); PG8_MMA(0, 0, At, B0); PG8_BAR; PG8_SCHED;
            PG8_LDB(B1, 1, 1); PG8_STAGE(PG8_SB(1, 0), b3, voffB);
            PG8_BAR; PG8_WAIT_L(0); PG8_MMA(0, 1, At, B1); PG8_BAR;
            PG8_LDA(At, 1, 1); PG8_STAGE(PG8_SA(1, 0), a3, voffA);
            PG8_BAR; PG8_WAIT_L(0); PG8_MMA(1, 0, At, B0); PG8_BAR; PG8_SCHED;
            PG8_STAGE(PG8_SB(1, 1), b3 + hstep, voffB);
            PG8_WAIT_V(6); PG8_BAR; PG8_MMA(1, 1, At, B1); PG8_BAR;
            }
        }
        if constexpr (FP8) asm volatile("s_nop 15\n\ts_nop 7" ::: "memory");
        if constexpr (ALIGN_EPI) { if (wr == 0) PG8_BAR; }
        if constexpr (!Epi::AFTER_DRAIN) { int fr_ = fr, fq_ = fq; asm volatile("" : "+v"(fr_), "+v"(fq_));
            E(acc, cur, wr, wc, fr_, fq_); S.done(cur); }
        if (!has_next) break;
#pragma unroll
        for (int a = 0; a < 2; ++a)
#pragma unroll
            for (int b = 0; b < 2; ++b)
#pragma unroll
                for (int m = 0; m < 4; ++m)
#pragma unroll
                    for (int n = 0; n < 2; ++n) acc[a][b][m][n] = (f32x4){0.f, 0.f, 0.f, 0.f};
        cur = nxt; cA = nA; cB = nB; ++ui;
        if constexpr (GATHER) { vC[0][0] = vN[0][0]; vC[0][1] = vN[0][1]; vC[1][0] = vN[1][0]; vC[1][1] = vN[1][1]; }
        if constexpr (ALIGN_EPI) { if (wr == 1) PG8_BAR; }
    }
    PG8_WAIT_V(0);
    if constexpr (!ALIGN_EPI) { if (wr == 0) PG8_BAR; }
    PG8_BAR;
    if constexpr (Epi::AFTER_DRAIN) { E.fused(acc, cur, wr, wc, fr, fq, lds, wid, lane); S.done(cur); }
#undef PG8_SA
#undef PG8_SB
#undef PG8_STAGE
#undef PG8_GDMA
#undef PG8_GREAD
#undef PG8_GSTAGE
#undef PG8_STA
#undef PG8_LDA
#undef PG8_LDB
#undef PG8_MMA
#undef PG8_CAT
#undef PG8_WAIT_V
#undef PG8_WAIT_L
#undef PG8_BAR
#undef PG8_SCHED
}
}

#define GAS __attribute__((address_space(1)))
#define LAS __attribute__((address_space(3)))
typedef unsigned v4u __attribute__((ext_vector_type(4)));
using pg8::f32x4;
typedef GAS unsigned gu32;
typedef GAS unsigned long long gu64;
#define RLX_AGENT __ATOMIC_RELAXED, __HIP_MEMORY_SCOPE_AGENT
#define LDS_WAIT() asm volatile("s_waitcnt lgkmcnt(0)" ::: "memory")
#define VM_WAIT() asm volatile("s_waitcnt vmcnt(0)" ::: "memory")

#define XB_TMO      128
#define XB_XCNT(j)  (256  + 64 * (j))
#define XB_XSUB(j)  (1280 + 64 * (j))
#define XB_XGEN(j)  (2304 + 64 * (j))
#define XB_TOP      3328
#define XB_TOPGEN   3392
#define XCD_BAR_WORDS 3456
#define XB_SPIN_CAP (1u << 18)

__device__ __forceinline__ unsigned xb_ld(unsigned* p)              { return __hip_atomic_load(p, __ATOMIC_RELAXED, __HIP_MEMORY_SCOPE_AGENT); }
__device__ __forceinline__ unsigned xb_add(unsigned* p, unsigned v) { return __hip_atomic_fetch_add(p, v, __ATOMIC_RELAXED, __HIP_MEMORY_SCOPE_AGENT); }
__device__ __forceinline__ unsigned xb_xcc_id() { return (unsigned)__builtin_amdgcn_s_getreg((3 << 11) | 20) & 0xFu; }
#define XB_SPIN(cond, bar) do { unsigned _sp = 0; while (cond) { __builtin_amdgcn_s_sleep(1); \
    if ((++_sp & 255u) == 0u) { if (xb_ld(&(bar)[XB_TMO])) break; if (_sp > XB_SPIN_CAP) { atomicAdd(&(bar)[XB_TMO], 1u); break; } } } } while (0)

struct XcdBarrier {
    unsigned* bar; unsigned x;
    volatile LAS unsigned* st;
};

__device__ __forceinline__ XcdBarrier xcd_barrier_post(unsigned* bar, volatile LAS unsigned* st) {
    XcdBarrier b; b.bar = bar; b.x = xb_xcc_id(); b.st = st;
    if (threadIdx.x == 0) (void)xb_add(&bar[XB_XCNT(b.x)], 1u);
    return b;
}
__device__ __forceinline__ void xcd_barrier_complete(unsigned* bar, unsigned x, unsigned& nloc, unsigned& nx) {
    const unsigned G = gridDim.x * gridDim.y * gridDim.z;
    unsigned sum, cnt, mine, sp = 0u;
    for (;;) {
        sum = 0u; cnt = 0u; mine = 0u;
#pragma unroll
        for (unsigned j = 0; j < 16; ++j) { const unsigned c = xb_ld(&bar[XB_XCNT(j)]); sum += c; cnt += (c > 0u) ? 1u : 0u; mine = (j == x) ? c : mine; }
        if (sum == G) break;
        __builtin_amdgcn_s_sleep(1);
        if ((++sp & 255u) == 0u) { if (xb_ld(&bar[XB_TMO])) break; if (sp > XB_SPIN_CAP) { atomicAdd(&bar[XB_TMO], 1u); break; } }
    }
    nloc = mine > 0u ? mine : 1u; nx = cnt > 0u ? cnt : 1u;
}

__device__ __forceinline__ void xcd_barrier(const XcdBarrier& b) {
    asm volatile("s_waitcnt vmcnt(0)" ::: "memory");
    __syncthreads();
    if (threadIdx.x == 0) {
        unsigned* bar = b.bar;
        __builtin_amdgcn_s_waitcnt(0);
        unsigned nloc = b.st[0], nx = b.st[1];
        if (nloc == 0u) { xcd_barrier_complete(bar, b.x, nloc, nx); b.st[0] = nloc; b.st[1] = nx; }
        const unsigned old = xb_add(&bar[XB_XSUB(b.x)], 1u);
        const unsigned gen = old / nloc;
        if (old + 1u == (gen + 1u) * nloc) {
            __builtin_amdgcn_fence(__ATOMIC_RELEASE, "agent");
            asm volatile("s_waitcnt vmcnt(0)" ::: "memory");
            const unsigned og = xb_add(&bar[XB_TOP], 1u);
            const unsigned tg = og / nx;
            if (og + 1u == (tg + 1u) * nx) xb_add(&bar[XB_TOPGEN], 1u);
            else XB_SPIN(xb_ld(&bar[XB_TOPGEN]) == tg, bar);
            __builtin_amdgcn_fence(__ATOMIC_ACQUIRE, "agent");
            xb_add(&bar[XB_XGEN(b.x)], 1u);
            asm volatile("s_waitcnt vmcnt(0)" ::: "memory");
        } else {
            XB_SPIN(xb_ld(&bar[XB_XGEN(b.x)]) == gen, bar);
            __builtin_amdgcn_fence(__ATOMIC_ACQUIRE, "agent");
            asm volatile("s_waitcnt vmcnt(0)" ::: "memory");
        }
    }
    __syncthreads();
}


namespace attn_body {
using bf16=__hip_bfloat16;
using bf16x8=__attribute__((ext_vector_type(8)))short;
using s16x4=__attribute__((ext_vector_type(4)))short;
using f32x16=__attribute__((ext_vector_type(16)))float;
using u32x4=__attribute__((ext_vector_type(4)))unsigned;
constexpr int SEQ=4096,D=64,KP=2048,OP=1024;
constexpr int NW=8,QBLK=32,QB=QBLK*NW,KVBLK=64,NQB=SEQ/QB;
__device__ __forceinline__ int crow(int r,int hi){return (r&3)+8*(r>>2)+4*hi;}
#define SBAR() __builtin_amdgcn_sched_barrier(0)
constexpr int NSLOT=3, SLOTB=8192;
constexpr int LDS_K=0, LDS_V=NSLOT*SLOTB, LDS_WS=2*NSLOT*SLOTB, LDS_OST=LDS_WS+NW*64*4, LDS_BYTES=LDS_OST+NW*4096;
constexpr float C2=0.125f*1.4426950408889634f;
__device__ __forceinline__ void glds16(const void*gsrc,unsigned lds_dst){unsigned keep;
  asm volatile("s_mov_b32 %0, m0\n\ts_mov_b32 m0, %2\n\ts_nop 0\n\tglobal_load_lds_dwordx4 %1, off\n\ts_mov_b32 m0, %0":"=&s"(keep):"v"(gsrc),"s"(lds_dst):"memory");}
__device__ __forceinline__ float max3f(float a,float b,float c){float r;asm("v_max3_f32 %0, %1, %2, %3":"=v"(r):"v"(a),"v"(b),"v"(c));return r;}
__device__ __forceinline__ float max2f(float a,float b){float r;asm("v_max_f32_e32 %0, %1, %2":"=v"(r):"v"(a),"v"(b));return r;}
__device__ __forceinline__ float fadd_s(float a,float b){float r;asm("v_add_f32_e32 %0, %1, %2":"=v"(r):"v"(a),"v"(b));return r;}
__device__ __forceinline__ float fsub_s(float a,float b){float r;asm("v_sub_f32_e32 %0, %1, %2":"=v"(r):"v"(a),"v"(b));return r;}
typedef float f32x2_t __attribute__((ext_vector_type(2))); typedef __bf16 bf16x2_t __attribute__((ext_vector_type(2)));
__device__ __forceinline__ unsigned cvtpk_s(float lo,float hi){f32x2_t v={lo,hi};bf16x2_t b=__builtin_convertvector(v,bf16x2_t);return __builtin_bit_cast(unsigned,b);}
#define WAIT_BAR(N) asm volatile("s_waitcnt vmcnt(" #N ") lgkmcnt(0)\n\ts_barrier":::"memory")

__device__ __forceinline__ void qkt(f32x16&p0,f32x16&p1,const char*Kslot,const bf16x8*qr,const f32x16&negm,int r32,int hi){
  const char*kb=Kslot+hi*1024+r32*16;
  #pragma unroll
  for(int d0=0;d0<4;++d0){
    const bf16x8 b0=*reinterpret_cast<const bf16x8*>(kb+d0*2048);
    const bf16x8 b1=*reinterpret_cast<const bf16x8*>(kb+d0*2048+512);
    if(d0==0){p0=__builtin_amdgcn_mfma_f32_32x32x16_bf16(b0,qr[0],negm,0,0,0);p1=__builtin_amdgcn_mfma_f32_32x32x16_bf16(b1,qr[0],negm,0,0,0);}
    else{p0=__builtin_amdgcn_mfma_f32_32x32x16_bf16(b0,qr[d0],p0,0,0,0);p1=__builtin_amdgcn_mfma_f32_32x32x16_bf16(b1,qr[d0],p1,0,0,0);}}
}
typedef __attribute__((address_space(3))) const char* lds_cptr;
typedef short v4i16_t __attribute__((ext_vector_type(4)));
__device__ __forceinline__ void kload8(bf16x8*kf,lds_cptr kp){
  kf[0]=*(const __attribute__((address_space(3))) bf16x8*)(kp);      kf[1]=*(const __attribute__((address_space(3))) bf16x8*)(kp+512);
  kf[2]=*(const __attribute__((address_space(3))) bf16x8*)(kp+2048); kf[3]=*(const __attribute__((address_space(3))) bf16x8*)(kp+2560);
  kf[4]=*(const __attribute__((address_space(3))) bf16x8*)(kp+4096); kf[5]=*(const __attribute__((address_space(3))) bf16x8*)(kp+4608);
  kf[6]=*(const __attribute__((address_space(3))) bf16x8*)(kp+6144); kf[7]=*(const __attribute__((address_space(3))) bf16x8*)(kp+6656);
}
__device__ __forceinline__ void kload2(bf16x8*kf,lds_cptr kp,int j){ kf[2*j]=*(const __attribute__((address_space(3))) bf16x8*)(kp+j*2048); kf[2*j+1]=*(const __attribute__((address_space(3))) bf16x8*)(kp+j*2048+512); }
__device__ __forceinline__ s16x4 vtr(lds_cptr p){ return __builtin_bit_cast(s16x4,__builtin_amdgcn_ds_read_tr16_b64_v4i16((__attribute__((address_space(3))) v4i16_t*)p)); }
__device__ __forceinline__ float rowmax(const f32x16&p0,const f32x16&p1){
  float a=max3f(p0[0],p0[1],p1[0]),b=max3f(p0[2],p0[3],p1[1]);a=max3f(a,p1[2],p1[3]);
  #pragma unroll
  for(int r=4;r<16;r+=4){a=max3f(a,p0[r],p0[r+1]);b=max3f(b,p0[r+2],p0[r+3]);a=max3f(a,p1[r],p1[r+1]);b=max3f(b,p1[r+2],p1[r+3]);}
  const float m=max2f(a,b);
  auto rr=__builtin_amdgcn_permlane32_swap(__float_as_uint(m),__float_as_uint(m),false,false);
  return max2f(__uint_as_float(rr[0]),__uint_as_float(rr[1]));
}
__device__ __forceinline__ void pv(f32x16*o,int vb,bf16x8 pa0,bf16x8 pa1,bf16x8 pa2,bf16x8 pa3){
  #pragma unroll
  for(int d0=0;d0<2;++d0){s16x4 lo[4],hi[4];
    #pragma unroll
    for(int ks=0;ks<4;++ks){
      asm volatile("ds_read_b64_tr_b16 %0,%1 offset:%c2":"=&v"(lo[ks]):"v"(vb),"i"(d0*4096+ks*1024):"memory");
      asm volatile("ds_read_b64_tr_b16 %0,%1 offset:%c2":"=&v"(hi[ks]):"v"(vb),"i"(d0*4096+ks*1024+512):"memory");}
    asm volatile("s_waitcnt lgkmcnt(0)":::"memory");SBAR();
    #define PK(k) (bf16x8){lo[k][0],lo[k][1],lo[k][2],lo[k][3],hi[k][0],hi[k][1],hi[k][2],hi[k][3]}
    o[d0]=__builtin_amdgcn_mfma_f32_32x32x16_bf16(pa0,PK(0),o[d0],0,0,0);
    o[d0]=__builtin_amdgcn_mfma_f32_32x32x16_bf16(pa1,PK(1),o[d0],0,0,0);
    o[d0]=__builtin_amdgcn_mfma_f32_32x32x16_bf16(pa2,PK(2),o[d0],0,0,0);
    o[d0]=__builtin_amdgcn_mfma_f32_32x32x16_bf16(pa3,PK(3),o[d0],0,0,0);
    #undef PK
  }
}

#ifndef ATTN_STORE16
#define ATTN_STORE16(p,v) (*(u32x4*)(p)=(v))
#endif
template<int THRL,bool NOMAX=false,bool MSUM=true> __device__ __forceinline__ void attn_unit(const bf16*Qw0,const bf16*__restrict__ Kh,const bf16*__restrict__ Vh,bf16*Ow0,char*shm,int tid_in){
  int tid_=tid_in; asm volatile("":"+v"(tid_));
  const int tid=tid_,lane=tid&63,r32=lane&31,hi=lane>>5; const int wid=__builtin_amdgcn_readfirstlane(tid>>6);
  const bf16*Qw=Qw0+(long)(wid*QBLK)*KP;
  const unsigned lds0=(unsigned)(uintptr_t)shm;
  float*wsf=(float*)(shm+LDS_WS)+wid*64;
  const bf16*ksrc=Kh+(long)lane*KP+wid*8;
  const bf16*vsrc=Vh+(long)(16*(wid&3)+(lane>>2))*KP+(wid>>2)*32+(lane&3)*8;
  const unsigned kdst=lds0+LDS_K+wid*1024, vdst=lds0+LDS_V+wid*1024;
  #define DMA_K(t,slot) glds16(ksrc+(long)(t)*KVBLK*KP,(unsigned)__builtin_amdgcn_readfirstlane(kdst+(slot)))
  #define DMA_V(t,slot) glds16(vsrc+(long)(t)*KVBLK*KP,(unsigned)__builtin_amdgcn_readfirstlane(vdst+(slot)))
  const int vb0=(int)(lds0+LDS_V)+((lane>>4)&1)*32+(lane&3)*8+(4*hi+((lane&15)>>2))*64;
  const char*Kbase=shm+LDS_K; bf16x8 kf[8];
  const lds_cptr shm3=(lds_cptr)shm; const lds_cptr kp0=shm3+LDS_K+hi*1024+r32*16; const lds_cptr vp0=shm3+LDS_V+((lane>>4)&1)*32+(lane&3)*8+(4*hi+((lane&15)>>2))*64;
  constexpr int NT=SEQ/KVBLK;
  DMA_K(0,0);DMA_V(0,0);DMA_K(1,SLOTB);
  bf16x8 qr[4];
  #pragma unroll
  for(int d0=0;d0<4;++d0)qr[d0]=*reinterpret_cast<const bf16x8*>(&Qw[(long)r32*KP+d0*16+hi*8]);
  float mhat=0.f,l_reg=0.f;f32x16 o[2];o[0]=f32x16{};o[1]=f32x16{};f32x16 negm=f32x16{};if constexpr(!NOMAX)asm volatile("":"+v"(negm));
  f32x16 lsum=f32x16{}; const bf16x8 ONESF={(short)0x3F80,(short)0x3F80,(short)0x3F80,(short)0x3F80,(short)0x3F80,(short)0x3F80,(short)0x3F80,(short)0x3F80};
  #define CMASK(P0,P1,t) do{}while(0)
  bool resc=false;
  #define START(P0,P1) do{ if constexpr(!NOMAX){ const float rm=rowmax(P0,P1); resc=false; \
    { const float dl=rm; mhat=fadd_s(mhat,dl); \
      _Pragma("unroll") for(int r=0;r<16;++r){P0[r]=fsub_s(P0[r],dl);P1[r]=fsub_s(P1[r],dl);} \
      _Pragma("unroll") for(int r=0;r<16;++r)negm[r]=-mhat; asm volatile("":"+v"(negm)); } } \
    _Pragma("unroll") for(int r=0;r<16;++r)P0[r]=__builtin_amdgcn_exp2f(P0[r]); }while(0)
  #define RESC() do{ if(resc){ asm volatile("s_waitcnt lgkmcnt(0)":::"memory"); \
      _Pragma("unroll") for(int d_=0;d_<2;++d_) _Pragma("unroll") for(int r=0;r<16;++r)o[d_][r]*=wsf[crow(r,hi)]; } }while(0)
  f32x16 pA0,pA1,pB0,pB1;
  int sl_prev=0,sl_cur=0,sl_next=SLOTB;
  #define ROT() do{sl_prev=sl_cur;sl_cur=sl_next;sl_next=(sl_next==(NSLOT-1)*SLOTB)?0:sl_next+SLOTB;}while(0)
  DMA_K(2,2*SLOTB);
  WAIT_BAR(3);
  qkt(pA0,pA1,Kbase,qr,negm,r32,hi);asm volatile("s_nop 15\n\ts_nop 7":"+v"(pA0),"+v"(pA1));CMASK(pA0,pA1,0);
  START(pA0,pA1);
  _Pragma("unroll") for(int r=0;r<16;++r)pA1[r]=__builtin_amdgcn_exp2f(pA1[r]);
  WAIT_BAR(0);
  DMA_K(3,0);DMA_V(1,SLOTB);
  ROT();
  kload8(kf,kp0+sl_cur);
  WAIT_BAR(2);
  s16x4 vlo[8],vhi[8]; u32x4 pw0,pw1,pw2,pw3;
  #define PKW(P,B) cvtpk_s(P[B],P[B+1])
  #define PAF(k) __builtin_bit_cast(bf16x8,pw##k)
  #define VFR(i) (bf16x8){vlo[i][0],vlo[i][1],vlo[i][2],vlo[i][3],vhi[i][0],vhi[i][1],vhi[i][2],vhi[i][3]}
  #define PIN(x) asm volatile("":"+v"(x))
  #define MX3(a,b,c) __builtin_fmaxf(__builtin_fmaxf((a),(b)),(c))
  #define GAPA(MF,A0,A1,A2,A3,W0,W1,PW) do{ MF; if constexpr(!(NOMAX&&MSUM)){ sacc+=A0; sacc+=A1; sacc+=A2; sacc+=A3; PIN(sacc); } W0; W1; PIN(PW); SBAR(); }while(0)
  #define LSUM(k) do{ if constexpr(NOMAX&&MSUM){ lsum=__builtin_amdgcn_mfma_f32_32x32x16_bf16(PAF(k),ONESF,lsum,0,0,0); SBAR(); } }while(0)
  #define EX(v) __builtin_amdgcn_exp2f(v)
  #define GAPB(MF,X,B) do{ MF; X[B]=EX(X[B]); X[B+1]=EX(X[B+1]); X[B+2]=EX(X[B+2]); X[B+3]=EX(X[B+3]); PIN(X); SBAR(); }while(0)
  #define VRD(i) do{ vlo[i]=vtr(vp_+(((i)>>2)*4096+((i)&3)*1024)); vhi[i]=vtr(vp_+(((i)>>2)*4096+((i)&3)*1024+512)); }while(0)
  #define KRD(G,j) do{ if(G){ kload2(kf,kp0+sl_next,j); SBAR(); } }while(0)
  #define STEP(C0,C1,P0,P1,t,GK,GV,GL) do{ SBAR(); \
    const lds_cptr vp_=vp0+sl_prev; \
    VRD(0); SBAR(); float sacc=0.f; if constexpr(!(NOMAX&&MSUM)) sacc=(P0[0]+P0[1]); \
    GAPA(C0=__builtin_amdgcn_mfma_f32_32x32x16_bf16(kf[0],qr[0],negm,0,0,0), P0[2],P0[3],P0[4],P0[5],     pw0[0]=PKW(P0,0), pw0[1]=PKW(P0,2), pw0); \
    VRD(4); SBAR(); GAPA(C1=__builtin_amdgcn_mfma_f32_32x32x16_bf16(kf[1],qr[0],negm,0,0,0), P0[6],P0[7],P0[8],P0[9],     pw0[2]=PKW(P0,4), pw0[3]=PKW(P0,6), pw0); \
    VRD(1); SBAR(); GAPA(C0=__builtin_amdgcn_mfma_f32_32x32x16_bf16(kf[2],qr[1],C0,0,0,0),   P0[10],P0[11],P0[12],P0[13], pw1[0]=PKW(P0,8), pw1[1]=PKW(P0,10), pw1); \
    VRD(5); SBAR(); GAPA(C1=__builtin_amdgcn_mfma_f32_32x32x16_bf16(kf[3],qr[1],C1,0,0,0),   P0[14],P0[15],P1[0],P1[1],   pw1[2]=PKW(P0,12),pw1[3]=PKW(P0,14), pw1); \
    VRD(2); SBAR(); GAPA(C0=__builtin_amdgcn_mfma_f32_32x32x16_bf16(kf[4],qr[2],C0,0,0,0),   P1[2],P1[3],P1[4],P1[5],     pw2[0]=PKW(P1,0), pw2[1]=PKW(P1,2), pw2); \
    VRD(6); SBAR(); GAPA(C1=__builtin_amdgcn_mfma_f32_32x32x16_bf16(kf[5],qr[2],C1,0,0,0),   P1[6],P1[7],P1[8],P1[9],     pw2[2]=PKW(P1,4), pw2[3]=PKW(P1,6), pw2); \
    VRD(3); SBAR(); GAPA(C0=__builtin_amdgcn_mfma_f32_32x32x16_bf16(kf[6],qr[3],C0,0,0,0),   P1[10],P1[11],P1[12],P1[13], pw3[0]=PKW(P1,8), pw3[1]=PKW(P1,10), pw3); \
    VRD(7); SBAR(); GAPA(C1=__builtin_amdgcn_mfma_f32_32x32x16_bf16(kf[7],qr[3],C1,0,0,0),   P1[14],P1[15],0.f,0.f,       pw3[2]=PKW(P1,12),pw3[3]=PKW(P1,14), pw3); \
    l_reg+=sacc; \
    if(GK){DMA_K((t)+3,sl_cur);} if(GV){DMA_V((t)+1,sl_next);} \
    CMASK(C0,C1,t); \
    if constexpr(!NOMAX){ float a=MX3(C0[0],C0[1],C1[0]),b=MX3(C0[2],C0[3],C1[1]); a=MX3(a,C1[2],C1[3]); \
      _Pragma("unroll") for(int r=4;r<16;r+=4){a=MX3(a,C0[r],C0[r+1]);b=MX3(b,C0[r+2],C0[r+3]);a=MX3(a,C1[r],C1[r+1]);b=MX3(b,C1[r+2],C1[r+3]);} \
      float rm=__builtin_fmaxf(a,b); { auto rr=__builtin_amdgcn_permlane32_swap(__float_as_uint(rm),__float_as_uint(rm),false,false); rm=__builtin_fmaxf(__uint_as_float(rr[0]),__uint_as_float(rr[1])); } \
      resc=false; \
      if(__builtin_expect(__any(rm>(float)THRL),0)){ const float dl=__builtin_fmaxf(rm,0.f); mhat+=dl; \
        _Pragma("unroll") for(int r=0;r<16;++r){C0[r]-=dl;C1[r]-=dl;} \
        _Pragma("unroll") for(int r=0;r<16;++r)negm[r]=-mhat; asm volatile("":"+v"(negm)); \
        const float f=__builtin_amdgcn_exp2f(-dl); l_reg*=f; if(hi==0)wsf[r32]=f; resc=true; } } \
    SBAR(); \
    GAPB(o[0]=__builtin_amdgcn_mfma_f32_32x32x16_bf16(PAF(0),VFR(0),o[0],0,0,0), C0,0); \
    GAPB(o[1]=__builtin_amdgcn_mfma_f32_32x32x16_bf16(PAF(0),VFR(4),o[1],0,0,0), C0,4); LSUM(0); \
    KRD(GL,0); GAPB(o[0]=__builtin_amdgcn_mfma_f32_32x32x16_bf16(PAF(1),VFR(1),o[0],0,0,0), C0,8); \
    KRD(GL,1); GAPB(o[1]=__builtin_amdgcn_mfma_f32_32x32x16_bf16(PAF(1),VFR(5),o[1],0,0,0), C0,12); LSUM(1); \
    KRD(GL,2); GAPB(o[0]=__builtin_amdgcn_mfma_f32_32x32x16_bf16(PAF(2),VFR(2),o[0],0,0,0), C1,0); \
    KRD(GL,3); GAPB(o[1]=__builtin_amdgcn_mfma_f32_32x32x16_bf16(PAF(2),VFR(6),o[1],0,0,0), C1,4); LSUM(2); \
    GAPB(o[0]=__builtin_amdgcn_mfma_f32_32x32x16_bf16(PAF(3),VFR(3),o[0],0,0,0), C1,8); \
    GAPB(o[1]=__builtin_amdgcn_mfma_f32_32x32x16_bf16(PAF(3),VFR(7),o[1],0,0,0), C1,12); LSUM(3); \
    }while(0)
  int t=1;
  for(;t+5<NT;t+=2){
    STEP(pB0,pB1,pA0,pA1,t,true,true,true);     WAIT_BAR(2); RESC(); ROT();
    STEP(pA0,pA1,pB0,pB1,t+1,true,true,true);   WAIT_BAR(2); RESC(); ROT();
  }
  #define ENDW(tt) do{ if((tt)+3<NT){WAIT_BAR(2);} else if((tt)+2<NT){WAIT_BAR(1);} else {WAIT_BAR(0);} }while(0)
  for(;t+1<NT;t+=2){
    STEP(pB0,pB1,pA0,pA1,t,(t+3<NT),(t+1<NT),(t+1<NT));       ENDW(t);   RESC(); ROT();
    STEP(pA0,pA1,pB0,pB1,t+1,(t+4<NT),(t+2<NT),(t+2<NT));     ENDW(t+1); RESC(); ROT();
  }
  STEP(pB0,pB1,pA0,pA1,NT-1,false,false,false); RESC();
  { if constexpr(!(NOMAX&&MSUM)){ float sacc=pB0[0]+pB0[1]; _Pragma("unroll") for(int r=2;r<16;++r)sacc+=pB0[r]; _Pragma("unroll") for(int r=0;r<16;++r)sacc+=pB1[r]; l_reg+=sacc; }
    pw0=(u32x4){PKW(pB0,0),PKW(pB0,2),PKW(pB0,4),PKW(pB0,6)};pw1=(u32x4){PKW(pB0,8),PKW(pB0,10),PKW(pB0,12),PKW(pB0,14)};pw2=(u32x4){PKW(pB1,0),PKW(pB1,2),PKW(pB1,4),PKW(pB1,6)};pw3=(u32x4){PKW(pB1,8),PKW(pB1,10),PKW(pB1,12),PKW(pB1,14)};
    SBAR(); pv(o,vb0+sl_cur,PAF(0),PAF(1),PAF(2),PAF(3)); LSUM(0); LSUM(1); LSUM(2); LSUM(3); }
  #undef PKW
  #undef PAF
  #undef VFR
  #undef PIN
  #undef MX3
  #undef GAPA
  #undef LSUM
  #undef GAPB
  #undef EX
  #undef VRD
  #undef KRD
  #undef STEP
  #undef ENDW
  float rli[16];
  if constexpr(NOMAX&&MSUM){
    #pragma unroll
    for(int r=0;r<16;++r)rli[r]=__builtin_amdgcn_rcpf(lsum[r]);
  } else {
  {auto rr=__builtin_amdgcn_permlane32_swap(__float_as_uint(l_reg),__float_as_uint(l_reg),false,false);l_reg=__uint_as_float(rr[0])+__uint_as_float(rr[1]);}
  if(hi==0)wsf[32+r32]=l_reg;asm volatile("s_waitcnt lgkmcnt(0)":::"memory");
  #pragma unroll
  for(int r=0;r<16;++r)rli[r]=__builtin_amdgcn_rcpf(wsf[32+crow(r,hi)]);
  }
  bf16*Ow=Ow0+(long)(wid*QBLK)*OP;
  { bf16*stg=(bf16*)(shm+LDS_OST)+wid*2048;
    #pragma unroll
    for(int r=0;r<16;++r){const int orow=crow(r,hi);
      #pragma unroll
      for(int d0=0;d0<2;++d0)stg[orow*64+d0*32+r32]=__float2bfloat16(o[d0][r]*rli[r]);}
    asm volatile("s_waitcnt lgkmcnt(0)":::"memory");
    #pragma unroll
    for(int i=0;i<4;++i){const int row=i*8+(lane>>3),ch=lane&7; const u32x4 v=*(const u32x4*)(stg+row*64+ch*8); ATTN_STORE16(Ow+(long)row*OP+ch*8,v);} }
  asm volatile("s_waitcnt lgkmcnt(0)\n\ts_barrier":::"memory");
  #undef DMA_K
  #undef DMA_V
  #undef CMASK
  #undef START
  #undef RESC
  #undef ROT
}
constexpr int ATTN_LDS_BYTES=LDS_BYTES;
#undef SBAR
#undef WAIT_BAR
}

typedef unsigned short bf16;
typedef float f32x16 __attribute__((ext_vector_type(16)));
typedef short s16x4 __attribute__((ext_vector_type(4)));
typedef short v4i16_t __attribute__((ext_vector_type(4)));
typedef unsigned u32x2 __attribute__((ext_vector_type(2)));
typedef float f32x2v __attribute__((ext_vector_type(2)));
using pg8::bf16x8; using pg8::u32x4;

constexpr int DM = 1024, SEQ = 4096, T_P = 4 * 4096, T_S = 16 * 4096, TT = T_P + T_S, NBATCH = 20;
constexpr int DIN = 2048, NLAYER = 4, NEXP = 16, DEXP = 2048;
constexpr int CAP_P = T_P / 8, CAP_S = T_S / 8, ROWS_P = NEXP * CAP_P, ROWS_E = 2 * TT;
constexpr float LN_EPS = 1e-5f, QK_EPS = 1e-6f;
constexpr float DN_ALPHA = 1.6817928305074290861f;
constexpr float LOG2E = 1.4426950408889634f;
constexpr float C2 = 0.125f * LOG2E;
constexpr int H_NAQ = 0, H_NAK = 256, H_NAV = 512, H_GQ = 768, H_GK = 1280, H_GV = 1408, H_UC = 1536, H_VC = 1792;
constexpr int Y_NA = 0, Y_GQA = 256, Y_SG = 768;

constexpr size_t MiB = 1u << 20;
constexpr size_t WS_CTL = 0, CTL_ZERO_BYTES = 1 * MiB;
constexpr size_t WS_ROPE = 1 * MiB;
constexpr size_t WS_WSBF = 2 * MiB;
constexpr size_t WS_WIN = 4 * MiB;
constexpr size_t WS_WOUT = 8 * MiB;
constexpr size_t WS_WGU = 16 * MiB;
constexpr size_t WS_WD = 144 * MiB;
constexpr size_t WS_AFF = 208 * MiB;
constexpr size_t WS_SLOTOF = 214 * MiB;
constexpr size_t WS_IDX = 220 * MiB;
constexpr size_t WS_GATE = 221 * MiB;
constexpr size_t WS_STATS = 222 * MiB;
constexpr size_t WS_XB = 224 * MiB;
constexpr size_t WS_H = 384 * MiB;
constexpr size_t WS_SB = 544 * MiB;
constexpr size_t WS_HID = 704 * MiB;
constexpr size_t WS_XB8 = 1344 * MiB;
constexpr size_t WS_VT = 1424 * MiB;
constexpr size_t WS_SET1 = 1468 * MiB;
constexpr size_t WS_DUMMY = 1676 * MiB;
constexpr size_t WS_END = 1676 * MiB;
__device__ __forceinline__ size_t wset(int l) { return (l & 1) ? (WS_SET1 - 2 * MiB) : (size_t)0; }
#ifndef CONV_SPLIT_ITEMS
#define CONV_SPLIT_ITEMS 20480
#endif
constexpr int VTP = SEQ + 64;
constexpr int CW_TMO = 0, CW_BAR = 4096;

constexpr int NWAVES = 8;
constexpr int RING_BYTES = 131072, LDSCTL_OFF = RING_BYTES, MISC_OFF = LDSCTL_OFF + 320, LDS_BYTES = 147456;

__device__ __forceinline__ unsigned f2bf(float f) { unsigned u = __builtin_bit_cast(unsigned, f); return (u + 0x7fffu + ((u >> 16) & 1u)) >> 16; }
__device__ __forceinline__ unsigned pk2(float lo, float hi) { return f2bf(lo) | (f2bf(hi) << 16); }
__device__ __forceinline__ float bf2f(unsigned short b) { return __builtin_bit_cast(float, (unsigned)b << 16); }
template <int CTRL> __device__ __forceinline__ float dppf(float v) { return __builtin_bit_cast(float, __builtin_amdgcn_update_dpp(0, __builtin_bit_cast(int, v), CTRL, 0xf, 0xf, false)); }
template <int O> __device__ __forceinline__ float shx(float v) { static_assert(O == 1 || O == 2, "exact xor partners: 1, 2"); return dppf<(O == 1) ? 0xB1 : 0x4E>(v); }
template <int O> __device__ __forceinline__ float shm(float v) { static_assert(O == 4 || O == 8, "mirror partners: 4 -> lane ^ 7, 8 -> lane ^ 15"); return dppf<(O == 4) ? 0x141 : 0x140>(v); }
__device__ __forceinline__ float sum16(float v) { const auto rr = __builtin_amdgcn_permlane16_swap(__float_as_uint(v), __float_as_uint(v), false, false); return __uint_as_float(rr[0]) + __uint_as_float(rr[1]); }
__device__ __forceinline__ float max16(float v) { const auto rr = __builtin_amdgcn_permlane16_swap(__float_as_uint(v), __float_as_uint(v), false, false); return fmaxf(__uint_as_float(rr[0]), __uint_as_float(rr[1])); }
__device__ __forceinline__ float other16(float v, bool odd_row) { const auto rr = __builtin_amdgcn_permlane16_swap(__float_as_uint(v), __float_as_uint(v), false, false); return __uint_as_float(odd_row ? rr[0] : rr[1]); }
__device__ __forceinline__ float sum32(float v) { const auto rr = __builtin_amdgcn_permlane32_swap(__float_as_uint(v), __float_as_uint(v), false, false); return __uint_as_float(rr[0]) + __uint_as_float(rr[1]); }
__device__ __forceinline__ float max32(float v) { const auto rr = __builtin_amdgcn_permlane32_swap(__float_as_uint(v), __float_as_uint(v), false, false); return fmaxf(__uint_as_float(rr[0]), __uint_as_float(rr[1])); }
__device__ __forceinline__ float other32(float v, bool upper) { const auto rr = __builtin_amdgcn_permlane32_swap(__float_as_uint(v), __float_as_uint(v), false, false); return __uint_as_float(upper ? rr[0] : rr[1]); }
__device__ __forceinline__ float wave_sum(float v) {
    v += shx<1>(v); v += shx<2>(v); v += shm<4>(v); v += shm<8>(v); v = sum16(v);
    return sum32(v);
}
__device__ __forceinline__ float gelu_tanh(float x) {
    const float u = 0.7978845608028654f * (x + 0.044715f * x * x * x);
    const float e = __builtin_amdgcn_exp2f((2.0f * LOG2E) * u);
    const float th = 1.0f - 2.0f * __builtin_amdgcn_rcpf(e + 1.0f);
    return 0.5f * x * (1.0f + th);
}
__device__ __forceinline__ float clamp8(float v) { return __builtin_amdgcn_fmed3f(v, -440.f, 440.f); }
__device__ __forceinline__ unsigned pk4_fp8(float a, float b, float c, float d) { int w = 0; w = __builtin_amdgcn_cvt_pk_fp8_f32(clamp8(a), clamp8(b), w, false); w = __builtin_amdgcn_cvt_pk_fp8_f32(clamp8(c), clamp8(d), w, true); return (unsigned)w; }
constexpr float WGU_SCALE = 64.f, WD_SCALE = 128.f, HID_SCALE = 8.f, YE_SCALE = 64.f;
__device__ __forceinline__ int crow(int r, int hi) { return (r & 3) + 8 * (r >> 2) + 4 * hi; }
__device__ __forceinline__ s16x4 tr_read(const LAS unsigned char* p) { return __builtin_bit_cast(s16x4, __builtin_amdgcn_ds_read_tr16_b64_v4i16((LAS v4i16_t*)p)); }
#define MFMA32(a, b, c) __builtin_amdgcn_mfma_f32_32x32x16_bf16((a), (b), (c), 0, 0, 0)

using pg8::Unit; using pg8::BM; using pg8::HALF;
__device__ __forceinline__ u32x4 pack8(const f32x4& a, const f32x4& b) { u32x4 w; w.x = pg8::cvt_pk_bf16(a[0], a[1]); w.y = pg8::cvt_pk_bf16(a[2], a[3]); w.z = pg8::cvt_pk_bf16(b[0], b[1]); w.w = pg8::cvt_pk_bf16(b[2], b[3]); return w; }

struct EpiIn {
    static constexpr bool PERM = true, AFTER_DRAIN = false;
    bf16* H; const float* qn; const float* kn; const float* gv; const float* bv; const float* rope; bf16* VT;
    __device__ __forceinline__ void operator()(const f32x4 (&acc)[2][2][4][2], const Unit& u, int wr, int wc, int fr, int fq) const {
        const int pn = u.pn;
        int mode; const float* gain = qn; float osc = 1.f;
        if (pn == 0) { mode = 1; osc = C2; } else if (pn <= 2) mode = 0; else if (pn <= 4) { mode = 2; gain = qn; osc = C2; }
        else if (pn == 5) { if (wc < 2) { mode = 2; gain = kn; osc = 1.f; } else mode = 0; } else if (pn == 6) mode = 3; else mode = 4;
        const int row0 = u.pm * BM + wr * 64 + fr;
        bf16* Hb = H + (size_t)row0 * DIN + pn * 256 + wc * 64 + 8 * fq;
#define EPI_ROWS(BODY) _Pragma("unroll") for (int ai = 0; ai < 2; ++ai) _Pragma("unroll") for (int m = 0; m < 4; ++m) { const int rofs = ai * HALF + m * 16; f32x4 v[2][2]; \
            _Pragma("unroll") for (int bj = 0; bj < 2; ++bj) _Pragma("unroll") for (int n = 0; n < 2; ++n) v[bj][n] = acc[ai][bj][m][n]; \
            BODY \
            bf16* rowp = Hb + (size_t)rofs * DIN; _Pragma("unroll") for (int bj = 0; bj < 2; ++bj) *(u32x4*)(rowp + 32 * bj) = pack8(v[bj][0], v[bj][1]); }
#define EPI_ALL(EXPR) _Pragma("unroll") for (int bj = 0; bj < 2; ++bj) _Pragma("unroll") for (int n = 0; n < 2; ++n) { EXPR }
        if (mode == 5) {
#pragma unroll
            for (int ai = 0; ai < 2; ++ai)
#pragma unroll
                for (int m = 0; m < 4; ++m) { const int t = row0 + ai * HALF + m * 16; bf16* vb = VT + ((size_t)((t >> 12) * 4 + wc) * 64 + 8 * fq) * VTP + (t & (SEQ - 1));
#pragma unroll
                    for (int bj = 0; bj < 2; ++bj)
#pragma unroll
                        for (int n = 0; n < 2; ++n)
#pragma unroll
                            for (int i = 0; i < 4; ++i) vb[(size_t)(32 * bj + 4 * n + i) * VTP] = (bf16)f2bf(acc[ai][bj][m][n][i]); }
        }
        else if (mode == 0) { EPI_ROWS( ; ) }
        else if (mode == 1) { EPI_ROWS( EPI_ALL( v[bj][n] = v[bj][n] * osc; ) ) }
        else if (mode == 2) {
            EPI_ROWS(
                float ss = 0.f;
                EPI_ALL( const f32x4 x = v[bj][n]; ss += (x[0] * x[0] + x[1] * x[1]) + (x[2] * x[2] + x[3] * x[3]); )
                ss = sum16(ss); ss = sum32(ss);
                const float rstd = osc * __builtin_amdgcn_rsqf(ss * (1.0f / 64.0f) + QK_EPS);
                const int sp = (row0 + rofs) & (SEQ - 1);
                EPI_ALL(
                    const f32x4 gg = *(const f32x4*)(gain + 32 * bj + 8 * fq + 4 * n);
                    const f32x4 cs = *(const f32x4*)(rope + ((size_t)sp * 32 + 16 * bj + 4 * fq + 2 * n) * 2);
                    const f32x4 x = v[bj][n] * rstd * gg;
                    f32x4 o; o[0] = x[0] * cs[0] - x[1] * cs[1]; o[1] = x[0] * cs[1] + x[1] * cs[0]; o[2] = x[2] * cs[2] - x[3] * cs[3]; o[3] = x[2] * cs[3] + x[3] * cs[2];
                    v[bj][n] = o; )
                asm volatile("" ::: "memory");
            )
        } else if (mode == 3) {
            EPI_ROWS( EPI_ALL( f32x4 x = v[bj][n]; x[0] = gelu_tanh(x[0]); x[1] = gelu_tanh(x[1]); x[2] = gelu_tanh(x[2]); x[3] = gelu_tanh(x[3]); v[bj][n] = x; ) )
        } else {
            EPI_ROWS(
                EPI_ALL( f32x4 x = v[bj][n]; x[0] = gelu_tanh(x[0]); x[1] = gelu_tanh(x[1]); x[2] = gelu_tanh(x[2]); x[3] = gelu_tanh(x[3]); v[bj][n] = x; )
                float sm = 0.f;
                EPI_ALL( const f32x4 x = v[bj][n]; sm += (x[0] + x[1]) + (x[2] + x[3]); )
                sm = sum16(sm); sm = sum32(sm);
                const float mean = sm * (1.0f / 64.0f); float q = 0.f;
                EPI_ALL( const f32x4 d = v[bj][n] - mean; v[bj][n] = d; q += (d[0] * d[0] + d[1] * d[1]) + (d[2] * d[2] + d[3] * d[3]); )
                q = sum16(q); q = sum32(q);
                const float rstd = __builtin_amdgcn_rsqf(q * (1.0f / 64.0f) + LN_EPS);
                EPI_ALL( const f32x4 gg = *(const f32x4*)(gv + wc * 64 + 32 * bj + 8 * fq + 4 * n); const f32x4 bb = *(const f32x4*)(bv + wc * 64 + 32 * bj + 8 * fq + 4 * n); v[bj][n] = v[bj][n] * rstd * gg + bb; )
                asm volatile("" ::: "memory");
            )
        }
#undef EPI_ROWS
#undef EPI_ALL
    }
};
struct EpiRes {
    static constexpr bool PERM = true, AFTER_DRAIN = false;
    const bf16* XB; bf16* S;
    __device__ __forceinline__ void operator()(const f32x4 (&acc)[2][2][4][2], const Unit& u, int wr, int wc, int fr, int fq) const {
        const int row0 = u.pm * BM + wr * 64 + fr, col0 = u.pn * BM + wc * 32 + 8 * fq;
#pragma unroll
        for (int ai = 0; ai < 2; ++ai)
#pragma unroll
            for (int m = 0; m < 4; ++m) { const size_t ro = (size_t)(row0 + ai * HALF + m * 16) * DM + col0;
#pragma unroll
                for (int bj = 0; bj < 2; ++bj) { const u32x4 xw = *(const u32x4*)(XB + ro + bj * HALF);
                    f32x4 x0, x1; x0[0] = __builtin_bit_cast(float, xw.x << 16); x0[1] = __builtin_bit_cast(float, xw.x & 0xffff0000u); x0[2] = __builtin_bit_cast(float, xw.y << 16); x0[3] = __builtin_bit_cast(float, xw.y & 0xffff0000u);
                    x1[0] = __builtin_bit_cast(float, xw.z << 16); x1[1] = __builtin_bit_cast(float, xw.z & 0xffff0000u); x1[2] = __builtin_bit_cast(float, xw.w << 16); x1[3] = __builtin_bit_cast(float, xw.w & 0xffff0000u);
                    const f32x4 s0 = x0 * DN_ALPHA + acc[ai][bj][m][0], s1 = x1 * DN_ALPHA + acc[ai][bj][m][1];
                    u32x4 o; o.x = pk2(s0[0], s0[1]); o.y = pk2(s0[2], s0[3]); o.z = pk2(s1[0], s1[1]); o.w = pk2(s1[2], s1[3]); *(u32x4*)(S + ro + bj * HALF) = o; } }
    }
};
struct EpiSwiglu {
    static constexpr bool PERM = true, AFTER_DRAIN = false;
    unsigned char* HID;
    __device__ __forceinline__ void operator()(const f32x4 (&acc)[2][2][4][2], const Unit& u, int wr, int wc, int fr, int fq) const {
        const int row0 = u.pm * BM + wr * 64 + fr, col0 = u.pn * 128 + wc * 32 + 8 * fq;
        constexpr float IS = 1.0f / WGU_SCALE, OS = HID_SCALE / WGU_SCALE;
#pragma unroll
        for (int ai = 0; ai < 2; ++ai)
#pragma unroll
            for (int m = 0; m < 4; ++m) { f32x4 o[2];
#pragma unroll
                for (int n = 0; n < 2; ++n) { const f32x4 g = acc[ai][0][m][n] * IS, up = acc[ai][1][m][n] * OS;
#pragma unroll
                    for (int i = 0; i < 4; ++i) o[n][i] = g[i] * __builtin_amdgcn_rcpf(1.0f + __builtin_amdgcn_exp2f(-LOG2E * g[i])) * up[i]; }
                u32x2 w; w.x = pk4_fp8(o[0][0], o[0][1], o[0][2], o[0][3]); w.y = pk4_fp8(o[1][0], o[1][1], o[1][2], o[1][3]);
                *(u32x2*)(HID + (size_t)(row0 + ai * HALF + m * 16) * DEXP + col0) = w; }
    }
};
struct EpiDown {
    static constexpr bool PERM = true, AFTER_DRAIN = false;
    unsigned char* YE; const float* gate;
    __device__ __forceinline__ void operator()(const f32x4 (&acc)[2][2][4][2], const Unit& u, int wr, int wc, int fr, int fq) const {
        const int row0 = u.pm * BM + wr * 64 + fr, col0 = u.pn * BM + wc * 32 + 8 * fq;
#pragma unroll
        for (int ai = 0; ai < 2; ++ai)
#pragma unroll
            for (int m = 0; m < 4; ++m) { const int row = row0 + ai * HALF + m * 16; const float gt = gate[row] * (YE_SCALE / (WD_SCALE * HID_SCALE));
#pragma unroll
                for (int bj = 0; bj < 2; ++bj) { const f32x4 a = acc[ai][bj][m][0] * gt, c = acc[ai][bj][m][1] * gt; u32x2 w; w.x = pk4_fp8(a[0], a[1], a[2], a[3]); w.y = pk4_fp8(c[0], c[1], c[2], c[3]);
                    *(u32x2*)(YE + (size_t)row * DM + col0 + bj * HALF) = w; } }
    }
};

struct Frame {
    LAS unsigned char* lds;
    int tid, lane, wave, vcu, G, gw, NGW;
};

__device__ __forceinline__ void transpose_item(const float* W, int N, int K, bf16* dst_row0, LAS float* scr, int k0, int n0, int lane) {
    float tv[32];
#pragma unroll
    for (int i = 0; i < 32; ++i) tv[i] = __builtin_nontemporal_load(W + (size_t)(k0 + 2 * i + (lane >> 5)) * N + n0 + (lane & 31));
#pragma unroll
    for (int i = 0; i < 32; ++i) scr[(2 * i + (lane >> 5)) * 33 + (lane & 31)] = tv[i];
    asm volatile("s_waitcnt lgkmcnt(0)" ::: "memory");
    const int c = lane & 7;
#pragma unroll
    for (int j = 0; j < 4; ++j) { const int n = (lane >> 3) + 8 * j; const LAS float* s = scr + (8 * c) * 33 + n;
        u32x4 o; o.x = pk2(s[0 * 33], s[1 * 33]); o.y = pk2(s[2 * 33], s[3 * 33]); o.z = pk2(s[4 * 33], s[5 * 33]); o.w = pk2(s[6 * 33], s[7 * 33]);
        *(u32x4*)(dst_row0 + (size_t)n * K + k0 + 8 * c) = o; }
    asm volatile("s_waitcnt lgkmcnt(0)" ::: "memory");
}
__device__ __forceinline__ void transpose_item_fp8(const float* W, int N, int K, unsigned char* dst_row0, LAS float* scr, int k0, int n0, int lane, float sc) {
    float tv[32];
#pragma unroll
    for (int i = 0; i < 32; ++i) tv[i] = __builtin_nontemporal_load(W + (size_t)(k0 + 2 * i + (lane >> 5)) * N + n0 + (lane & 31));
#pragma unroll
    for (int i = 0; i < 32; ++i) scr[(2 * i + (lane >> 5)) * 33 + (lane & 31)] = tv[i];
    asm volatile("s_waitcnt lgkmcnt(0)" ::: "memory");
    const int c = lane & 7;
#pragma unroll
    for (int j = 0; j < 4; ++j) { const int n = (lane >> 3) + 8 * j; const LAS float* s = scr + (8 * c) * 33 + n;
        u32x2 o; o.x = pk4_fp8(s[0 * 33] * sc, s[1 * 33] * sc, s[2 * 33] * sc, s[3 * 33] * sc); o.y = pk4_fp8(s[4 * 33] * sc, s[5 * 33] * sc, s[6 * 33] * sc, s[7 * 33] * sc);
        *(u32x2*)(dst_row0 + (size_t)n * K + k0 + 8 * c) = o; }
    asm volatile("s_waitcnt lgkmcnt(0)" ::: "memory");
}
__device__ __forceinline__ void conv_phase(Frame& F, int l, const float* w_in, const float* w_out, const float* w_gate, const float* w_up, const float* w_down, const float* sg_w, unsigned char* ws0, int it_lo, int it_hi, int vgw, int vngw, bool tail) {
    unsigned char* ws = ws0 + wset(l);
    LAS float* scr = (LAS float*)(F.lds + F.wave * 16384);
    bf16* WIN = (bf16*)(ws + WS_WIN); bf16* WOUT = (bf16*)(ws + WS_WOUT); unsigned char* WGU = ws + WS_WGU; unsigned char* WD = ws + WS_WD; bf16* WSB = (bf16*)(ws + WS_WSBF);
    constexpr int I_IN = 16 * 64, I_OUT = 16 * 32, I_G = 16 * 1024, I_D = 16 * 1024, NIT = I_IN + I_OUT + 2 * I_G + I_D;
    if (it_hi > NIT) it_hi = NIT;
    for (int it = it_lo + vgw; it < it_hi; it += vngw) {
        int r = it;
        if (r < I_IN) { const int kb = r >> 6, nb = r & 63, n0 = 32 * nb; const int pn = n0 >> 8, c = n0 & 255, wc = c >> 6, bj = (c >> 5) & 1;
            transpose_item(w_in + (size_t)l * DM * DIN, DIN, DM, WIN + (size_t)(256 * pn + 128 * bj + 32 * wc) * DM, scr, 64 * kb, n0, F.lane); continue; }
        r -= I_IN;
        if (r < I_OUT) { const int kb = r >> 5, nb = r & 31, n0 = 32 * nb;
            transpose_item(w_out + (size_t)l * DM * DM, DM, DM, WOUT + (size_t)n0 * DM, scr, 64 * kb, n0, F.lane); continue; }
        r -= I_OUT;
        if (r < 2 * I_G) { const int which = r >= I_G; if (which) r -= I_G; const int e = r >> 10, kb = (r >> 6) & 15, nb = r & 63, n0 = 32 * nb;
            const float* W = (which ? w_up : w_gate) + ((size_t)l * NEXP + e) * DM * DEXP;
            transpose_item_fp8(W, DEXP, DM, WGU + ((size_t)e * 4096 + (n0 >> 7) * 256 + which * 128 + (n0 & 127)) * DM, scr, 64 * kb, n0, F.lane, WGU_SCALE); continue; }
        r -= 2 * I_G;
        { const int e = r >> 10, kb = (r >> 5) & 31, nb = r & 31, n0 = 32 * nb;
            transpose_item_fp8(w_down + ((size_t)l * NEXP + e) * DEXP * DM, DM, DEXP, WD + ((size_t)e * DM + n0) * DEXP, scr, 64 * kb, n0, F.lane, WD_SCALE); }
    }
    if (tail) { const float* sw = sg_w + (size_t)l * 4 * 128 * 128;
        for (int i = vgw * 64 + F.lane; i < 4 * 128 * 128; i += vngw * 64) WSB[i] = (bf16)f2bf(sw[i]); }
}

__device__ __forceinline__ f32x4 bf4(u32x2 w) { f32x4 r; r[0] = __builtin_bit_cast(float, w.x << 16); r[1] = __builtin_bit_cast(float, w.x & 0xffff0000u); r[2] = __builtin_bit_cast(float, w.y << 16); r[3] = __builtin_bit_cast(float, w.y & 0xffff0000u); return r; }
__device__ __forceinline__ void row_ln(f32x4 (&v)[4], const float* g, const float* b, int lane) {
    float s = 0.f;
#pragma unroll
    for (int j = 0; j < 4; ++j) s += (v[j][0] + v[j][1]) + (v[j][2] + v[j][3]);
    const float mean = wave_sum(s) * (1.f / DM); float s2 = 0.f;
#pragma unroll
    for (int j = 0; j < 4; ++j) { v[j] = v[j] - mean; s2 += (v[j][0] * v[j][0] + v[j][1] * v[j][1]) + (v[j][2] * v[j][2] + v[j][3] * v[j][3]); }
    const float rstd = 1.f / sqrtf(wave_sum(s2) * (1.f / DM) + LN_EPS);
#pragma unroll
    for (int j = 0; j < 4; ++j) { const f32x4 gg = *(const f32x4*)(g + 4 * lane + 256 * j), bb = *(const f32x4*)(b + 4 * lane + 256 * j); v[j] = v[j] * rstd * gg + bb; }
}
__device__ __forceinline__ void row_ln_stats(f32x4 (&v)[4], const float* g, const float* b, int lane, float& mean_o, float& rstd_o) {
    float s = 0.f;
#pragma unroll
    for (int j = 0; j < 4; ++j) s += (v[j][0] + v[j][1]) + (v[j][2] + v[j][3]);
    const float mean = wave_sum(s) * (1.f / DM); float s2 = 0.f;
#pragma unroll
    for (int j = 0; j < 4; ++j) { v[j] = v[j] - mean; s2 += (v[j][0] * v[j][0] + v[j][1] * v[j][1]) + (v[j][2] * v[j][2] + v[j][3] * v[j][3]); }
    const float rstd = 1.f / sqrtf(wave_sum(s2) * (1.f / DM) + LN_EPS);
#pragma unroll
    for (int j = 0; j < 4; ++j) { const f32x4 gg = *(const f32x4*)(g + 4 * lane + 256 * j), bb = *(const f32x4*)(b + 4 * lane + 256 * j); v[j] = v[j] * rstd * gg + bb; }
    mean_o = mean; rstd_o = rstd;
}
__device__ __forceinline__ void store_row(const f32x4 (&v)[4], float* xrow, bf16* xbrow, int lane) {
#pragma unroll
    for (int j = 0; j < 4; ++j) { *(f32x4*)(xrow + 4 * lane + 256 * j) = v[j]; u32x2 w; w.x = pk2(v[j][0], v[j][1]); w.y = pk2(v[j][2], v[j][3]); *(u32x2*)(xbrow + 4 * lane + 256 * j) = w; }
}

__device__ __forceinline__ void store_row_bf(const f32x4 (&v)[4], bf16* xbrow, int lane) {
#pragma unroll
    for (int j = 0; j < 4; ++j) { u32x2 w; w.x = pk2(v[j][0], v[j][1]); w.y = pk2(v[j][2], v[j][3]); *(u32x2*)(xbrow + 4 * lane + 256 * j) = w; }
}
__device__ __forceinline__ void prologue_phase(Frame& F, const float* xp, const float* xs, const float* g, const float* b, float* X, unsigned char* ws) {
    float* rope = (float*)(ws + WS_ROPE);
    for (int i = F.gw * 64 + F.lane; i < SEQ * 32; i += F.NGW * 64) {
        const int s = i >> 5, p = i & 31, fi = p & 15; const float pos = (float)((p < 16) ? (s >> 6) : (s & 63));
        const float inv = powf(10000.0f, -(float)fi / 16.0f); const float ang = pos * inv;
        rope[2 * i] = cosf(ang); rope[2 * i + 1] = sinf(ang);
    }
    bf16* XB = (bf16*)(ws + WS_XB);
    for (int m = F.gw; m < TT; m += F.NGW) {
        const float* src = (m < T_P) ? xp + (size_t)m * DM : xs + (size_t)(m - T_P) * DM;
        f32x4 v[4];
#pragma unroll
        for (int j = 0; j < 4; ++j) v[j] = *(const f32x4*)(src + 4 * F.lane + 256 * j);
        row_ln(v, g, b, F.lane);
        store_row_bf(v, XB + (size_t)m * DM, F.lane);
    }
}

__device__ __forceinline__ float router_reduce(float (&lg)[16], int lane) {
    float r8[8], r4[4], r2[2], r1;
    const bool b5 = lane & 32, b4 = lane & 16, b3 = lane & 8, b2 = lane & 4;
#pragma unroll
    for (int i = 0; i < 8; ++i) { const float snd = b5 ? lg[i] : lg[i + 8], kp = b5 ? lg[i + 8] : lg[i]; r8[i] = kp + other32(snd, b5); }
#pragma unroll
    for (int i = 0; i < 4; ++i) { const float snd = b4 ? r8[i] : r8[i + 4], kp = b4 ? r8[i + 4] : r8[i]; r4[i] = kp + other16(snd, b4); }
#pragma unroll
    for (int i = 0; i < 2; ++i) { const float snd = b3 ? r4[i] : r4[i + 2], kp = b3 ? r4[i + 2] : r4[i]; r2[i] = kp + shm<8>(snd); }
    { const float snd = b2 ? r2[0] : r2[1], kp = b2 ? r2[1] : r2[0]; r1 = kp + shm<4>(snd); }
    r1 += shx<1>(r1); r1 += shx<2>(r1);
    float mx = r1;
    mx = fmaxf(mx, shm<4>(mx)); mx = fmaxf(mx, shm<8>(mx)); mx = max16(mx); mx = max32(mx);
    const float ex = expf(r1 - mx); float sm = ex;
    sm += shm<4>(sm); sm += shm<8>(sm); sm = sum16(sm); sm = sum32(sm);
    return ex / sm;
}
template <bool DRY> __device__ __forceinline__ void ln1_router_mfma(Frame& F, const bf16* X, const float* g, const float* b, const float* wr, unsigned char* ws) {
    constexpr int WP = 2064;
    LAS unsigned char* WH = F.lds; LAS unsigned char* WL = F.lds + 16 * WP;
    LAS float* GB = (LAS float*)(F.lds + 2 * 16 * WP);
    LAS float* PART = GB + 2048;
    LAS float* CST = PART + 1024;
    LAS float* WST = CST + 32 + F.wave * 32;
    { const int e = F.tid & 15, part = F.tid >> 4; float sg = 0.f, sb = 0.f;
      for (int i = 0; i < 32; ++i) { const int c = part * 32 + i; const float w = wr[c * 16 + e]; const float wp = g[c] * w;
          const unsigned hi = f2bf(wp); const float hif = __builtin_bit_cast(float, hi << 16); const unsigned lo = f2bf(wp - hif);
          *(LAS unsigned short*)(WH + e * WP + c * 2) = (unsigned short)hi; *(LAS unsigned short*)(WL + e * WP + c * 2) = (unsigned short)lo;
          sg += hif + __builtin_bit_cast(float, lo << 16); sb += b[c] * w; }
      PART[part * 16 + e] = sg; PART[512 + part * 16 + e] = sb; }
    for (int i = F.tid; i < DM; i += NWAVES * 64) { GB[i] = g[i]; GB[DM + i] = b[i]; }
    __syncthreads();
    if (F.tid < 32) { const int e = F.tid & 15, which = F.tid >> 4; float a = 0.f; for (int p2 = 0; p2 < 32; ++p2) a += PART[which * 512 + p2 * 16 + e]; CST[which * 16 + e] = a; }
    __syncthreads();
    unsigned char* XB8 = ws + (DRY ? WS_DUMMY + 16 * MiB : WS_XB8); float* AFF = (float*)(ws + (DRY ? WS_DUMMY + 100 * MiB : WS_AFF)); float* ST = (float*)(ws + (DRY ? WS_DUMMY : WS_STATS));
    const int lane = F.lane, r16 = lane & 15, q = lane >> 4;
    const float Ge = CST[r16], Bce = CST[16 + r16];
    constexpr int NBLK = TT / 16;
    const int blo = (int)((long)NBLK * F.vcu / F.G), bhi = (int)((long)NBLK * (F.vcu + 1) / F.G);
    for (int blk = blo + F.wave; blk < bhi; blk += NWAVES) {
        const int m0 = blk * 16;
        const bf16* src = X + (size_t)(m0 + r16) * DM + 16 * q;
        u32x4 sr[32];
#pragma unroll
        for (int t = 0; t < 16; ++t) { sr[2 * t] = *(const u32x4*)(src + 64 * t); sr[2 * t + 1] = *(const u32x4*)(src + 64 * t + 8); }
        f32x4 acc = (f32x4){0.f, 0.f, 0.f, 0.f}; float s1 = 0.f, s2 = 0.f;
        const LAS unsigned char* wh = WH + r16 * WP + 32 * q; const LAS unsigned char* wl = WL + r16 * WP + 32 * q;
#pragma unroll
        for (int u = 0; u < 32; ++u) { const u32x4 w = sr[u];
            const bf16x8 bh = *(const LAS bf16x8*)(wh + (u >> 1) * 128 + (u & 1) * 16), bl = *(const LAS bf16x8*)(wl + (u >> 1) * 128 + (u & 1) * 16);
            const bf16x8 a = __builtin_bit_cast(bf16x8, w);
            acc = __builtin_amdgcn_mfma_f32_16x16x32_bf16(a, bh, acc, 0, 0, 0); acc = __builtin_amdgcn_mfma_f32_16x16x32_bf16(a, bl, acc, 0, 0, 0);
#pragma unroll
            for (int d = 0; d < 4; ++d) { const float x0 = __builtin_bit_cast(float, w[d] << 16), x1 = __builtin_bit_cast(float, w[d] & 0xffff0000u); s1 += x0 + x1; s2 = fmaf(x0, x0, s2); s2 = fmaf(x1, x1, s2); }
            if ((u & 3) == 3) asm volatile("" ::: "memory"); }
        s1 = sum16(s1); s1 = sum32(s1); s2 = sum16(s2); s2 = sum32(s2);
        const float mean = s1 * (1.f / DM); const float rstd = 1.f / sqrtf(fmaxf(s2 * (1.f / DM) - mean * mean, 0.f) + LN_EPS);
        if (q == 0) { f32x2v st; st[0] = mean; st[1] = rstd; *(f32x2v*)(ST + (size_t)(m0 + r16) * 2) = st; WST[r16] = mean; WST[16 + r16] = rstd; }
        asm volatile("s_waitcnt lgkmcnt(0)" ::: "memory");
        const f32x4 mu4 = *(const LAS f32x4*)(WST + 4 * q), rs4 = *(const LAS f32x4*)(WST + 16 + 4 * q);
        f32x4 af;
#pragma unroll
        for (int i = 0; i < 4; ++i) { const float lg = rs4[i] * (acc[i] - mu4[i] * Ge) + Bce;
            float mx = lg; mx = fmaxf(mx, shx<1>(mx)); mx = fmaxf(mx, shx<2>(mx)); mx = fmaxf(mx, shm<4>(mx)); mx = fmaxf(mx, shm<8>(mx));
            const float ex = expf(lg - mx); float sm = ex; sm += shx<1>(sm); sm += shx<2>(sm); sm += shm<4>(sm); sm += shm<8>(sm);
            af[i] = ex / sm; }
        { const int m = m0 + 4 * q; const size_t off = (m < T_P) ? (size_t)r16 * T_P + m : (size_t)16 * T_P + (size_t)r16 * T_S + (m - T_P);
          *(f32x4*)(AFF + off) = af; }
        asm volatile("" ::: "memory");
#pragma unroll
        for (int u = 0; u < 32; ++u) asm volatile("" : "+v"(sr[u]));
        const float nmr = -mean * rstd;
        unsigned char* dst = XB8 + (size_t)(m0 + r16) * DM + 16 * q;
#pragma unroll
        for (int t = 0; t < 16; ++t) { u32x4 o;
#pragma unroll
            for (int h = 0; h < 2; ++h) { const u32x4 w = sr[2 * t + h]; const LAS float* gp = GB + 64 * t + 16 * q + 8 * h;
                const f32x4 g0 = *(const LAS f32x4*)gp, g1 = *(const LAS f32x4*)(gp + 4), b0 = *(const LAS f32x4*)(gp + DM), b1 = *(const LAS f32x4*)(gp + DM + 4);
                float x[8];
#pragma unroll
                for (int d = 0; d < 4; ++d) { x[2 * d] = fmaf(__builtin_bit_cast(float, w[d] << 16), rstd, nmr); x[2 * d + 1] = fmaf(__builtin_bit_cast(float, w[d] & 0xffff0000u), rstd, nmr); }
                const unsigned p0 = pk4_fp8(fmaf(x[0], g0[0], b0[0]), fmaf(x[1], g0[1], b0[1]), fmaf(x[2], g0[2], b0[2]), fmaf(x[3], g0[3], b0[3]));
                const unsigned p1 = pk4_fp8(fmaf(x[4], g1[0], b1[0]), fmaf(x[5], g1[1], b1[1]), fmaf(x[6], g1[2], b1[2]), fmaf(x[7], g1[3], b1[3]));
                if (h == 0) { o.x = p0; o.y = p1; } else { o.z = p0; o.w = p1; } }
            *(u32x4*)(dst + 64 * t) = o; asm volatile("" ::: "memory"); }
    }
    __syncthreads();
}
template <bool DRY> __device__ __forceinline__ void ln1_router_phase(Frame& F, const bf16* X, const float* g, const float* b, const float* wr, unsigned char* ws) {
    constexpr int NR = LN1_ROWS;
    LAS float* wl = (LAS float*)F.lds;
    for (int i = F.tid; i < DM * NEXP; i += NWAVES * 64) wl[(i & 15) * DM + (i >> 4)] = wr[i];
    __syncthreads();
    unsigned char* XB8 = ws + (DRY ? WS_DUMMY + 16 * MiB : WS_XB8); float* AFF = (float*)(ws + (DRY ? WS_DUMMY + 100 * MiB : WS_AFF)); float* ST = (float*)(ws + (DRY ? WS_DUMMY : WS_STATS));
    const int lane = F.lane, e_mine = ((lane >> 5) & 1) * 8 + ((lane >> 4) & 1) * 4 + ((lane >> 3) & 1) * 2 + ((lane >> 2) & 1);
    int m = NR * F.gw;
    u32x2 nx[NR][4];
#pragma unroll
    for (int r = 0; r < NR; ++r)
#pragma unroll
        for (int j = 0; j < 4; ++j) nx[r][j] = (u32x2){0u, 0u};
    if (m < TT) {
#pragma unroll
        for (int r = 0; r < NR; ++r)
#pragma unroll
            for (int j = 0; j < 4; ++j) nx[r][j] = *(const u32x2*)(X + (size_t)(m + r) * DM + 4 * lane + 256 * j); }
    for (; m < TT; m += NR * F.NGW) {
        f32x4 v[NR][4];
#pragma unroll
        for (int r = 0; r < NR; ++r)
#pragma unroll
            for (int j = 0; j < 4; ++j) v[r][j] = bf4(nx[r][j]);
        { const int mn = m + NR * F.NGW;
          if (mn < TT) {
#pragma unroll
            for (int r = 0; r < NR; ++r)
#pragma unroll
                for (int j = 0; j < 4; ++j) nx[r][j] = *(const u32x2*)(X + (size_t)(mn + r) * DM + 4 * lane + 256 * j); } }
        float mu[NR], rs[NR];
#pragma unroll
        for (int r = 0; r < NR; ++r) row_ln_stats(v[r], g, b, lane, mu[r], rs[r]);
        if (lane == 0) {
#pragma unroll
            for (int r = 0; r < NR; r += 2) { f32x4 st; st[0] = mu[r]; st[1] = rs[r]; st[2] = mu[r + 1]; st[3] = rs[r + 1]; *(f32x4*)(ST + (size_t)(m + r) * 2) = st; } }
#pragma unroll
        for (int r = 0; r < NR; ++r)
#pragma unroll
            for (int j = 0; j < 4; ++j) *(unsigned*)(XB8 + (size_t)(m + r) * DM + 4 * lane + 256 * j) = pk4_fp8(v[r][j][0], v[r][j][1], v[r][j][2], v[r][j][3]);
        float lg[NR][16];
#pragma unroll
        for (int e = 0; e < 16; ++e) { f32x4 a[NR];
#pragma unroll
            for (int r = 0; r < NR; ++r) a[r] = (f32x4){0.f, 0.f, 0.f, 0.f};
#pragma unroll
            for (int j = 0; j < 4; ++j) { const f32x4 w = *(const LAS f32x4*)(wl + e * DM + 4 * lane + 256 * j);
#pragma unroll
                for (int r = 0; r < NR; ++r) a[r] += v[r][j] * w; }
#pragma unroll
            for (int r = 0; r < NR; ++r) lg[r][e] = (a[r][0] + a[r][1]) + (a[r][2] + a[r][3]);
            if ((e & 3) == 3) asm volatile("" ::: "memory"); }
        float af[NR];
#pragma unroll
        for (int r = 0; r < NR; ++r) af[r] = router_reduce(lg[r], lane);
        if ((lane & 3) == 0) { const size_t off = (m < T_P) ? (size_t)e_mine * T_P + m : (size_t)16 * T_P + (size_t)e_mine * T_S + (m - T_P);
#pragma unroll
            for (int r = 0; r < NR; ++r) AFF[off + r] = af[r]; }
    }
    __syncthreads();
}

constexpr int TK_COPIES = 8, TK_STRIDE = 2048;
template <int NB>
__device__ __forceinline__ void bin_search(LAS unsigned* hist, LAS unsigned* wtot, LAS unsigned* res, unsigned remaining, int tid, int lane, int wave, unsigned& bin, unsigned& rem_out) {
    constexpr int BPT = NB / 512;
    unsigned hb[BPT]; unsigned own = 0;
#pragma unroll
    for (int k = 0; k < BPT; ++k) { unsigned a = 0;
#pragma unroll
        for (int c = 0; c < TK_COPIES; ++c) a += hist[c * TK_STRIDE + tid * BPT + k];
        hb[k] = a; own += a; }
    unsigned x = own;
#pragma unroll
    for (int o = 1; o < 64; o <<= 1) { const unsigned y = (unsigned)__builtin_amdgcn_ds_bpermute((lane + o) << 2, (int)x); if (lane + o < 64) x += y; }
    if (lane == 0) wtot[wave] = x;
    __syncthreads();
    unsigned above = 0;
#pragma unroll
    for (int w = 0; w < 8; ++w) above += (w > wave) ? wtot[w] : 0u;
    const unsigned suf_incl = x + above, suf_excl = suf_incl - own;
    if (suf_excl < remaining && remaining <= suf_incl) {
        unsigned c = suf_excl; bool done = false;
#pragma unroll
        for (int k = BPT - 1; k >= 0; --k) { if (!done && c + hb[k] >= remaining) { res[0] = (unsigned)(tid * BPT + k); res[1] = remaining - c; done = true; } c += hb[k]; }
    }
    __syncthreads();
    bin = res[0]; rem_out = res[1];
    __syncthreads();
}
template <int NPT>
__device__ __forceinline__ void topk_block(Frame& F, const unsigned* vals, int cap, int slotbase, int tokbase, int e, unsigned char* ws) {
    LAS unsigned* hist = (LAS unsigned*)F.lds; LAS unsigned* wtot = hist + TK_COPIES * TK_STRIDE; LAS unsigned* res = wtot + 16;
    const int base = F.wave * (NPT * 64) + F.lane;
    unsigned v[NPT];
#pragma unroll
    for (int j = 0; j < NPT; ++j) v[j] = vals[base + j * 64];
    LAS unsigned* hc = hist + (F.lane & 7) * TK_STRIDE;
    unsigned remaining = (unsigned)cap, prefix = 0, bin;
#define TK_ZERO() do { for (int i = F.tid; i < TK_COPIES * TK_STRIDE; i += 512) hist[i] = 0u; __syncthreads(); } while (0)
#define TK_ADD(idx) (void)__hip_atomic_fetch_add(&hc[(idx)], 1u, __ATOMIC_RELAXED, __HIP_MEMORY_SCOPE_WORKGROUP)
    TK_ZERO();
#pragma unroll
    for (int j = 0; j < NPT; ++j) { unsigned vv = v[j]; asm volatile("" : "+v"(vv) :: "memory"); TK_ADD(vv >> 21); }
    __syncthreads();
    bin_search<2048>(hist, wtot, res, remaining, F.tid, F.lane, F.wave, bin, remaining); prefix = bin;
    TK_ZERO();
#pragma unroll
    for (int j = 0; j < NPT; ++j) { unsigned vv = v[j]; asm volatile("" : "+v"(vv) :: "memory"); if ((vv >> 21) == prefix) TK_ADD((vv >> 10) & 2047u); }
    __syncthreads();
    bin_search<2048>(hist, wtot, res, remaining, F.tid, F.lane, F.wave, bin, remaining); prefix = (prefix << 11) | bin;
    TK_ZERO();
#pragma unroll
    for (int j = 0; j < NPT; ++j) { unsigned vv = v[j]; asm volatile("" : "+v"(vv) :: "memory"); if ((vv >> 10) == prefix) TK_ADD(vv & 1023u); }
    __syncthreads();
    bin_search<1024>(hist, wtot, res, remaining, F.tid, F.lane, F.wave, bin, remaining);
#undef TK_ZERO
#undef TK_ADD
    const unsigned thr = (prefix << 10) | bin, need_eq = remaining;
    unsigned cg = 0, ce = 0;
#pragma unroll
    for (int j = 0; j < NPT; ++j) { unsigned vv = v[j]; asm volatile("" : "+v"(vv)); cg += (unsigned)__popcll(__ballot(vv > thr)); ce += (unsigned)__popcll(__ballot(vv == thr)); asm volatile("" : "+v"(cg), "+v"(ce)); }
    if (F.lane == 0) { wtot[F.wave] = cg; wtot[8 + F.wave] = ce; }
    __syncthreads();
    unsigned run_gt = 0, run_eq = 0;
#pragma unroll
    for (int w = 0; w < 8; ++w) { run_gt += (w < F.wave) ? wtot[w] : 0u; run_eq += (w < F.wave) ? wtot[8 + w] : 0u; }
    int* IDX = (int*)(ws + WS_IDX); float* GATE = (float*)(ws + WS_GATE); int* SLOTOF = (int*)(ws + WS_SLOTOF);
    const unsigned long long ltmask = (1ull << F.lane) - 1ull;
#pragma unroll
    for (int j = 0; j < NPT; ++j) {
        unsigned vv = v[j]; asm volatile("" : "+v"(vv));
        const bool gt = vv > thr, eq = vv == thr;
        const unsigned long long bg = __ballot(gt), be = __ballot(eq);
        const unsigned gb = (unsigned)__popcll(bg & ltmask), eb = (unsigned)__popcll(be & ltmask);
        const unsigned eq_rank = run_eq + eb;
        const bool sel = gt || (eq && eq_rank < need_eq);
        const unsigned slot = run_gt + gb + (eq_rank < need_eq ? eq_rank : need_eq);
        const int tok = tokbase + base + j * 64;
        if (sel) { IDX[slotbase + slot] = tok; GATE[slotbase + slot] = __builtin_bit_cast(float, vv); }
        SLOTOF[(size_t)e * TT + tok] = sel ? (int)(slotbase + slot) : -1;
        run_gt += (unsigned)__popcll(bg); run_eq += (unsigned)__popcll(be); asm volatile("" : "+v"(run_gt), "+v"(run_eq));
    }
    __syncthreads();
}
__device__ __forceinline__ void topk_phase(Frame& F, unsigned char* ws) {
    if (blockIdx.x >= 32) return;
    const int g = blockIdx.x >> 4, e = blockIdx.x & 15;
    const unsigned* aff = (const unsigned*)(ws + WS_AFF);
    if (g == 0) topk_block<T_P / 512>(F, aff + (size_t)e * T_P, CAP_P, e * CAP_P, 0, e, ws);
    else        topk_block<T_S / 512>(F, aff + (size_t)16 * T_P + (size_t)e * T_S, CAP_S, ROWS_P + e * CAP_S, T_P, e, ws);
}

__device__ __forceinline__ void gather_phase(Frame& F, unsigned char* ws) {
    const int* IDX = (const int*)(ws + WS_IDX); const unsigned char* XB8 = ws + WS_XB8; unsigned char* XE = ws + WS_H;
    for (int r = F.gw; r < ROWS_E; r += F.NGW) { const int tok = IDX[r];
        *(u32x4*)(XE + (size_t)r * DM + 16 * F.lane) = *(const u32x4*)(XB8 + (size_t)tok * DM + 16 * F.lane); }
}

template <bool DRY> __device__ __forceinline__ void combine_phase(Frame& F, float* X, const bf16* SB, const float* g1, const float* b1, const float* g, const float* b, unsigned char* ws, bool last_layer) {
    const int* SLOTOF = (const int*)(ws + WS_SLOTOF); const unsigned char* YE = ws + WS_H; bf16* XB = (bf16*)(ws + (DRY ? WS_DUMMY + 16 * MiB : WS_XB)); float* Xo = DRY ? (float*)(ws + WS_DUMMY + 16 * MiB) : X;
    const int lane = F.lane;
    int m = 2 * F.gw;
    int so_n = (m < TT) ? SLOTOF[(size_t)(lane & 15) * TT + m + ((lane >> 4) & 1)] : -1;
    for (; m < TT; m += 2 * F.NGW) {
        const int so = so_n; const int mn = m + 2 * F.NGW;
        so_n = (mn < TT) ? SLOTOF[(size_t)(lane & 15) * TT + mn + ((lane >> 4) & 1)] : -1;
        f32x4 v0[4], v1[4];
#pragma unroll
        for (int j = 0; j < 4; ++j) { v0[j] = bf4(*(const u32x2*)(SB + (size_t)m * DM + 4 * lane + 256 * j)); v1[j] = bf4(*(const u32x2*)(SB + (size_t)(m + 1) * DM + 4 * lane + 256 * j)); }
        { const f32x4 st = *(const f32x4*)((const float*)(ws + WS_STATS) + (size_t)m * 2);
#pragma unroll
          for (int j = 0; j < 4; ++j) { const f32x4 gg = *(const f32x4*)(g1 + 4 * lane + 256 * j) * DN_ALPHA, bb = *(const f32x4*)(b1 + 4 * lane + 256 * j) * DN_ALPHA;
              v0[j] = (v0[j] - st[0]) * st[1] * gg + bb; v1[j] = (v1[j] - st[2]) * st[3] * gg + bb; } }
        constexpr int CK = 4;
        unsigned m0 = (unsigned)__ballot(so >= 0); unsigned m1 = (m0 >> 16) & 0xffffu; m0 &= 0xffffu;
        unsigned w0[CK][4], w1[CK][4]; float f0[CK], f1[CK];
#pragma unroll
        for (int k = 0; k < CK; ++k) {
            const int e0 = m0 ? __builtin_ctz(m0) : 0, e1 = m1 ? __builtin_ctz(m1) : 0;
            const int sl0 = __builtin_amdgcn_readlane(so, e0), sl1 = __builtin_amdgcn_readlane(so, 16 + e1);
            const size_t r0 = (size_t)(m0 ? sl0 : 0) * DM, r1 = (size_t)(m1 ? sl1 : 0) * DM;
            f0[k] = m0 ? (1.0f / YE_SCALE) : 0.f; f1[k] = m1 ? (1.0f / YE_SCALE) : 0.f;
#pragma unroll
            for (int j = 0; j < 4; ++j) { w0[k][j] = *(const unsigned*)(YE + r0 + 4 * lane + 256 * j); w1[k][j] = *(const unsigned*)(YE + r1 + 4 * lane + 256 * j); }
            m0 &= m0 - 1; m1 &= m1 - 1;
        }
#pragma unroll
        for (int k = 0; k < CK; ++k)
#pragma unroll
            for (int j = 0; j < 4; ++j) {
                { const f32x2v lo = __builtin_amdgcn_cvt_pk_f32_fp8((int)w0[k][j], false), hi = __builtin_amdgcn_cvt_pk_f32_fp8((int)w0[k][j], true);
                  v0[j][0] += lo[0] * f0[k]; v0[j][1] += lo[1] * f0[k]; v0[j][2] += hi[0] * f0[k]; v0[j][3] += hi[1] * f0[k]; }
                { const f32x2v lo = __builtin_amdgcn_cvt_pk_f32_fp8((int)w1[k][j], false), hi = __builtin_amdgcn_cvt_pk_f32_fp8((int)w1[k][j], true);
                  v1[j][0] += lo[0] * f1[k]; v1[j][1] += lo[1] * f1[k]; v1[j][2] += hi[0] * f1[k]; v1[j][3] += hi[1] * f1[k]; }
            }
        while (m0) { const int sl = __builtin_amdgcn_readlane(so, __builtin_ctz(m0)); m0 &= m0 - 1;
#pragma unroll
            for (int j = 0; j < 4; ++j) { const unsigned w = *(const unsigned*)(YE + (size_t)sl * DM + 4 * lane + 256 * j);
                const f32x2v lo = __builtin_amdgcn_cvt_pk_f32_fp8((int)w, false), hi = __builtin_amdgcn_cvt_pk_f32_fp8((int)w, true);
                v0[j][0] += lo[0] * (1.0f / YE_SCALE); v0[j][1] += lo[1] * (1.0f / YE_SCALE); v0[j][2] += hi[0] * (1.0f / YE_SCALE); v0[j][3] += hi[1] * (1.0f / YE_SCALE); } }
        while (m1) { const int sl = __builtin_amdgcn_readlane(so, 16 + __builtin_ctz(m1)); m1 &= m1 - 1;
#pragma unroll
            for (int j = 0; j < 4; ++j) { const unsigned w = *(const unsigned*)(YE + (size_t)sl * DM + 4 * lane + 256 * j);
                const f32x2v lo = __builtin_amdgcn_cvt_pk_f32_fp8((int)w, false), hi = __builtin_amdgcn_cvt_pk_f32_fp8((int)w, true);
                v1[j][0] += lo[0] * (1.0f / YE_SCALE); v1[j][1] += lo[1] * (1.0f / YE_SCALE); v1[j][2] += hi[0] * (1.0f / YE_SCALE); v1[j][3] += hi[1] * (1.0f / YE_SCALE); } }
        row_ln(v0, g, b, lane); row_ln(v1, g, b, lane);
        if (last_layer) {
#pragma unroll
            for (int j = 0; j < 4; ++j) { *(f32x4*)(Xo + (size_t)m * DM + 4 * lane + 256 * j) = v0[j]; *(f32x4*)(Xo + (size_t)(m + 1) * DM + 4 * lane + 256 * j) = v1[j]; }
        } else { store_row_bf(v0, XB + (size_t)m * DM, lane); store_row_bf(v1, XB + (size_t)(m + 1) * DM, lane); }
    }
}

template <bool NA>
__device__ __forceinline__ void attn_wave(const bf16* __restrict__ Qb, const bf16* __restrict__ Kb, const bf16* __restrict__ Vb, bf16* __restrict__ Ob, int ntiles,
                                          LAS unsigned char* wl, const LAS float* rpbh, int rr, int rs, int qh, int lane) {
    const int r = lane & 31, h = lane >> 5;
    bf16x8 qf[4];
#pragma unroll
    for (int d0 = 0; d0 < 4; ++d0) qf[d0] = *(const bf16x8*)(Qb + (size_t)r * DIN + 16 * d0 + 8 * h);
    f32x16 o0, o1;
#pragma unroll
    for (int i = 0; i < 16; ++i) { o0[i] = 0.f; o1[i] = 0.f; }
    float m = -1e30f, l = 0.f;
    LAS unsigned char* vl = wl; LAS float* wsf = (LAS float*)(wl + 4608);
    const bf16* vsrc = Vb + (size_t)(lane >> 3) * DIN + 8 * (lane & 7);
    const bf16* ksrc = Kb + (size_t)r * DIN + 8 * h;
    const int vwoff = (lane >> 3) * 144 + (lane & 7) * 16;
    const int i16 = lane & 15, tq = i16 >> 2, tp = i16 & 3, blk = (lane >> 4) & 1;
    const int troff = (4 * h + tq) * 144 + (16 * blk + 4 * tp) * 2;
    const int qc = 32 * qh + r; const int cs = qc - 8 < 0 ? 0 : (qc - 8 > 48 ? 48 : qc - 8);
    for (int t = 0; t < ntiles; ++t) {
        const size_t ko = (size_t)(32 * t) * DIN;
        bf16x8 kf[4];
#pragma unroll
        for (int d0 = 0; d0 < 4; ++d0) kf[d0] = *(const bf16x8*)(ksrc + ko + 16 * d0);
        u32x4 vr[4];
#pragma unroll
        for (int i = 0; i < 4; ++i) vr[i] = *(const u32x4*)(vsrc + ko + (size_t)(8 * i) * DIN);
        f32x16 s;
#pragma unroll
        for (int i = 0; i < 16; ++i) s[i] = 0.f;
#pragma unroll
        for (int d0 = 0; d0 < 4; ++d0) s = MFMA32(kf[d0], qf[d0], s);
        unsigned okm = 0xffffu;
        if (NA) {
            okm = 0u; const int kr = rs + (t >> 1), kh = t & 1, brow = (kr - rr + 7) * 31;
#pragma unroll
            for (int i = 0; i < 16; ++i) { const int kc = 32 * kh + crow(i, h); const bool ok = (kc >= cs) && (kc < cs + 16); const int idx = ok ? brow + kc - qc + 15 : 0;
                const float bia = rpbh[idx]; s[i] = ok ? s[i] + bia : -1e30f; okm |= ok ? (1u << i) : 0u; }
        }
        float mx = s[0];
#pragma unroll
        for (int i = 1; i < 16; ++i) mx = fmaxf(mx, s[i]);
        mx = max32(mx);
        const float mn = fmaxf(m, mx), alpha = __builtin_amdgcn_exp2f(m - mn); m = mn;
        float rsum = 0.f;
#pragma unroll
        for (int i = 0; i < 16; ++i) { float p = __builtin_amdgcn_exp2f(s[i] - mn); if (NA) p = ((okm >> i) & 1u) ? p : 0.f; s[i] = p; rsum += p; }
        l = l * alpha + rsum;
#pragma unroll
        for (int i = 0; i < 4; ++i) *(LAS u32x4*)(vl + vwoff + i * 8 * 144) = vr[i];
        if (h == 0) wsf[r] = alpha;
        asm volatile("s_waitcnt lgkmcnt(0)" ::: "memory");
#pragma unroll
        for (int g4 = 0; g4 < 4; ++g4) { const f32x4 a4 = *(const LAS f32x4*)(wsf + 8 * g4 + 4 * h);
#pragma unroll
            for (int j = 0; j < 4; ++j) { o0[4 * g4 + j] *= a4[j]; o1[4 * g4 + j] *= a4[j]; } }
        u32x4 pw0, pw1;
        pw0.x = pg8::cvt_pk_bf16(s[0], s[1]); pw0.y = pg8::cvt_pk_bf16(s[2], s[3]); pw0.z = pg8::cvt_pk_bf16(s[4], s[5]); pw0.w = pg8::cvt_pk_bf16(s[6], s[7]);
        pw1.x = pg8::cvt_pk_bf16(s[8], s[9]); pw1.y = pg8::cvt_pk_bf16(s[10], s[11]); pw1.z = pg8::cvt_pk_bf16(s[12], s[13]); pw1.w = pg8::cvt_pk_bf16(s[14], s[15]);
        const bf16x8 pa0 = __builtin_bit_cast(bf16x8, pw0), pa1 = __builtin_bit_cast(bf16x8, pw1);
#pragma unroll
        for (int sp = 0; sp < 2; ++sp) {
#pragma unroll
            for (int db = 0; db < 2; ++db) {
                const s16x4 lo = tr_read(vl + troff + (16 * sp) * 144 + 64 * db), hi = tr_read(vl + troff + (16 * sp + 8) * 144 + 64 * db);
                const bf16x8 bfr = __builtin_shufflevector(lo, hi, 0, 1, 2, 3, 4, 5, 6, 7);
                if (db == 0) o0 = MFMA32(sp ? pa1 : pa0, bfr, o0); else o1 = MFMA32(sp ? pa1 : pa0, bfr, o1);
            }
        }
        asm volatile("s_waitcnt lgkmcnt(0)" ::: "memory");
    }
    l = sum32(l);
    if (h == 0) wsf[32 + r] = l;
    asm volatile("s_waitcnt lgkmcnt(0)" ::: "memory");
#pragma unroll
    for (int i = 0; i < 16; ++i) { const int q = crow(i, h); const float rl = 1.0f / wsf[32 + q];
        Ob[(size_t)q * DM + r] = (bf16)f2bf(o0[i] * rl); Ob[(size_t)q * DM + 32 + r] = (bf16)f2bf(o1[i] * rl); }
    asm volatile("s_waitcnt lgkmcnt(0)" ::: "memory");
}

__device__ __forceinline__ void sgu_part(Frame& F, int l, const float* sg_b, unsigned char* ws) {
    const bf16* H = (const bf16*)(ws + WS_H); bf16* Y = (bf16*)(ws + WS_HID); const bf16* WSB = (const bf16*)(ws + wset(l) + WS_WSBF);
    const int lane = F.lane, r = lane & 31, h = lane >> 5;
    LAS unsigned char* vnl = F.lds;
    const int pt = F.wave >> 1, ct = F.wave & 1;
    const int i16 = lane & 15, tq = i16 >> 2, tp = i16 & 3, blk = (lane >> 4) & 1;
    u32x4 stg[2];
    { const int u = F.vcu; if (u < NBATCH * 32 * 4) { const int g = u & 3, ch = (u >> 2) & 31, b = u >> 7; const size_t tok0 = (size_t)b * SEQ + ch * 128;
#pragma unroll
        for (int i = 0; i < 2; ++i) { const int idx = F.tid + 512 * i, row = idx >> 3, chunk = idx & 7; stg[i] = *(const u32x4*)(H + (tok0 + row) * DIN + H_VC + 64 * g + 8 * chunk); } } }
    for (int u = F.vcu; u < NBATCH * 32 * 4; u += F.G) {
        const int g = u & 3, ch = (u >> 2) & 31, b = u >> 7; const size_t tok0 = (size_t)b * SEQ + ch * 128;
#pragma unroll
        for (int i = 0; i < 2; ++i) { const int idx = F.tid + 512 * i, row = idx >> 3, chunk = idx & 7; *(LAS u32x4*)(vnl + row * 144 + chunk * 16) = stg[i]; }
        __syncthreads();
        { const int un = u + F.G; if (un < NBATCH * 32 * 4) { const int gn = un & 3, chn = (un >> 2) & 31, bn = un >> 7; const size_t tokn = (size_t)bn * SEQ + chn * 128;
#pragma unroll
            for (int i = 0; i < 2; ++i) { const int idx = F.tid + 512 * i, row = idx >> 3, chunk = idx & 7; stg[i] = *(const u32x4*)(H + (tokn + row) * DIN + H_VC + 64 * gn + 8 * chunk); } } }
        unsigned short uu[16];
#pragma unroll
        for (int i = 0; i < 16; ++i) uu[i] = H[(tok0 + 32 * pt + crow(i, h)) * DIN + H_UC + 64 * g + 32 * ct + r];
        f32x16 z;
#pragma unroll
        for (int i = 0; i < 16; ++i) z[i] = 0.f;
#pragma unroll
        for (int s = 0; s < 8; ++s) {
            const bf16x8 a = *(const bf16x8*)(WSB + ((size_t)(g * 128 + 32 * pt + r) * 128 + 16 * s + 8 * h));
            const s16x4 lo = tr_read(vnl + (16 * s + 8 * h + tq) * 144 + (32 * ct + 16 * blk + 4 * tp) * 2), hi = tr_read(vnl + (16 * s + 8 * h + 4 + tq) * 144 + (32 * ct + 16 * blk + 4 * tp) * 2);
            z = MFMA32(a, __builtin_shufflevector(lo, hi, 0, 1, 2, 3, 4, 5, 6, 7), z);
        }
        const float* bs = sg_b + ((size_t)l * 4 + g) * 128;
#pragma unroll
        for (int i = 0; i < 16; ++i) { const int pp = 32 * pt + crow(i, h); const size_t tok = tok0 + pp; const int c = 32 * ct + r;
            Y[tok * DM + Y_SG + 64 * g + c] = (bf16)f2bf(bf2f(uu[i]) * (z[i] + bs[pp])); }
        __syncthreads();
    }
}
__device__ __forceinline__ void gqa_part(int vcu, int G, int tid, char* lds, unsigned char* ws, const float* qn, const float* kn) {
    const bf16* H = (const bf16*)(ws + WS_H); bf16* Y = (bf16*)(ws + WS_HID);
    float gq = 0.f, gk = 0.f;
    for (int i = 0; i < 64; ++i) { gq = fmaxf(gq, fabsf(qn[i])); gk = fmaxf(gk, fabsf(kn[i])); }
    const bool nomax = (64.0f * C2 * gq * gk) * 1.02f <= 40.0f;
    if (nomax) {
        for (int id = vcu; id < NBATCH * 8 * 16; id += G) {
            const int qb = id & 15, hg = (id >> 4) & 3, kvh = (id >> 6) & 1, b = id >> 7, hq = kvh * 4 + hg;
            const size_t t0 = (size_t)b * SEQ;
            attn_body::attn_unit<8, true, GQA_MSUM>((const attn_body::bf16*)(H + (t0 + 256 * qb) * DIN + H_GQ + 64 * hq), (const attn_body::bf16*)(H + t0 * DIN + H_GK + 64 * kvh),
                                          (const attn_body::bf16*)(H + t0 * DIN + H_GV + 64 * kvh), (attn_body::bf16*)(Y + (t0 + 256 * qb) * DM + Y_GQA + 64 * hq), lds, tid);
        }
    } else {
        for (int id = vcu; id < NBATCH * 8 * 16; id += G) {
            const int qb = id & 15, hg = (id >> 4) & 3, kvh = (id >> 6) & 1, b = id >> 7, hq = kvh * 4 + hg;
            const size_t t0 = (size_t)b * SEQ;
            attn_body::attn_unit<8, false>((const attn_body::bf16*)(H + (t0 + 256 * qb) * DIN + H_GQ + 64 * hq), (const attn_body::bf16*)(H + t0 * DIN + H_GK + 64 * kvh),
                                           (const attn_body::bf16*)(H + t0 * DIN + H_GV + 64 * kvh), (attn_body::bf16*)(Y + (t0 + 256 * qb) * DM + Y_GQA + 64 * hq), lds, tid);
        }
    }
    __syncthreads();
}
typedef float f32x4_t __attribute__((ext_vector_type(4)));
#define MFMA16(a, b, c) __builtin_amdgcn_mfma_f32_16x16x32_bf16((a), (b), (c), 0, 0, 0)
constexpr int NA_VP = 144;
__device__ __forceinline__ void na_wave(const bf16* __restrict__ H, const LAS unsigned char* vl, bf16* __restrict__ Y, const LAS float* rpbh, int b, int hd, int rr, int rs, int qb4, int lane) {
    const int n16 = lane & 15, g = lane >> 4;
    const int c0 = 16 * qb4, w0 = (16 * qb4 - 8 < 0) ? 0 : (16 * qb4 - 8 > 32 ? 32 : 16 * qb4 - 8);
    const size_t t0 = (size_t)b * SEQ, qtok = t0 + rr * 64 + c0 + n16;
    bf16x8 qf[2];
#pragma unroll
    for (int ks = 0; ks < 2; ++ks) qf[ks] = *(const bf16x8*)(H + qtok * DIN + H_NAQ + 64 * hd + 32 * ks + 8 * g);
    f32x4_t s[16];
    const bf16* kb = H + (t0 + rs * 64 + w0 + 8 * (n16 >> 2) + (n16 & 3)) * DIN + H_NAK + 64 * hd + 8 * g;
    {
        bf16x8 kf[16][2];
#pragma unroll
        for (int T = 0; T < 16; ++T) { const bf16* kp = kb + (size_t)((T >> 1) * 64 + 4 * (T & 1)) * DIN; kf[T][0] = *(const bf16x8*)kp; kf[T][1] = *(const bf16x8*)(kp + 32); }
        asm volatile("" ::: "memory");
#pragma unroll
        for (int T = 0; T < 16; ++T) { f32x4_t z = {0.f, 0.f, 0.f, 0.f}; z = MFMA16(kf[T][0], qf[0], z); s[T] = MFMA16(kf[T][1], qf[1], z); }
    }
    const int qc = c0 + n16, cs = qc - 8 < 0 ? 0 : (qc - 8 > 48 ? 48 : qc - 8);
    const LAS float* tb[8];
#pragma unroll
    for (int j = 0; j < 8; ++j) { const int kc = w0 + 8 * g + 4 * (j >> 2) + (j & 3); const bool ok = (unsigned)(kc - cs) < 16u; tb[j] = rpbh + (rs - rr + 7) * 32 + (ok ? kc - qc + 15 : 31); }
    float mx = -1e30f;
#pragma unroll
    for (int T = 0; T < 16; ++T)
#pragma unroll
        for (int i = 0; i < 4; ++i) { const float v = s[T][i] + tb[(T & 1) * 4 + i][(T >> 1) * 32]; s[T][i] = v; mx = fmaxf(mx, v); }
    mx = max16(mx); mx = max32(mx);
    float sum = 0.f;
#pragma unroll
    for (int T = 0; T < 16; ++T)
#pragma unroll
        for (int i = 0; i < 4; ++i) { const float p = __builtin_amdgcn_exp2f(s[T][i] - mx); s[T][i] = p; sum += p; }
    sum = sum16(sum); sum = sum32(sum);
    f32x4_t o[4];
#pragma unroll
    for (int db = 0; db < 4; ++db) o[db] = (f32x4_t){0.f, 0.f, 0.f, 0.f};
    const LAS unsigned char* vb = vl + (w0 + 8 * g + (n16 >> 2)) * NA_VP + (n16 & 3) * 8;
#pragma unroll
    for (int kr = 0; kr < 8; ++kr) {
        u32x4 pw; pw.x = pg8::cvt_pk_bf16(s[2 * kr][0], s[2 * kr][1]); pw.y = pg8::cvt_pk_bf16(s[2 * kr][2], s[2 * kr][3]);
        pw.z = pg8::cvt_pk_bf16(s[2 * kr + 1][0], s[2 * kr + 1][1]); pw.w = pg8::cvt_pk_bf16(s[2 * kr + 1][2], s[2 * kr + 1][3]);
        const bf16x8 pb = __builtin_bit_cast(bf16x8, pw);
#pragma unroll
        for (int db = 0; db < 4; ++db) { const LAS unsigned char* vp = vb + (kr * 64) * NA_VP + db * 32;
            const s16x4 lo = tr_read(vp), hi = tr_read(vp + 4 * NA_VP);
            o[db] = MFMA16(__builtin_shufflevector(lo, hi, 0, 1, 2, 3, 4, 5, 6, 7), pb, o[db]); }
    }
    const float rl = 1.0f / sum;
    bf16* yp = Y + qtok * DM + Y_NA + 64 * hd + 4 * g;
#pragma unroll
    for (int db = 0; db < 4; ++db) { u32x2 w; w.x = pg8::cvt_pk_bf16(o[db][0] * rl, o[db][1] * rl); w.y = pg8::cvt_pk_bf16(o[db][2] * rl, o[db][3] * rl); *(u32x2*)(yp + 16 * db) = w; }
}
__device__ __forceinline__ void na_part(Frame& F, int l, const float* na_rpb, unsigned char* ws) {
    const bf16* H = (const bf16*)(ws + WS_H); bf16* Y = (bf16*)(ws + WS_HID);
    LAS float* rpbl = (LAS float*)(F.lds + 90112);
    for (int i = F.tid; i < 4 * 15 * 32; i += 512) { const int c = i & 31, hr = i >> 5; rpbl[i] = (c < 31) ? na_rpb[(size_t)l * 4 * 15 * 31 + hr * 31 + c] * LOG2E : -1e30f; }
    LAS unsigned char* vl = F.lds;
    u32x4 stg[9];
#define NA_VSRC(id_) (H + ((size_t)((id_) >> 7) * SEQ + (2 * ((id_) & 31) - 4 < 0 ? 0 : (2 * ((id_) & 31) - 4 > 56 ? 56 : 2 * ((id_) & 31) - 4)) * 64) * DIN + H_NAV + 64 * (((id_) >> 5) & 3))
    if (F.vcu < NBATCH * 4 * 32) { const bf16* vsrc = NA_VSRC(F.vcu);
#pragma unroll
        for (int i = 0; i < 9; ++i) { const int idx = F.tid + 512 * i, tok = idx >> 3, ch = idx & 7; stg[i] = *(const u32x4*)(vsrc + (size_t)tok * DIN + ch * 8); } }
    for (int id = F.vcu; id < NBATCH * 4 * 32; id += F.G) {
        const int rp = id & 31, hd = (id >> 5) & 3, b = id >> 7, rr0 = 2 * rp;
        const int sb = rr0 - 4 < 0 ? 0 : (rr0 - 4 > 56 ? 56 : rr0 - 4);
        __syncthreads();
#pragma unroll
        for (int i = 0; i < 9; ++i) { const int idx = F.tid + 512 * i, tok = idx >> 3, ch = idx & 7; *(LAS u32x4*)(vl + tok * NA_VP + ch * 16) = stg[i]; }
        __syncthreads();
        { const int idn = id + F.G; if (idn < NBATCH * 4 * 32) { const bf16* vsrc = NA_VSRC(idn);
#pragma unroll
            for (int i = 0; i < 9; ++i) { const int idx = F.tid + 512 * i, tok = idx >> 3, ch = idx & 7; stg[i] = *(const u32x4*)(vsrc + (size_t)tok * DIN + ch * 8); } } }
        const int rr = rr0 + (F.wave >> 2); const int rs = rr - 4 < 0 ? 0 : (rr - 4 > 56 ? 56 : rr - 4);
        na_wave(H, vl + (rs - sb) * 64 * NA_VP, Y, rpbl + hd * 480, b, hd, rr, rs, F.wave & 3, F.lane);
    }
#undef NA_VSRC
    __syncthreads();
}

__device__ __forceinline__ void frame_init(Frame& F, LAS unsigned char* lds, int wave_s) {
    int t = wave_s * 64 + (int)__builtin_amdgcn_mbcnt_hi(~0u, __builtin_amdgcn_mbcnt_lo(~0u, 0u)); asm volatile("" : "+v"(t));
    F.lds = lds; F.tid = t; F.lane = t & 63; F.wave = __builtin_amdgcn_readfirstlane(t >> 6);
    int G_ = gridDim.x; asm volatile("" : "+s"(G_));
    F.G = G_; { const int bx = blockIdx.x; F.vcu = (F.G % 8 == 0) ? (bx % 8) * (F.G / 8) + bx / 8 : bx; }
    F.gw = F.vcu * NWAVES + F.wave; F.NGW = F.G * NWAVES;
}
#ifndef MK_FUSED
#define MK_FUSED 1
#endif
struct Args { const float* in[21]; float* out; unsigned char* ws; int l_lo, l_hi, ph_lo, ph_hi, use_bar, pad; };
constexpr int NPH = 10;

__global__ void __launch_bounds__(NWAVES * 64, 2) enc_fwd(Args a) {
    extern __shared__ __attribute__((aligned(16))) unsigned char lds[];
    int wave_s_ = __builtin_amdgcn_readfirstlane((int)threadIdx.x >> 6); asm volatile("" : "+s"(wave_s_));
    Frame F0; frame_init(F0, (LAS unsigned char*)lds, wave_s_);
#define FRAME() Frame F; frame_init(F, (LAS unsigned char*)lds, wave_s_)
    volatile LAS unsigned* MISC = (volatile LAS unsigned*)(F0.lds + MISC_OFF);
    for (int u = F0.tid; u < (LDS_BYTES - LDSCTL_OFF) / 4; u += NWAVES * 64) ((LAS unsigned*)(F0.lds + LDSCTL_OFF))[u] = 0u;
    __syncthreads();
    unsigned* ctl = (unsigned*)(a.ws + WS_CTL);
    XcdBarrier bar; bar.bar = ctl + CW_BAR; bar.x = 0; bar.st = nullptr;
    if (a.use_bar) bar = xcd_barrier_post(ctl + CW_BAR, MISC + 8);
#if MK_FUSED
#define SEAM() xcd_barrier(bar)
#else
#define SEAM() do { if (a.use_bar) xcd_barrier(bar); } while (0)
#endif
    typedef const __attribute__((address_space(4))) Args* KArgP;
#define KA() ({ KArgP p_ = (KArgP)__builtin_amdgcn_kernarg_segment_ptr(); asm volatile("" : "+s"(p_)); p_; })
#if !MK_FUSED
    const int lo = a.ph_lo, hi = a.ph_hi;
#endif
#ifndef ONLY_PH
#define ONLY_PH -1
#endif
#if MK_FUSED
#define IN(k) (ONLY_PH < 0 || ONLY_PH == (k))
#else
#define IN(k) ((ONLY_PH < 0 || ONLY_PH == (k)) && lo <= (k) && (k) < hi)
#endif
#ifndef REP0
#define REP0 1
#endif
#ifndef REP2
#define REP2 1
#endif
#ifndef REP4
#define REP4 1
#endif
#ifndef REP9
#define REP9 1
#endif
#ifndef REP1
#define REP1 1
#endif
#ifndef REP2A
#define REP2A 1
#endif
#ifndef REP2B
#define REP2B 1
#endif
#ifndef REP2C
#define REP2C 1
#endif
#ifndef NA_VAR
#define NA_VAR 1
#endif
#ifndef REP3
#define REP3 1
#endif
#ifndef REPP
#define REPP 1
#endif
#ifndef REP5
#define REP5 1
#endif
#ifndef REP6
#define REP6 1
#endif
#ifndef REP7
#define REP7 1
#endif
#ifndef REP8
#define REP8 1
#endif
#define REPEAT(n) _Pragma("nounroll") for (int rep_ = 0; rep_ < (n); ++rep_)
#if MK_FUSED
    for (int l = 0; l < NLAYER; ++l) {
#else
    for (int l = a.l_lo; l < a.l_hi; ++l) {
#endif
        if (IN(0) && (l == 0 || REP0 > 1)) {
            REPEAT(l == 0 ? REP0 : REP0 - 1) { FRAME(); KArgP k = KA(); conv_phase(F, l, k->in[4], k->in[12], k->in[16], k->in[17], k->in[18], k->in[8], k->ws, 0, 1 << 30, F.gw, F.NGW, true); }
            if (l == 0) REPEAT(REPP) { FRAME(); KArgP k = KA(); prologue_phase(F, k->in[0], k->in[1], k->in[2], k->in[3], k->out, k->ws); }
            SEAM();
        }
        if (IN(1)) REPEAT(REP1) {
            FRAME(); KArgP k = KA(); unsigned char* ws = k->ws;
            pg8::Gemm g{(const bf16*)(ws + WS_XB), (const bf16*)(ws + wset(l) + WS_WIN), TT, DIN, DM, 0};
            pg8::RotOrder S; S.init(TT, DIN, F.G, (int)blockIdx.x);
            EpiIn E{(bf16*)(ws + WS_H), k->in[6] + l * 64, k->in[7] + l * 64, k->in[10] + l * 256, k->in[11] + l * 256, (const float*)(ws + WS_ROPE), (bf16*)(ws + WS_VT)};
            pg8::gemm_phase<EpiIn, pg8::RotOrder, true, true, false, false, false, true>(F.lds, g, S, E, F.tid);
            SEAM();
        }
        if (IN(2)) REPEAT(REP2) {
            REPEAT(REP2A) { FRAME(); KArgP k = KA(); sgu_part(F, l, k->in[9], k->ws); }
            REPEAT(REP2B) { FRAME(); KArgP k = KA(); gqa_part(F.vcu, F.G, F.tid, (char*)lds, k->ws, k->in[6] + l * 64, k->in[7] + l * 64); }
            REPEAT(REP2C) { FRAME(); KArgP k = KA(); na_part(F, l, k->in[5], k->ws); }
            SEAM();
        }
        if (IN(3)) {
            REPEAT(REP3 - 1) {
                FRAME(); KArgP k = KA(); unsigned char* ws = k->ws;
                pg8::Gemm g{(const bf16*)(ws + WS_HID), (const bf16*)(ws + wset(l) + WS_WOUT), TT, DM, DM, 0};
                pg8::StaticOrder S; S.init(TT, DM, F.G, (int)blockIdx.x);
                EpiRes E{(const bf16*)(ws + WS_XB), (bf16*)(ws + WS_DUMMY)};
                pg8::gemm_phase<EpiRes, pg8::StaticOrder, true, true, false, false, false, true>(F.lds, g, S, E, F.tid);
                SEAM();
            }
            FRAME(); KArgP k = KA(); unsigned char* ws = k->ws;
            pg8::Gemm g{(const bf16*)(ws + WS_HID), (const bf16*)(ws + wset(l) + WS_WOUT), TT, DM, DM, 0};
            pg8::StaticOrder S; S.init(TT, DM, F.G, (int)blockIdx.x);
            EpiRes E{(const bf16*)(ws + WS_XB), (bf16*)(ws + WS_SB)};
            pg8::gemm_phase<EpiRes, pg8::StaticOrder, true, true, false, false, false, true>(F.lds, g, S, E, F.tid);
            SEAM();
        }
        if (IN(4)) { REPEAT(REP4 - 1) { FRAME(); KArgP k = KA(); ln1_router_mfma<true>(F, (const bf16*)(k->ws + WS_SB), k->in[13] + l * DM, k->in[14] + l * DM, k->in[15] + (size_t)l * DM * NEXP, k->ws); SEAM(); }
            FRAME(); KArgP k = KA(); ln1_router_mfma<false>(F, (const bf16*)(k->ws + WS_SB), k->in[13] + l * DM, k->in[14] + l * DM, k->in[15] + (size_t)l * DM * NEXP, k->ws); SEAM(); }
        if (IN(5)) REPEAT(REP5) { FRAME(); KArgP k = KA(); topk_phase(F, k->ws);
            if (l + 1 < NLAYER && blockIdx.x >= 32) { FRAME(); KArgP k2 = KA(); conv_phase(F, l + 1, k2->in[4], k2->in[12], k2->in[16], k2->in[17], k2->in[18], k2->in[8], k2->ws, 0, CONV_SPLIT_ITEMS, (blockIdx.x - 32) * NWAVES + F.wave, (gridDim.x - 32) * NWAVES, false); }
            SEAM(); }
        if (IN(7)) REPEAT(REP7) {
            FRAME(); KArgP k = KA(); unsigned char* ws = k->ws;
            pg8::Gemm g{(const bf16*)(ws + WS_XB8), (const bf16*)(ws + wset(l) + WS_WGU), ROWS_E, 4096, DM / 2, (size_t)4096 * DM, (const int*)(ws + WS_IDX)};
            pg8::StaticOrder S; S.init(ROWS_E, 4096, F.G, (int)blockIdx.x);
            EpiSwiglu E{ws + WS_HID};
            pg8::gemm_phase<EpiSwiglu, pg8::StaticOrder, true, true, true, true, true, true>(F.lds, g, S, E, F.tid);
            SEAM();
        }
        if (IN(8)) REPEAT(REP8) {
            FRAME(); KArgP k = KA(); unsigned char* ws = k->ws;
            pg8::Gemm g{(const bf16*)(ws + WS_HID), (const bf16*)(ws + wset(l) + WS_WD), ROWS_E, DM, DEXP / 2, (size_t)DM * DEXP};
            pg8::StaticOrder S; S.init(ROWS_E, DM, F.G, (int)blockIdx.x);
            EpiDown E{ws + WS_H, (const float*)(ws + WS_GATE)};
            pg8::gemm_phase<EpiDown, pg8::StaticOrder, true, true, true, true, false, true>(F.lds, g, S, E, F.tid);
            SEAM();
        }
#if BAL_PROBE_N
        if (IN(8)) REPEAT(BAL_PROBE_N) {
            FRAME(); KArgP k = KA(); unsigned char* ws = k->ws;
            pg8::Gemm g{(const bf16*)(ws + WS_HID), (const bf16*)(ws + wset(l) + WS_WD), ROWS_E, DM, DEXP / 2, (size_t)DM * DEXP};
            pg8::StaticOrder S; S.init(ROWS_E, DM, F.G, (int)blockIdx.x);
            EpiDown E{ws + WS_DUMMY, (const float*)(ws + WS_GATE)};
            pg8::gemm_phase<EpiDown, pg8::StaticOrder, true, true, true, true, false, (BAL_PROBE != 0)>(F.lds, g, S, E, F.tid);
            SEAM();
        }
#endif
        if (IN(9)) { REPEAT(REP9 - 1) { FRAME(); KArgP k = KA(); combine_phase<true>(F, k->out, (const bf16*)(k->ws + WS_SB), k->in[13] + l * DM, k->in[14] + l * DM, k->in[19] + l * DM, k->in[20] + l * DM, k->ws, l + 1 == NLAYER); SEAM(); }
            FRAME(); KArgP k = KA(); combine_phase<false>(F, k->out, (const bf16*)(k->ws + WS_SB), k->in[13] + l * DM, k->in[14] + l * DM, k->in[19] + l * DM, k->in[20] + l * DM, k->ws, l + 1 == NLAYER);
            if (l + 1 < NLAYER) { FRAME(); KArgP k = KA(); conv_phase(F, l + 1, k->in[4], k->in[12], k->in[16], k->in[17], k->in[18], k->in[8], k->ws, CONV_SPLIT_ITEMS, 1 << 30, F.gw, F.NGW, true); }
            SEAM(); }
    }
#undef IN
#undef SEAM
}

extern "C" void kernel_launch(void* const* d_in, const int* in_sizes, int n_in, void* d_out, int out_size, void* d_ws, size_t ws_size, hipStream_t stream) {
    static int grid = 0;
    if (grid == 0) {
        if (n_in != 21 || out_size != TT * DM || ws_size < WS_END) { fprintf(stderr, "kernel_launch: unexpected shapes (n_in %d, out %d, ws %zu)\n", n_in, out_size, ws_size); grid = -1; return; }
        int dev = 0, cus = 0, per_cu = 0;
        if (hipGetDevice(&dev) != hipSuccess || hipDeviceGetAttribute(&cus, hipDeviceAttributeMultiprocessorCount, dev) != hipSuccess) { grid = -1; return; }
        if (hipFuncSetAttribute((const void*)enc_fwd, hipFuncAttributeMaxDynamicSharedMemorySize, LDS_BYTES) != hipSuccess) { fprintf(stderr, "kernel_launch: hipFuncSetAttribute failed\n"); grid = -1; return; }
        if (hipOccupancyMaxActiveBlocksPerMultiprocessor(&per_cu, (const void*)enc_fwd, NWAVES * 64, LDS_BYTES) != hipSuccess || per_cu < 1) fprintf(stderr, "kernel_launch: occupancy query reports %d\n", per_cu);
        (void)hipGetLastError();
        grid = cus;
    }
    if (grid < 0) return;
    if (hipMemsetAsync((char*)d_ws + WS_CTL, 0, CTL_ZERO_BYTES, stream) != hipSuccess) return;
    Args a{};
    for (int i = 0; i < 21; ++i) a.in[i] = (const float*)d_in[i];
    a.out = (float*)d_out; a.ws = (unsigned char*)d_ws; a.pad = 0;
#if MK_FUSED
    a.l_lo = 0; a.l_hi = NLAYER; a.ph_lo = 0; a.ph_hi = NPH; a.use_bar = 1;
    hipLaunchKernelGGL(enc_fwd, dim3(grid), dim3(NWAVES * 64), LDS_BYTES, stream, a);
#else
    a.use_bar = 0;
    for (int l = 0; l < NLAYER; ++l)
        for (int ph = 0; ph < NPH; ++ph) { a.l_lo = l; a.l_hi = l + 1; a.ph_lo = ph; a.ph_hi = ph + 1; hipLaunchKernelGGL(enc_fwd, dim3(grid), dim3(NWAVES * 64), LDS_BYTES, stream, a); }
#endif
}
```

```cpp
#include <hip/hip_runtime.h>
#include <hip/hip_bf16.h>
#include <cstdio>
#include <cstdint>
#ifndef BAL_PROBE
#define BAL_PROBE 0
#endif
#ifndef BAL_PROBE_N
#define BAL_PROBE_N 0
#endif
#ifndef LN1_ROWS
#define LN1_ROWS 4
#endif
#ifndef GQA_MSUM
#define GQA_MSUM false
#endif
namespace pg8 {
#define PG8_LAS __attribute__((address_space(3)))
typedef unsigned short bf16_t;
typedef short bf16x8 __attribute__((ext_vector_type(8)));
typedef float f32x4 __attribute__((ext_vector_type(4)));
typedef unsigned u32x4 __attribute__((ext_vector_type(4)));
typedef int v4i_t __attribute__((ext_vector_type(4)));
typedef int v8i_t __attribute__((ext_vector_type(8)));
constexpr int BM = 256, BK = 64, HALF = 128, HTB = HALF * BK * 2  , STAGE_BYTES = 8 * HTB, NXCD = 8, WGM = 8;

__host__ __device__ __forceinline__ int lds_byte(int r, int c) { const int st = (r >> 4) * 2 + (c >> 5), rr = r & 15, cc = c & 31, ob = rr * 64 + cc * 2; return st * 1024 + (ob ^ (((ob >> 9) & 1) << 5)); }
__host__ __device__ __forceinline__ void stage_rc(int b, int& R, int& C) { const int st = b / 1024, sb = b % 1024, swz = sb ^ (((sb >> 9) & 1) << 5); R = (st >> 1) * 16 + swz / 64; C = (st & 1) * 32 + (swz % 64) / 2; }
__host__ __device__ __forceinline__ int perm32(int rho) { const int n = rho >> 4, i = rho & 15; return 8 * (i >> 2) + 4 * n + (i & 3); }

struct Unit { int pm, pn; };
struct Gemm { const bf16_t* A; const bf16_t* Bt; int M, N, K; size_t estride; const int* idx; };
__host__ __device__ __forceinline__ int expert_of_tile(int pm) { return pm < 128 ? (pm >> 3) : ((pm - 128) >> 5); }

struct StaticOrder {
    int nM, nN, nwg, G, c;
    __host__ __device__ void init(int M, int N, int G_, int c_) { nM = M / BM; nN = N / BM; nwg = nM * nN; G = G_; c = c_; }
    __host__ __device__ bool next(int i, Unit& u) const {
        const long L = (long)i * G + c; if (L >= nwg) return false;
        int wgid = (int)L; { const int q = nwg / NXCD, r = nwg % NXCD, xcd = wgid % NXCD, off = wgid / NXCD; wgid = (xcd < r ? xcd * (q + 1) : r * (q + 1) + (xcd - r) * q) + off; }
        const int nig = WGM * nN, gid = wgid / nig, fm = gid * WGM, gsz = (nM - fm) < WGM ? (nM - fm) : WGM;
        u.pm = fm + ((wgid % nig) % gsz); u.pn = (wgid % nig) / gsz; return true;
    }
    __device__ __forceinline__ void a_ready(const Unit&) const {}
    __device__ __forceinline__ void done(const Unit&) const {}
};

struct RotOrder {
    StaticOrder S;
    __host__ __device__ void init(int M, int N, int G_, int c_) { S.init(M, N, G_, c_); }
    __host__ __device__ bool next(int i, Unit& u) const {
        if (S.G != 256) return S.next(i, u);
        StaticOrder T = S; T.c = (S.c & 63) + 64 * (((S.c >> 6) + (i >> 1)) & 3);
        return T.next(i, u);
    }
    __device__ __forceinline__ void a_ready(const Unit&) const {}
    __device__ __forceinline__ void done(const Unit&) const {}
};

__device__ __forceinline__ unsigned cvt_pk_bf16(float lo, float hi) { unsigned r; asm volatile("v_cvt_pk_bf16_f32 %0, %1, %2" : "=v"(r) : "v"(lo), "v"(hi)); return r; }
typedef float f32x2 __attribute__((ext_vector_type(2)));

__device__ __forceinline__ void mfma_fp8(f32x4& acc, const v8i_t& a, const v8i_t& b, int sc) {
    asm volatile("v_mfma_scale_f32_16x16x128_f8f6f4 %0, %1, %2, %0, %3, %3 op_sel_hi:[0,0,0]" : "+v"(acc) : "v"(a), "v"(b), "v"(sc));
}
template <class Epi, class Sched, bool ALIGN_EPI = false, bool SP2 = false, bool GROUPED = false, bool FP8 = false, bool GATHER = false, bool BAL = false>
__device__ __forceinline__ void gemm_phase(PG8_LAS unsigned char* lds, const Gemm g, const Sched& S, const Epi& E, int tid_in) {
    int tid_ = tid_in; asm volatile("" : "+v"(tid_));
    const int tid = tid_, wid = __builtin_amdgcn_readfirstlane(tid >> 6), lane = tid & 63, wr = wid >> 2, wc = wid & 3, fr = lane & 15, fq = lane >> 4;
    const int K = g.K, nt = K / BK;
    unsigned voffA[2], voffB[2];
#pragma unroll
    for (int i = 0; i < 2; ++i) { int R, C; stage_rc(tid * 16 + i * 8192, R, C); const int Rb = Epi::PERM ? ((R & ~31) + perm32(R & 31)) : R;
        voffA[i] = (unsigned)(R * K + C) * 2u; voffB[i] = (unsigned)(Rb * K + C) * 2u; }
    const size_t kstep = (size_t)(BK * 2);
    const size_t hstep = (size_t)HALF * K * 2;
    const size_t tstep = 2 * hstep;
    const unsigned ldsw = (unsigned)wid * 1024u;
    const int aoff = lds_byte(wr * 64 + fr, fq * 8), boff = lds_byte(wc * 32 + fr, fq * 8);
#define PG8_SA(b, h) (((b) * 2 + (h)) * HTB)
#define PG8_SB(b, h) ((4 + (b) * 2 + (h)) * HTB)
#define PG8_STAGE(bufoff, gbase, voff) do { _Pragma("unroll") for (int _i = 0; _i < 2; ++_i) \
        __builtin_amdgcn_global_load_lds((const unsigned*)((const char*)(gbase) + (voff)[_i]), (PG8_LAS unsigned*)(lds + (bufoff) + ldsw + _i * 8192), 16, 0, 0); } while (0)
    static_assert(!GATHER || SP2, "GATHER is wired into the SP2 loop only");
    unsigned vC[2][2], vN[2][2]; unsigned cC[2];
    PG8_LAS unsigned char* gtab = lds + 131072 + 1024 + wid * 512;
    if constexpr (GATHER) {
#pragma unroll
        for (int i = 0; i < 2; ++i) { int R, C; stage_rc(tid * 16 + i * 8192, R, C); cC[i] = (unsigned)C * 2u; }
    }
    const int grow = ((lane >> 5) & 1) * 128 + ((lane >> 4) & 1) * 64 + (wid >> 1) * 16 + (lane & 15);
#define PG8_GDMA(unit, buf) __builtin_amdgcn_global_load_lds((const unsigned*)(g.idx + (size_t)(unit).pm * BM + grow), (PG8_LAS unsigned*)(gtab + (buf) * 256), 4, 0, 0)
#define PG8_GREAD(dst, buf) do { unsigned r00_, r01_, r10_, r11_; const unsigned ga_ = (unsigned)(size_t)gtab + (unsigned)(buf) * 256u + (unsigned)(lane >> 2) * 4u; \
        asm volatile("ds_read_b32 %0, %4\n\tds_read_b32 %1, %4 offset:64\n\tds_read_b32 %2, %4 offset:128\n\tds_read_b32 %3, %4 offset:192\n\ts_waitcnt lgkmcnt(0)" \
                     : "=&v"(r00_), "=&v"(r01_), "=&v"(r10_), "=&v"(r11_) : "v"(ga_) : "memory"); \
        dst[0][0] = r00_ * (unsigned)(K * 2) + cC[0]; dst[0][1] = r01_ * (unsigned)(K * 2) + cC[1]; dst[1][0] = r10_ * (unsigned)(K * 2) + cC[0]; dst[1][1] = r11_ * (unsigned)(K * 2) + cC[1]; } while (0)
#define PG8_GSTAGE(bufoff, kb, h, nx) do { _Pragma("unroll") for (int _i = 0; _i < 2; ++_i) \
        __builtin_amdgcn_global_load_lds((const unsigned*)((const char*)g.A + (kb) + ((nx) ? vN[h][_i] : vC[h][_i])), (PG8_LAS unsigned*)(lds + (bufoff) + ldsw + _i * 8192), 16, 0, 0); } while (0)
#define PG8_STA(bufoff, ptr, kb, h, nx) do { if constexpr (GATHER) { PG8_GSTAGE(bufoff, kb, h, nx); } else { PG8_STAGE(bufoff, ptr, voffA); } } while (0)
#define PG8_LDA(dst, b, h) do { if constexpr (FP8) { _Pragma("unroll") for (int m = 0; m < 4; ++m) dst##8[m] = PG8_CAT(*(const PG8_LAS bf16x8*)(lds + PG8_SA(b, h) + aoff + m * 2048), *(const PG8_LAS bf16x8*)(lds + PG8_SA(b, h) + aoff + m * 2048 + 1024)); } \
        else { _Pragma("unroll") for (int m = 0; m < 4; ++m) _Pragma("unroll") for (int k = 0; k < 2; ++k) dst[m][k] = *(const PG8_LAS bf16x8*)(lds + PG8_SA(b, h) + aoff + m * 2048 + k * 1024); } } while (0)
#define PG8_LDB(dst, b, h) do { if constexpr (FP8) { _Pragma("unroll") for (int n = 0; n < 2; ++n) dst##8[n] = PG8_CAT(*(const PG8_LAS bf16x8*)(lds + PG8_SB(b, h) + boff + n * 2048), *(const PG8_LAS bf16x8*)(lds + PG8_SB(b, h) + boff + n * 2048 + 1024)); } \
        else { _Pragma("unroll") for (int n = 0; n < 2; ++n) _Pragma("unroll") for (int k = 0; k < 2; ++k) dst[n][k] = *(const PG8_LAS bf16x8*)(lds + PG8_SB(b, h) + boff + n * 2048 + k * 1024); } } while (0)
#define PG8_MMA(ai, bj, At, Bt) do { __builtin_amdgcn_s_setprio(1); if constexpr (FP8) { _Pragma("unroll") for (int m = 0; m < 4; ++m) _Pragma("unroll") for (int n = 0; n < 2; ++n) \
        mfma_fp8(acc[ai][bj][m][n], Bt##8[n], At##8[m], sc8); } \
        else { _Pragma("unroll") for (int m = 0; m < 4; ++m) _Pragma("unroll") for (int n = 0; n < 2; ++n) _Pragma("unroll") for (int k = 0; k < 2; ++k) \
        acc[ai][bj][m][n] = __builtin_amdgcn_mfma_f32_16x16x32_bf16(Bt[n][k], At[m][k], acc[ai][bj][m][n], 0, 0, 0); } __builtin_amdgcn_s_setprio(0); } while (0)
#define PG8_CAT(x, y) __builtin_shufflevector(__builtin_bit_cast(v4i_t, (x)), __builtin_bit_cast(v4i_t, (y)), 0, 1, 2, 3, 4, 5, 6, 7)
#define PG8_WAIT_V(n) asm volatile("s_waitcnt vmcnt(" #n ")" ::: "memory")
#define PG8_WAIT_L(n) asm volatile("s_waitcnt lgkmcnt(" #n ")" ::: "memory")
#define PG8_BAR __builtin_amdgcn_s_barrier()
#define PG8_SCHED __builtin_amdgcn_sched_barrier(0)
    Unit cur, nxt; int ui = 0;
    if (!S.next(0, cur)) return;
    f32x4 acc[2][2][4][2];
#pragma unroll
    for (int a = 0; a < 2; ++a)
#pragma unroll
        for (int b = 0; b < 2; ++b)
#pragma unroll
            for (int m = 0; m < 4; ++m)
#pragma unroll
                for (int n = 0; n < 2; ++n) acc[a][b][m][n] = (f32x4){0.f, 0.f, 0.f, 0.f};
    int sc8 = 0x7f7f7f7f; if constexpr (FP8) asm volatile("" : "+v"(sc8));
    bf16x8 At[4][2], B0[2][2], B1[2][2]; v8i_t At8[4], B08[2], B18[2];
    const char* cA = (const char*)g.A + (size_t)cur.pm * tstep; const char* cB = (const char*)g.Bt + (size_t)cur.pn * tstep + (GROUPED ? (size_t)expert_of_tile(cur.pm) * g.estride : (size_t)0);
    S.a_ready(cur);
    if constexpr (SP2) {
        if constexpr (GATHER) { PG8_GDMA(cur, 0); PG8_WAIT_V(0); PG8_GREAD(vC, 0); }
        PG8_STAGE(PG8_SB(0, 0), cB, voffB); PG8_STAGE(PG8_SB(0, 1), cB + hstep, voffB); PG8_STA(PG8_SA(0, 0), cA, 0, 0, false); PG8_STA(PG8_SA(0, 1), cA + hstep, 0, 1, false);
        if (wr == 1) PG8_BAR;
        PG8_WAIT_V(2); PG8_BAR;
        if constexpr (BAL) { PG8_STAGE(PG8_SB(1, 0), cB + kstep, voffB); PG8_STAGE(PG8_SB(1, 1), cB + hstep + kstep, voffB); PG8_WAIT_V(4); PG8_BAR; }
        else {
        PG8_STAGE(PG8_SB(1, 0), cB + kstep, voffB); PG8_STA(PG8_SA(1, 0), cA + kstep, kstep, 0, false); PG8_STAGE(PG8_SB(1, 1), cB + hstep + kstep, voffB);
        PG8_WAIT_V(6); PG8_BAR;
        }
    } else {
        PG8_STAGE(PG8_SB(0, 0), cB, voffB); PG8_STAGE(PG8_SA(0, 0), cA, voffA); PG8_STAGE(PG8_SB(0, 1), cB + hstep, voffB); PG8_STAGE(PG8_SA(0, 1), cA + hstep, voffA);
        if (wr == 1) PG8_BAR;
        PG8_WAIT_V(4); PG8_BAR;
        PG8_STAGE(PG8_SB(1, 0), cB + kstep, voffB); PG8_STAGE(PG8_SA(1, 0), cA + kstep, voffA); PG8_STAGE(PG8_SB(1, 1), cB + hstep + kstep, voffB);
        PG8_WAIT_V(6); PG8_BAR;
    }
    for (;;) {
        const bool has_next = S.next(ui + 1, nxt);
        if constexpr (GATHER) { if (has_next) PG8_GDMA(nxt, (ui + 1) & 1); }
        const char* nA = has_next ? (const char*)g.A + (size_t)nxt.pm * tstep : cA; const char* nB = has_next ? (const char*)g.Bt + (size_t)nxt.pn * tstep + (GROUPED ? (size_t)expert_of_tile(nxt.pm) * g.estride : (size_t)0) : cB;
        for (int t = 0; t < nt; t += 2) {
            const bool last = (t == nt - 2);
            const char* a1 = cA + (size_t)(t + 1) * kstep;
            const char* a2 = last ? nA : cA + (size_t)(t + 2) * kstep; const char* b2 = last ? nB : cB + (size_t)(t + 2) * kstep;
            const char* a3 = a2 + kstep; const char* b3 = b2 + kstep;
            if (last && has_next) S.a_ready(nxt);
            if constexpr (SP2) {
            const bool nx = last && has_next; const size_t kb2 = last ? (size_t)0 : (size_t)(t + 2) * kstep;
            if constexpr (GATHER) { if (nx) PG8_GREAD(vN, (ui + 1) & 1); }
            if constexpr (BAL) {
            PG8_LDB(B0, 0, 0); PG8_LDB(B1, 0, 1); PG8_SCHED; PG8_LDA(At, 0, 0); PG8_STA(PG8_SA(1, 0), a1, (size_t)(t + 1) * kstep, 0, false); PG8_STA(PG8_SA(1, 1), a1 + hstep, (size_t)(t + 1) * kstep, 1, false);
            PG8_WAIT_V(8); PG8_WAIT_L(0); PG8_BAR; PG8_MMA(0, 0, At, B0); PG8_MMA(0, 1, At, B1); PG8_BAR; PG8_SCHED;
            PG8_LDA(At, 0, 1); PG8_STAGE(PG8_SB(0, 0), b2, voffB); PG8_STAGE(PG8_SB(0, 1), b2 + hstep, voffB);
            PG8_WAIT_V(6); PG8_WAIT_L(0); PG8_BAR; PG8_MMA(1, 0, At, B0); PG8_MMA(1, 1, At, B1); PG8_BAR; PG8_SCHED;
            PG8_LDB(B0, 1, 0); PG8_LDB(B1, 1, 1); PG8_SCHED; PG8_LDA(At, 1, 0); PG8_STA(PG8_SA(0, 0), a2, kb2, 0, nx); PG8_STA(PG8_SA(0, 1), a2 + hstep, kb2, 1, nx);
            PG8_WAIT_V(8); PG8_WAIT_L(0); PG8_BAR; PG8_MMA(0, 0, At, B0); PG8_MMA(0, 1, At, B1); PG8_BAR; PG8_SCHED;
            PG8_LDA(At, 1, 1); PG8_STAGE(PG8_SB(1, 0), b3, voffB); PG8_STAGE(PG8_SB(1, 1), b3 + hstep, voffB);
            PG8_WAIT_V(6); PG8_WAIT_L(0); PG8_BAR; PG8_MMA(1, 0, At, B0); PG8_MMA(1, 1, At, B1); PG8_BAR; PG8_SCHED;
            } else {
            PG8_LDB(B0, 0, 0); PG8_LDB(B1, 0, 1); PG8_SCHED; PG8_LDA(At, 0, 0); PG8_STA(PG8_SA(1, 1), a1 + hstep, (size_t)(t + 1) * kstep, 1, false);
            PG8_WAIT_V(8); PG8_WAIT_L(0); PG8_BAR; PG8_MMA(0, 0, At, B0); PG8_MMA(0, 1, At, B1); PG8_BAR; PG8_SCHED;
            PG8_LDA(At, 0, 1); PG8_STAGE(PG8_SB(0, 0), b2, voffB); PG8_STAGE(PG8_SB(0, 1), b2 + hstep, voffB); PG8_STA(PG8_SA(0, 0), a2, kb2, 0, nx);
            PG8_WAIT_V(8); PG8_WAIT_L(0); PG8_BAR; PG8_MMA(1, 0, At, B0); PG8_MMA(1, 1, At, B1); PG8_BAR; PG8_SCHED;
            PG8_LDB(B0, 1, 0); PG8_LDB(B1, 1, 1); PG8_SCHED; PG8_LDA(At, 1, 0); PG8_STA(PG8_SA(0, 1), a2 + hstep, kb2, 1, nx);
            PG8_WAIT_V(8); PG8_WAIT_L(0); PG8_BAR; PG8_MMA(0, 0, At, B0); PG8_MMA(0, 1, At, B1); PG8_BAR; PG8_SCHED;
            PG8_LDA(At, 1, 1); PG8_STAGE(PG8_SB(1, 0), b3, voffB); PG8_STAGE(PG8_SB(1, 1), b3 + hstep, voffB); PG8_STA(PG8_SA(1, 0), a3, kb2 + kstep, 0, nx);
            PG8_WAIT_V(8); PG8_WAIT_L(0); PG8_BAR; PG8_MMA(1, 0, At, B0); PG8_MMA(1, 1, At, B1); PG8_BAR; PG8_SCHED;
            }
            } else {
            PG8_LDB(B0, 0, 0); PG8_SCHED; PG8_LDA(At, 0, 0); PG8_STAGE(PG8_SA(1, 1), a1 + hstep, voffA);
            PG8_WAIT_L(8); PG8_BAR; PG8_WAIT_L(0); PG8_MMA(0, 0, At, B0); PG8_BAR; PG8_SCHED;
            PG8_LDB(B1, 0, 1); PG8_STAGE(PG8_SB(0, 0), b2, voffB);
            PG8_BAR; PG8_WAIT_L(0); PG8_MMA(0, 1, At, B1); PG8_BAR;
            PG8_LDA(At, 0, 1); PG8_STAGE(PG8_SA(0, 0), a2, voffA);
            PG8_BAR; PG8_WAIT_L(0); PG8_MMA(1, 0, At, B0); PG8_BAR; PG8_SCHED;
            PG8_STAGE(PG8_SB(0, 1), b2 + hstep, voffB);
            PG8_WAIT_V(6); PG8_BAR; PG8_MMA(1, 1, At, B1); PG8_BAR;
            PG8_LDB(B0, 1, 0); PG8_SCHED; PG8_LDA(At, 1, 0); PG8_STAGE(PG8_SA(0, 1), a2 + hstep, voffA);
            PG8_WAIT_L(8); PG8_BAR; PG8_WAIT_L(0); PG8_MMA(0, 0, At, B0); PG8_BAR; PG8_SCHED;
            PG8_LDB(B1, 1, 1); PG8_STAGE(PG8_SB(1, 0), b3, voffB);
            PG8_BAR; PG8_WAIT_L(0); PG8_MMA(0, 1, At, B1); PG8_BAR;
            PG8_LDA(At, 1, 1); PG8_STAGE(PG8_SA(1, 0), a3, voffA);
            PG8_BAR; PG8_WAIT_L(0); PG8_MMA(1, 0, At, B0); PG8_BAR; PG8_SCHED;
            PG8_STAGE(PG8_SB(1, 1), b3 + hstep, voffB);
            PG8_WAIT_V(6); PG8_BAR; PG8_MMA(1, 1, At, B1); PG8_BAR;
            }
        }
        if constexpr (FP8) asm volatile("s_nop 15\n\ts_nop 7" ::: "memory");
        if constexpr (ALIGN_EPI) { if (wr == 0) PG8_BAR; }
        if constexpr (!Epi::AFTER_DRAIN) { int fr_ = fr, fq_ = fq; asm volatile("" : "+v"(fr_), "+v"(fq_));
            E(acc, cur, wr, wc, fr_, fq_); S.done(cur); }
        if (!has_next) break;
#pragma unroll
        for (int a = 0; a < 2; ++a)
#pragma unroll
            for (int b = 0; b < 2; ++b)
#pragma unroll
                for (int m = 0; m < 4; ++m)
#pragma unroll
                    for (int n = 0; n < 2; ++n) acc[a][b][m][n] = (f32x4){0.f, 0.f, 0.f, 0.f};
        cur = nxt; cA = nA; cB = nB; ++ui;
        if constexpr (GATHER) { vC[0][0] = vN[0][0]; vC[0][1] = vN[0][1]; vC[1][0] = vN[1][0]; vC[1][1] = vN[1][1]; }
        if constexpr (ALIGN_EPI) { if (wr == 1) PG8_BAR; }
    }
    PG8_WAIT_V(0);
    if constexpr (!ALIGN_EPI) { if (wr == 0) PG8_BAR; }
    PG8_BAR;
    if constexpr (Epi::AFTER_DRAIN) { E.fused(acc, cur, wr, wc, fr, fq, lds, wid, lane); S.done(cur); }
#undef PG8_SA
#undef PG8_SB
#undef PG8_STAGE
#undef PG8_GDMA
#undef PG8_GREAD
#undef PG8_GSTAGE
#undef PG8_STA
#undef PG8_LDA
#undef PG8_LDB
#undef PG8_MMA
#undef PG8_CAT
#undef PG8_WAIT_V
#undef PG8_WAIT_L
#undef PG8_BAR
#undef PG8_SCHED
}
}

#define GAS __attribute__((address_space(1)))
#define LAS __attribute__((address_space(3)))
typedef unsigned v4u __attribute__((ext_vector_type(4)));
using pg8::f32x4;
typedef GAS unsigned gu32;
typedef GAS unsigned long long gu64;
#define RLX_AGENT __ATOMIC_RELAXED, __HIP_MEMORY_SCOPE_AGENT
#define LDS_WAIT() asm volatile("s_waitcnt lgkmcnt(0)" ::: "memory")
#define VM_WAIT() asm volatile("s_waitcnt vmcnt(0)" ::: "memory")

#define XB_TMO      128
#define XB_XCNT(j)  (256  + 64 * (j))
#define XB_XSUB(j)  (1280 + 64 * (j))
#define XB_XGEN(j)  (2304 + 64 * (j))
#define XB_TOP      3328
#define XB_TOPGEN   3392
#define XCD_BAR_WORDS 3456
#define XB_SPIN_CAP (1u << 18)

__device__ __forceinline__ unsigned xb_ld(unsigned* p)              { return __hip_atomic_load(p, __ATOMIC_RELAXED, __HIP_MEMORY_SCOPE_AGENT); }
__device__ __forceinline__ unsigned xb_add(unsigned* p, unsigned v) { return __hip_atomic_fetch_add(p, v, __ATOMIC_RELAXED, __HIP_MEMORY_SCOPE_AGENT); }
__device__ __forceinline__ unsigned xb_xcc_id() { return (unsigned)__builtin_amdgcn_s_getreg((3 << 11) | 20) & 0xFu; }
#define XB_SPIN(cond, bar) do { unsigned _sp = 0; while (cond) { __builtin_amdgcn_s_sleep(1); \
    if ((++_sp & 255u) == 0u) { if (xb_ld(&(bar)[XB_TMO])) break; if (_sp > XB_SPIN_CAP) { atomicAdd(&(bar)[XB_TMO], 1u); break; } } } } while (0)

struct XcdBarrier {
    unsigned* bar; unsigned x;
    volatile LAS unsigned* st;
};

__device__ __forceinline__ XcdBarrier xcd_barrier_post(unsigned* bar, volatile LAS unsigned* st) {
    XcdBarrier b; b.bar = bar; b.x = xb_xcc_id(); b.st = st;
    if (threadIdx.x == 0) (void)xb_add(&bar[XB_XCNT(b.x)], 1u);
    return b;
}
__device__ __forceinline__ void xcd_barrier_complete(unsigned* bar, unsigned x, unsigned& nloc, unsigned& nx) {
    const unsigned G = gridDim.x * gridDim.y * gridDim.z;
    unsigned sum, cnt, mine, sp = 0u;
    for (;;) {
        sum = 0u; cnt = 0u; mine = 0u;
#pragma unroll
        for (unsigned j = 0; j < 16; ++j) { const unsigned c = xb_ld(&bar[XB_XCNT(j)]); sum += c; cnt += (c > 0u) ? 1u : 0u; mine = (j == x) ? c : mine; }
        if (sum == G) break;
        __builtin_amdgcn_s_sleep(1);
        if ((++sp & 255u) == 0u) { if (xb_ld(&bar[XB_TMO])) break; if (sp > XB_SPIN_CAP) { atomicAdd(&bar[XB_TMO], 1u); break; } }
    }
    nloc = mine > 0u ? mine : 1u; nx = cnt > 0u ? cnt : 1u;
}

__device__ __forceinline__ void xcd_barrier(const XcdBarrier& b) {
    asm volatile("s_waitcnt vmcnt(0)" ::: "memory");
    __syncthreads();
    if (threadIdx.x == 0) {
        unsigned* bar = b.bar;
        __builtin_amdgcn_s_waitcnt(0);
        unsigned nloc = b.st[0], nx = b.st[1];
        if (nloc == 0u) { xcd_barrier_complete(bar, b.x, nloc, nx); b.st[0] = nloc; b.st[1] = nx; }
        const unsigned old = xb_add(&bar[XB_XSUB(b.x)], 1u);
        const unsigned gen = old / nloc;
        if (old + 1u == (gen + 1u) * nloc) {
            __builtin_amdgcn_fence(__ATOMIC_RELEASE, "agent");
            asm volatile("s_waitcnt vmcnt(0)" ::: "memory");
            const unsigned og = xb_add(&bar[XB_TOP], 1u);
            const unsigned tg = og / nx;
            if (og + 1u == (tg + 1u) * nx) xb_add(&bar[XB_TOPGEN], 1u);
            else XB_SPIN(xb_ld(&bar[XB_TOPGEN]) == tg, bar);
            __builtin_amdgcn_fence(__ATOMIC_ACQUIRE, "agent");
            xb_add(&bar[XB_XGEN(b.x)], 1u);
            asm volatile("s_waitcnt vmcnt(0)" ::: "memory");
        } else {
            XB_SPIN(xb_ld(&bar[XB_XGEN(b.x)]) == gen, bar);
            __builtin_amdgcn_fence(__ATOMIC_ACQUIRE, "agent");
            asm volatile("s_waitcnt vmcnt(0)" ::: "memory");
        }
    }
    __syncthreads();
}


namespace attn_body {
using bf16=__hip_bfloat16;
using bf16x8=__attribute__((ext_vector_type(8)))short;
using s16x4=__attribute__((ext_vector_type(4)))short;
using f32x16=__attribute__((ext_vector_type(16)))float;
using u32x4=__attribute__((ext_vector_type(4)))unsigned;
constexpr int SEQ=4096,D=64,KP=2048,OP=1024;
constexpr int NW=8,QBLK=32,QB=QBLK*NW,KVBLK=64,NQB=SEQ/QB;
__device__ __forceinline__ int crow(int r,int hi){return (r&3)+8*(r>>2)+4*hi;}
#define SBAR() __builtin_amdgcn_sched_barrier(0)
constexpr int NSLOT=3, SLOTB=8192;
constexpr int LDS_K=0, LDS_V=NSLOT*SLOTB, LDS_WS=2*NSLOT*SLOTB, LDS_OST=LDS_WS+NW*64*4, LDS_BYTES=LDS_OST+NW*4096;
constexpr float C2=0.125f*1.4426950408889634f;
__device__ __forceinline__ void glds16(const void*gsrc,unsigned lds_dst){unsigned keep;
  asm volatile("s_mov_b32 %0, m0\n\ts_mov_b32 m0, %2\n\ts_nop 0\n\tglobal_load_lds_dwordx4 %1, off\n\ts_mov_b32 m0, %0":"=&s"(keep):"v"(gsrc),"s"(lds_dst):"memory");}
__device__ __forceinline__ float max3f(float a,float b,float c){float r;asm("v_max3_f32 %0, %1, %2, %3":"=v"(r):"v"(a),"v"(b),"v"(c));return r;}
__device__ __forceinline__ float max2f(float a,float b){float r;asm("v_max_f32_e32 %0, %1, %2":"=v"(r):"v"(a),"v"(b));return r;}
__device__ __forceinline__ float fadd_s(float a,float b){float r;asm("v_add_f32_e32 %0, %1, %2":"=v"(r):"v"(a),"v"(b));return r;}
__device__ __forceinline__ float fsub_s(float a,float b){float r;asm("v_sub_f32_e32 %0, %1, %2":"=v"(r):"v"(a),"v"(b));return r;}
typedef float f32x2_t __attribute__((ext_vector_type(2))); typedef __bf16 bf16x2_t __attribute__((ext_vector_type(2)));
__device__ __forceinline__ unsigned cvtpk_s(float lo,float hi){f32x2_t v={lo,hi};bf16x2_t b=__builtin_convertvector(v,bf16x2_t);return __builtin_bit_cast(unsigned,b);}
#define WAIT_BAR(N) asm volatile("s_waitcnt vmcnt(" #N ") lgkmcnt(0)\n\ts_barrier":::"memory")

__device__ __forceinline__ void qkt(f32x16&p0,f32x16&p1,const char*Kslot,const bf16x8*qr,const f32x16&negm,int r32,int hi){
  const char*kb=Kslot+hi*1024+r32*16;
  #pragma unroll
  for(int d0=0;d0<4;++d0){
    const bf16x8 b0=*reinterpret_cast<const bf16x8*>(kb+d0*2048);
    const bf16x8 b1=*reinterpret_cast<const bf16x8*>(kb+d0*2048+512);
    if(d0==0){p0=__builtin_amdgcn_mfma_f32_32x32x16_bf16(b0,qr[0],negm,0,0,0);p1=__builtin_amdgcn_mfma_f32_32x32x16_bf16(b1,qr[0],negm,0,0,0);}
    else{p0=__builtin_amdgcn_mfma_f32_32x32x16_bf16(b0,qr[d0],p0,0,0,0);p1=__builtin_amdgcn_mfma_f32_32x32x16_bf16(b1,qr[d0],p1,0,0,0);}}
}
typedef __attribute__((address_space(3))) const char* lds_cptr;
typedef short v4i16_t __attribute__((ext_vector_type(4)));
__device__ __forceinline__ void kload8(bf16x8*kf,lds_cptr kp){
  kf[0]=*(const __attribute__((address_space(3))) bf16x8*)(kp);      kf[1]=*(const __attribute__((address_space(3))) bf16x8*)(kp+512);
  kf[2]=*(const __attribute__((address_space(3))) bf16x8*)(kp+2048); kf[3]=*(const __attribute__((address_space(3))) bf16x8*)(kp+2560);
  kf[4]=*(const __attribute__((address_space(3))) bf16x8*)(kp+4096); kf[5]=*(const __attribute__((address_space(3))) bf16x8*)(kp+4608);
  kf[6]=*(const __attribute__((address_space(3))) bf16x8*)(kp+6144); kf[7]=*(const __attribute__((address_space(3))) bf16x8*)(kp+6656);
}
__device__ __forceinline__ void kload2(bf16x8*kf,lds_cptr kp,int j){ kf[2*j]=*(const __attribute__((address_space(3))) bf16x8*)(kp+j*2048); kf[2*j+1]=*(const __attribute__((address_space(3))) bf16x8*)(kp+j*2048+512); }
__device__ __forceinline__ s16x4 vtr(lds_cptr p){ return __builtin_bit_cast(s16x4,__builtin_amdgcn_ds_read_tr16_b64_v4i16((__attribute__((address_space(3))) v4i16_t*)p)); }
__device__ __forceinline__ float rowmax(const f32x16&p0,const f32x16&p1){
  float a=max3f(p0[0],p0[1],p1[0]),b=max3f(p0[2],p0[3],p1[1]);a=max3f(a,p1[2],p1[3]);
  #pragma unroll
  for(int r=4;r<16;r+=4){a=max3f(a,p0[r],p0[r+1]);b=max3f(b,p0[r+2],p0[r+3]);a=max3f(a,p1[r],p1[r+1]);b=max3f(b,p1[r+2],p1[r+3]);}
  const float m=max2f(a,b);
  auto rr=__builtin_amdgcn_permlane32_swap(__float_as_uint(m),__float_as_uint(m),false,false);
  return max2f(__uint_as_float(rr[0]),__uint_as_float(rr[1]));
}
__device__ __forceinline__ void pv(f32x16*o,int vb,bf16x8 pa0,bf16x8 pa1,bf16x8 pa2,bf16x8 pa3){
  #pragma unroll
  for(int d0=0;d0<2;++d0){s16x4 lo[4],hi[4];
    #pragma unroll
    for(int ks=0;ks<4;++ks){
      asm volatile("ds_read_b64_tr_b16 %0,%1 offset:%c2":"=&v"(lo[ks]):"v"(vb),"i"(d0*4096+ks*1024):"memory");
      asm volatile("ds_read_b64_tr_b16 %0,%1 offset:%c2":"=&v"(hi[ks]):"v"(vb),"i"(d0*4096+ks*1024+512):"memory");}
    asm volatile("s_waitcnt lgkmcnt(0)":::"memory");SBAR();
    #define PK(k) (bf16x8){lo[k][0],lo[k][1],lo[k][2],lo[k][3],hi[k][0],hi[k][1],hi[k][2],hi[k][3]}
    o[d0]=__builtin_amdgcn_mfma_f32_32x32x16_bf16(pa0,PK(0),o[d0],0,0,0);
    o[d0]=__builtin_amdgcn_mfma_f32_32x32x16_bf16(pa1,PK(1),o[d0],0,0,0);
    o[d0]=__builtin_amdgcn_mfma_f32_32x32x16_bf16(pa2,PK(2),o[d0],0,0,0);
    o[d0]=__builtin_amdgcn_mfma_f32_32x32x16_bf16(pa3,PK(3),o[d0],0,0,0);
    #undef PK
  }
}

#ifndef ATTN_STORE16
#define ATTN_STORE16(p,v) (*(u32x4*)(p)=(v))
#endif
template<int THRL,bool NOMAX=false,bool MSUM=true> __device__ __forceinline__ void attn_unit(const bf16*Qw0,const bf16*__restrict__ Kh,const bf16*__restrict__ Vh,bf16*Ow0,char*shm,int tid_in){
  int tid_=tid_in; asm volatile("":"+v"(tid_));
  const int tid=tid_,lane=tid&63,r32=lane&31,hi=lane>>5; const int wid=__builtin_amdgcn_readfirstlane(tid>>6);
  const bf16*Qw=Qw0+(long)(wid*QBLK)*KP;
  const unsigned lds0=(unsigned)(uintptr_t)shm;
  float*wsf=(float*)(shm+LDS_WS)+wid*64;
  const bf16*ksrc=Kh+(long)lane*KP+wid*8;
  const bf16*vsrc=Vh+(long)(16*(wid&3)+(lane>>2))*KP+(wid>>2)*32+(lane&3)*8;
  const unsigned kdst=lds0+LDS_K+wid*1024, vdst=lds0+LDS_V+wid*1024;
  #define DMA_K(t,slot) glds16(ksrc+(long)(t)*KVBLK*KP,(unsigned)__builtin_amdgcn_readfirstlane(kdst+(slot)))
  #define DMA_V(t,slot) glds16(vsrc+(long)(t)*KVBLK*KP,(unsigned)__builtin_amdgcn_readfirstlane(vdst+(slot)))
  const int vb0=(int)(lds0+LDS_V)+((lane>>4)&1)*32+(lane&3)*8+(4*hi+((lane&15)>>2))*64;
  const char*Kbase=shm+LDS_K; bf16x8 kf[8];
  const lds_cptr shm3=(lds_cptr)shm; const lds_cptr kp0=shm3+LDS_K+hi*1024+r32*16; const lds_cptr vp0=shm3+LDS_V+((lane>>4)&1)*32+(lane&3)*8+(4*hi+((lane&15)>>2))*64;
  constexpr int NT=SEQ/KVBLK;
  DMA_K(0,0);DMA_V(0,0);DMA_K(1,SLOTB);
  bf16x8 qr[4];
  #pragma unroll
  for(int d0=0;d0<4;++d0)qr[d0]=*reinterpret_cast<const bf16x8*>(&Qw[(long)r32*KP+d0*16+hi*8]);
  float mhat=0.f,l_reg=0.f;f32x16 o[2];o[0]=f32x16{};o[1]=f32x16{};f32x16 negm=f32x16{};if constexpr(!NOMAX)asm volatile("":"+v"(negm));
  f32x16 lsum=f32x16{}; const bf16x8 ONESF={(short)0x3F80,(short)0x3F80,(short)0x3F80,(short)0x3F80,(short)0x3F80,(short)0x3F80,(short)0x3F80,(short)0x3F80};
  #define CMASK(P0,P1,t) do{}while(0)
  bool resc=false;
  #define START(P0,P1) do{ if constexpr(!NOMAX){ const float rm=rowmax(P0,P1); resc=false; \
    { const float dl=rm; mhat=fadd_s(mhat,dl); \
      _Pragma("unroll") for(int r=0;r<16;++r){P0[r]=fsub_s(P0[r],dl);P1[r]=fsub_s(P1[r],dl);} \
      _Pragma("unroll") for(int r=0;r<16;++r)negm[r]=-mhat; asm volatile("":"+v"(negm)); } } \
    _Pragma("unroll") for(int r=0;r<16;++r)P0[r]=__builtin_amdgcn_exp2f(P0[r]); }while(0)
  #define RESC() do{ if(resc){ asm volatile("s_waitcnt lgkmcnt(0)":::"memory"); \
      _Pragma("unroll") for(int d_=0;d_<2;++d_) _Pragma("unroll") for(int r=0;r<16;++r)o[d_][r]*=wsf[crow(r,hi)]; } }while(0)
  f32x16 pA0,pA1,pB0,pB1;
  int sl_prev=0,sl_cur=0,sl_next=SLOTB;
  #define ROT() do{sl_prev=sl_cur;sl_cur=sl_next;sl_next=(sl_next==(NSLOT-1)*SLOTB)?0:sl_next+SLOTB;}while(0)
  DMA_K(2,2*SLOTB);
  WAIT_BAR(3);
  qkt(pA0,pA1,Kbase,qr,negm,r32,hi);asm volatile("s_nop 15\n\ts_nop 7":"+v"(pA0),"+v"(pA1));CMASK(pA0,pA1,0);
  START(pA0,pA1);
  _Pragma("unroll") for(int r=0;r<16;++r)pA1[r]=__builtin_amdgcn_exp2f(pA1[r]);
  WAIT_BAR(0);
  DMA_K(3,0);DMA_V(1,SLOTB);
  ROT();
  kload8(kf,kp0+sl_cur);
  WAIT_BAR(2);
  s16x4 vlo[8],vhi[8]; u32x4 pw0,pw1,pw2,pw3;
  #define PKW(P,B) cvtpk_s(P[B],P[B+1])
  #define PAF(k) __builtin_bit_cast(bf16x8,pw##k)
  #define VFR(i) (bf16x8){vlo[i][0],vlo[i][1],vlo[i][2],vlo[i][3],vhi[i][0],vhi[i][1],vhi[i][2],vhi[i][3]}
  #define PIN(x) asm volatile("":"+v"(x))
  #define MX3(a,b,c) __builtin_fmaxf(__builtin_fmaxf((a),(b)),(c))
  #define GAPA(MF,A0,A1,A2,A3,W0,W1,PW) do{ MF; if constexpr(!(NOMAX&&MSUM)){ sacc+=A0; sacc+=A1; sacc+=A2; sacc+=A3; PIN(sacc); } W0; W1; PIN(PW); SBAR(); }while(0)
  #define LSUM(k) do{ if constexpr(NOMAX&&MSUM){ lsum=__builtin_amdgcn_mfma_f32_32x32x16_bf16(PAF(k),ONESF,lsum,0,0,0); SBAR(); } }while(0)
  #define EX(v) __builtin_amdgcn_exp2f(v)
  #define GAPB(MF,X,B) do{ MF; X[B]=EX(X[B]); X[B+1]=EX(X[B+1]); X[B+2]=EX(X[B+2]); X[B+3]=EX(X[B+3]); PIN(X); SBAR(); }while(0)
  #define VRD(i) do{ vlo[i]=vtr(vp_+(((i)>>2)*4096+((i)&3)*1024)); vhi[i]=vtr(vp_+(((i)>>2)*4096+((i)&3)*1024+512)); }while(0)
  #define KRD(G,j) do{ if(G){ kload2(kf,kp0+sl_next,j); SBAR(); } }while(0)
  #define STEP(C0,C1,P0,P1,t,GK,GV,GL) do{ SBAR(); \
    const lds_cptr vp_=vp0+sl_prev; \
    VRD(0); SBAR(); float sacc=0.f; if constexpr(!(NOMAX&&MSUM)) sacc=(P0[0]+P0[1]); \
    GAPA(C0=__builtin_amdgcn_mfma_f32_32x32x16_bf16(kf[0],qr[0],negm,0,0,0), P0[2],P0[3],P0[4],P0[5],     pw0[0]=PKW(P0,0), pw0[1]=PKW(P0,2), pw0); \
    VRD(4); SBAR(); GAPA(C1=__builtin_amdgcn_mfma_f32_32x32x16_bf16(kf[1],qr[0],negm,0,0,0), P0[6],P0[7],P0[8],P0[9],     pw0[2]=PKW(P0,4), pw0[3]=PKW(P0,6), pw0); \
    VRD(1); SBAR(); GAPA(C0=__builtin_amdgcn_mfma_f32_32x32x16_bf16(kf[2],qr[1],C0,0,0,0),   P0[10],P0[11],P0[12],P0[13], pw1[0]=PKW(P0,8), pw1[1]=PKW(P0,10), pw1); \
    VRD(5); SBAR(); GAPA(C1=__builtin_amdgcn_mfma_f32_32x32x16_bf16(kf[3],qr[1],C1,0,0,0),   P0[14],P0[15],P1[0],P1[1],   pw1[2]=PKW(P0,12),pw1[3]=PKW(P0,14), pw1); \
    VRD(2); SBAR(); GAPA(C0=__builtin_amdgcn_mfma_f32_32x32x16_bf16(kf[4],qr[2],C0,0,0,0),   P1[2],P1[3],P1[4],P1[5],     pw2[0]=PKW(P1,0), pw2[1]=PKW(P1,2), pw2); \
    VRD(6); SBAR(); GAPA(C1=__builtin_amdgcn_mfma_f32_32x32x16_bf16(kf[5],qr[2],C1,0,0,0),   P1[6],P1[7],P1[8],P1[9],     pw2[2]=PKW(P1,4), pw2[3]=PKW(P1,6), pw2); \
    VRD(3); SBAR(); GAPA(C0=__builtin_amdgcn_mfma_f32_32x32x16_bf16(kf[6],qr[3],C0,0,0,0),   P1[10],P1[11],P1[12],P1[13], pw3[0]=PKW(P1,8), pw3[1]=PKW(P1,10), pw3); \
    VRD(7); SBAR(); GAPA(C1=__builtin_amdgcn_mfma_f32_32x32x16_bf16(kf[7],qr[3],C1,0,0,0),   P1[14],P1[15],0.f,0.f,       pw3[2]=PKW(P1,12),pw3[3]=PKW(P1,14), pw3); \
    l_reg+=sacc; \
    if(GK){DMA_K((t)+3,sl_cur);} if(GV){DMA_V((t)+1,sl_next);} \
    CMASK(C0,C1,t); \
    if constexpr(!NOMAX){ float a=MX3(C0[0],C0[1],C1[0]),b=MX3(C0[2],C0[3],C1[1]); a=MX3(a,C1[2],C1[3]); \
      _Pragma("unroll") for(int r=4;r<16;r+=4){a=MX3(a,C0[r],C0[r+1]);b=MX3(b,C0[r+2],C0[r+3]);a=MX3(a,C1[r],C1[r+1]);b=MX3(b,C1[r+2],C1[r+3]);} \
      float rm=__builtin_fmaxf(a,b); { auto rr=__builtin_amdgcn_permlane32_swap(__float_as_uint(rm),__float_as_uint(rm),false,false); rm=__builtin_fmaxf(__uint_as_float(rr[0]),__uint_as_float(rr[1])); } \
      resc=false; \
      if(__builtin_expect(__any(rm>(float)THRL),0)){ const float dl=__builtin_fmaxf(rm,0.f); mhat+=dl; \
        _Pragma("unroll") for(int r=0;r<16;++r){C0[r]-=dl;C1[r]-=dl;} \
        _Pragma("unroll") for(int r=0;r<16;++r)negm[r]=-mhat; asm volatile("":"+v"(negm)); \
        const float f=__builtin_amdgcn_exp2f(-dl); l_reg*=f; if(hi==0)wsf[r32]=f; resc=true; } } \
    SBAR(); \
    GAPB(o[0]=__builtin_amdgcn_mfma_f32_32x32x16_bf16(PAF(0),VFR(0),o[0],0,0,0), C0,0); \
    GAPB(o[1]=__builtin_amdgcn_mfma_f32_32x32x16_bf16(PAF(0),VFR(4),o[1],0,0,0), C0,4); LSUM(0); \
    KRD(GL,0); GAPB(o[0]=__builtin_amdgcn_mfma_f32_32x32x16_bf16(PAF(1),VFR(1),o[0],0,0,0), C0,8); \
    KRD(GL,1); GAPB(o[1]=__builtin_amdgcn_mfma_f32_32x32x16_bf16(PAF(1),VFR(5),o[1],0,0,0), C0,12); LSUM(1); \
    KRD(GL,2); GAPB(o[0]=__builtin_amdgcn_mfma_f32_32x32x16_bf16(PAF(2),VFR(2),o[0],0,0,0), C1,0); \
    KRD(GL,3); GAPB(o[1]=__builtin_amdgcn_mfma_f32_32x32x16_bf16(PAF(2),VFR(6),o[1],0,0,0), C1,4); LSUM(2); \
    GAPB(o[0]=__builtin_amdgcn_mfma_f32_32x32x16_bf16(PAF(3),VFR(3),o[0],0,0,0), C1,8); \
    GAPB(o[1]=__builtin_amdgcn_mfma_f32_32x32x16_bf16(PAF(3),VFR(7),o[1],0,0,0), C1,12); LSUM(3); \
    }while(0)
  int t=1;
  for(;t+5<NT;t+=2){
    STEP(pB0,pB1,pA0,pA1,t,true,true,true);     WAIT_BAR(2); RESC(); ROT();
    STEP(pA0,pA1,pB0,pB1,t+1,true,true,true);   WAIT_BAR(2); RESC(); ROT();
  }
  #define ENDW(tt) do{ if((tt)+3<NT){WAIT_BAR(2);} else if((tt)+2<NT){WAIT_BAR(1);} else {WAIT_BAR(0);} }while(0)
  for(;t+1<NT;t+=2){
    STEP(pB0,pB1,pA0,pA1,t,(t+3<NT),(t+1<NT),(t+1<NT));       ENDW(t);   RESC(); ROT();
    STEP(pA0,pA1,pB0,pB1,t+1,(t+4<NT),(t+2<NT),(t+2<NT));     ENDW(t+1); RESC(); ROT();
  }
  STEP(pB0,pB1,pA0,pA1,NT-1,false,false,false); RESC();
  { if constexpr(!(NOMAX&&MSUM)){ float sacc=pB0[0]+pB0[1]; _Pragma("unroll") for(int r=2;r<16;++r)sacc+=pB0[r]; _Pragma("unroll") for(int r=0;r<16;++r)sacc+=pB1[r]; l_reg+=sacc; }
    pw0=(u32x4){PKW(pB0,0),PKW(pB0,2),PKW(pB0,4),PKW(pB0,6)};pw1=(u32x4){PKW(pB0,8),PKW(pB0,10),PKW(pB0,12),PKW(pB0,14)};pw2=(u32x4){PKW(pB1,0),PKW(pB1,2),PKW(pB1,4),PKW(pB1,6)};pw3=(u32x4){PKW(pB1,8),PKW(pB1,10),PKW(pB1,12),PKW(pB1,14)};
    SBAR(); pv(o,vb0+sl_cur,PAF(0),PAF(1),PAF(2),PAF(3)); LSUM(0); LSUM(1); LSUM(2); LSUM(3); }
  #undef PKW
  #undef PAF
  #undef VFR
  #undef PIN
  #undef MX3
  #undef GAPA
  #undef LSUM
  #undef GAPB
  #undef EX
  #undef VRD
  #undef KRD
  #undef STEP
  #undef ENDW
  float rli[16];
  if constexpr(NOMAX&&MSUM){
    #pragma unroll
    for(int r=0;r<16;++r)rli[r]=__builtin_amdgcn_rcpf(lsum[r]);
  } else {
  {auto rr=__builtin_amdgcn_permlane32_swap(__float_as_uint(l_reg),__float_as_uint(l_reg),false,false);l_reg=__uint_as_float(rr[0])+__uint_as_float(rr[1]);}
  if(hi==0)wsf[32+r32]=l_reg;asm volatile("s_waitcnt lgkmcnt(0)":::"memory");
  #pragma unroll
  for(int r=0;r<16;++r)rli[r]=__builtin_amdgcn_rcpf(wsf[32+crow(r,hi)]);
  }
  bf16*Ow=Ow0+(long)(wid*QBLK)*OP;
  { bf16*stg=(bf16*)(shm+LDS_OST)+wid*2048;
    #pragma unroll
    for(int r=0;r<16;++r){const int orow=crow(r,hi);
      #pragma unroll
      for(int d0=0;d0<2;++d0)stg[orow*64+d0*32+r32]=__float2bfloat16(o[d0][r]*rli[r]);}
    asm volatile("s_waitcnt lgkmcnt(0)":::"memory");
    #pragma unroll
    for(int i=0;i<4;++i){const int row=i*8+(lane>>3),ch=lane&7; const u32x4 v=*(const u32x4*)(stg+row*64+ch*8); ATTN_STORE16(Ow+(long)row*OP+ch*8,v);} }
  asm volatile("s_waitcnt lgkmcnt(0)\n\ts_barrier":::"memory");
  #undef DMA_K
  #undef DMA_V
  #undef CMASK
  #undef START
  #undef RESC
  #undef ROT
}
constexpr int ATTN_LDS_BYTES=LDS_BYTES;
#undef SBAR
#undef WAIT_BAR
}

typedef unsigned short bf16;
typedef float f32x16 __attribute__((ext_vector_type(16)));
typedef short s16x4 __attribute__((ext_vector_type(4)));
typedef short v4i16_t __attribute__((ext_vector_type(4)));
typedef unsigned u32x2 __attribute__((ext_vector_type(2)));
typedef float f32x2v __attribute__((ext_vector_type(2)));
using pg8::bf16x8; using pg8::u32x4;

constexpr int DM = 1024, SEQ = 4096, T_P = 4 * 4096, T_S = 16 * 4096, TT = T_P + T_S, NBATCH = 20;
constexpr int DIN = 2048, NLAYER = 4, NEXP = 16, DEXP = 2048;
constexpr int CAP_P = T_P / 8, CAP_S = T_S / 8, ROWS_P = NEXP * CAP_P, ROWS_E = 2 * TT;
constexpr float LN_EPS = 1e-5f, QK_EPS = 1e-6f;
constexpr float DN_ALPHA = 1.6817928305074290861f;
constexpr float LOG2E = 1.4426950408889634f;
constexpr float C2 = 0.125f * LOG2E;
constexpr int H_NAQ = 0, H_NAK = 256, H_NAV = 512, H_GQ = 768, H_GK = 1280, H_GV = 1408, H_UC = 1536, H_VC = 1792;
constexpr int Y_NA = 0, Y_GQA = 256, Y_SG = 768;

constexpr size_t MiB = 1u << 20;
constexpr size_t WS_CTL = 0, CTL_ZERO_BYTES = 1 * MiB;
constexpr size_t WS_ROPE = 1 * MiB;
constexpr size_t WS_WSBF = 2 * MiB;
constexpr size_t WS_WIN = 4 * MiB;
constexpr size_t WS_WOUT = 8 * MiB;
constexpr size_t WS_WGU = 16 * MiB;
constexpr size_t WS_WD = 144 * MiB;
constexpr size_t WS_AFF = 208 * MiB;
constexpr size_t WS_SLOTOF = 214 * MiB;
constexpr size_t WS_IDX = 220 * MiB;
constexpr size_t WS_GATE = 221 * MiB;
constexpr size_t WS_STATS = 222 * MiB;
constexpr size_t WS_XB = 224 * MiB;
constexpr size_t WS_H = 384 * MiB;
constexpr size_t WS_SB = 544 * MiB;
constexpr size_t WS_HID = 704 * MiB;
constexpr size_t WS_XB8 = 1344 * MiB;
constexpr size_t WS_VT = 1424 * MiB;
constexpr size_t WS_SET1 = 1468 * MiB;
constexpr size_t WS_DUMMY = 1676 * MiB;
constexpr size_t WS_END = 1676 * MiB;
__device__ __forceinline__ size_t wset(int l) { return (l & 1) ? (WS_SET1 - 2 * MiB) : (size_t)0; }
#ifndef CONV_SPLIT_ITEMS
#define CONV_SPLIT_ITEMS 20480
#endif
constexpr int VTP = SEQ + 64;
constexpr int CW_TMO = 0, CW_BAR = 4096;

constexpr int NWAVES = 8;
constexpr int RING_BYTES = 131072, LDSCTL_OFF = RING_BYTES, MISC_OFF = LDSCTL_OFF + 320, LDS_BYTES = 147456;

__device__ __forceinline__ unsigned f2bf(float f) { unsigned u = __builtin_bit_cast(unsigned, f); return (u + 0x7fffu + ((u >> 16) & 1u)) >> 16; }
__device__ __forceinline__ unsigned pk2(float lo, float hi) { typedef float f2_t __attribute__((ext_vector_type(2))); typedef __bf16 b2_t __attribute__((ext_vector_type(2))); const f2_t v = {lo, hi}; return __builtin_bit_cast(unsigned, __builtin_convertvector(v, b2_t)); }
__device__ __forceinline__ float bf2f(unsigned short b) { return __builtin_bit_cast(float, (unsigned)b << 16); }
template <int CTRL> __device__ __forceinline__ float dppf(float v) { return __builtin_bit_cast(float, __builtin_amdgcn_update_dpp(0, __builtin_bit_cast(int, v), CTRL, 0xf, 0xf, false)); }
template <int O> __device__ __forceinline__ float shx(float v) { static_assert(O == 1 || O == 2, "exact xor partners: 1, 2"); return dppf<(O == 1) ? 0xB1 : 0x4E>(v); }
template <int O> __device__ __forceinline__ float shm(float v) { static_assert(O == 4 || O == 8, "mirror partners: 4 -> lane ^ 7, 8 -> lane ^ 15"); return dppf<(O == 4) ? 0x141 : 0x140>(v); }
__device__ __forceinline__ float sum16(float v) { const auto rr = __builtin_amdgcn_permlane16_swap(__float_as_uint(v), __float_as_uint(v), false, false); return __uint_as_float(rr[0]) + __uint_as_float(rr[1]); }
__device__ __forceinline__ float max16(float v) { const auto rr = __builtin_amdgcn_permlane16_swap(__float_as_uint(v), __float_as_uint(v), false, false); return fmaxf(__uint_as_float(rr[0]), __uint_as_float(rr[1])); }
__device__ __forceinline__ float other16(float v, bool odd_row) { const auto rr = __builtin_amdgcn_permlane16_swap(__float_as_uint(v), __float_as_uint(v), false, false); return __uint_as_float(odd_row ? rr[0] : rr[1]); }
__device__ __forceinline__ float sum32(float v) { const auto rr = __builtin_amdgcn_permlane32_swap(__float_as_uint(v), __float_as_uint(v), false, false); return __uint_as_float(rr[0]) + __uint_as_float(rr[1]); }
__device__ __forceinline__ float max32(float v) { const auto rr = __builtin_amdgcn_permlane32_swap(__float_as_uint(v), __float_as_uint(v), false, false); return fmaxf(__uint_as_float(rr[0]), __uint_as_float(rr[1])); }
__device__ __forceinline__ float other32(float v, bool upper) { const auto rr = __builtin_amdgcn_permlane32_swap(__float_as_uint(v), __float_as_uint(v), false, false); return __uint_as_float(upper ? rr[0] : rr[1]); }
__device__ __forceinline__ float wave_sum(float v) {
    v += shx<1>(v); v += shx<2>(v); v += shm<4>(v); v += shm<8>(v); v = sum16(v);
    return sum32(v);
}
__device__ __forceinline__ float gelu_tanh(float x) {
    constexpr float A = -2.0f * LOG2E * 0.7978845608028654f, B = A * 0.044715f;
    const float e = __builtin_amdgcn_exp2f(x * fmaf(x * x, B, A));
    return x * __builtin_amdgcn_rcpf(1.0f + e);
}
__device__ __forceinline__ float clamp8(float v) { return __builtin_amdgcn_fmed3f(v, -440.f, 440.f); }
__device__ __forceinline__ unsigned pk4_fp8(float a, float b, float c, float d) { int w = 0; w = __builtin_amdgcn_cvt_pk_fp8_f32(clamp8(a), clamp8(b), w, false); w = __builtin_amdgcn_cvt_pk_fp8_f32(clamp8(c), clamp8(d), w, true); return (unsigned)w; }
constexpr float WGU_SCALE = 64.f, WD_SCALE = 128.f, HID_SCALE = 8.f, YE_SCALE = 64.f;
__device__ __forceinline__ int crow(int r, int hi) { return (r & 3) + 8 * (r >> 2) + 4 * hi; }
__device__ __forceinline__ s16x4 tr_read(const LAS unsigned char* p) { return __builtin_bit_cast(s16x4, __builtin_amdgcn_ds_read_tr16_b64_v4i16((LAS v4i16_t*)p)); }
#define MFMA32(a, b, c) __builtin_amdgcn_mfma_f32_32x32x16_bf16((a), (b), (c), 0, 0, 0)

using pg8::Unit; using pg8::BM; using pg8::HALF;
__device__ __forceinline__ u32x4 pack8(const f32x4& a, const f32x4& b) { u32x4 w; w.x = pg8::cvt_pk_bf16(a[0], a[1]); w.y = pg8::cvt_pk_bf16(a[2], a[3]); w.z = pg8::cvt_pk_bf16(b[0], b[1]); w.w = pg8::cvt_pk_bf16(b[2], b[3]); return w; }

struct EpiIn {
    static constexpr bool PERM = true, AFTER_DRAIN = false;
    bf16* H; const float* qn; const float* kn; const float* gv; const float* bv; const float* rope; bf16* VT;
    __device__ __forceinline__ void operator()(const f32x4 (&acc)[2][2][4][2], const Unit& u, int wr, int wc, int fr, int fq) const {
        const int pn = u.pn;
        int mode; const float* gain = qn; float osc = 1.f;
        if (pn == 0) { mode = 1; osc = C2; } else if (pn <= 2) mode = 0; else if (pn <= 4) { mode = 2; gain = qn; osc = C2; }
        else if (pn == 5) { if (wc < 2) { mode = 2; gain = kn; osc = 1.f; } else mode = 0; } else if (pn == 6) mode = 3; else mode = 4;
        const int row0 = u.pm * BM + wr * 64 + fr;
        bf16* Hb = H + (size_t)row0 * DIN + pn * 256 + wc * 64 + 8 * fq;
#define EPI_ROWS(BODY) _Pragma("unroll") for (int ai = 0; ai < 2; ++ai) _Pragma("unroll") for (int m = 0; m < 4; ++m) { const int rofs = ai * HALF + m * 16; f32x4 v[2][2]; \
            _Pragma("unroll") for (int bj = 0; bj < 2; ++bj) _Pragma("unroll") for (int n = 0; n < 2; ++n) v[bj][n] = acc[ai][bj][m][n]; \
            BODY \
            bf16* rowp = Hb + (size_t)rofs * DIN; _Pragma("unroll") for (int bj = 0; bj < 2; ++bj) *(u32x4*)(rowp + 32 * bj) = pack8(v[bj][0], v[bj][1]); }
#define EPI_ALL(EXPR) _Pragma("unroll") for (int bj = 0; bj < 2; ++bj) _Pragma("unroll") for (int n = 0; n < 2; ++n) { EXPR }
        if (mode == 5) {
#pragma unroll
            for (int ai = 0; ai < 2; ++ai)
#pragma unroll
                for (int m = 0; m < 4; ++m) { const int t = row0 + ai * HALF + m * 16; bf16* vb = VT + ((size_t)((t >> 12) * 4 + wc) * 64 + 8 * fq) * VTP + (t & (SEQ - 1));
#pragma unroll
                    for (int bj = 0; bj < 2; ++bj)
#pragma unroll
                        for (int n = 0; n < 2; ++n)
#pragma unroll
                            for (int i = 0; i < 4; ++i) vb[(size_t)(32 * bj + 4 * n + i) * VTP] = (bf16)f2bf(acc[ai][bj][m][n][i]); }
        }
        else if (mode == 0) { EPI_ROWS( ; ) }
        else if (mode == 1) { EPI_ROWS( EPI_ALL( v[bj][n] = v[bj][n] * osc; ) ) }
        else if (mode == 2) {
            EPI_ROWS(
                float ss = 0.f;
                EPI_ALL( const f32x4 x = v[bj][n]; ss += (x[0] * x[0] + x[1] * x[1]) + (x[2] * x[2] + x[3] * x[3]); )
                ss = sum16(ss); ss = sum32(ss);
                const float rstd = osc * __builtin_amdgcn_rsqf(ss * (1.0f / 64.0f) + QK_EPS);
                const int sp = (row0 + rofs) & (SEQ - 1);
                EPI_ALL(
                    const f32x4 gg = *(const f32x4*)(gain + 32 * bj + 8 * fq + 4 * n);
                    const f32x4 cs = *(const f32x4*)(rope + ((size_t)sp * 32 + 16 * bj + 4 * fq + 2 * n) * 2);
                    const f32x4 x = v[bj][n] * rstd * gg;
                    f32x4 o; o[0] = x[0] * cs[0] - x[1] * cs[1]; o[1] = x[0] * cs[1] + x[1] * cs[0]; o[2] = x[2] * cs[2] - x[3] * cs[3]; o[3] = x[2] * cs[3] + x[3] * cs[2];
                    v[bj][n] = o; )
                asm volatile("" ::: "memory");
            )
        } else if (mode == 3) {
            EPI_ROWS( EPI_ALL( f32x4 x = v[bj][n]; x[0] = gelu_tanh(x[0]); x[1] = gelu_tanh(x[1]); x[2] = gelu_tanh(x[2]); x[3] = gelu_tanh(x[3]); v[bj][n] = x; ) )
        } else {
            EPI_ROWS(
                EPI_ALL( f32x4 x = v[bj][n]; x[0] = gelu_tanh(x[0]); x[1] = gelu_tanh(x[1]); x[2] = gelu_tanh(x[2]); x[3] = gelu_tanh(x[3]); v[bj][n] = x; )
                float sm = 0.f;
                EPI_ALL( const f32x4 x = v[bj][n]; sm += (x[0] + x[1]) + (x[2] + x[3]); )
                sm = sum16(sm); sm = sum32(sm);
                const float mean = sm * (1.0f / 64.0f); float q = 0.f;
                EPI_ALL( const f32x4 d = v[bj][n] - mean; v[bj][n] = d; q += (d[0] * d[0] + d[1] * d[1]) + (d[2] * d[2] + d[3] * d[3]); )
                q = sum16(q); q = sum32(q);
                const float rstd = __builtin_amdgcn_rsqf(q * (1.0f / 64.0f) + LN_EPS);
                EPI_ALL( const f32x4 gg = *(const f32x4*)(gv + wc * 64 + 32 * bj + 8 * fq + 4 * n); const f32x4 bb = *(const f32x4*)(bv + wc * 64 + 32 * bj + 8 * fq + 4 * n); v[bj][n] = v[bj][n] * rstd * gg + bb; )
                asm volatile("" ::: "memory");
            )
        }
#undef EPI_ROWS
#undef EPI_ALL
    }
};
struct EpiRes {
    static constexpr bool PERM = true, AFTER_DRAIN = false;
    const bf16* XB; bf16* S;
    __device__ __forceinline__ void operator()(const f32x4 (&acc)[2][2][4][2], const Unit& u, int wr, int wc, int fr, int fq) const {
        const int row0 = u.pm * BM + wr * 64 + fr, col0 = u.pn * BM + wc * 32 + 8 * fq;
#pragma unroll
        for (int ai = 0; ai < 2; ++ai)
#pragma unroll
            for (int m = 0; m < 4; ++m) { const size_t ro = (size_t)(row0 + ai * HALF + m * 16) * DM + col0;
#pragma unroll
                for (int bj = 0; bj < 2; ++bj) { const u32x4 xw = *(const u32x4*)(XB + ro + bj * HALF);
                    f32x4 x0, x1; x0[0] = __builtin_bit_cast(float, xw.x << 16); x0[1] = __builtin_bit_cast(float, xw.x & 0xffff0000u); x0[2] = __builtin_bit_cast(float, xw.y << 16); x0[3] = __builtin_bit_cast(float, xw.y & 0xffff0000u);
                    x1[0] = __builtin_bit_cast(float, xw.z << 16); x1[1] = __builtin_bit_cast(float, xw.z & 0xffff0000u); x1[2] = __builtin_bit_cast(float, xw.w << 16); x1[3] = __builtin_bit_cast(float, xw.w & 0xffff0000u);
                    const f32x4 s0 = x0 * DN_ALPHA + acc[ai][bj][m][0], s1 = x1 * DN_ALPHA + acc[ai][bj][m][1];
                    u32x4 o; o.x = pk2(s0[0], s0[1]); o.y = pk2(s0[2], s0[3]); o.z = pk2(s1[0], s1[1]); o.w = pk2(s1[2], s1[3]); *(u32x4*)(S + ro + bj * HALF) = o; } }
    }
};
struct EpiSwiglu {
    static constexpr bool PERM = true, AFTER_DRAIN = false;
    unsigned char* HID;
    __device__ __forceinline__ void operator()(const f32x4 (&acc)[2][2][4][2], const Unit& u, int wr, int wc, int fr, int fq) const {
        const int row0 = u.pm * BM + wr * 64 + fr, col0 = u.pn * 128 + wc * 32 + 8 * fq;
        constexpr float IS = 1.0f / WGU_SCALE, OS = HID_SCALE / WGU_SCALE;
#pragma unroll
        for (int ai = 0; ai < 2; ++ai)
#pragma unroll
            for (int m = 0; m < 4; ++m) { f32x4 o[2];
#pragma unroll
                for (int n = 0; n < 2; ++n) {
                    f32x4 t = acc[ai][0][m][n] * (-LOG2E * IS);
#pragma unroll
                    for (int i = 0; i < 4; ++i) t[i] = __builtin_amdgcn_exp2f(t[i]);
                    t = t * (1.0f / (IS * OS)) + (1.0f / (IS * OS));
#pragma unroll
                    for (int i = 0; i < 4; ++i) t[i] = __builtin_amdgcn_rcpf(t[i]);
                    o[n] = acc[ai][0][m][n] * acc[ai][1][m][n] * t; }
                u32x2 w; w.x = pk4_fp8(o[0][0], o[0][1], o[0][2], o[0][3]); w.y = pk4_fp8(o[1][0], o[1][1], o[1][2], o[1][3]);
                *(u32x2*)(HID + (size_t)(row0 + ai * HALF + m * 16) * DEXP + col0) = w; }
    }
};
struct EpiDown {
    static constexpr bool PERM = true, AFTER_DRAIN = false;
    unsigned char* YE; const float* gate;
    __device__ __forceinline__ void operator()(const f32x4 (&acc)[2][2][4][2], const Unit& u, int wr, int wc, int fr, int fq) const {
        const int row0 = u.pm * BM + wr * 64 + fr, col0 = u.pn * BM + wc * 32 + 8 * fq;
#pragma unroll
        for (int ai = 0; ai < 2; ++ai)
#pragma unroll
            for (int m = 0; m < 4; ++m) { const int row = row0 + ai * HALF + m * 16; const float gt = gate[row] * (YE_SCALE / (WD_SCALE * HID_SCALE));
#pragma unroll
                for (int bj = 0; bj < 2; ++bj) { const f32x4 a = acc[ai][bj][m][0] * gt, c = acc[ai][bj][m][1] * gt; u32x2 w; w.x = pk4_fp8(a[0], a[1], a[2], a[3]); w.y = pk4_fp8(c[0], c[1], c[2], c[3]);
                    *(u32x2*)(YE + (size_t)row * DM + col0 + bj * HALF) = w; } }
    }
};

struct Frame {
    LAS unsigned char* lds;
    int tid, lane, wave, vcu, G, gw, NGW;
};

__device__ __forceinline__ void transpose_item(const float* W, int N, int K, bf16* dst_row0, LAS float* scr, int k0, int n0, int lane) {
    float tv[32];
#pragma unroll
    for (int i = 0; i < 32; ++i) tv[i] = __builtin_nontemporal_load(W + (size_t)(k0 + 2 * i + (lane >> 5)) * N + n0 + (lane & 31));
#pragma unroll
    for (int i = 0; i < 32; ++i) scr[(2 * i + (lane >> 5)) * 33 + (lane & 31)] = tv[i];
    asm volatile("s_waitcnt lgkmcnt(0)" ::: "memory");
    const int c = lane & 7;
#pragma unroll
    for (int j = 0; j < 4; ++j) { const int n = (lane >> 3) + 8 * j; const LAS float* s = scr + (8 * c) * 33 + n;
        u32x4 o; o.x = pk2(s[0 * 33], s[1 * 33]); o.y = pk2(s[2 * 33], s[3 * 33]); o.z = pk2(s[4 * 33], s[5 * 33]); o.w = pk2(s[6 * 33], s[7 * 33]);
        *(u32x4*)(dst_row0 + (size_t)n * K + k0 + 8 * c) = o; }
    asm volatile("s_waitcnt lgkmcnt(0)" ::: "memory");
}
__device__ __forceinline__ void transpose_item_fp8(const float* W, int N, int K, unsigned char* dst_row0, LAS float* scr, int k0, int n0, int lane, float sc) {
    float tv[32];
#pragma unroll
    for (int i = 0; i < 32; ++i) tv[i] = __builtin_nontemporal_load(W + (size_t)(k0 + 2 * i + (lane >> 5)) * N + n0 + (lane & 31));
#pragma unroll
    for (int i = 0; i < 32; ++i) scr[(2 * i + (lane >> 5)) * 33 + (lane & 31)] = tv[i];
    asm volatile("s_waitcnt lgkmcnt(0)" ::: "memory");
    const int c = lane & 7;
#pragma unroll
    for (int j = 0; j < 4; ++j) { const int n = (lane >> 3) + 8 * j; const LAS float* s = scr + (8 * c) * 33 + n;
        u32x2 o; o.x = pk4_fp8(s[0 * 33] * sc, s[1 * 33] * sc, s[2 * 33] * sc, s[3 * 33] * sc); o.y = pk4_fp8(s[4 * 33] * sc, s[5 * 33] * sc, s[6 * 33] * sc, s[7 * 33] * sc);
        *(u32x2*)(dst_row0 + (size_t)n * K + k0 + 8 * c) = o; }
    asm volatile("s_waitcnt lgkmcnt(0)" ::: "memory");
}
__device__ __forceinline__ void conv_phase(Frame& F, int l, const float* w_in, const float* w_out, const float* w_gate, const float* w_up, const float* w_down, const float* sg_w, unsigned char* ws0, int it_lo, int it_hi, int vgw, int vngw, bool tail) {
    unsigned char* ws = ws0 + wset(l);
    LAS float* scr = (LAS float*)(F.lds + F.wave * 16384);
    bf16* WIN = (bf16*)(ws + WS_WIN); bf16* WOUT = (bf16*)(ws + WS_WOUT); unsigned char* WGU = ws + WS_WGU; unsigned char* WD = ws + WS_WD; bf16* WSB = (bf16*)(ws + WS_WSBF);
    constexpr int I_IN = 16 * 64, I_OUT = 16 * 32, I_G = 16 * 1024, I_D = 16 * 1024, NIT = I_IN + I_OUT + 2 * I_G + I_D;
    if (it_hi > NIT) it_hi = NIT;
    for (int it = it_lo + vgw; it < it_hi; it += vngw) {
        int r = it;
        if (r < I_IN) { const int kb = r >> 6, nb = r & 63, n0 = 32 * nb; const int pn = n0 >> 8, c = n0 & 255, wc = c >> 6, bj = (c >> 5) & 1;
            transpose_item(w_in + (size_t)l * DM * DIN, DIN, DM, WIN + (size_t)(256 * pn + 128 * bj + 32 * wc) * DM, scr, 64 * kb, n0, F.lane); continue; }
        r -= I_IN;
        if (r < I_OUT) { const int kb = r >> 5, nb = r & 31, n0 = 32 * nb;
            transpose_item(w_out + (size_t)l * DM * DM, DM, DM, WOUT + (size_t)n0 * DM, scr, 64 * kb, n0, F.lane); continue; }
        r -= I_OUT;
        if (r < 2 * I_G) { const int which = r >= I_G; if (which) r -= I_G; const int e = r >> 10, kb = (r >> 6) & 15, nb = r & 63, n0 = 32 * nb;
            const float* W = (which ? w_up : w_gate) + ((size_t)l * NEXP + e) * DM * DEXP;
            transpose_item_fp8(W, DEXP, DM, WGU + ((size_t)e * 4096 + (n0 >> 7) * 256 + which * 128 + (n0 & 127)) * DM, scr, 64 * kb, n0, F.lane, WGU_SCALE); continue; }
        r -= 2 * I_G;
        { const int e = r >> 10, kb = (r >> 5) & 31, nb = r & 31, n0 = 32 * nb;
            transpose_item_fp8(w_down + ((size_t)l * NEXP + e) * DEXP * DM, DM, DEXP, WD + ((size_t)e * DM + n0) * DEXP, scr, 64 * kb, n0, F.lane, WD_SCALE); }
    }
    if (tail) { const float* sw = sg_w + (size_t)l * 4 * 128 * 128;
        for (int i = vgw * 64 + F.lane; i < 4 * 128 * 128; i += vngw * 64) WSB[i] = (bf16)f2bf(sw[i]); }
}

__device__ __forceinline__ f32x4 bf4(u32x2 w) { f32x4 r; r[0] = __builtin_bit_cast(float, w.x << 16); r[1] = __builtin_bit_cast(float, w.x & 0xffff0000u); r[2] = __builtin_bit_cast(float, w.y << 16); r[3] = __builtin_bit_cast(float, w.y & 0xffff0000u); return r; }
__device__ __forceinline__ void row_ln(f32x4 (&v)[4], const float* g, const float* b, int lane) {
    float s = 0.f;
#pragma unroll
    for (int j = 0; j < 4; ++j) s += (v[j][0] + v[j][1]) + (v[j][2] + v[j][3]);
    const float mean = wave_sum(s) * (1.f / DM); float s2 = 0.f;
#pragma unroll
    for (int j = 0; j < 4; ++j) { v[j] = v[j] - mean; s2 += (v[j][0] * v[j][0] + v[j][1] * v[j][1]) + (v[j][2] * v[j][2] + v[j][3] * v[j][3]); }
    const float rstd = 1.f / sqrtf(wave_sum(s2) * (1.f / DM) + LN_EPS);
#pragma unroll
    for (int j = 0; j < 4; ++j) { const f32x4 gg = *(const f32x4*)(g + 4 * lane + 256 * j), bb = *(const f32x4*)(b + 4 * lane + 256 * j); v[j] = v[j] * rstd * gg + bb; }
}
__device__ __forceinline__ void row_ln_stats(f32x4 (&v)[4], const float* g, const float* b, int lane, float& mean_o, float& rstd_o) {
    float s = 0.f;
#pragma unroll
    for (int j = 0; j < 4; ++j) s += (v[j][0] + v[j][1]) + (v[j][2] + v[j][3]);
    const float mean = wave_sum(s) * (1.f / DM); float s2 = 0.f;
#pragma unroll
    for (int j = 0; j < 4; ++j) { v[j] = v[j] - mean; s2 += (v[j][0] * v[j][0] + v[j][1] * v[j][1]) + (v[j][2] * v[j][2] + v[j][3] * v[j][3]); }
    const float rstd = 1.f / sqrtf(wave_sum(s2) * (1.f / DM) + LN_EPS);
#pragma unroll
    for (int j = 0; j < 4; ++j) { const f32x4 gg = *(const f32x4*)(g + 4 * lane + 256 * j), bb = *(const f32x4*)(b + 4 * lane + 256 * j); v[j] = v[j] * rstd * gg + bb; }
    mean_o = mean; rstd_o = rstd;
}
__device__ __forceinline__ void store_row(const f32x4 (&v)[4], float* xrow, bf16* xbrow, int lane) {
#pragma unroll
    for (int j = 0; j < 4; ++j) { *(f32x4*)(xrow + 4 * lane + 256 * j) = v[j]; u32x2 w; w.x = pk2(v[j][0], v[j][1]); w.y = pk2(v[j][2], v[j][3]); *(u32x2*)(xbrow + 4 * lane + 256 * j) = w; }
}

__device__ __forceinline__ void store_row_bf(const f32x4 (&v)[4], bf16* xbrow, int lane) {
#pragma unroll
    for (int j = 0; j < 4; ++j) { u32x2 w; w.x = pk2(v[j][0], v[j][1]); w.y = pk2(v[j][2], v[j][3]); *(u32x2*)(xbrow + 4 * lane + 256 * j) = w; }
}
__device__ __forceinline__ void prologue_phase(Frame& F, const float* xp, const float* xs, const float* g, const float* b, float* X, unsigned char* ws) {
    float* rope = (float*)(ws + WS_ROPE);
    for (int i = F.gw * 64 + F.lane; i < SEQ * 32; i += F.NGW * 64) {
        const int s = i >> 5, p = i & 31, fi = p & 15; const float pos = (float)((p < 16) ? (s >> 6) : (s & 63));
        const float inv = powf(10000.0f, -(float)fi / 16.0f); const float ang = pos * inv;
        rope[2 * i] = cosf(ang); rope[2 * i + 1] = sinf(ang);
    }
    bf16* XB = (bf16*)(ws + WS_XB);
    for (int m = F.gw; m < TT; m += F.NGW) {
        const float* src = (m < T_P) ? xp + (size_t)m * DM : xs + (size_t)(m - T_P) * DM;
        f32x4 v[4];
#pragma unroll
        for (int j = 0; j < 4; ++j) v[j] = *(const f32x4*)(src + 4 * F.lane + 256 * j);
        row_ln(v, g, b, F.lane);
        store_row_bf(v, XB + (size_t)m * DM, F.lane);
    }
}

__device__ __forceinline__ float router_reduce(float (&lg)[16], int lane) {
    float r8[8], r4[4], r2[2], r1;
    const bool b5 = lane & 32, b4 = lane & 16, b3 = lane & 8, b2 = lane & 4;
#pragma unroll
    for (int i = 0; i < 8; ++i) { const float snd = b5 ? lg[i] : lg[i + 8], kp = b5 ? lg[i + 8] : lg[i]; r8[i] = kp + other32(snd, b5); }
#pragma unroll
    for (int i = 0; i < 4; ++i) { const float snd = b4 ? r8[i] : r8[i + 4], kp = b4 ? r8[i + 4] : r8[i]; r4[i] = kp + other16(snd, b4); }
#pragma unroll
    for (int i = 0; i < 2; ++i) { const float snd = b3 ? r4[i] : r4[i + 2], kp = b3 ? r4[i + 2] : r4[i]; r2[i] = kp + shm<8>(snd); }
    { const float snd = b2 ? r2[0] : r2[1], kp = b2 ? r2[1] : r2[0]; r1 = kp + shm<4>(snd); }
    r1 += shx<1>(r1); r1 += shx<2>(r1);
    float mx = r1;
    mx = fmaxf(mx, shm<4>(mx)); mx = fmaxf(mx, shm<8>(mx)); mx = max16(mx); mx = max32(mx);
    const float ex = expf(r1 - mx); float sm = ex;
    sm += shm<4>(sm); sm += shm<8>(sm); sm = sum16(sm); sm = sum32(sm);
    return ex / sm;
}
template <bool DRY> __device__ __forceinline__ void ln1_router_mfma(Frame& F, const bf16* X, const float* g, const float* b, const float* wr, unsigned char* ws) {
    constexpr int WP = 2064;
    LAS unsigned char* WH = F.lds; LAS unsigned char* WL = F.lds + 16 * WP;
    LAS float* GB = (LAS float*)(F.lds + 2 * 16 * WP);
    LAS float* PART = GB + 2048;
    LAS float* CST = PART + 1024;
    LAS float* WST = CST + 32 + F.wave * 32;
    { const int e = F.tid & 15, part = F.tid >> 4; float sg = 0.f, sb = 0.f;
      for (int i = 0; i < 32; ++i) { const int c = part * 32 + i; const float w = wr[c * 16 + e]; const float wp = g[c] * w;
          const unsigned hi = f2bf(wp); const float hif = __builtin_bit_cast(float, hi << 16); const unsigned lo = f2bf(wp - hif);
          *(LAS unsigned short*)(WH + e * WP + c * 2) = (unsigned short)hi; *(LAS unsigned short*)(WL + e * WP + c * 2) = (unsigned short)lo;
          sg += hif + __builtin_bit_cast(float, lo << 16); sb += b[c] * w; }
      PART[part * 16 + e] = sg; PART[512 + part * 16 + e] = sb; }
    for (int i = F.tid; i < DM; i += NWAVES * 64) { GB[i] = g[i]; GB[DM + i] = b[i]; }
    __syncthreads();
    if (F.tid < 32) { const int e = F.tid & 15, which = F.tid >> 4; float a = 0.f; for (int p2 = 0; p2 < 32; ++p2) a += PART[which * 512 + p2 * 16 + e]; CST[which * 16 + e] = a; }
    __syncthreads();
    unsigned char* XB8 = ws + (DRY ? WS_DUMMY + 16 * MiB : WS_XB8); float* AFF = (float*)(ws + (DRY ? WS_DUMMY + 100 * MiB : WS_AFF)); float* ST = (float*)(ws + (DRY ? WS_DUMMY : WS_STATS));
    const int lane = F.lane, r16 = lane & 15, q = lane >> 4;
    const float Ge = CST[r16], Bce = CST[16 + r16];
    constexpr int NBLK = TT / 16;
    const int blo = (int)((long)NBLK * F.vcu / F.G), bhi = (int)((long)NBLK * (F.vcu + 1) / F.G);
    for (int blk = blo + F.wave; blk < bhi; blk += NWAVES) {
        const int m0 = blk * 16;
        const bf16* src = X + (size_t)(m0 + r16) * DM + 16 * q;
        u32x4 sr[32];
#pragma unroll
        for (int t = 0; t < 16; ++t) { sr[2 * t] = *(const u32x4*)(src + 64 * t); sr[2 * t + 1] = *(const u32x4*)(src + 64 * t + 8); }
        f32x4 acc = (f32x4){0.f, 0.f, 0.f, 0.f}; float s1 = 0.f, s2 = 0.f;
        const LAS unsigned char* wh = WH + r16 * WP + 32 * q; const LAS unsigned char* wl = WL + r16 * WP + 32 * q;
#pragma unroll
        for (int u = 0; u < 32; ++u) { const u32x4 w = sr[u];
            const bf16x8 bh = *(const LAS bf16x8*)(wh + (u >> 1) * 128 + (u & 1) * 16), bl = *(const LAS bf16x8*)(wl + (u >> 1) * 128 + (u & 1) * 16);
            const bf16x8 a = __builtin_bit_cast(bf16x8, w);
            acc = __builtin_amdgcn_mfma_f32_16x16x32_bf16(a, bh, acc, 0, 0, 0); acc = __builtin_amdgcn_mfma_f32_16x16x32_bf16(a, bl, acc, 0, 0, 0);
#pragma unroll
            for (int d = 0; d < 4; ++d) { const float x0 = __builtin_bit_cast(float, w[d] << 16), x1 = __builtin_bit_cast(float, w[d] & 0xffff0000u); s1 += x0 + x1; s2 = fmaf(x0, x0, s2); s2 = fmaf(x1, x1, s2); }
            if ((u & 3) == 3) asm volatile("" ::: "memory"); }
        s1 = sum16(s1); s1 = sum32(s1); s2 = sum16(s2); s2 = sum32(s2);
        const float mean = s1 * (1.f / DM); const float rstd = 1.f / sqrtf(fmaxf(s2 * (1.f / DM) - mean * mean, 0.f) + LN_EPS);
        if (q == 0) { f32x2v st; st[0] = mean; st[1] = rstd; *(f32x2v*)(ST + (size_t)(m0 + r16) * 2) = st; WST[r16] = mean; WST[16 + r16] = rstd; }
        asm volatile("s_waitcnt lgkmcnt(0)" ::: "memory");
        const f32x4 mu4 = *(const LAS f32x4*)(WST + 4 * q), rs4 = *(const LAS f32x4*)(WST + 16 + 4 * q);
        f32x4 af;
#pragma unroll
        for (int i = 0; i < 4; ++i) { const float lg = rs4[i] * (acc[i] - mu4[i] * Ge) + Bce;
            float mx = lg; mx = fmaxf(mx, shx<1>(mx)); mx = fmaxf(mx, shx<2>(mx)); mx = fmaxf(mx, shm<4>(mx)); mx = fmaxf(mx, shm<8>(mx));
            const float ex = expf(lg - mx); float sm = ex; sm += shx<1>(sm); sm += shx<2>(sm); sm += shm<4>(sm); sm += shm<8>(sm);
            af[i] = ex / sm; }
        { const int m = m0 + 4 * q; const size_t off = (m < T_P) ? (size_t)r16 * T_P + m : (size_t)16 * T_P + (size_t)r16 * T_S + (m - T_P);
          *(f32x4*)(AFF + off) = af; }
        asm volatile("" ::: "memory");
#pragma unroll
        for (int u = 0; u < 32; ++u) asm volatile("" : "+v"(sr[u]));
        const float nmr = -mean * rstd;
        unsigned char* dst = XB8 + (size_t)(m0 + r16) * DM + 16 * q;
#pragma unroll
        for (int t = 0; t < 16; ++t) { u32x4 o;
#pragma unroll
            for (int h = 0; h < 2; ++h) { const u32x4 w = sr[2 * t + h]; const LAS float* gp = GB + 64 * t + 16 * q + 8 * h;
                const f32x4 g0 = *(const LAS f32x4*)gp, g1 = *(const LAS f32x4*)(gp + 4), b0 = *(const LAS f32x4*)(gp + DM), b1 = *(const LAS f32x4*)(gp + DM + 4);
                float x[8];
#pragma unroll
                for (int d = 0; d < 4; ++d) { x[2 * d] = fmaf(__builtin_bit_cast(float, w[d] << 16), rstd, nmr); x[2 * d + 1] = fmaf(__builtin_bit_cast(float, w[d] & 0xffff0000u), rstd, nmr); }
                const unsigned p0 = pk4_fp8(fmaf(x[0], g0[0], b0[0]), fmaf(x[1], g0[1], b0[1]), fmaf(x[2], g0[2], b0[2]), fmaf(x[3], g0[3], b0[3]));
                const unsigned p1 = pk4_fp8(fmaf(x[4], g1[0], b1[0]), fmaf(x[5], g1[1], b1[1]), fmaf(x[6], g1[2], b1[2]), fmaf(x[7], g1[3], b1[3]));
                if (h == 0) { o.x = p0; o.y = p1; } else { o.z = p0; o.w = p1; } }
            *(u32x4*)(dst + 64 * t) = o; asm volatile("" ::: "memory"); }
    }
    __syncthreads();
}
template <bool DRY> __device__ __forceinline__ void ln1_router_phase(Frame& F, const bf16* X, const float* g, const float* b, const float* wr, unsigned char* ws) {
    constexpr int NR = LN1_ROWS;
    LAS float* wl = (LAS float*)F.lds;
    for (int i = F.tid; i < DM * NEXP; i += NWAVES * 64) wl[(i & 15) * DM + (i >> 4)] = wr[i];
    __syncthreads();
    unsigned char* XB8 = ws + (DRY ? WS_DUMMY + 16 * MiB : WS_XB8); float* AFF = (float*)(ws + (DRY ? WS_DUMMY + 100 * MiB : WS_AFF)); float* ST = (float*)(ws + (DRY ? WS_DUMMY : WS_STATS));
    const int lane = F.lane, e_mine = ((lane >> 5) & 1) * 8 + ((lane >> 4) & 1) * 4 + ((lane >> 3) & 1) * 2 + ((lane >> 2) & 1);
    int m = NR * F.gw;
    u32x2 nx[NR][4];
#pragma unroll
    for (int r = 0; r < NR; ++r)
#pragma unroll
        for (int j = 0; j < 4; ++j) nx[r][j] = (u32x2){0u, 0u};
    if (m < TT) {
#pragma unroll
        for (int r = 0; r < NR; ++r)
#pragma unroll
            for (int j = 0; j < 4; ++j) nx[r][j] = *(const u32x2*)(X + (size_t)(m + r) * DM + 4 * lane + 256 * j); }
    for (; m < TT; m += NR * F.NGW) {
        f32x4 v[NR][4];
#pragma unroll
        for (int r = 0; r < NR; ++r)
#pragma unroll
            for (int j = 0; j < 4; ++j) v[r][j] = bf4(nx[r][j]);
        { const int mn = m + NR * F.NGW;
          if (mn < TT) {
#pragma unroll
            for (int r = 0; r < NR; ++r)
#pragma unroll
                for (int j = 0; j < 4; ++j) nx[r][j] = *(const u32x2*)(X + (size_t)(mn + r) * DM + 4 * lane + 256 * j); } }
        float mu[NR], rs[NR];
#pragma unroll
        for (int r = 0; r < NR; ++r) row_ln_stats(v[r], g, b, lane, mu[r], rs[r]);
        if (lane == 0) {
#pragma unroll
            for (int r = 0; r < NR; r += 2) { f32x4 st; st[0] = mu[r]; st[1] = rs[r]; st[2] = mu[r + 1]; st[3] = rs[r + 1]; *(f32x4*)(ST + (size_t)(m + r) * 2) = st; } }
#pragma unroll
        for (int r = 0; r < NR; ++r)
#pragma unroll
            for (int j = 0; j < 4; ++j) *(unsigned*)(XB8 + (size_t)(m + r) * DM + 4 * lane + 256 * j) = pk4_fp8(v[r][j][0], v[r][j][1], v[r][j][2], v[r][j][3]);
        float lg[NR][16];
#pragma unroll
        for (int e = 0; e < 16; ++e) { f32x4 a[NR];
#pragma unroll
            for (int r = 0; r < NR; ++r) a[r] = (f32x4){0.f, 0.f, 0.f, 0.f};
#pragma unroll
            for (int j = 0; j < 4; ++j) { const f32x4 w = *(const LAS f32x4*)(wl + e * DM + 4 * lane + 256 * j);
#pragma unroll
                for (int r = 0; r < NR; ++r) a[r] += v[r][j] * w; }
#pragma unroll
            for (int r = 0; r < NR; ++r) lg[r][e] = (a[r][0] + a[r][1]) + (a[r][2] + a[r][3]);
            if ((e & 3) == 3) asm volatile("" ::: "memory"); }
        float af[NR];
#pragma unroll
        for (int r = 0; r < NR; ++r) af[r] = router_reduce(lg[r], lane);
        if ((lane & 3) == 0) { const size_t off = (m < T_P) ? (size_t)e_mine * T_P + m : (size_t)16 * T_P + (size_t)e_mine * T_S + (m - T_P);
#pragma unroll
            for (int r = 0; r < NR; ++r) AFF[off + r] = af[r]; }
    }
    __syncthreads();
}

constexpr int TK_COPIES = 8, TK_STRIDE = 2048;
template <int NB>
__device__ __forceinline__ void bin_search(LAS unsigned* hist, LAS unsigned* wtot, LAS unsigned* res, unsigned remaining, int tid, int lane, int wave, unsigned& bin, unsigned& rem_out) {
    constexpr int BPT = NB / 512;
    unsigned hb[BPT]; unsigned own = 0;
#pragma unroll
    for (int k = 0; k < BPT; ++k) { unsigned a = 0;
#pragma unroll
        for (int c = 0; c < TK_COPIES; ++c) a += hist[c * TK_STRIDE + tid * BPT + k];
        hb[k] = a; own += a; }
    unsigned x = own;
#pragma unroll
    for (int o = 1; o < 64; o <<= 1) { const unsigned y = (unsigned)__builtin_amdgcn_ds_bpermute((lane + o) << 2, (int)x); if (lane + o < 64) x += y; }
    if (lane == 0) wtot[wave] = x;
    __syncthreads();
    unsigned above = 0;
#pragma unroll
    for (int w = 0; w < 8; ++w) above += (w > wave) ? wtot[w] : 0u;
    const unsigned suf_incl = x + above, suf_excl = suf_incl - own;
    if (suf_excl < remaining && remaining <= suf_incl) {
        unsigned c = suf_excl; bool done = false;
#pragma unroll
        for (int k = BPT - 1; k >= 0; --k) { if (!done && c + hb[k] >= remaining) { res[0] = (unsigned)(tid * BPT + k); res[1] = remaining - c; done = true; } c += hb[k]; }
    }
    __syncthreads();
    bin = res[0]; rem_out = res[1];
    __syncthreads();
}
template <int NPT>
__device__ __forceinline__ void topk_block(Frame& F, const unsigned* vals, int cap, int slotbase, int tokbase, int e, unsigned char* ws) {
    LAS unsigned* hist = (LAS unsigned*)F.lds; LAS unsigned* wtot = hist + TK_COPIES * TK_STRIDE; LAS unsigned* res = wtot + 16;
    const int base = F.wave * (NPT * 64) + F.lane;
    unsigned v[NPT];
#pragma unroll
    for (int j = 0; j < NPT; ++j) v[j] = vals[base + j * 64];
    LAS unsigned* hc = hist + (F.lane & 7) * TK_STRIDE;
    unsigned remaining = (unsigned)cap, prefix = 0, bin;
#define TK_ZERO() do { for (int i = F.tid; i < TK_COPIES * TK_STRIDE; i += 512) hist[i] = 0u; __syncthreads(); } while (0)
#define TK_ADD(idx) (void)__hip_atomic_fetch_add(&hc[(idx)], 1u, __ATOMIC_RELAXED, __HIP_MEMORY_SCOPE_WORKGROUP)
    TK_ZERO();
#pragma unroll
    for (int j = 0; j < NPT; ++j) { unsigned vv = v[j]; asm volatile("" : "+v"(vv) :: "memory"); TK_ADD(vv >> 21); }
    __syncthreads();
    bin_search<2048>(hist, wtot, res, remaining, F.tid, F.lane, F.wave, bin, remaining); prefix = bin;
    TK_ZERO();
#pragma unroll
    for (int j = 0; j < NPT; ++j) { unsigned vv = v[j]; asm volatile("" : "+v"(vv) :: "memory"); if ((vv >> 21) == prefix) TK_ADD((vv >> 10) & 2047u); }
    __syncthreads();
    bin_search<2048>(hist, wtot, res, remaining, F.tid, F.lane, F.wave, bin, remaining); prefix = (prefix << 11) | bin;
    TK_ZERO();
#pragma unroll
    for (int j = 0; j < NPT; ++j) { unsigned vv = v[j]; asm volatile("" : "+v"(vv) :: "memory"); if ((vv >> 10) == prefix) TK_ADD(vv & 1023u); }
    __syncthreads();
    bin_search<1024>(hist, wtot, res, remaining, F.tid, F.lane, F.wave, bin, remaining);
#undef TK_ZERO
#undef TK_ADD
    const unsigned thr = (prefix << 10) | bin, need_eq = remaining;
    unsigned cg = 0, ce = 0;
#pragma unroll
    for (int j = 0; j < NPT; ++j) { unsigned vv = v[j]; asm volatile("" : "+v"(vv)); cg += (unsigned)__popcll(__ballot(vv > thr)); ce += (unsigned)__popcll(__ballot(vv == thr)); asm volatile("" : "+v"(cg), "+v"(ce)); }
    if (F.lane == 0) { wtot[F.wave] = cg; wtot[8 + F.wave] = ce; }
    __syncthreads();
    unsigned run_gt = 0, run_eq = 0;
#pragma unroll
    for (int w = 0; w < 8; ++w) { run_gt += (w < F.wave) ? wtot[w] : 0u; run_eq += (w < F.wave) ? wtot[8 + w] : 0u; }
    int* IDX = (int*)(ws + WS_IDX); float* GATE = (float*)(ws + WS_GATE); int* SLOTOF = (int*)(ws + WS_SLOTOF);
    const unsigned long long ltmask = (1ull << F.lane) - 1ull;
#pragma unroll
    for (int j = 0; j < NPT; ++j) {
        unsigned vv = v[j]; asm volatile("" : "+v"(vv));
        const bool gt = vv > thr, eq = vv == thr;
        const unsigned long long bg = __ballot(gt), be = __ballot(eq);
        const unsigned gb = (unsigned)__popcll(bg & ltmask), eb = (unsigned)__popcll(be & ltmask);
        const unsigned eq_rank = run_eq + eb;
        const bool sel = gt || (eq && eq_rank < need_eq);
        const unsigned slot = run_gt + gb + (eq_rank < need_eq ? eq_rank : need_eq);
        const int tok = tokbase + base + j * 64;
        if (sel) { IDX[slotbase + slot] = tok; GATE[slotbase + slot] = __builtin_bit_cast(float, vv); }
        SLOTOF[(size_t)e * TT + tok] = sel ? (int)(slotbase + slot) : -1;
        run_gt += (unsigned)__popcll(bg); run_eq += (unsigned)__popcll(be); asm volatile("" : "+v"(run_gt), "+v"(run_eq));
    }
    __syncthreads();
}
__device__ __forceinline__ void topk_phase(Frame& F, unsigned char* ws) {
    if (blockIdx.x >= 32) return;
    const int g = blockIdx.x >> 4, e = blockIdx.x & 15;
    const unsigned* aff = (const unsigned*)(ws + WS_AFF);
    if (g == 0) topk_block<T_P / 512>(F, aff + (size_t)e * T_P, CAP_P, e * CAP_P, 0, e, ws);
    else        topk_block<T_S / 512>(F, aff + (size_t)16 * T_P + (size_t)e * T_S, CAP_S, ROWS_P + e * CAP_S, T_P, e, ws);
}

__device__ __forceinline__ void gather_phase(Frame& F, unsigned char* ws) {
    const int* IDX = (const int*)(ws + WS_IDX); const unsigned char* XB8 = ws + WS_XB8; unsigned char* XE = ws + WS_H;
    for (int r = F.gw; r < ROWS_E; r += F.NGW) { const int tok = IDX[r];
        *(u32x4*)(XE + (size_t)r * DM + 16 * F.lane) = *(const u32x4*)(XB8 + (size_t)tok * DM + 16 * F.lane); }
}

template <bool DRY> __device__ __forceinline__ void combine_phase(Frame& F, float* X, const bf16* SB, const float* g1, const float* b1, const float* g, const float* b, unsigned char* ws, bool last_layer) {
    const int* SLOTOF = (const int*)(ws + WS_SLOTOF); const unsigned char* YE = ws + WS_H; bf16* XB = (bf16*)(ws + (DRY ? WS_DUMMY + 16 * MiB : WS_XB)); float* Xo = DRY ? (float*)(ws + WS_DUMMY + 16 * MiB) : X;
    const int lane = F.lane;
    int m = 2 * F.gw;
    int so_n = (m < TT) ? SLOTOF[(size_t)(lane & 15) * TT + m + ((lane >> 4) & 1)] : -1;
    for (; m < TT; m += 2 * F.NGW) {
        const int so = so_n; const int mn = m + 2 * F.NGW;
        so_n = (mn < TT) ? SLOTOF[(size_t)(lane & 15) * TT + mn + ((lane >> 4) & 1)] : -1;
        f32x4 v0[4], v1[4];
#pragma unroll
        for (int j = 0; j < 4; ++j) { v0[j] = bf4(*(const u32x2*)(SB + (size_t)m * DM + 4 * lane + 256 * j)); v1[j] = bf4(*(const u32x2*)(SB + (size_t)(m + 1) * DM + 4 * lane + 256 * j)); }
        { const f32x4 st = *(const f32x4*)((const float*)(ws + WS_STATS) + (size_t)m * 2);
#pragma unroll
          for (int j = 0; j < 4; ++j) { const f32x4 gg = *(const f32x4*)(g1 + 4 * lane + 256 * j) * DN_ALPHA, bb = *(const f32x4*)(b1 + 4 * lane + 256 * j) * DN_ALPHA;
              v0[j] = (v0[j] - st[0]) * st[1] * gg + bb; v1[j] = (v1[j] - st[2]) * st[3] * gg + bb; } }
        constexpr int CK = 4;
        unsigned m0 = (unsigned)__ballot(so >= 0); unsigned m1 = (m0 >> 16) & 0xffffu; m0 &= 0xffffu;
        unsigned w0[CK][4], w1[CK][4]; float f0[CK], f1[CK];
#pragma unroll
        for (int k = 0; k < CK; ++k) {
            const int e0 = m0 ? __builtin_ctz(m0) : 0, e1 = m1 ? __builtin_ctz(m1) : 0;
            const int sl0 = __builtin_amdgcn_readlane(so, e0), sl1 = __builtin_amdgcn_readlane(so, 16 + e1);
            const size_t r0 = (size_t)(m0 ? sl0 : 0) * DM, r1 = (size_t)(m1 ? sl1 : 0) * DM;
            f0[k] = m0 ? (1.0f / YE_SCALE) : 0.f; f1[k] = m1 ? (1.0f / YE_SCALE) : 0.f;
#pragma unroll
            for (int j = 0; j < 4; ++j) { w0[k][j] = *(const unsigned*)(YE + r0 + 4 * lane + 256 * j); w1[k][j] = *(const unsigned*)(YE + r1 + 4 * lane + 256 * j); }
            m0 &= m0 - 1; m1 &= m1 - 1;
        }
#pragma unroll
        for (int k = 0; k < CK; ++k)
#pragma unroll
            for (int j = 0; j < 4; ++j) {
                { const f32x2v lo = __builtin_amdgcn_cvt_pk_f32_fp8((int)w0[k][j], false), hi = __builtin_amdgcn_cvt_pk_f32_fp8((int)w0[k][j], true);
                  v0[j][0] += lo[0] * f0[k]; v0[j][1] += lo[1] * f0[k]; v0[j][2] += hi[0] * f0[k]; v0[j][3] += hi[1] * f0[k]; }
                { const f32x2v lo = __builtin_amdgcn_cvt_pk_f32_fp8((int)w1[k][j], false), hi = __builtin_amdgcn_cvt_pk_f32_fp8((int)w1[k][j], true);
                  v1[j][0] += lo[0] * f1[k]; v1[j][1] += lo[1] * f1[k]; v1[j][2] += hi[0] * f1[k]; v1[j][3] += hi[1] * f1[k]; }
            }
        while (m0) { const int sl = __builtin_amdgcn_readlane(so, __builtin_ctz(m0)); m0 &= m0 - 1;
#pragma unroll
            for (int j = 0; j < 4; ++j) { const unsigned w = *(const unsigned*)(YE + (size_t)sl * DM + 4 * lane + 256 * j);
                const f32x2v lo = __builtin_amdgcn_cvt_pk_f32_fp8((int)w, false), hi = __builtin_amdgcn_cvt_pk_f32_fp8((int)w, true);
                v0[j][0] += lo[0] * (1.0f / YE_SCALE); v0[j][1] += lo[1] * (1.0f / YE_SCALE); v0[j][2] += hi[0] * (1.0f / YE_SCALE); v0[j][3] += hi[1] * (1.0f / YE_SCALE); } }
        while (m1) { const int sl = __builtin_amdgcn_readlane(so, 16 + __builtin_ctz(m1)); m1 &= m1 - 1;
#pragma unroll
            for (int j = 0; j < 4; ++j) { const unsigned w = *(const unsigned*)(YE + (size_t)sl * DM + 4 * lane + 256 * j);
                const f32x2v lo = __builtin_amdgcn_cvt_pk_f32_fp8((int)w, false), hi = __builtin_amdgcn_cvt_pk_f32_fp8((int)w, true);
                v1[j][0] += lo[0] * (1.0f / YE_SCALE); v1[j][1] += lo[1] * (1.0f / YE_SCALE); v1[j][2] += hi[0] * (1.0f / YE_SCALE); v1[j][3] += hi[1] * (1.0f / YE_SCALE); } }
        row_ln(v0, g, b, lane); row_ln(v1, g, b, lane);
        if (last_layer) {
#pragma unroll
            for (int j = 0; j < 4; ++j) { *(f32x4*)(Xo + (size_t)m * DM + 4 * lane + 256 * j) = v0[j]; *(f32x4*)(Xo + (size_t)(m + 1) * DM + 4 * lane + 256 * j) = v1[j]; }
        } else { store_row_bf(v0, XB + (size_t)m * DM, lane); store_row_bf(v1, XB + (size_t)(m + 1) * DM, lane); }
    }
}

template <bool NA>
__device__ __forceinline__ void attn_wave(const bf16* __restrict__ Qb, const bf16* __restrict__ Kb, const bf16* __restrict__ Vb, bf16* __restrict__ Ob, int ntiles,
                                          LAS unsigned char* wl, const LAS float* rpbh, int rr, int rs, int qh, int lane) {
    const int r = lane & 31, h = lane >> 5;
    bf16x8 qf[4];
#pragma unroll
    for (int d0 = 0; d0 < 4; ++d0) qf[d0] = *(const bf16x8*)(Qb + (size_t)r * DIN + 16 * d0 + 8 * h);
    f32x16 o0, o1;
#pragma unroll
    for (int i = 0; i < 16; ++i) { o0[i] = 0.f; o1[i] = 0.f; }
    float m = -1e30f, l = 0.f;
    LAS unsigned char* vl = wl; LAS float* wsf = (LAS float*)(wl + 4608);
    const bf16* vsrc = Vb + (size_t)(lane >> 3) * DIN + 8 * (lane & 7);
    const bf16* ksrc = Kb + (size_t)r * DIN + 8 * h;
    const int vwoff = (lane >> 3) * 144 + (lane & 7) * 16;
    const int i16 = lane & 15, tq = i16 >> 2, tp = i16 & 3, blk = (lane >> 4) & 1;
    const int troff = (4 * h + tq) * 144 + (16 * blk + 4 * tp) * 2;
    const int qc = 32 * qh + r; const int cs = qc - 8 < 0 ? 0 : (qc - 8 > 48 ? 48 : qc - 8);
    for (int t = 0; t < ntiles; ++t) {
        const size_t ko = (size_t)(32 * t) * DIN;
        bf16x8 kf[4];
#pragma unroll
        for (int d0 = 0; d0 < 4; ++d0) kf[d0] = *(const bf16x8*)(ksrc + ko + 16 * d0);
        u32x4 vr[4];
#pragma unroll
        for (int i = 0; i < 4; ++i) vr[i] = *(const u32x4*)(vsrc + ko + (size_t)(8 * i) * DIN);
        f32x16 s;
#pragma unroll
        for (int i = 0; i < 16; ++i) s[i] = 0.f;
#pragma unroll
        for (int d0 = 0; d0 < 4; ++d0) s = MFMA32(kf[d0], qf[d0], s);
        unsigned okm = 0xffffu;
        if (NA) {
            okm = 0u; const int kr = rs + (t >> 1), kh = t & 1, brow = (kr - rr + 7) * 31;
#pragma unroll
            for (int i = 0; i < 16; ++i) { const int kc = 32 * kh + crow(i, h); const bool ok = (kc >= cs) && (kc < cs + 16); const int idx = ok ? brow + kc - qc + 15 : 0;
                const float bia = rpbh[idx]; s[i] = ok ? s[i] + bia : -1e30f; okm |= ok ? (1u << i) : 0u; }
        }
        float mx = s[0];
#pragma unroll
        for (int i = 1; i < 16; ++i) mx = fmaxf(mx, s[i]);
        mx = max32(mx);
        const float mn = fmaxf(m, mx), alpha = __builtin_amdgcn_exp2f(m - mn); m = mn;
        float rsum = 0.f;
#pragma unroll
        for (int i = 0; i < 16; ++i) { float p = __builtin_amdgcn_exp2f(s[i] - mn); if (NA) p = ((okm >> i) & 1u) ? p : 0.f; s[i] = p; rsum += p; }
        l = l * alpha + rsum;
#pragma unroll
        for (int i = 0; i < 4; ++i) *(LAS u32x4*)(vl + vwoff + i * 8 * 144) = vr[i];
        if (h == 0) wsf[r] = alpha;
        asm volatile("s_waitcnt lgkmcnt(0)" ::: "memory");
#pragma unroll
        for (int g4 = 0; g4 < 4; ++g4) { const f32x4 a4 = *(const LAS f32x4*)(wsf + 8 * g4 + 4 * h);
#pragma unroll
            for (int j = 0; j < 4; ++j) { o0[4 * g4 + j] *= a4[j]; o1[4 * g4 + j] *= a4[j]; } }
        u32x4 pw0, pw1;
        pw0.x = pg8::cvt_pk_bf16(s[0], s[1]); pw0.y = pg8::cvt_pk_bf16(s[2], s[3]); pw0.z = pg8::cvt_pk_bf16(s[4], s[5]); pw0.w = pg8::cvt_pk_bf16(s[6], s[7]);
        pw1.x = pg8::cvt_pk_bf16(s[8], s[9]); pw1.y = pg8::cvt_pk_bf16(s[10], s[11]); pw1.z = pg8::cvt_pk_bf16(s[12], s[13]); pw1.w = pg8::cvt_pk_bf16(s[14], s[15]);
        const bf16x8 pa0 = __builtin_bit_cast(bf16x8, pw0), pa1 = __builtin_bit_cast(bf16x8, pw1);
#pragma unroll
        for (int sp = 0; sp < 2; ++sp) {
#pragma unroll
            for (int db = 0; db < 2; ++db) {
                const s16x4 lo = tr_read(vl + troff + (16 * sp) * 144 + 64 * db), hi = tr_read(vl + troff + (16 * sp + 8) * 144 + 64 * db);
                const bf16x8 bfr = __builtin_shufflevector(lo, hi, 0, 1, 2, 3, 4, 5, 6, 7);
                if (db == 0) o0 = MFMA32(sp ? pa1 : pa0, bfr, o0); else o1 = MFMA32(sp ? pa1 : pa0, bfr, o1);
            }
        }
        asm volatile("s_waitcnt lgkmcnt(0)" ::: "memory");
    }
    l = sum32(l);
    if (h == 0) wsf[32 + r] = l;
    asm volatile("s_waitcnt lgkmcnt(0)" ::: "memory");
#pragma unroll
    for (int i = 0; i < 16; ++i) { const int q = crow(i, h); const float rl = 1.0f / wsf[32 + q];
        Ob[(size_t)q * DM + r] = (bf16)f2bf(o0[i] * rl); Ob[(size_t)q * DM + 32 + r] = (bf16)f2bf(o1[i] * rl); }
    asm volatile("s_waitcnt lgkmcnt(0)" ::: "memory");
}

__device__ __forceinline__ void sgu_part(Frame& F, int l, const float* sg_b, unsigned char* ws) {
    const bf16* H = (const bf16*)(ws + WS_H); bf16* Y = (bf16*)(ws + WS_HID); const bf16* WSB = (const bf16*)(ws + wset(l) + WS_WSBF);
    const int lane = F.lane, r = lane & 31, h = lane >> 5;
    LAS unsigned char* vnl = F.lds;
    const int pt = F.wave >> 1, ct = F.wave & 1;
    const int i16 = lane & 15, tq = i16 >> 2, tp = i16 & 3, blk = (lane >> 4) & 1;
    u32x4 stg[2];
    { const int u = F.vcu; if (u < NBATCH * 32 * 4) { const int g = u & 3, ch = (u >> 2) & 31, b = u >> 7; const size_t tok0 = (size_t)b * SEQ + ch * 128;
#pragma unroll
        for (int i = 0; i < 2; ++i) { const int idx = F.tid + 512 * i, row = idx >> 3, chunk = idx & 7; stg[i] = *(const u32x4*)(H + (tok0 + row) * DIN + H_VC + 64 * g + 8 * chunk); } } }
    for (int u = F.vcu; u < NBATCH * 32 * 4; u += F.G) {
        const int g = u & 3, ch = (u >> 2) & 31, b = u >> 7; const size_t tok0 = (size_t)b * SEQ + ch * 128;
#pragma unroll
        for (int i = 0; i < 2; ++i) { const int idx = F.tid + 512 * i, row = idx >> 3, chunk = idx & 7; *(LAS u32x4*)(vnl + row * 144 + chunk * 16) = stg[i]; }
        __syncthreads();
        { const int un = u + F.G; if (un < NBATCH * 32 * 4) { const int gn = un & 3, chn = (un >> 2) & 31, bn = un >> 7; const size_t tokn = (size_t)bn * SEQ + chn * 128;
#pragma unroll
            for (int i = 0; i < 2; ++i) { const int idx = F.tid + 512 * i, row = idx >> 3, chunk = idx & 7; stg[i] = *(const u32x4*)(H + (tokn + row) * DIN + H_VC + 64 * gn + 8 * chunk); } } }
        unsigned short uu[16];
#pragma unroll
        for (int i = 0; i < 16; ++i) uu[i] = H[(tok0 + 32 * pt + crow(i, h)) * DIN + H_UC + 64 * g + 32 * ct + r];
        f32x16 z;
#pragma unroll
        for (int i = 0; i < 16; ++i) z[i] = 0.f;
#pragma unroll
        for (int s = 0; s < 8; ++s) {
            const bf16x8 a = *(const bf16x8*)(WSB + ((size_t)(g * 128 + 32 * pt + r) * 128 + 16 * s + 8 * h));
            const s16x4 lo = tr_read(vnl + (16 * s + 8 * h + tq) * 144 + (32 * ct + 16 * blk + 4 * tp) * 2), hi = tr_read(vnl + (16 * s + 8 * h + 4 + tq) * 144 + (32 * ct + 16 * blk + 4 * tp) * 2);
            z = MFMA32(a, __builtin_shufflevector(lo, hi, 0, 1, 2, 3, 4, 5, 6, 7), z);
        }
        const float* bs = sg_b + ((size_t)l * 4 + g) * 128;
#pragma unroll
        for (int i = 0; i < 16; ++i) { const int pp = 32 * pt + crow(i, h); const size_t tok = tok0 + pp; const int c = 32 * ct + r;
            Y[tok * DM + Y_SG + 64 * g + c] = (bf16)f2bf(bf2f(uu[i]) * (z[i] + bs[pp])); }
        __syncthreads();
    }
}
__device__ __forceinline__ void gqa_part(int vcu, int G, int tid, char* lds, unsigned char* ws, const float* qn, const float* kn) {
    const bf16* H = (const bf16*)(ws + WS_H); bf16* Y = (bf16*)(ws + WS_HID);
    float gq = 0.f, gk = 0.f;
    for (int i = 0; i < 64; ++i) { gq = fmaxf(gq, fabsf(qn[i])); gk = fmaxf(gk, fabsf(kn[i])); }
    const bool nomax = (64.0f * C2 * gq * gk) * 1.02f <= 40.0f;
    if (nomax) {
        for (int id = vcu; id < NBATCH * 8 * 16; id += G) {
            const int qb = id & 15, hg = (id >> 4) & 3, kvh = (id >> 6) & 1, b = id >> 7, hq = kvh * 4 + hg;
            const size_t t0 = (size_t)b * SEQ;
            attn_body::attn_unit<8, true, GQA_MSUM>((const attn_body::bf16*)(H + (t0 + 256 * qb) * DIN + H_GQ + 64 * hq), (const attn_body::bf16*)(H + t0 * DIN + H_GK + 64 * kvh),
                                          (const attn_body::bf16*)(H + t0 * DIN + H_GV + 64 * kvh), (attn_body::bf16*)(Y + (t0 + 256 * qb) * DM + Y_GQA + 64 * hq), lds, tid);
        }
    } else {
        for (int id = vcu; id < NBATCH * 8 * 16; id += G) {
            const int qb = id & 15, hg = (id >> 4) & 3, kvh = (id >> 6) & 1, b = id >> 7, hq = kvh * 4 + hg;
            const size_t t0 = (size_t)b * SEQ;
            attn_body::attn_unit<8, false>((const attn_body::bf16*)(H + (t0 + 256 * qb) * DIN + H_GQ + 64 * hq), (const attn_body::bf16*)(H + t0 * DIN + H_GK + 64 * kvh),
                                           (const attn_body::bf16*)(H + t0 * DIN + H_GV + 64 * kvh), (attn_body::bf16*)(Y + (t0 + 256 * qb) * DM + Y_GQA + 64 * hq), lds, tid);
        }
    }
    __syncthreads();
}
typedef float f32x4_t __attribute__((ext_vector_type(4)));
#define MFMA16(a, b, c) __builtin_amdgcn_mfma_f32_16x16x32_bf16((a), (b), (c), 0, 0, 0)
constexpr int NA_VP = 144;
__device__ __forceinline__ void na_wave(const bf16* __restrict__ H, const LAS unsigned char* vl, bf16* __restrict__ Y, const LAS float* rpbh, int b, int hd, int rr, int rs, int qb4, int lane) {
    const int n16 = lane & 15, g = lane >> 4;
    const int c0 = 16 * qb4, w0 = (16 * qb4 - 8 < 0) ? 0 : (16 * qb4 - 8 > 32 ? 32 : 16 * qb4 - 8);
    const size_t t0 = (size_t)b * SEQ, qtok = t0 + rr * 64 + c0 + n16;
    bf16x8 qf[2];
#pragma unroll
    for (int ks = 0; ks < 2; ++ks) qf[ks] = *(const bf16x8*)(H + qtok * DIN + H_NAQ + 64 * hd + 32 * ks + 8 * g);
    f32x4_t s[16];
    const bf16* kb = H + (t0 + rs * 64 + w0 + 8 * (n16 >> 2) + (n16 & 3)) * DIN + H_NAK + 64 * hd + 8 * g;
    {
        bf16x8 kf[16][2];
#pragma unroll
        for (int T = 0; T < 16; ++T) { const bf16* kp = kb + (size_t)((T >> 1) * 64 + 4 * (T & 1)) * DIN; kf[T][0] = *(const bf16x8*)kp; kf[T][1] = *(const bf16x8*)(kp + 32); }
        asm volatile("" ::: "memory");
#pragma unroll
        for (int T = 0; T < 16; ++T) { f32x4_t z = {0.f, 0.f, 0.f, 0.f}; z = MFMA16(kf[T][0], qf[0], z); s[T] = MFMA16(kf[T][1], qf[1], z); }
    }
    const int qc = c0 + n16, cs = qc - 8 < 0 ? 0 : (qc - 8 > 48 ? 48 : qc - 8);
    const LAS float* tb[8];
#pragma unroll
    for (int j = 0; j < 8; ++j) { const int kc = w0 + 8 * g + 4 * (j >> 2) + (j & 3); const bool ok = (unsigned)(kc - cs) < 16u; tb[j] = rpbh + (rs - rr + 7) * 32 + (ok ? kc - qc + 15 : 31); }
    float mx = -1e30f;
#pragma unroll
    for (int T = 0; T < 16; ++T)
#pragma unroll
        for (int i = 0; i < 4; ++i) { const float v = s[T][i] + tb[(T & 1) * 4 + i][(T >> 1) * 32]; s[T][i] = v; mx = fmaxf(mx, v); }
    mx = max16(mx); mx = max32(mx);
    float sum = 0.f;
#pragma unroll
    for (int T = 0; T < 16; ++T)
#pragma unroll
        for (int i = 0; i < 4; ++i) { const float p = __builtin_amdgcn_exp2f(s[T][i] - mx); s[T][i] = p; sum += p; }
    sum = sum16(sum); sum = sum32(sum);
    f32x4_t o[4];
#pragma unroll
    for (int db = 0; db < 4; ++db) o[db] = (f32x4_t){0.f, 0.f, 0.f, 0.f};
    const LAS unsigned char* vb = vl + (w0 + 8 * g + (n16 >> 2)) * NA_VP + (n16 & 3) * 8;
#pragma unroll
    for (int kr = 0; kr < 8; ++kr) {
        u32x4 pw; pw.x = pg8::cvt_pk_bf16(s[2 * kr][0], s[2 * kr][1]); pw.y = pg8::cvt_pk_bf16(s[2 * kr][2], s[2 * kr][3]);
        pw.z = pg8::cvt_pk_bf16(s[2 * kr + 1][0], s[2 * kr + 1][1]); pw.w = pg8::cvt_pk_bf16(s[2 * kr + 1][2], s[2 * kr + 1][3]);
        const bf16x8 pb = __builtin_bit_cast(bf16x8, pw);
#pragma unroll
        for (int db = 0; db < 4; ++db) { const LAS unsigned char* vp = vb + (kr * 64) * NA_VP + db * 32;
            const s16x4 lo = tr_read(vp), hi = tr_read(vp + 4 * NA_VP);
            o[db] = MFMA16(__builtin_shufflevector(lo, hi, 0, 1, 2, 3, 4, 5, 6, 7), pb, o[db]); }
    }
    const float rl = 1.0f / sum;
    bf16* yp = Y + qtok * DM + Y_NA + 64 * hd + 4 * g;
#pragma unroll
    for (int db = 0; db < 4; ++db) { u32x2 w; w.x = pg8::cvt_pk_bf16(o[db][0] * rl, o[db][1] * rl); w.y = pg8::cvt_pk_bf16(o[db][2] * rl, o[db][3] * rl); *(u32x2*)(yp + 16 * db) = w; }
}
__device__ __forceinline__ void na_part(Frame& F, int l, const float* na_rpb, unsigned char* ws) {
    const bf16* H = (const bf16*)(ws + WS_H); bf16* Y = (bf16*)(ws + WS_HID);
    LAS float* rpbl = (LAS float*)(F.lds + 90112);
    for (int i = F.tid; i < 4 * 15 * 32; i += 512) { const int c = i & 31, hr = i >> 5; rpbl[i] = (c < 31) ? na_rpb[(size_t)l * 4 * 15 * 31 + hr * 31 + c] * LOG2E : -1e30f; }
    LAS unsigned char* vl = F.lds;
    u32x4 stg[9];
#define NA_VSRC(id_) (H + ((size_t)((id_) >> 7) * SEQ + (2 * ((id_) & 31) - 4 < 0 ? 0 : (2 * ((id_) & 31) - 4 > 56 ? 56 : 2 * ((id_) & 31) - 4)) * 64) * DIN + H_NAV + 64 * (((id_) >> 5) & 3))
    if (F.vcu < NBATCH * 4 * 32) { const bf16* vsrc = NA_VSRC(F.vcu);
#pragma unroll
        for (int i = 0; i < 9; ++i) { const int idx = F.tid + 512 * i, tok = idx >> 3, ch = idx & 7; stg[i] = *(const u32x4*)(vsrc + (size_t)tok * DIN + ch * 8); } }
    for (int id = F.vcu; id < NBATCH * 4 * 32; id += F.G) {
        const int rp = id & 31, hd = (id >> 5) & 3, b = id >> 7, rr0 = 2 * rp;
        const int sb = rr0 - 4 < 0 ? 0 : (rr0 - 4 > 56 ? 56 : rr0 - 4);
        __syncthreads();
#pragma unroll
        for (int i = 0; i < 9; ++i) { const int idx = F.tid + 512 * i, tok = idx >> 3, ch = idx & 7; *(LAS u32x4*)(vl + tok * NA_VP + ch * 16) = stg[i]; }
        __syncthreads();
        { const int idn = id + F.G; if (idn < NBATCH * 4 * 32) { const bf16* vsrc = NA_VSRC(idn);
#pragma unroll
            for (int i = 0; i < 9; ++i) { const int idx = F.tid + 512 * i, tok = idx >> 3, ch = idx & 7; stg[i] = *(const u32x4*)(vsrc + (size_t)tok * DIN + ch * 8); } } }
        const int rr = rr0 + (F.wave >> 2); const int rs = rr - 4 < 0 ? 0 : (rr - 4 > 56 ? 56 : rr - 4);
        na_wave(H, vl + (rs - sb) * 64 * NA_VP, Y, rpbl + hd * 480, b, hd, rr, rs, F.wave & 3, F.lane);
    }
#undef NA_VSRC
    __syncthreads();
}

__device__ __forceinline__ void frame_init(Frame& F, LAS unsigned char* lds, int wave_s) {
    int t = wave_s * 64 + (int)__builtin_amdgcn_mbcnt_hi(~0u, __builtin_amdgcn_mbcnt_lo(~0u, 0u)); asm volatile("" : "+v"(t));
    F.lds = lds; F.tid = t; F.lane = t & 63; F.wave = __builtin_amdgcn_readfirstlane(t >> 6);
    int G_ = gridDim.x; asm volatile("" : "+s"(G_));
    F.G = G_; { const int bx = blockIdx.x; F.vcu = (F.G % 8 == 0) ? (bx % 8) * (F.G / 8) + bx / 8 : bx; }
    F.gw = F.vcu * NWAVES + F.wave; F.NGW = F.G * NWAVES;
}
#ifndef MK_FUSED
#define MK_FUSED 1
#endif
struct Args { const float* in[21]; float* out; unsigned char* ws; int l_lo, l_hi, ph_lo, ph_hi, use_bar, pad; };
constexpr int NPH = 10;

__global__ void __launch_bounds__(NWAVES * 64, 2) enc_fwd(Args a) {
    extern __shared__ __attribute__((aligned(16))) unsigned char lds[];
    int wave_s_ = __builtin_amdgcn_readfirstlane((int)threadIdx.x >> 6); asm volatile("" : "+s"(wave_s_));
    Frame F0; frame_init(F0, (LAS unsigned char*)lds, wave_s_);
#define FRAME() Frame F; frame_init(F, (LAS unsigned char*)lds, wave_s_)
    volatile LAS unsigned* MISC = (volatile LAS unsigned*)(F0.lds + MISC_OFF);
    for (int u = F0.tid; u < (LDS_BYTES - LDSCTL_OFF) / 4; u += NWAVES * 64) ((LAS unsigned*)(F0.lds + LDSCTL_OFF))[u] = 0u;
    __syncthreads();
    unsigned* ctl = (unsigned*)(a.ws + WS_CTL);
    XcdBarrier bar; bar.bar = ctl + CW_BAR; bar.x = 0; bar.st = nullptr;
    if (a.use_bar) bar = xcd_barrier_post(ctl + CW_BAR, MISC + 8);
#if MK_FUSED
#define SEAM() xcd_barrier(bar)
#else
#define SEAM() do { if (a.use_bar) xcd_barrier(bar); } while (0)
#endif
    typedef const __attribute__((address_space(4))) Args* KArgP;
#define KA() ({ KArgP p_ = (KArgP)__builtin_amdgcn_kernarg_segment_ptr(); asm volatile("" : "+s"(p_)); p_; })
#if !MK_FUSED
    const int lo = a.ph_lo, hi = a.ph_hi;
#endif
#ifndef ONLY_PH
#define ONLY_PH -1
#endif
#if MK_FUSED
#define IN(k) (ONLY_PH < 0 || ONLY_PH == (k))
#else
#define IN(k) ((ONLY_PH < 0 || ONLY_PH == (k)) && lo <= (k) && (k) < hi)
#endif
#ifndef REP0
#define REP0 1
#endif
#ifndef REP2
#define REP2 1
#endif
#ifndef REP4
#define REP4 1
#endif
#ifndef REP9
#define REP9 1
#endif
#ifndef REP1
#define REP1 1
#endif
#ifndef REP2A
#define REP2A 1
#endif
#ifndef REP2B
#define REP2B 1
#endif
#ifndef REP2C
#define REP2C 1
#endif
#ifndef NA_VAR
#define NA_VAR 1
#endif
#ifndef REP3
#define REP3 1
#endif
#ifndef REPP
#define REPP 1
#endif
#ifndef REP5
#define REP5 1
#endif
#ifndef REP6
#define REP6 1
#endif
#ifndef REP7
#define REP7 1
#endif
#ifndef REP8
#define REP8 1
#endif
#define REPEAT(n) _Pragma("nounroll") for (int rep_ = 0; rep_ < (n); ++rep_)
#if MK_FUSED
    for (int l = 0; l < NLAYER; ++l) {
#else
    for (int l = a.l_lo; l < a.l_hi; ++l) {
#endif
        if (IN(0) && (l == 0 || REP0 > 1)) {
            REPEAT(l == 0 ? REP0 : REP0 - 1) { FRAME(); KArgP k = KA(); conv_phase(F, l, k->in[4], k->in[12], k->in[16], k->in[17], k->in[18], k->in[8], k->ws, 0, 1 << 30, F.gw, F.NGW, true); }
            if (l == 0) REPEAT(REPP) { FRAME(); KArgP k = KA(); prologue_phase(F, k->in[0], k->in[1], k->in[2], k->in[3], k->out, k->ws); }
            SEAM();
        }
        if (IN(1)) REPEAT(REP1) {
            FRAME(); KArgP k = KA(); unsigned char* ws = k->ws;
            pg8::Gemm g{(const bf16*)(ws + WS_XB), (const bf16*)(ws + wset(l) + WS_WIN), TT, DIN, DM, 0};
            pg8::RotOrder S; S.init(TT, DIN, F.G, (int)blockIdx.x);
            EpiIn E{(bf16*)(ws + WS_H), k->in[6] + l * 64, k->in[7] + l * 64, k->in[10] + l * 256, k->in[11] + l * 256, (const float*)(ws + WS_ROPE), (bf16*)(ws + WS_VT)};
            pg8::gemm_phase<EpiIn, pg8::RotOrder, true, true, false, false, false, true>(F.lds, g, S, E, F.tid);
            SEAM();
        }
        if (IN(2)) REPEAT(REP2) {
            REPEAT(REP2A) { FRAME(); KArgP k = KA(); sgu_part(F, l, k->in[9], k->ws); }
            REPEAT(REP2B) { FRAME(); KArgP k = KA(); gqa_part(F.vcu, F.G, F.tid, (char*)lds, k->ws, k->in[6] + l * 64, k->in[7] + l * 64); }
            REPEAT(REP2C) { FRAME(); KArgP k = KA(); na_part(F, l, k->in[5], k->ws); }
            SEAM();
        }
        if (IN(3)) {
            REPEAT(REP3 - 1) {
                FRAME(); KArgP k = KA(); unsigned char* ws = k->ws;
                pg8::Gemm g{(const bf16*)(ws + WS_HID), (const bf16*)(ws + wset(l) + WS_WOUT), TT, DM, DM, 0};
                pg8::StaticOrder S; S.init(TT, DM, F.G, (int)blockIdx.x);
                EpiRes E{(const bf16*)(ws + WS_XB), (bf16*)(ws + WS_DUMMY)};
                pg8::gemm_phase<EpiRes, pg8::StaticOrder, true, true, false, false, false, true>(F.lds, g, S, E, F.tid);
                SEAM();
            }
            FRAME(); KArgP k = KA(); unsigned char* ws = k->ws;
            pg8::Gemm g{(const bf16*)(ws + WS_HID), (const bf16*)(ws + wset(l) + WS_WOUT), TT, DM, DM, 0};
            pg8::StaticOrder S; S.init(TT, DM, F.G, (int)blockIdx.x);
            EpiRes E{(const bf16*)(ws + WS_XB), (bf16*)(ws + WS_SB)};
            pg8::gemm_phase<EpiRes, pg8::StaticOrder, true, true, false, false, false, true>(F.lds, g, S, E, F.tid);
            SEAM();
        }
        if (IN(4)) { REPEAT(REP4 - 1) { FRAME(); KArgP k = KA(); ln1_router_mfma<true>(F, (const bf16*)(k->ws + WS_SB), k->in[13] + l * DM, k->in[14] + l * DM, k->in[15] + (size_t)l * DM * NEXP, k->ws); SEAM(); }
            FRAME(); KArgP k = KA(); ln1_router_mfma<false>(F, (const bf16*)(k->ws + WS_SB), k->in[13] + l * DM, k->in[14] + l * DM, k->in[15] + (size_t)l * DM * NEXP, k->ws); SEAM(); }
        if (IN(5)) REPEAT(REP5) { FRAME(); KArgP k = KA(); topk_phase(F, k->ws);
            if (l + 1 < NLAYER && blockIdx.x >= 32) { FRAME(); KArgP k2 = KA(); conv_phase(F, l + 1, k2->in[4], k2->in[12], k2->in[16], k2->in[17], k2->in[18], k2->in[8], k2->ws, 0, CONV_SPLIT_ITEMS, (blockIdx.x - 32) * NWAVES + F.wave, (gridDim.x - 32) * NWAVES, false); }
            SEAM(); }
        if (IN(7)) REPEAT(REP7) {
            FRAME(); KArgP k = KA(); unsigned char* ws = k->ws;
            pg8::Gemm g{(const bf16*)(ws + WS_XB8), (const bf16*)(ws + wset(l) + WS_WGU), ROWS_E, 4096, DM / 2, (size_t)4096 * DM, (const int*)(ws + WS_IDX)};
            pg8::StaticOrder S; S.init(ROWS_E, 4096, F.G, (int)blockIdx.x);
            EpiSwiglu E{ws + WS_HID};
            pg8::gemm_phase<EpiSwiglu, pg8::StaticOrder, true, true, true, true, true, true>(F.lds, g, S, E, F.tid);
            SEAM();
        }
        if (IN(8)) REPEAT(REP8) {
            FRAME(); KArgP k = KA(); unsigned char* ws = k->ws;
            pg8::Gemm g{(const bf16*)(ws + WS_HID), (const bf16*)(ws + wset(l) + WS_WD), ROWS_E, DM, DEXP / 2, (size_t)DM * DEXP};
            pg8::StaticOrder S; S.init(ROWS_E, DM, F.G, (int)blockIdx.x);
            EpiDown E{ws + WS_H, (const float*)(ws + WS_GATE)};
            pg8::gemm_phase<EpiDown, pg8::StaticOrder, true, true, true, true, false, true>(F.lds, g, S, E, F.tid);
            SEAM();
        }
#if BAL_PROBE_N
        if (IN(8)) REPEAT(BAL_PROBE_N) {
            FRAME(); KArgP k = KA(); unsigned char* ws = k->ws;
            pg8::Gemm g{(const bf16*)(ws + WS_HID), (const bf16*)(ws + wset(l) + WS_WD), ROWS_E, DM, DEXP / 2, (size_t)DM * DEXP};
            pg8::StaticOrder S; S.init(ROWS_E, DM, F.G, (int)blockIdx.x);
            EpiDown E{ws + WS_DUMMY, (const float*)(ws + WS_GATE)};
            pg8::gemm_phase<EpiDown, pg8::StaticOrder, true, true, true, true, false, (BAL_PROBE != 0)>(F.lds, g, S, E, F.tid);
            SEAM();
        }
#endif
        if (IN(9)) { REPEAT(REP9 - 1) { FRAME(); KArgP k = KA(); combine_phase<true>(F, k->out, (const bf16*)(k->ws + WS_SB), k->in[13] + l * DM, k->in[14] + l * DM, k->in[19] + l * DM, k->in[20] + l * DM, k->ws, l + 1 == NLAYER); SEAM(); }
            FRAME(); KArgP k = KA(); combine_phase<false>(F, k->out, (const bf16*)(k->ws + WS_SB), k->in[13] + l * DM, k->in[14] + l * DM, k->in[19] + l * DM, k->in[20] + l * DM, k->ws, l + 1 == NLAYER);
            if (l + 1 < NLAYER) { FRAME(); KArgP k = KA(); conv_phase(F, l + 1, k->in[4], k->in[12], k->in[16], k->in[17], k->in[18], k->in[8], k->ws, CONV_SPLIT_ITEMS, 1 << 30, F.gw, F.NGW, true); }
            SEAM(); }
    }
#undef IN
#undef SEAM
}

extern "C" void kernel_launch(void* const* d_in, const int* in_sizes, int n_in, void* d_out, int out_size, void* d_ws, size_t ws_size, hipStream_t stream) {
    static int grid = 0;
    if (grid == 0) {
        if (n_in != 21 || out_size != TT * DM || ws_size < WS_END) { fprintf(stderr, "kernel_launch: unexpected shapes (n_in %d, out %d, ws %zu)\n", n_in, out_size, ws_size); grid = -1; return; }
        int dev = 0, cus = 0, per_cu = 0;
        if (hipGetDevice(&dev) != hipSuccess || hipDeviceGetAttribute(&cus, hipDeviceAttributeMultiprocessorCount, dev) != hipSuccess) { grid = -1; return; }
        if (hipFuncSetAttribute((const void*)enc_fwd, hipFuncAttributeMaxDynamicSharedMemorySize, LDS_BYTES) != hipSuccess) { fprintf(stderr, "kernel_launch: hipFuncSetAttribute failed\n"); grid = -1; return; }
        if (hipOccupancyMaxActiveBlocksPerMultiprocessor(&per_cu, (const void*)enc_fwd, NWAVES * 64, LDS_BYTES) != hipSuccess || per_cu < 1) fprintf(stderr, "kernel_launch: occupancy query reports %d\n", per_cu);
        (void)hipGetLastError();
        grid = cus;
    }
    if (grid < 0) return;
    if (hipMemsetAsync((char*)d_ws + WS_CTL, 0, CTL_ZERO_BYTES, stream) != hipSuccess) return;
    Args a{};
    for (int i = 0; i < 21; ++i) a.in[i] = (const float*)d_in[i];
    a.out = (float*)d_out; a.ws = (unsigned char*)d_ws; a.pad = 0;
#if MK_FUSED
    a.l_lo = 0; a.l_hi = NLAYER; a.ph_lo = 0; a.ph_hi = NPH; a.use_bar = 1;
    hipLaunchKernelGGL(enc_fwd, dim3(grid), dim3(NWAVES * 64), LDS_BYTES, stream, a);
#else
    a.use_bar = 0;
    for (int l = 0; l < NLAYER; ++l)
        for (int ph = 0; ph < NPH; ++ph) { a.l_lo = l; a.l_hi = l + 1; a.ph_lo = ph; a.ph_hi = ph + 1; hipLaunchKernelGGL(enc_fwd, dim3(grid), dim3(NWAVES * 64), LDS_BYTES, stream, a); }
#endif
}
```

```cpp
#include <hip/hip_runtime.h>
#include <hip/hip_bf16.h>
#include <cstdio>
#include <cstdint>
#ifndef BAL_PROBE
#define BAL_PROBE 0
#endif
#ifndef BAL_PROBE_N
#define BAL_PROBE_N 0
#endif
#ifndef LN1_ROWS
#define LN1_ROWS 4
#endif
#ifndef GQA_MSUM
#define GQA_MSUM false
#endif
namespace pg8 {
#define PG8_LAS __attribute__((address_space(3)))
typedef unsigned short bf16_t;
typedef short bf16x8 __attribute__((ext_vector_type(8)));
typedef float f32x4 __attribute__((ext_vector_type(4)));
typedef unsigned u32x4 __attribute__((ext_vector_type(4)));
typedef int v4i_t __attribute__((ext_vector_type(4)));
typedef int v8i_t __attribute__((ext_vector_type(8)));
constexpr int BM = 256, BK = 64, HALF = 128, HTB = HALF * BK * 2  , STAGE_BYTES = 8 * HTB, NXCD = 8, WGM = 8;

__host__ __device__ __forceinline__ int lds_byte(int r, int c) { const int st = (r >> 4) * 2 + (c >> 5), rr = r & 15, cc = c & 31, ob = rr * 64 + cc * 2; return st * 1024 + (ob ^ (((ob >> 9) & 1) << 5)); }
__host__ __device__ __forceinline__ void stage_rc(int b, int& R, int& C) { const int st = b / 1024, sb = b % 1024, swz = sb ^ (((sb >> 9) & 1) << 5); R = (st >> 1) * 16 + swz / 64; C = (st & 1) * 32 + (swz % 64) / 2; }
__host__ __device__ __forceinline__ int perm32(int rho) { const int n = rho >> 4, i = rho & 15; return 8 * (i >> 2) + 4 * n + (i & 3); }

struct Unit { int pm, pn; };
struct Gemm { const bf16_t* A; const bf16_t* Bt; int M, N, K; size_t estride; const int* idx; };
__host__ __device__ __forceinline__ int expert_of_tile(int pm) { return pm < 128 ? (pm >> 3) : ((pm - 128) >> 5); }

struct StaticOrder {
    int nM, nN, nwg, G, c;
    __host__ __device__ void init(int M, int N, int G_, int c_) { nM = M / BM; nN = N / BM; nwg = nM * nN; G = G_; c = c_; }
    __host__ __device__ bool next(int i, Unit& u) const {
        const long L = (long)i * G + c; if (L >= nwg) return false;
        int wgid = (int)L; { const int q = nwg / NXCD, r = nwg % NXCD, xcd = wgid % NXCD, off = wgid / NXCD; wgid = (xcd < r ? xcd * (q + 1) : r * (q + 1) + (xcd - r) * q) + off; }
        const int nig = WGM * nN, gid = wgid / nig, fm = gid * WGM, gsz = (nM - fm) < WGM ? (nM - fm) : WGM;
        u.pm = fm + ((wgid % nig) % gsz); u.pn = (wgid % nig) / gsz; return true;
    }
    __device__ __forceinline__ void a_ready(const Unit&) const {}
    __device__ __forceinline__ void done(const Unit&) const {}
};

struct RotOrder {
    StaticOrder S;
    __host__ __device__ void init(int M, int N, int G_, int c_) { S.init(M, N, G_, c_); }
    __host__ __device__ bool next(int i, Unit& u) const {
        if (S.G != 256) return S.next(i, u);
        StaticOrder T = S; T.c = (S.c & 63) + 64 * (((S.c >> 6) + (i >> 1)) & 3);
        return T.next(i, u);
    }
    __device__ __forceinline__ void a_ready(const Unit&) const {}
    __device__ __forceinline__ void done(const Unit&) const {}
};

__device__ __forceinline__ unsigned cvt_pk_bf16(float lo, float hi) { unsigned r; asm volatile("v_cvt_pk_bf16_f32 %0, %1, %2" : "=v"(r) : "v"(lo), "v"(hi)); return r; }
typedef float f32x2 __attribute__((ext_vector_type(2)));

__device__ __forceinline__ void mfma_fp8(f32x4& acc, const v8i_t& a, const v8i_t& b, int sc) {
    asm volatile("v_mfma_scale_f32_16x16x128_f8f6f4 %0, %1, %2, %0, %3, %3 op_sel_hi:[0,0,0]" : "+v"(acc) : "v"(a), "v"(b), "v"(sc));
}
template <class Epi, class Sched, bool ALIGN_EPI = false, bool SP2 = false, bool GROUPED = false, bool FP8 = false, bool GATHER = false, bool BAL = false>
__device__ __forceinline__ void gemm_phase(PG8_LAS unsigned char* lds, const Gemm g, const Sched& S, const Epi& E, int tid_in) {
    int tid_ = tid_in; asm volatile("" : "+v"(tid_));
    const int tid = tid_, wid = __builtin_amdgcn_readfirstlane(tid >> 6), lane = tid & 63, wr = wid >> 2, wc = wid & 3, fr = lane & 15, fq = lane >> 4;
    const int K = g.K, nt = K / BK;
    unsigned voffA[2], voffB[2];
#pragma unroll
    for (int i = 0; i < 2; ++i) { int R, C; stage_rc(tid * 16 + i * 8192, R, C); const int Rb = Epi::PERM ? ((R & ~31) + perm32(R & 31)) : R;
        voffA[i] = (unsigned)(R * K + C) * 2u; voffB[i] = (unsigned)(Rb * K + C) * 2u; }
    const size_t kstep = (size_t)(BK * 2);
    const size_t hstep = (size_t)HALF * K * 2;
    const size_t tstep = 2 * hstep;
    const unsigned ldsw = (unsigned)wid * 1024u;
    const int aoff = lds_byte(wr * 64 + fr, fq * 8), boff = lds_byte(wc * 32 + fr, fq * 8);
#define PG8_SA(b, h) (((b) * 2 + (h)) * HTB)
#define PG8_SB(b, h) ((4 + (b) * 2 + (h)) * HTB)
#define PG8_STAGE(bufoff, gbase, voff) do { _Pragma("unroll") for (int _i = 0; _i < 2; ++_i) \
        __builtin_amdgcn_global_load_lds((const unsigned*)((const char*)(gbase) + (voff)[_i]), (PG8_LAS unsigned*)(lds + (bufoff) + ldsw + _i * 8192), 16, 0, 0); } while (0)
    static_assert(!GATHER || SP2, "GATHER is wired into the SP2 loop only");
    unsigned vC[2][2], vN[2][2]; unsigned cC[2];
    PG8_LAS unsigned char* gtab = lds + 131072 + 1024 + wid * 512;
    if constexpr (GATHER) {
#pragma unroll
        for (int i = 0; i < 2; ++i) { int R, C; stage_rc(tid * 16 + i * 8192, R, C); cC[i] = (unsigned)C * 2u; }
    }
    const int grow = ((lane >> 5) & 1) * 128 + ((lane >> 4) & 1) * 64 + (wid >> 1) * 16 + (lane & 15);
#define PG8_GDMA(unit, buf) __builtin_amdgcn_global_load_lds((const unsigned*)(g.idx + (size_t)(unit).pm * BM + grow), (PG8_LAS unsigned*)(gtab + (buf) * 256), 4, 0, 0)
#define PG8_GREAD(dst, buf) do { unsigned r00_, r01_, r10_, r11_; const unsigned ga_ = (unsigned)(size_t)gtab + (unsigned)(buf) * 256u + (unsigned)(lane >> 2) * 4u; \
        asm volatile("ds_read_b32 %0, %4\n\tds_read_b32 %1, %4 offset:64\n\tds_read_b32 %2, %4 offset:128\n\tds_read_b32 %3, %4 offset:192\n\ts_waitcnt lgkmcnt(0)" \
                     : "=&v"(r00_), "=&v"(r01_), "=&v"(r10_), "=&v"(r11_) : "v"(ga_) : "memory"); \
        dst[0][0] = r00_ * (unsigned)(K * 2) + cC[0]; dst[0][1] = r01_ * (unsigned)(K * 2) + cC[1]; dst[1][0] = r10_ * (unsigned)(K * 2) + cC[0]; dst[1][1] = r11_ * (unsigned)(K * 2) + cC[1]; } while (0)
#define PG8_GSTAGE(bufoff, kb, h, nx) do { _Pragma("unroll") for (int _i = 0; _i < 2; ++_i) \
        __builtin_amdgcn_global_load_lds((const unsigned*)((const char*)g.A + (kb) + ((nx) ? vN[h][_i] : vC[h][_i])), (PG8_LAS unsigned*)(lds + (bufoff) + ldsw + _i * 8192), 16, 0, 0); } while (0)
#define PG8_STA(bufoff, ptr, kb, h, nx) do { if constexpr (GATHER) { PG8_GSTAGE(bufoff, kb, h, nx); } else { PG8_STAGE(bufoff, ptr, voffA); } } while (0)
#define PG8_LDA(dst, b, h) do { if constexpr (FP8) { _Pragma("unroll") for (int m = 0; m < 4; ++m) dst##8[m] = PG8_CAT(*(const PG8_LAS bf16x8*)(lds + PG8_SA(b, h) + aoff + m * 2048), *(const PG8_LAS bf16x8*)(lds + PG8_SA(b, h) + aoff + m * 2048 + 1024)); } \
        else { _Pragma("unroll") for (int m = 0; m < 4; ++m) _Pragma("unroll") for (int k = 0; k < 2; ++k) dst[m][k] = *(const PG8_LAS bf16x8*)(lds + PG8_SA(b, h) + aoff + m * 2048 + k * 1024); } } while (0)
#define PG8_LDB(dst, b, h) do { if constexpr (FP8) { _Pragma("unroll") for (int n = 0; n < 2; ++n) dst##8[n] = PG8_CAT(*(const PG8_LAS bf16x8*)(lds + PG8_SB(b, h) + boff + n * 2048), *(const PG8_LAS bf16x8*)(lds + PG8_SB(b, h) + boff + n * 2048 + 1024)); } \
        else { _Pragma("unroll") for (int n = 0; n < 2; ++n) _Pragma("unroll") for (int k = 0; k < 2; ++k) dst[n][k] = *(const PG8_LAS bf16x8*)(lds + PG8_SB(b, h) + boff + n * 2048 + k * 1024); } } while (0)
#define PG8_MMA(ai, bj, At, Bt) do { __builtin_amdgcn_s_setprio(1); if constexpr (FP8) { _Pragma("unroll") for (int m = 0; m < 4; ++m) _Pragma("unroll") for (int n = 0; n < 2; ++n) \
        mfma_fp8(acc[ai][bj][m][n], Bt##8[n], At##8[m], sc8); } \
        else { _Pragma("unroll") for (int m = 0; m < 4; ++m) _Pragma("unroll") for (int n = 0; n < 2; ++n) _Pragma("unroll") for (int k = 0; k < 2; ++k) \
        acc[ai][bj][m][n] = __builtin_amdgcn_mfma_f32_16x16x32_bf16(Bt[n][k], At[m][k], acc[ai][bj][m][n], 0, 0, 0); } __builtin_amdgcn_s_setprio(0); } while (0)
#define PG8_CAT(x, y) __builtin_shufflevector(__builtin_bit_cast(v4i_t, (x)), __builtin_bit_cast(v4i_t, (y)), 0, 1, 2, 3, 4, 5, 6, 7)
#define PG8_WAIT_V(n) asm volatile("s_waitcnt vmcnt(" #n ")" ::: "memory")
#define PG8_WAIT_L(n) asm volatile("s_waitcnt lgkmcnt(" #n ")" ::: "memory")
#define PG8_BAR __builtin_amdgcn_s_barrier()
#define PG8_SCHED __builtin_amdgcn_sched_barrier(0)
    Unit cur, nxt; int ui = 0;
    if (!S.next(0, cur)) return;
    f32x4 acc[2][2][4][2];
#pragma unroll
    for (int a = 0; a < 2; ++a)
#pragma unroll
        for (int b = 0; b < 2; ++b)
#pragma unroll
            for (int m = 0; m < 4; ++m)
#pragma unroll
                for (int n = 0; n < 2; ++n) acc[a][b][m][n] = (f32x4){0.f, 0.f, 0.f, 0.f};
    int sc8 = 0x7f7f7f7f; if constexpr (FP8) asm volatile("" : "+v"(sc8));
    bf16x8 At[4][2], B0[2][2], B1[2][2]; v8i_t At8[4], B08[2], B18[2];
    const char* cA = (const char*)g.A + (size_t)cur.pm * tstep; const char* cB = (const char*)g.Bt + (size_t)cur.pn * tstep + (GROUPED ? (size_t)expert_of_tile(cur.pm) * g.estride : (size_t)0);
    S.a_ready(cur);
    if constexpr (SP2) {
        if constexpr (GATHER) { PG8_GDMA(cur, 0); PG8_WAIT_V(0); PG8_GREAD(vC, 0); }
        PG8_STAGE(PG8_SB(0, 0), cB, voffB); PG8_STAGE(PG8_SB(0, 1), cB + hstep, voffB); PG8_STA(PG8_SA(0, 0), cA, 0, 0, false); PG8_STA(PG8_SA(0, 1), cA + hstep, 0, 1, false);
        if (wr == 1) PG8_BAR;
        PG8_WAIT_V(2); PG8_BAR;
        if constexpr (BAL) { PG8_STAGE(PG8_SB(1, 0), cB + kstep, voffB); PG8_STAGE(PG8_SB(1, 1), cB + hstep + kstep, voffB); PG8_WAIT_V(4); PG8_BAR; }
        else {
        PG8_STAGE(PG8_SB(1, 0), cB + kstep, voffB); PG8_STA(PG8_SA(1, 0), cA + kstep, kstep, 0, false); PG8_STAGE(PG8_SB(1, 1), cB + hstep + kstep, voffB);
        PG8_WAIT_V(6); PG8_BAR;
        }
    } else {
        PG8_STAGE(PG8_SB(0, 0), cB, voffB); PG8_STAGE(PG8_SA(0, 0), cA, voffA); PG8_STAGE(PG8_SB(0, 1), cB + hstep, voffB); PG8_STAGE(PG8_SA(0, 1), cA + hstep, voffA);
        if (wr == 1) PG8_BAR;
        PG8_WAIT_V(4); PG8_BAR;
        PG8_STAGE(PG8_SB(1, 0), cB + kstep, voffB); PG8_STAGE(PG8_SA(1, 0), cA + kstep, voffA); PG8_STAGE(PG8_SB(1, 1), cB + hstep + kstep, voffB);
        PG8_WAIT_V(6); PG8_BAR;
    }
    for (;;) {
        const bool has_next = S.next(ui + 1, nxt);
        if constexpr (GATHER) { if (has_next) PG8_GDMA(nxt, (ui + 1) & 1); }
        const char* nA = has_next ? (const char*)g.A + (size_t)nxt.pm * tstep : cA; const char* nB = has_next ? (const char*)g.Bt + (size_t)nxt.pn * tstep + (GROUPED ? (size_t)expert_of_tile(nxt.pm) * g.estride : (size_t)0) : cB;
        for (int t = 0; t < nt; t += 2) {
            const bool last = (t == nt - 2);
            const char* a1 = cA + (size_t)(t + 1) * kstep;
            const char* a2 = last ? nA : cA + (size_t)(t + 2) * kstep; const char* b2 = last ? nB : cB + (size_t)(t + 2) * kstep;
            const char* a3 = a2 + kstep; const char* b3 = b2 + kstep;
            if (last && has_next) S.a_ready(nxt);
            if constexpr (SP2) {
            const bool nx = last && has_next; const size_t kb2 = last ? (size_t)0 : (size_t)(t + 2) * kstep;
            if constexpr (GATHER) { if (nx) PG8_GREAD(vN, (ui + 1) & 1); }
            if constexpr (BAL) {
            PG8_LDB(B0, 0, 0); PG8_LDB(B1, 0, 1); PG8_SCHED; PG8_LDA(At, 0, 0); PG8_STA(PG8_SA(1, 0), a1, (size_t)(t + 1) * kstep, 0, false); PG8_STA(PG8_SA(1, 1), a1 + hstep, (size_t)(t + 1) * kstep, 1, false);
            PG8_WAIT_V(8); PG8_WAIT_L(0); PG8_BAR; PG8_MMA(0, 0, At, B0); PG8_MMA(0, 1, At, B1); PG8_BAR; PG8_SCHED;
            PG8_LDA(At, 0, 1); PG8_STAGE(PG8_SB(0, 0), b2, voffB); PG8_STAGE(PG8_SB(0, 1), b2 + hstep, voffB);
            PG8_WAIT_V(6); PG8_WAIT_L(0); PG8_BAR; PG8_MMA(1, 0, At, B0); PG8_MMA(1, 1, At, B1); PG8_BAR; PG8_SCHED;
            PG8_LDB(B0, 1, 0); PG8_LDB(B1, 1, 1); PG8_SCHED; PG8_LDA(At, 1, 0); PG8_STA(PG8_SA(0, 0), a2, kb2, 0, nx); PG8_STA(PG8_SA(0, 1), a2 + hstep, kb2, 1, nx);
            PG8_WAIT_V(8); PG8_WAIT_L(0); PG8_BAR; PG8_MMA(0, 0, At, B0); PG8_MMA(0, 1, At, B1); PG8_BAR; PG8_SCHED;
            PG8_LDA(At, 1, 1); PG8_STAGE(PG8_SB(1, 0), b3, voffB); PG8_STAGE(PG8_SB(1, 1), b3 + hstep, voffB);
            PG8_WAIT_V(6); PG8_WAIT_L(0); PG8_BAR; PG8_MMA(1, 0, At, B0); PG8_MMA(1, 1, At, B1); PG8_BAR; PG8_SCHED;
            } else {
            PG8_LDB(B0, 0, 0); PG8_LDB(B1, 0, 1); PG8_SCHED; PG8_LDA(At, 0, 0); PG8_STA(PG8_SA(1, 1), a1 + hstep, (size_t)(t + 1) * kstep, 1, false);
            PG8_WAIT_V(8); PG8_WAIT_L(0); PG8_BAR; PG8_MMA(0, 0, At, B0); PG8_MMA(0, 1, At, B1); PG8_BAR; PG8_SCHED;
            PG8_LDA(At, 0, 1); PG8_STAGE(PG8_SB(0, 0), b2, voffB); PG8_STAGE(PG8_SB(0, 1), b2 + hstep, voffB); PG8_STA(PG8_SA(0, 0), a2, kb2, 0, nx);
            PG8_WAIT_V(8); PG8_WAIT_L(0); PG8_BAR; PG8_MMA(1, 0, At, B0); PG8_MMA(1, 1, At, B1); PG8_BAR; PG8_SCHED;
            PG8_LDB(B0, 1, 0); PG8_LDB(B1, 1, 1); PG8_SCHED; PG8_LDA(At, 1, 0); PG8_STA(PG8_SA(0, 1), a2 + hstep, kb2, 1, nx);
            PG8_WAIT_V(8); PG8_WAIT_L(0); PG8_BAR; PG8_MMA(0, 0, At, B0); PG8_MMA(0, 1, At, B1); PG8_BAR; PG8_SCHED;
            PG8_LDA(At, 1, 1); PG8_STAGE(PG8_SB(1, 0), b3, voffB); PG8_STAGE(PG8_SB(1, 1), b3 + hstep, voffB); PG8_STA(PG8_SA(1, 0), a3, kb2 + kstep, 0, nx);
            PG8_WAIT_V(8); PG8_WAIT_L(0); PG8_BAR; PG8_MMA(1, 0, At, B0); PG8_MMA(1, 1, At, B1); PG8_BAR; PG8_SCHED;
            }
            } else {
            PG8_LDB(B0, 0, 0); PG8_SCHED; PG8_LDA(At, 0, 0); PG8_STAGE(PG8_SA(1, 1), a1 + hstep, voffA);
            PG8_WAIT_L(8); PG8_BAR; PG8_WAIT_L(0); PG8_MMA(0, 0, At, B0); PG8_BAR; PG8_SCHED;
            PG8_LDB(B1, 0, 1); PG8_STAGE(PG8_SB(0, 0), b2, voffB);
            PG8_BAR; PG8_WAIT_L(0); PG8_MMA(0, 1, At, B1); PG8_BAR;
            PG8_LDA(At, 0, 1); PG8_STAGE(PG8_SA(0, 0), a2, voffA);
            PG8_BAR; PG8_WAIT_L(0); PG8_MMA(1, 0, At, B0); PG8_BAR; PG8_SCHED;
            PG8_STAGE(PG8_SB(0, 1), b2 + hstep, voffB);
            PG8_WAIT_V(6); PG8_BAR; PG8_MMA(1, 1, At, B1); PG8_BAR;
            PG8_LDB(B0, 1, 0); PG8_SCHED; PG8_LDA(At, 1, 0); PG8_STAGE(PG8_SA(0, 1), a2 + hstep, voffA);
            PG8_WAIT_L(8); PG8_BAR; PG8_WAIT_L(0); PG8_MMA(0, 0, At, B0); PG8_BAR; PG8_SCHED;
            PG8_LDB(B1, 1, 1); PG8_STAGE(PG8_SB(1, 0), b3, voffB);
            PG8_BAR; PG8_WAIT_L(0); PG8_MMA(0, 1, At, B1); PG8_BAR;
            PG8_LDA(At, 1, 1); PG8_STAGE(PG8_SA(1, 0), a3, voffA);
            PG8_BAR; PG8_WAIT_L(0); PG8_MMA(1, 0, At, B0); PG8_BAR; PG8_SCHED;
            PG8_STAGE(PG8_SB(1, 1), b3 + hstep, voffB);
            PG8_WAIT_V(6); PG8_BAR; PG8_MMA(1, 1, At, B1); PG8_BAR;
            }
        }
        if constexpr (FP8) asm volatile("s_nop 15\n\ts_nop 7" ::: "memory");
        if constexpr (ALIGN_EPI) { if (wr == 0) PG8_BAR; }
        if constexpr (!Epi::AFTER_DRAIN) { int fr_ = fr, fq_ = fq; asm volatile("" : "+v"(fr_), "+v"(fq_));
            E(acc, cur, wr, wc, fr_, fq_); S.done(cur); }
        if (!has_next) break;
#pragma unroll
        for (int a = 0; a < 2; ++a)
#pragma unroll
            for (int b = 0; b < 2; ++b)
#pragma unroll
                for (int m = 0; m < 4; ++m)
#pragma unroll
                    for (int n = 0; n < 2; ++n) acc[a][b][m][n] = (f32x4){0.f, 0.f, 0.f, 0.f};
        cur = nxt; cA = nA; cB = nB; ++ui;
        if constexpr (GATHER) { vC[0][0] = vN[0][0]; vC[0][1] = vN[0][1]; vC[1][0] = vN[1][0]; vC[1][1] = vN[1][1]; }
        if constexpr (ALIGN_EPI) { if (wr == 1) PG8_BAR; }
    }
    PG8_WAIT_V(0);
    if constexpr (!ALIGN_EPI) { if (wr == 0) PG8_BAR; }
    PG8_BAR;
    if constexpr (Epi::AFTER_DRAIN) { E.fused(acc, cur, wr, wc, fr, fq, lds, wid, lane); S.done(cur); }
#undef PG8_SA
#undef PG8_SB
#undef PG8_STAGE
#undef PG8_GDMA
#undef PG8_GREAD
#undef PG8_GSTAGE
#undef PG8_STA
#undef PG8_LDA
#undef PG8_LDB
#undef PG8_MMA
#undef PG8_CAT
#undef PG8_WAIT_V
#undef PG8_WAIT_L
#undef PG8_BAR
#undef PG8_SCHED
}
}

#define GAS __attribute__((address_space(1)))
#define LAS __attribute__((address_space(3)))
typedef unsigned v4u __attribute__((ext_vector_type(4)));
using pg8::f32x4;
typedef GAS unsigned gu32;
typedef GAS unsigned long long gu64;
#define RLX_AGENT __ATOMIC_RELAXED, __HIP_MEMORY_SCOPE_AGENT
#define LDS_WAIT() asm volatile("s_waitcnt lgkmcnt(0)" ::: "memory")
#define VM_WAIT() asm volatile("s_waitcnt vmcnt(0)" ::: "memory")

#define XB_TMO      128
#define XB_XCNT(j)  (256  + 64 * (j))
#define XB_XSUB(j)  (1280 + 64 * (j))
#define XB_XGEN(j)  (2304 + 64 * (j))
#define XB_TOP      3328
#define XB_TOPGEN   3392
#define XCD_BAR_WORDS 3456
#define XB_SPIN_CAP (1u << 18)

__device__ __forceinline__ unsigned xb_ld(unsigned* p)              { return __hip_atomic_load(p, __ATOMIC_RELAXED, __HIP_MEMORY_SCOPE_AGENT); }
__device__ __forceinline__ unsigned xb_add(unsigned* p, unsigned v) { return __hip_atomic_fetch_add(p, v, __ATOMIC_RELAXED, __HIP_MEMORY_SCOPE_AGENT); }
__device__ __forceinline__ unsigned xb_xcc_id() { return (unsigned)__builtin_amdgcn_s_getreg((3 << 11) | 20) & 0xFu; }
#define XB_SPIN(cond, bar) do { unsigned _sp = 0; while (cond) { __builtin_amdgcn_s_sleep(1); \
    if ((++_sp & 255u) == 0u) { if (xb_ld(&(bar)[XB_TMO])) break; if (_sp > XB_SPIN_CAP) { atomicAdd(&(bar)[XB_TMO], 1u); break; } } } } while (0)

struct XcdBarrier {
    unsigned* bar; unsigned x;
    volatile LAS unsigned* st;
};

__device__ __forceinline__ XcdBarrier xcd_barrier_post(unsigned* bar, volatile LAS unsigned* st) {
    XcdBarrier b; b.bar = bar; b.x = xb_xcc_id(); b.st = st;
    if (threadIdx.x == 0) (void)xb_add(&bar[XB_XCNT(b.x)], 1u);
    return b;
}
__device__ __forceinline__ void xcd_barrier_complete(unsigned* bar, unsigned x, unsigned& nloc, unsigned& nx) {
    const unsigned G = gridDim.x * gridDim.y * gridDim.z;
    unsigned sum, cnt, mine, sp = 0u;
    for (;;) {
        sum = 0u; cnt = 0u; mine = 0u;
#pragma unroll
        for (unsigned j = 0; j < 16; ++j) { const unsigned c = xb_ld(&bar[XB_XCNT(j)]); sum += c; cnt += (c > 0u) ? 1u : 0u; mine = (j == x) ? c : mine; }
        if (sum == G) break;
        __builtin_amdgcn_s_sleep(1);
        if ((++sp & 255u) == 0u) { if (xb_ld(&bar[XB_TMO])) break; if (sp > XB_SPIN_CAP) { atomicAdd(&bar[XB_TMO], 1u); break; } }
    }
    nloc = mine > 0u ? mine : 1u; nx = cnt > 0u ? cnt : 1u;
}

__device__ __forceinline__ void xcd_barrier(const XcdBarrier& b) {
    asm volatile("s_waitcnt vmcnt(0)" ::: "memory");
    __syncthreads();
    if (threadIdx.x == 0) {
        unsigned* bar = b.bar;
        __builtin_amdgcn_s_waitcnt(0);
        unsigned nloc = b.st[0], nx = b.st[1];
        if (nloc == 0u) { xcd_barrier_complete(bar, b.x, nloc, nx); b.st[0] = nloc; b.st[1] = nx; }
        const unsigned old = xb_add(&bar[XB_XSUB(b.x)], 1u);
        const unsigned gen = old / nloc;
        if (old + 1u == (gen + 1u) * nloc) {
            __builtin_amdgcn_fence(__ATOMIC_RELEASE, "agent");
            asm volatile("s_waitcnt vmcnt(0)" ::: "memory");
            const unsigned og = xb_add(&bar[XB_TOP], 1u);
            const unsigned tg = og / nx;
            if (og + 1u == (tg + 1u) * nx) xb_add(&bar[XB_TOPGEN], 1u);
            else XB_SPIN(xb_ld(&bar[XB_TOPGEN]) == tg, bar);
            __builtin_amdgcn_fence(__ATOMIC_ACQUIRE, "agent");
            xb_add(&bar[XB_XGEN(b.x)], 1u);
            asm volatile("s_waitcnt vmcnt(0)" ::: "memory");
        } else {
            XB_SPIN(xb_ld(&bar[XB_XGEN(b.x)]) == gen, bar);
            __builtin_amdgcn_fence(__ATOMIC_ACQUIRE, "agent");
            asm volatile("s_waitcnt vmcnt(0)" ::: "memory");
        }
    }
    __syncthreads();
}


namespace attn_body {
using bf16=__hip_bfloat16;
using bf16x8=__attribute__((ext_vector_type(8)))short;
using s16x4=__attribute__((ext_vector_type(4)))short;
using f32x16=__attribute__((ext_vector_type(16)))float;
using u32x4=__attribute__((ext_vector_type(4)))unsigned;
constexpr int SEQ=4096,D=64,KP=2048,OP=1024;
constexpr int NW=8,QBLK=32,QB=QBLK*NW,KVBLK=64,NQB=SEQ/QB;
__device__ __forceinline__ int crow(int r,int hi){return (r&3)+8*(r>>2)+4*hi;}
#define SBAR() __builtin_amdgcn_sched_barrier(0)
constexpr int NSLOT=3, SLOTB=8192;
constexpr int LDS_K=0, LDS_V=NSLOT*SLOTB, LDS_WS=2*NSLOT*SLOTB, LDS_OST=LDS_WS+NW*64*4, LDS_BYTES=LDS_OST+NW*4096;
constexpr float C2=0.125f*1.4426950408889634f;
__device__ __forceinline__ void glds16(const void*gsrc,unsigned lds_dst){unsigned keep;
  asm volatile("s_mov_b32 %0, m0\n\ts_mov_b32 m0, %2\n\ts_nop 0\n\tglobal_load_lds_dwordx4 %1, off\n\ts_mov_b32 m0, %0":"=&s"(keep):"v"(gsrc),"s"(lds_dst):"memory");}
__device__ __forceinline__ float max3f(float a,float b,float c){float r;asm("v_max3_f32 %0, %1, %2, %3":"=v"(r):"v"(a),"v"(b),"v"(c));return r;}
__device__ __forceinline__ float max2f(float a,float b){float r;asm("v_max_f32_e32 %0, %1, %2":"=v"(r):"v"(a),"v"(b));return r;}
__device__ __forceinline__ float fadd_s(float a,float b){float r;asm("v_add_f32_e32 %0, %1, %2":"=v"(r):"v"(a),"v"(b));return r;}
__device__ __forceinline__ float fsub_s(float a,float b){float r;asm("v_sub_f32_e32 %0, %1, %2":"=v"(r):"v"(a),"v"(b));return r;}
typedef float f32x2_t __attribute__((ext_vector_type(2))); typedef __bf16 bf16x2_t __attribute__((ext_vector_type(2)));
__device__ __forceinline__ unsigned cvtpk_s(float lo,float hi){f32x2_t v={lo,hi};bf16x2_t b=__builtin_convertvector(v,bf16x2_t);return __builtin_bit_cast(unsigned,b);}
#define WAIT_BAR(N) asm volatile("s_waitcnt vmcnt(" #N ") lgkmcnt(0)\n\ts_barrier":::"memory")

__device__ __forceinline__ void qkt(f32x16&p0,f32x16&p1,const char*Kslot,const bf16x8*qr,const f32x16&negm,int r32,int hi){
  const char*kb=Kslot+hi*1024+r32*16;
  #pragma unroll
  for(int d0=0;d0<4;++d0){
    const bf16x8 b0=*reinterpret_cast<const bf16x8*>(kb+d0*2048);
    const bf16x8 b1=*reinterpret_cast<const bf16x8*>(kb+d0*2048+512);
    if(d0==0){p0=__builtin_amdgcn_mfma_f32_32x32x16_bf16(b0,qr[0],negm,0,0,0);p1=__builtin_amdgcn_mfma_f32_32x32x16_bf16(b1,qr[0],negm,0,0,0);}
    else{p0=__builtin_amdgcn_mfma_f32_32x32x16_bf16(b0,qr[d0],p0,0,0,0);p1=__builtin_amdgcn_mfma_f32_32x32x16_bf16(b1,qr[d0],p1,0,0,0);}}
}
typedef __attribute__((address_space(3))) const char* lds_cptr;
typedef short v4i16_t __attribute__((ext_vector_type(4)));
__device__ __forceinline__ void kload8(bf16x8*kf,lds_cptr kp){
  kf[0]=*(const __attribute__((address_space(3))) bf16x8*)(kp);      kf[1]=*(const __attribute__((address_space(3))) bf16x8*)(kp+512);
  kf[2]=*(const __attribute__((address_space(3))) bf16x8*)(kp+2048); kf[3]=*(const __attribute__((address_space(3))) bf16x8*)(kp+2560);
  kf[4]=*(const __attribute__((address_space(3))) bf16x8*)(kp+4096); kf[5]=*(const __attribute__((address_space(3))) bf16x8*)(kp+4608);
  kf[6]=*(const __attribute__((address_space(3))) bf16x8*)(kp+6144); kf[7]=*(const __attribute__((address_space(3))) bf16x8*)(kp+6656);
}
__device__ __forceinline__ void kload2(bf16x8*kf,lds_cptr kp,int j){ kf[2*j]=*(const __attribute__((address_space(3))) bf16x8*)(kp+j*2048); kf[2*j+1]=*(const __attribute__((address_space(3))) bf16x8*)(kp+j*2048+512); }
__device__ __forceinline__ s16x4 vtr(lds_cptr p){ return __builtin_bit_cast(s16x4,__builtin_amdgcn_ds_read_tr16_b64_v4i16((__attribute__((address_space(3))) v4i16_t*)p)); }
__device__ __forceinline__ float rowmax(const f32x16&p0,const f32x16&p1){
  float a=max3f(p0[0],p0[1],p1[0]),b=max3f(p0[2],p0[3],p1[1]);a=max3f(a,p1[2],p1[3]);
  #pragma unroll
  for(int r=4;r<16;r+=4){a=max3f(a,p0[r],p0[r+1]);b=max3f(b,p0[r+2],p0[r+3]);a=max3f(a,p1[r],p1[r+1]);b=max3f(b,p1[r+2],p1[r+3]);}
  const float m=max2f(a,b);
  auto rr=__builtin_amdgcn_permlane32_swap(__float_as_uint(m),__float_as_uint(m),false,false);
  return max2f(__uint_as_float(rr[0]),__uint_as_float(rr[1]));
}
__device__ __forceinline__ void pv(f32x16*o,int vb,bf16x8 pa0,bf16x8 pa1,bf16x8 pa2,bf16x8 pa3){
  #pragma unroll
  for(int d0=0;d0<2;++d0){s16x4 lo[4],hi[4];
    #pragma unroll
    for(int ks=0;ks<4;++ks){
      asm volatile("ds_read_b64_tr_b16 %0,%1 offset:%c2":"=&v"(lo[ks]):"v"(vb),"i"(d0*4096+ks*1024):"memory");
      asm volatile("ds_read_b64_tr_b16 %0,%1 offset:%c2":"=&v"(hi[ks]):"v"(vb),"i"(d0*4096+ks*1024+512):"memory");}
    asm volatile("s_waitcnt lgkmcnt(0)":::"memory");SBAR();
    #define PK(k) (bf16x8){lo[k][0],lo[k][1],lo[k][2],lo[k][3],hi[k][0],hi[k][1],hi[k][2],hi[k][3]}
    o[d0]=__builtin_amdgcn_mfma_f32_32x32x16_bf16(pa0,PK(0),o[d0],0,0,0);
    o[d0]=__builtin_amdgcn_mfma_f32_32x32x16_bf16(pa1,PK(1),o[d0],0,0,0);
    o[d0]=__builtin_amdgcn_mfma_f32_32x32x16_bf16(pa2,PK(2),o[d0],0,0,0);
    o[d0]=__builtin_amdgcn_mfma_f32_32x32x16_bf16(pa3,PK(3),o[d0],0,0,0);
    #undef PK
  }
}

#ifndef ATTN_STORE16
#define ATTN_STORE16(p,v) (*(u32x4*)(p)=(v))
#endif
template<int THRL,bool NOMAX=false,bool MSUM=true> __device__ __forceinline__ void attn_unit(const bf16*Qw0,const bf16*__restrict__ Kh,const bf16*__restrict__ Vh,bf16*Ow0,char*shm,int tid_in){
  int tid_=tid_in; asm volatile("":"+v"(tid_));
  const int tid=tid_,lane=tid&63,r32=lane&31,hi=lane>>5; const int wid=__builtin_amdgcn_readfirstlane(tid>>6);
  const bf16*Qw=Qw0+(long)(wid*QBLK)*KP;
  const unsigned lds0=(unsigned)(uintptr_t)shm;
  float*wsf=(float*)(shm+LDS_WS)+wid*64;
  const bf16*ksrc=Kh+(long)lane*KP+wid*8;
  const bf16*vsrc=Vh+(long)(16*(wid&3)+(lane>>2))*KP+(wid>>2)*32+(lane&3)*8;
  const unsigned kdst=lds0+LDS_K+wid*1024, vdst=lds0+LDS_V+wid*1024;
  #define DMA_K(t,slot) glds16(ksrc+(long)(t)*KVBLK*KP,(unsigned)__builtin_amdgcn_readfirstlane(kdst+(slot)))
  #define DMA_V(t,slot) glds16(vsrc+(long)(t)*KVBLK*KP,(unsigned)__builtin_amdgcn_readfirstlane(vdst+(slot)))
  const int vb0=(int)(lds0+LDS_V)+((lane>>4)&1)*32+(lane&3)*8+(4*hi+((lane&15)>>2))*64;
  const char*Kbase=shm+LDS_K; bf16x8 kf[8];
  const lds_cptr shm3=(lds_cptr)shm; const lds_cptr kp0=shm3+LDS_K+hi*1024+r32*16; const lds_cptr vp0=shm3+LDS_V+((lane>>4)&1)*32+(lane&3)*8+(4*hi+((lane&15)>>2))*64;
  constexpr int NT=SEQ/KVBLK;
  DMA_K(0,0);DMA_V(0,0);DMA_K(1,SLOTB);
  bf16x8 qr[4];
  #pragma unroll
  for(int d0=0;d0<4;++d0)qr[d0]=*reinterpret_cast<const bf16x8*>(&Qw[(long)r32*KP+d0*16+hi*8]);
  float mhat=0.f,l_reg=0.f;f32x16 o[2];o[0]=f32x16{};o[1]=f32x16{};f32x16 negm=f32x16{};if constexpr(!NOMAX)asm volatile("":"+v"(negm));
  f32x16 lsum=f32x16{}; const bf16x8 ONESF={(short)0x3F80,(short)0x3F80,(short)0x3F80,(short)0x3F80,(short)0x3F80,(short)0x3F80,(short)0x3F80,(short)0x3F80};
  #define CMASK(P0,P1,t) do{}while(0)
  bool resc=false;
  #define START(P0,P1) do{ if constexpr(!NOMAX){ const float rm=rowmax(P0,P1); resc=false; \
    { const float dl=rm; mhat=fadd_s(mhat,dl); \
      _Pragma("unroll") for(int r=0;r<16;++r){P0[r]=fsub_s(P0[r],dl);P1[r]=fsub_s(P1[r],dl);} \
      _Pragma("unroll") for(int r=0;r<16;++r)negm[r]=-mhat; asm volatile("":"+v"(negm)); } } \
    _Pragma("unroll") for(int r=0;r<16;++r)P0[r]=__builtin_amdgcn_exp2f(P0[r]); }while(0)
  #define RESC() do{ if(resc){ asm volatile("s_waitcnt lgkmcnt(0)":::"memory"); \
      _Pragma("unroll") for(int d_=0;d_<2;++d_) _Pragma("unroll") for(int r=0;r<16;++r)o[d_][r]*=wsf[crow(r,hi)]; } }while(0)
  f32x16 pA0,pA1,pB0,pB1;
  int sl_prev=0,sl_cur=0,sl_next=SLOTB;
  #define ROT() do{sl_prev=sl_cur;sl_cur=sl_next;sl_next=(sl_next==(NSLOT-1)*SLOTB)?0:sl_next+SLOTB;}while(0)
  DMA_K(2,2*SLOTB);
  WAIT_BAR(3);
  qkt(pA0,pA1,Kbase,qr,negm,r32,hi);asm volatile("s_nop 15\n\ts_nop 7":"+v"(pA0),"+v"(pA1));CMASK(pA0,pA1,0);
  START(pA0,pA1);
  _Pragma("unroll") for(int r=0;r<16;++r)pA1[r]=__builtin_amdgcn_exp2f(pA1[r]);
  WAIT_BAR(0);
  DMA_K(3,0);DMA_V(1,SLOTB);
  ROT();
  kload8(kf,kp0+sl_cur);
  WAIT_BAR(2);
  s16x4 vlo[8],vhi[8]; u32x4 pw0,pw1,pw2,pw3;
  #define PKW(P,B) cvtpk_s(P[B],P[B+1])
  #define PAF(k) __builtin_bit_cast(bf16x8,pw##k)
  #define VFR(i) (bf16x8){vlo[i][0],vlo[i][1],vlo[i][2],vlo[i][3],vhi[i][0],vhi[i][1],vhi[i][2],vhi[i][3]}
  #define PIN(x) asm volatile("":"+v"(x))
  #define MX3(a,b,c) __builtin_fmaxf(__builtin_fmaxf((a),(b)),(c))
  #define GAPA(MF,A0,A1,A2,A3,W0,W1,PW) do{ MF; if constexpr(!(NOMAX&&MSUM)){ sacc+=A0; sacc+=A1; sacc+=A2; sacc+=A3; PIN(sacc); } W0; W1; PIN(PW); SBAR(); }while(0)
  #define LSUM(k) do{ if constexpr(NOMAX&&MSUM){ lsum=__builtin_amdgcn_mfma_f32_32x32x16_bf16(PAF(k),ONESF,lsum,0,0,0); SBAR(); } }while(0)
  #define EX(v) __builtin_amdgcn_exp2f(v)
  #define GAPB(MF,X,B) do{ MF; X[B]=EX(X[B]); X[B+1]=EX(X[B+1]); X[B+2]=EX(X[B+2]); X[B+3]=EX(X[B+3]); PIN(X); SBAR(); }while(0)
  #define VRD(i) do{ vlo[i]=vtr(vp_+(((i)>>2)*4096+((i)&3)*1024)); vhi[i]=vtr(vp_+(((i)>>2)*4096+((i)&3)*1024+512)); }while(0)
  #define KRD(G,j) do{ if(G){ kload2(kf,kp0+sl_next,j); SBAR(); } }while(0)
  #define STEP(C0,C1,P0,P1,t,GK,GV,GL) do{ SBAR(); \
    const lds_cptr vp_=vp0+sl_prev; \
    VRD(0); SBAR(); float sacc=0.f; if constexpr(!(NOMAX&&MSUM)) sacc=(P0[0]+P0[1]); \
    GAPA(C0=__builtin_amdgcn_mfma_f32_32x32x16_bf16(kf[0],qr[0],negm,0,0,0), P0[2],P0[3],P0[4],P0[5],     pw0[0]=PKW(P0,0), pw0[1]=PKW(P0,2), pw0); \
    VRD(4); SBAR(); GAPA(C1=__builtin_amdgcn_mfma_f32_32x32x16_bf16(kf[1],qr[0],negm,0,0,0), P0[6],P0[7],P0[8],P0[9],     pw0[2]=PKW(P0,4), pw0[3]=PKW(P0,6), pw0); \
    VRD(1); SBAR(); GAPA(C0=__builtin_amdgcn_mfma_f32_32x32x16_bf16(kf[2],qr[1],C0,0,0,0),   P0[10],P0[11],P0[12],P0[13], pw1[0]=PKW(P0,8), pw1[1]=PKW(P0,10), pw1); \
    VRD(5); SBAR(); GAPA(C1=__builtin_amdgcn_mfma_f32_32x32x16_bf16(kf[3],qr[1],C1,0,0,0),   P0[14],P0[15],P1[0],P1[1],   pw1[2]=PKW(P0,12),pw1[3]=PKW(P0,14), pw1); \
    VRD(2); SBAR(); GAPA(C0=__builtin_amdgcn_mfma_f32_32x32x16_bf16(kf[4],qr[2],C0,0,0,0),   P1[2],P1[3],P1[4],P1[5],     pw2[0]=PKW(P1,0), pw2[1]=PKW(P1,2), pw2); \
    VRD(6); SBAR(); GAPA(C1=__builtin_amdgcn_mfma_f32_32x32x16_bf16(kf[5],qr[2],C1,0,0,0),   P1[6],P1[7],P1[8],P1[9],     pw2[2]=PKW(P1,4), pw2[3]=PKW(P1,6), pw2); \
    VRD(3); SBAR(); GAPA(C0=__builtin_amdgcn_mfma_f32_32x32x16_bf16(kf[6],qr[3],C0,0,0,0),   P1[10],P1[11],P1[12],P1[13], pw3[0]=PKW(P1,8), pw3[1]=PKW(P1,10), pw3); \
    VRD(7); SBAR(); GAPA(C1=__builtin_amdgcn_mfma_f32_32x32x16_bf16(kf[7],qr[3],C1,0,0,0),   P1[14],P1[15],0.f,0.f,       pw3[2]=PKW(P1,12),pw3[3]=PKW(P1,14), pw3); \
    l_reg+=sacc; \
    if(GK){DMA_K((t)+3,sl_cur);} if(GV){DMA_V((t)+1,sl_next);} \
    CMASK(C0,C1,t); \
    if constexpr(!NOMAX){ float a=MX3(C0[0],C0[1],C1[0]),b=MX3(C0[2],C0[3],C1[1]); a=MX3(a,C1[2],C1[3]); \
      _Pragma("unroll") for(int r=4;r<16;r+=4){a=MX3(a,C0[r],C0[r+1]);b=MX3(b,C0[r+2],C0[r+3]);a=MX3(a,C1[r],C1[r+1]);b=MX3(b,C1[r+2],C1[r+3]);} \
      float rm=__builtin_fmaxf(a,b); { auto rr=__builtin_amdgcn_permlane32_swap(__float_as_uint(rm),__float_as_uint(rm),false,false); rm=__builtin_fmaxf(__uint_as_float(rr[0]),__uint_as_float(rr[1])); } \
      resc=false; \
      if(__builtin_expect(__any(rm>(float)THRL),0)){ const float dl=__builtin_fmaxf(rm,0.f); mhat+=dl; \
        _Pragma("unroll") for(int r=0;r<16;++r){C0[r]-=dl;C1[r]-=dl;} \
        _Pragma("unroll") for(int r=0;r<16;++r)negm[r]=-mhat; asm volatile("":"+v"(negm)); \
        const float f=__builtin_amdgcn_exp2f(-dl); l_reg*=f; if(hi==0)wsf[r32]=f; resc=true; } } \
    SBAR(); \
    GAPB(o[0]=__builtin_amdgcn_mfma_f32_32x32x16_bf16(PAF(0),VFR(0),o[0],0,0,0), C0,0); \
    GAPB(o[1]=__builtin_amdgcn_mfma_f32_32x32x16_bf16(PAF(0),VFR(4),o[1],0,0,0), C0,4); LSUM(0); \
    KRD(GL,0); GAPB(o[0]=__builtin_amdgcn_mfma_f32_32x32x16_bf16(PAF(1),VFR(1),o[0],0,0,0), C0,8); \
    KRD(GL,1); GAPB(o[1]=__builtin_amdgcn_mfma_f32_32x32x16_bf16(PAF(1),VFR(5),o[1],0,0,0), C0,12); LSUM(1); \
    KRD(GL,2); GAPB(o[0]=__builtin_amdgcn_mfma_f32_32x32x16_bf16(PAF(2),VFR(2),o[0],0,0,0), C1,0); \
    KRD(GL,3); GAPB(o[1]=__builtin_amdgcn_mfma_f32_32x32x16_bf16(PAF(2),VFR(6),o[1],0,0,0), C1,4); LSUM(2); \
    GAPB(o[0]=__builtin_amdgcn_mfma_f32_32x32x16_bf16(PAF(3),VFR(3),o[0],0,0,0), C1,8); \
    GAPB(o[1]=__builtin_amdgcn_mfma_f32_32x32x16_bf16(PAF(3),VFR(7),o[1],0,0,0), C1,12); LSUM(3); \
    }while(0)
  int t=1;
  for(;t+5<NT;t+=2){
    STEP(pB0,pB1,pA0,pA1,t,true,true,true);     WAIT_BAR(2); RESC(); ROT();
    STEP(pA0,pA1,pB0,pB1,t+1,true,true,true);   WAIT_BAR(2); RESC(); ROT();
  }
  #define ENDW(tt) do{ if((tt)+3<NT){WAIT_BAR(2);} else if((tt)+2<NT){WAIT_BAR(1);} else {WAIT_BAR(0);} }while(0)
  for(;t+1<NT;t+=2){
    STEP(pB0,pB1,pA0,pA1,t,(t+3<NT),(t+1<NT),(t+1<NT));       ENDW(t);   RESC(); ROT();
    STEP(pA0,pA1,pB0,pB1,t+1,(t+4<NT),(t+2<NT),(t+2<NT));     ENDW(t+1); RESC(); ROT();
  }
  STEP(pB0,pB1,pA0,pA1,NT-1,false,false,false); RESC();
  { if constexpr(!(NOMAX&&MSUM)){ float sacc=pB0[0]+pB0[1]; _Pragma("unroll") for(int r=2;r<16;++r)sacc+=pB0[r]; _Pragma("unroll") for(int r=0;r<16;++r)sacc+=pB1[r]; l_reg+=sacc; }
    pw0=(u32x4){PKW(pB0,0),PKW(pB0,2),PKW(pB0,4),PKW(pB0,6)};pw1=(u32x4){PKW(pB0,8),PKW(pB0,10),PKW(pB0,12),PKW(pB0,14)};pw2=(u32x4){PKW(pB1,0),PKW(pB1,2),PKW(pB1,4),PKW(pB1,6)};pw3=(u32x4){PKW(pB1,8),PKW(pB1,10),PKW(pB1,12),PKW(pB1,14)};
    SBAR(); pv(o,vb0+sl_cur,PAF(0),PAF(1),PAF(2),PAF(3)); LSUM(0); LSUM(1); LSUM(2); LSUM(3); }
  #undef PKW
  #undef PAF
  #undef VFR
  #undef PIN
  #undef MX3
  #undef GAPA
  #undef LSUM
  #undef GAPB
  #undef EX
  #undef VRD
  #undef KRD
  #undef STEP
  #undef ENDW
  float rli[16];
  if constexpr(NOMAX&&MSUM){
    #pragma unroll
    for(int r=0;r<16;++r)rli[r]=__builtin_amdgcn_rcpf(lsum[r]);
  } else {
  {auto rr=__builtin_amdgcn_permlane32_swap(__float_as_uint(l_reg),__float_as_uint(l_reg),false,false);l_reg=__uint_as_float(rr[0])+__uint_as_float(rr[1]);}
  if(hi==0)wsf[32+r32]=l_reg;asm volatile("s_waitcnt lgkmcnt(0)":::"memory");
  #pragma unroll
  for(int r=0;r<16;++r)rli[r]=__builtin_amdgcn_rcpf(wsf[32+crow(r,hi)]);
  }
  bf16*Ow=Ow0+(long)(wid*QBLK)*OP;
  { bf16*stg=(bf16*)(shm+LDS_OST)+wid*2048;
    #pragma unroll
    for(int r=0;r<16;++r){const int orow=crow(r,hi);
      #pragma unroll
      for(int d0=0;d0<2;++d0)stg[orow*64+d0*32+r32]=__float2bfloat16(o[d0][r]*rli[r]);}
    asm volatile("s_waitcnt lgkmcnt(0)":::"memory");
    #pragma unroll
    for(int i=0;i<4;++i){const int row=i*8+(lane>>3),ch=lane&7; const u32x4 v=*(const u32x4*)(stg+row*64+ch*8); ATTN_STORE16(Ow+(long)row*OP+ch*8,v);} }
  asm volatile("s_waitcnt lgkmcnt(0)\n\ts_barrier":::"memory");
  #undef DMA_K
  #undef DMA_V
  #undef CMASK
  #undef START
  #undef RESC
  #undef ROT
}
constexpr int ATTN_LDS_BYTES=LDS_BYTES;
#undef SBAR
#undef WAIT_BAR
}

typedef unsigned short bf16;
typedef float f32x16 __attribute__((ext_vector_type(16)));
typedef short s16x4 __attribute__((ext_vector_type(4)));
typedef short v4i16_t __attribute__((ext_vector_type(4)));
typedef unsigned u32x2 __attribute__((ext_vector_type(2)));
typedef float f32x2v __attribute__((ext_vector_type(2)));
using pg8::bf16x8; using pg8::u32x4;

constexpr int DM = 1024, SEQ = 4096, T_P = 4 * 4096, T_S = 16 * 4096, TT = T_P + T_S, NBATCH = 20;
constexpr int DIN = 2048, NLAYER = 4, NEXP = 16, DEXP = 2048;
constexpr int CAP_P = T_P / 8, CAP_S = T_S / 8, ROWS_P = NEXP * CAP_P, ROWS_E = 2 * TT;
constexpr float LN_EPS = 1e-5f, QK_EPS = 1e-6f;
constexpr float DN_ALPHA = 1.6817928305074290861f;
constexpr float LOG2E = 1.4426950408889634f;
constexpr float C2 = 0.125f * LOG2E;
constexpr int H_NAQ = 0, H_NAK = 256, H_NAV = 512, H_GQ = 768, H_GK = 1280, H_GV = 1408, H_UC = 1536, H_VC = 1792;
constexpr int Y_NA = 0, Y_GQA = 256, Y_SG = 768;

constexpr size_t MiB = 1u << 20;
constexpr size_t WS_CTL = 0, CTL_ZERO_BYTES = 1 * MiB;
constexpr size_t WS_ROPE = 1 * MiB;
constexpr size_t WS_WSBF = 2 * MiB;
constexpr size_t WS_WIN = 4 * MiB;
constexpr size_t WS_WOUT = 8 * MiB;
constexpr size_t WS_WGU = 16 * MiB;
constexpr size_t WS_WD = 144 * MiB;
constexpr size_t WS_AFF = 208 * MiB;
constexpr size_t WS_SLOTOF = 214 * MiB;
constexpr size_t WS_IDX = 220 * MiB;
constexpr size_t WS_GATE = 221 * MiB;
constexpr size_t WS_STATS = 222 * MiB;
constexpr size_t WS_XB = 224 * MiB;
constexpr size_t WS_H = 384 * MiB;
constexpr size_t WS_SB = 544 * MiB;
constexpr size_t WS_HID = 704 * MiB;
constexpr size_t WS_XB8 = 1344 * MiB;
constexpr size_t WS_VT = 1424 * MiB;
constexpr size_t WS_SET1 = 1468 * MiB;
constexpr size_t WS_DUMMY = 1676 * MiB;
constexpr size_t WS_END = 1676 * MiB;
__device__ __forceinline__ size_t wset(int l) { return (l & 1) ? (WS_SET1 - 2 * MiB) : (size_t)0; }
#ifndef CONV_SPLIT_ITEMS
#define CONV_SPLIT_ITEMS 20480
#endif
constexpr int VTP = SEQ + 64;
constexpr int CW_TMO = 0, CW_BAR = 4096;

constexpr int NWAVES = 8;
constexpr int RING_BYTES = 131072, LDSCTL_OFF = RING_BYTES, MISC_OFF = LDSCTL_OFF + 320, LDS_BYTES = 147456;

__device__ __forceinline__ unsigned f2bf(float f) { unsigned u = __builtin_bit_cast(unsigned, f); return (u + 0x7fffu + ((u >> 16) & 1u)) >> 16; }
__device__ __forceinline__ unsigned pk2(float lo, float hi) { typedef float f2_t __attribute__((ext_vector_type(2))); typedef __bf16 b2_t __attribute__((ext_vector_type(2))); const f2_t v = {lo, hi}; return __builtin_bit_cast(unsigned, __builtin_convertvector(v, b2_t)); }
__device__ __forceinline__ float bf2f(unsigned short b) { return __builtin_bit_cast(float, (unsigned)b << 16); }
template <int CTRL> __device__ __forceinline__ float dppf(float v) { return __builtin_bit_cast(float, __builtin_amdgcn_update_dpp(0, __builtin_bit_cast(int, v), CTRL, 0xf, 0xf, false)); }
template <int O> __device__ __forceinline__ float shx(float v) { static_assert(O == 1 || O == 2, "exact xor partners: 1, 2"); return dppf<(O == 1) ? 0xB1 : 0x4E>(v); }
template <int O> __device__ __forceinline__ float shm(float v) { static_assert(O == 4 || O == 8, "mirror partners: 4 -> lane ^ 7, 8 -> lane ^ 15"); return dppf<(O == 4) ? 0x141 : 0x140>(v); }
__device__ __forceinline__ float sum16(float v) { const auto rr = __builtin_amdgcn_permlane16_swap(__float_as_uint(v), __float_as_uint(v), false, false); return __uint_as_float(rr[0]) + __uint_as_float(rr[1]); }
__device__ __forceinline__ float max16(float v) { const auto rr = __builtin_amdgcn_permlane16_swap(__float_as_uint(v), __float_as_uint(v), false, false); return fmaxf(__uint_as_float(rr[0]), __uint_as_float(rr[1])); }
__device__ __forceinline__ float other16(float v, bool odd_row) { const auto rr = __builtin_amdgcn_permlane16_swap(__float_as_uint(v), __float_as_uint(v), false, false); return __uint_as_float(odd_row ? rr[0] : rr[1]); }
__device__ __forceinline__ float sum32(float v) { const auto rr = __builtin_amdgcn_permlane32_swap(__float_as_uint(v), __float_as_uint(v), false, false); return __uint_as_float(rr[0]) + __uint_as_float(rr[1]); }
__device__ __forceinline__ float max32(float v) { const auto rr = __builtin_amdgcn_permlane32_swap(__float_as_uint(v), __float_as_uint(v), false, false); return fmaxf(__uint_as_float(rr[0]), __uint_as_float(rr[1])); }
__device__ __forceinline__ float other32(float v, bool upper) { const auto rr = __builtin_amdgcn_permlane32_swap(__float_as_uint(v), __float_as_uint(v), false, false); return __uint_as_float(upper ? rr[0] : rr[1]); }
__device__ __forceinline__ float wave_sum(float v) {
    v += shx<1>(v); v += shx<2>(v); v += shm<4>(v); v += shm<8>(v); v = sum16(v);
    return sum32(v);
}
__device__ __forceinline__ float gelu_tanh(float x) {
    constexpr float A = -2.0f * LOG2E * 0.7978845608028654f, B = A * 0.044715f;
    const float e = __builtin_amdgcn_exp2f(x * fmaf(x * x, B, A));
    return x * __builtin_amdgcn_rcpf(1.0f + e);
}
__device__ __forceinline__ float clamp8(float v) { return __builtin_amdgcn_fmed3f(v, -440.f, 440.f); }
__device__ __forceinline__ unsigned pk4_fp8(float a, float b, float c, float d) { int w = 0; w = __builtin_amdgcn_cvt_pk_fp8_f32(clamp8(a), clamp8(b), w, false); w = __builtin_amdgcn_cvt_pk_fp8_f32(clamp8(c), clamp8(d), w, true); return (unsigned)w; }
constexpr float WGU_SCALE = 64.f, WD_SCALE = 128.f, HID_SCALE = 8.f, YE_SCALE = 64.f;
__device__ __forceinline__ int crow(int r, int hi) { return (r & 3) + 8 * (r >> 2) + 4 * hi; }
__device__ __forceinline__ s16x4 tr_read(const LAS unsigned char* p) { return __builtin_bit_cast(s16x4, __builtin_amdgcn_ds_read_tr16_b64_v4i16((LAS v4i16_t*)p)); }
#define MFMA32(a, b, c) __builtin_amdgcn_mfma_f32_32x32x16_bf16((a), (b), (c), 0, 0, 0)

using pg8::Unit; using pg8::BM; using pg8::HALF;
__device__ __forceinline__ u32x4 pack8(const f32x4& a, const f32x4& b) { u32x4 w; w.x = pg8::cvt_pk_bf16(a[0], a[1]); w.y = pg8::cvt_pk_bf16(a[2], a[3]); w.z = pg8::cvt_pk_bf16(b[0], b[1]); w.w = pg8::cvt_pk_bf16(b[2], b[3]); return w; }

struct EpiIn {
    static constexpr bool PERM = true, AFTER_DRAIN = false;
    bf16* H; const float* qn; const float* kn; const float* gv; const float* bv; const float* rope; bf16* VT;
    __device__ __forceinline__ void operator()(const f32x4 (&acc)[2][2][4][2], const Unit& u, int wr, int wc, int fr, int fq) const {
        const int pn = u.pn;
        int mode; const float* gain = qn; float osc = 1.f;
        if (pn == 0) { mode = 1; osc = C2; } else if (pn <= 2) mode = 0; else if (pn <= 4) { mode = 2; gain = qn; osc = C2; }
        else if (pn == 5) { if (wc < 2) { mode = 2; gain = kn; osc = 1.f; } else mode = 0; } else if (pn == 6) mode = 3; else mode = 4;
        const int row0 = u.pm * BM + wr * 64 + fr;
        bf16* Hb = H + (size_t)row0 * DIN + pn * 256 + wc * 64 + 8 * fq;
#define EPI_ROWS(BODY) _Pragma("unroll") for (int ai = 0; ai < 2; ++ai) _Pragma("unroll") for (int m = 0; m < 4; ++m) { const int rofs = ai * HALF + m * 16; f32x4 v[2][2]; \
            _Pragma("unroll") for (int bj = 0; bj < 2; ++bj) _Pragma("unroll") for (int n = 0; n < 2; ++n) v[bj][n] = acc[ai][bj][m][n]; \
            BODY \
            bf16* rowp = Hb + (size_t)rofs * DIN; _Pragma("unroll") for (int bj = 0; bj < 2; ++bj) *(u32x4*)(rowp + 32 * bj) = pack8(v[bj][0], v[bj][1]); }
#define EPI_ALL(EXPR) _Pragma("unroll") for (int bj = 0; bj < 2; ++bj) _Pragma("unroll") for (int n = 0; n < 2; ++n) { EXPR }
        if (mode == 5) {
#pragma unroll
            for (int ai = 0; ai < 2; ++ai)
#pragma unroll
                for (int m = 0; m < 4; ++m) { const int t = row0 + ai * HALF + m * 16; bf16* vb = VT + ((size_t)((t >> 12) * 4 + wc) * 64 + 8 * fq) * VTP + (t & (SEQ - 1));
#pragma unroll
                    for (int bj = 0; bj < 2; ++bj)
#pragma unroll
                        for (int n = 0; n < 2; ++n)
#pragma unroll
                            for (int i = 0; i < 4; ++i) vb[(size_t)(32 * bj + 4 * n + i) * VTP] = (bf16)f2bf(acc[ai][bj][m][n][i]); }
        }
        else if (mode == 0) { EPI_ROWS( ; ) }
        else if (mode == 1) { EPI_ROWS( EPI_ALL( v[bj][n] = v[bj][n] * osc; ) ) }
        else if (mode == 2) {
            EPI_ROWS(
                float ss = 0.f;
                EPI_ALL( const f32x4 x = v[bj][n]; ss += (x[0] * x[0] + x[1] * x[1]) + (x[2] * x[2] + x[3] * x[3]); )
                ss = sum16(ss); ss = sum32(ss);
                const float rstd = osc * __builtin_amdgcn_rsqf(ss * (1.0f / 64.0f) + QK_EPS);
                const int sp = (row0 + rofs) & (SEQ - 1);
                EPI_ALL(
                    const f32x4 gg = *(const f32x4*)(gain + 32 * bj + 8 * fq + 4 * n);
                    const f32x4 cs = *(const f32x4*)(rope + ((size_t)sp * 32 + 16 * bj + 4 * fq + 2 * n) * 2);
                    const f32x4 x = v[bj][n] * rstd * gg;
                    f32x4 o; o[0] = x[0] * cs[0] - x[1] * cs[1]; o[1] = x[0] * cs[1] + x[1] * cs[0]; o[2] = x[2] * cs[2] - x[3] * cs[3]; o[3] = x[2] * cs[3] + x[3] * cs[2];
                    v[bj][n] = o; )
                asm volatile("" ::: "memory");
            )
        } else if (mode == 3) {
            EPI_ROWS( EPI_ALL( f32x4 x = v[bj][n]; x[0] = gelu_tanh(x[0]); x[1] = gelu_tanh(x[1]); x[2] = gelu_tanh(x[2]); x[3] = gelu_tanh(x[3]); v[bj][n] = x; ) )
        } else {
            EPI_ROWS(
                EPI_ALL( f32x4 x = v[bj][n]; x[0] = gelu_tanh(x[0]); x[1] = gelu_tanh(x[1]); x[2] = gelu_tanh(x[2]); x[3] = gelu_tanh(x[3]); v[bj][n] = x; )
                float sm = 0.f;
                EPI_ALL( const f32x4 x = v[bj][n]; sm += (x[0] + x[1]) + (x[2] + x[3]); )
                sm = sum16(sm); sm = sum32(sm);
                const float mean = sm * (1.0f / 64.0f); float q = 0.f;
                EPI_ALL( const f32x4 d = v[bj][n] - mean; v[bj][n] = d; q += (d[0] * d[0] + d[1] * d[1]) + (d[2] * d[2] + d[3] * d[3]); )
                q = sum16(q); q = sum32(q);
                const float rstd = __builtin_amdgcn_rsqf(q * (1.0f / 64.0f) + LN_EPS);
                EPI_ALL( const f32x4 gg = *(const f32x4*)(gv + wc * 64 + 32 * bj + 8 * fq + 4 * n); const f32x4 bb = *(const f32x4*)(bv + wc * 64 + 32 * bj + 8 * fq + 4 * n); v[bj][n] = v[bj][n] * rstd * gg + bb; )
                asm volatile("" ::: "memory");
            )
        }
#undef EPI_ROWS
#undef EPI_ALL
    }
};
struct EpiRes {
    static constexpr bool PERM = true, AFTER_DRAIN = false;
    const bf16* XB; bf16* S;
    __device__ __forceinline__ void operator()(const f32x4 (&acc)[2][2][4][2], const Unit& u, int wr, int wc, int fr, int fq) const {
        const int row0 = u.pm * BM + wr * 64 + fr, col0 = u.pn * BM + wc * 32 + 8 * fq;
#pragma unroll
        for (int ai = 0; ai < 2; ++ai)
#pragma unroll
            for (int m = 0; m < 4; ++m) { const size_t ro = (size_t)(row0 + ai * HALF + m * 16) * DM + col0;
#pragma unroll
                for (int bj = 0; bj < 2; ++bj) { const u32x4 xw = *(const u32x4*)(XB + ro + bj * HALF);
                    f32x4 x0, x1; x0[0] = __builtin_bit_cast(float, xw.x << 16); x0[1] = __builtin_bit_cast(float, xw.x & 0xffff0000u); x0[2] = __builtin_bit_cast(float, xw.y << 16); x0[3] = __builtin_bit_cast(float, xw.y & 0xffff0000u);
                    x1[0] = __builtin_bit_cast(float, xw.z << 16); x1[1] = __builtin_bit_cast(float, xw.z & 0xffff0000u); x1[2] = __builtin_bit_cast(float, xw.w << 16); x1[3] = __builtin_bit_cast(float, xw.w & 0xffff0000u);
                    const f32x4 s0 = x0 * DN_ALPHA + acc[ai][bj][m][0], s1 = x1 * DN_ALPHA + acc[ai][bj][m][1];
                    u32x4 o; o.x = pk2(s0[0], s0[1]); o.y = pk2(s0[2], s0[3]); o.z = pk2(s1[0], s1[1]); o.w = pk2(s1[2], s1[3]); *(u32x4*)(S + ro + bj * HALF) = o; } }
    }
};
struct EpiSwiglu {
    static constexpr bool PERM = true, AFTER_DRAIN = false;
    unsigned char* HID;
    __device__ __forceinline__ void operator()(const f32x4 (&acc)[2][2][4][2], const Unit& u, int wr, int wc, int fr, int fq) const {
        const int row0 = u.pm * BM + wr * 64 + fr, col0 = u.pn * 128 + wc * 32 + 8 * fq;
        constexpr float IS = 1.0f / WGU_SCALE, OS = HID_SCALE / WGU_SCALE;
#pragma unroll
        for (int ai = 0; ai < 2; ++ai)
#pragma unroll
            for (int m = 0; m < 4; ++m) { f32x4 o[2];
#pragma unroll
                for (int n = 0; n < 2; ++n) {
                    f32x4 t = acc[ai][0][m][n] * (-LOG2E * IS);
#pragma unroll
                    for (int i = 0; i < 4; ++i) t[i] = __builtin_amdgcn_exp2f(t[i]);
                    t = t * (1.0f / (IS * OS)) + (1.0f / (IS * OS));
#pragma unroll
                    for (int i = 0; i < 4; ++i) t[i] = __builtin_amdgcn_rcpf(t[i]);
                    o[n] = acc[ai][0][m][n] * acc[ai][1][m][n] * t; }
                u32x2 w; w.x = pk4_fp8(o[0][0], o[0][1], o[0][2], o[0][3]); w.y = pk4_fp8(o[1][0], o[1][1], o[1][2], o[1][3]);
                *(u32x2*)(HID + (size_t)(row0 + ai * HALF + m * 16) * DEXP + col0) = w; }
    }
};
struct EpiDown {
    static constexpr bool PERM = true, AFTER_DRAIN = false;
    unsigned char* YE; const float* gate;
    __device__ __forceinline__ void operator()(const f32x4 (&acc)[2][2][4][2], const Unit& u, int wr, int wc, int fr, int fq) const {
        const int row0 = u.pm * BM + wr * 64 + fr, col0 = u.pn * BM + wc * 32 + 8 * fq;
#pragma unroll
        for (int ai = 0; ai < 2; ++ai)
#pragma unroll
            for (int m = 0; m < 4; ++m) { const int row = row0 + ai * HALF + m * 16; const float gt = gate[row] * (YE_SCALE / (WD_SCALE * HID_SCALE));
#pragma unroll
                for (int bj = 0; bj < 2; ++bj) { const f32x4 a = acc[ai][bj][m][0] * gt, c = acc[ai][bj][m][1] * gt; u32x2 w; w.x = pk4_fp8(a[0], a[1], a[2], a[3]); w.y = pk4_fp8(c[0], c[1], c[2], c[3]);
                    *(u32x2*)(YE + (size_t)row * DM + col0 + bj * HALF) = w; } }
    }
};

struct Frame {
    LAS unsigned char* lds;
    int tid, lane, wave, vcu, G, gw, NGW;
};

__device__ __forceinline__ void transpose_item(const float* W, int N, int K, bf16* dst_row0, LAS float* scr, int k0, int n0, int lane) {
    float tv[32];
#pragma unroll
    for (int i = 0; i < 32; ++i) tv[i] = __builtin_nontemporal_load(W + (size_t)(k0 + 2 * i + (lane >> 5)) * N + n0 + (lane & 31));
#pragma unroll
    for (int i = 0; i < 32; ++i) scr[(2 * i + (lane >> 5)) * 33 + (lane & 31)] = tv[i];
    asm volatile("s_waitcnt lgkmcnt(0)" ::: "memory");
    const int c = lane & 7;
#pragma unroll
    for (int j = 0; j < 4; ++j) { const int n = (lane >> 3) + 8 * j; const LAS float* s = scr + (8 * c) * 33 + n;
        u32x4 o; o.x = pk2(s[0 * 33], s[1 * 33]); o.y = pk2(s[2 * 33], s[3 * 33]); o.z = pk2(s[4 * 33], s[5 * 33]); o.w = pk2(s[6 * 33], s[7 * 33]);
        *(u32x4*)(dst_row0 + (size_t)n * K + k0 + 8 * c) = o; }
    asm volatile("s_waitcnt lgkmcnt(0)" ::: "memory");
}
__device__ __forceinline__ void transpose_item_fp8(const float* W, int N, int K, unsigned char* dst_row0, LAS float* scr, int k0, int n0, int lane, float sc) {
    float tv[32];
#pragma unroll
    for (int i = 0; i < 32; ++i) tv[i] = __builtin_nontemporal_load(W + (size_t)(k0 + 2 * i + (lane >> 5)) * N + n0 + (lane & 31));
#pragma unroll
    for (int i = 0; i < 32; ++i) scr[(2 * i + (lane >> 5)) * 33 + (lane & 31)] = tv[i];
    asm volatile("s_waitcnt lgkmcnt(0)" ::: "memory");
    const int c = lane & 7;
#pragma unroll
    for (int j = 0; j < 4; ++j) { const int n = (lane >> 3) + 8 * j; const LAS float* s = scr + (8 * c) * 33 + n;
        u32x2 o; o.x = pk4_fp8(s[0 * 33] * sc, s[1 * 33] * sc, s[2 * 33] * sc, s[3 * 33] * sc); o.y = pk4_fp8(s[4 * 33] * sc, s[5 * 33] * sc, s[6 * 33] * sc, s[7 * 33] * sc);
        *(u32x2*)(dst_row0 + (size_t)n * K + k0 + 8 * c) = o; }
    asm volatile("s_waitcnt lgkmcnt(0)" ::: "memory");
}
__device__ __forceinline__ void conv_phase(Frame& F, int l, const float* w_in, const float* w_out, const float* w_gate, const float* w_up, const float* w_down, const float* sg_w, unsigned char* ws0, int it_lo, int it_hi, int vgw, int vngw, bool tail) {
    unsigned char* ws = ws0 + wset(l);
    LAS float* scr = (LAS float*)(F.lds + F.wave * 16384);
    bf16* WIN = (bf16*)(ws + WS_WIN); bf16* WOUT = (bf16*)(ws + WS_WOUT); unsigned char* WGU = ws + WS_WGU; unsigned char* WD = ws + WS_WD; bf16* WSB = (bf16*)(ws + WS_WSBF);
    constexpr int I_IN = 16 * 64, I_OUT = 16 * 32, I_G = 16 * 1024, I_D = 16 * 1024, NIT = I_IN + I_OUT + 2 * I_G + I_D;
    if (it_hi > NIT) it_hi = NIT;
    for (int it = it_lo + vgw; it < it_hi; it += vngw) {
        int r = it;
        if (r < I_IN) { const int kb = r >> 6, nb = r & 63, n0 = 32 * nb; const int pn = n0 >> 8, c = n0 & 255, wc = c >> 6, bj = (c >> 5) & 1;
            transpose_item(w_in + (size_t)l * DM * DIN, DIN, DM, WIN + (size_t)(256 * pn + 128 * bj + 32 * wc) * DM, scr, 64 * kb, n0, F.lane); continue; }
        r -= I_IN;
        if (r < I_OUT) { const int kb = r >> 5, nb = r & 31, n0 = 32 * nb;
            transpose_item(w_out + (size_t)l * DM * DM, DM, DM, WOUT + (size_t)n0 * DM, scr, 64 * kb, n0, F.lane); continue; }
        r -= I_OUT;
        if (r < 2 * I_G) { const int which = r >= I_G; if (which) r -= I_G; const int e = r >> 10, kb = (r >> 6) & 15, nb = r & 63, n0 = 32 * nb;
            const float* W = (which ? w_up : w_gate) + ((size_t)l * NEXP + e) * DM * DEXP;
            transpose_item_fp8(W, DEXP, DM, WGU + ((size_t)e * 4096 + (n0 >> 7) * 256 + which * 128 + (n0 & 127)) * DM, scr, 64 * kb, n0, F.lane, WGU_SCALE); continue; }
        r -= 2 * I_G;
        { const int e = r >> 10, kb = (r >> 5) & 31, nb = r & 31, n0 = 32 * nb;
            transpose_item_fp8(w_down + ((size_t)l * NEXP + e) * DEXP * DM, DM, DEXP, WD + ((size_t)e * DM + n0) * DEXP, scr, 64 * kb, n0, F.lane, WD_SCALE); }
    }
    if (tail) { const float* sw = sg_w + (size_t)l * 4 * 128 * 128;
        for (int i = vgw * 64 + F.lane; i < 4 * 128 * 128; i += vngw * 64) WSB[i] = (bf16)f2bf(sw[i]); }
}

__device__ __forceinline__ f32x4 bf4(u32x2 w) { f32x4 r; r[0] = __builtin_bit_cast(float, w.x << 16); r[1] = __builtin_bit_cast(float, w.x & 0xffff0000u); r[2] = __builtin_bit_cast(float, w.y << 16); r[3] = __builtin_bit_cast(float, w.y & 0xffff0000u); return r; }
__device__ __forceinline__ void row_ln(f32x4 (&v)[4], const float* g, const float* b, int lane) {
    float s = 0.f;
#pragma unroll
    for (int j = 0; j < 4; ++j) s += (v[j][0] + v[j][1]) + (v[j][2] + v[j][3]);
    const float mean = wave_sum(s) * (1.f / DM); float s2 = 0.f;
#pragma unroll
    for (int j = 0; j < 4; ++j) { v[j] = v[j] - mean; s2 += (v[j][0] * v[j][0] + v[j][1] * v[j][1]) + (v[j][2] * v[j][2] + v[j][3] * v[j][3]); }
    const float rstd = 1.f / sqrtf(wave_sum(s2) * (1.f / DM) + LN_EPS);
#pragma unroll
    for (int j = 0; j < 4; ++j) { const f32x4 gg = *(const f32x4*)(g + 4 * lane + 256 * j), bb = *(const f32x4*)(b + 4 * lane + 256 * j); v[j] = v[j] * rstd * gg + bb; }
}
__device__ __forceinline__ void row_ln_stats(f32x4 (&v)[4], const float* g, const float* b, int lane, float& mean_o, float& rstd_o) {
    float s = 0.f;
#pragma unroll
    for (int j = 0; j < 4; ++j) s += (v[j][0] + v[j][1]) + (v[j][2] + v[j][3]);
    const float mean = wave_sum(s) * (1.f / DM); float s2 = 0.f;
#pragma unroll
    for (int j = 0; j < 4; ++j) { v[j] = v[j] - mean; s2 += (v[j][0] * v[j][0] + v[j][1] * v[j][1]) + (v[j][2] * v[j][2] + v[j][3] * v[j][3]); }
    const float rstd = 1.f / sqrtf(wave_sum(s2) * (1.f / DM) + LN_EPS);
#pragma unroll
    for (int j = 0; j < 4; ++j) { const f32x4 gg = *(const f32x4*)(g + 4 * lane + 256 * j), bb = *(const f32x4*)(b + 4 * lane + 256 * j); v[j] = v[j] * rstd * gg + bb; }
    mean_o = mean; rstd_o = rstd;
}
__device__ __forceinline__ void store_row(const f32x4 (&v)[4], float* xrow, bf16* xbrow, int lane) {
#pragma unroll
    for (int j = 0; j < 4; ++j) { *(f32x4*)(xrow + 4 * lane + 256 * j) = v[j]; u32x2 w; w.x = pk2(v[j][0], v[j][1]); w.y = pk2(v[j][2], v[j][3]); *(u32x2*)(xbrow + 4 * lane + 256 * j) = w; }
}

__device__ __forceinline__ void store_row_bf(const f32x4 (&v)[4], bf16* xbrow, int lane) {
#pragma unroll
    for (int j = 0; j < 4; ++j) { u32x2 w; w.x = pk2(v[j][0], v[j][1]); w.y = pk2(v[j][2], v[j][3]); *(u32x2*)(xbrow + 4 * lane + 256 * j) = w; }
}
__device__ __forceinline__ void prologue_phase(Frame& F, const float* xp, const float* xs, const float* g, const float* b, float* X, unsigned char* ws) {
    float* rope = (float*)(ws + WS_ROPE);
    for (int i = F.gw * 64 + F.lane; i < SEQ * 32; i += F.NGW * 64) {
        const int s = i >> 5, p = i & 31, fi = p & 15; const float pos = (float)((p < 16) ? (s >> 6) : (s & 63));
        const float inv = powf(10000.0f, -(float)fi / 16.0f); const float ang = pos * inv;
        rope[2 * i] = cosf(ang); rope[2 * i + 1] = sinf(ang);
    }
    bf16* XB = (bf16*)(ws + WS_XB);
    for (int m = F.gw; m < TT; m += F.NGW) {
        const float* src = (m < T_P) ? xp + (size_t)m * DM : xs + (size_t)(m - T_P) * DM;
        f32x4 v[4];
#pragma unroll
        for (int j = 0; j < 4; ++j) v[j] = *(const f32x4*)(src + 4 * F.lane + 256 * j);
        row_ln(v, g, b, F.lane);
        store_row_bf(v, XB + (size_t)m * DM, F.lane);
    }
}

__device__ __forceinline__ float router_reduce(float (&lg)[16], int lane) {
    float r8[8], r4[4], r2[2], r1;
    const bool b5 = lane & 32, b4 = lane & 16, b3 = lane & 8, b2 = lane & 4;
#pragma unroll
    for (int i = 0; i < 8; ++i) { const float snd = b5 ? lg[i] : lg[i + 8], kp = b5 ? lg[i + 8] : lg[i]; r8[i] = kp + other32(snd, b5); }
#pragma unroll
    for (int i = 0; i < 4; ++i) { const float snd = b4 ? r8[i] : r8[i + 4], kp = b4 ? r8[i + 4] : r8[i]; r4[i] = kp + other16(snd, b4); }
#pragma unroll
    for (int i = 0; i < 2; ++i) { const float snd = b3 ? r4[i] : r4[i + 2], kp = b3 ? r4[i + 2] : r4[i]; r2[i] = kp + shm<8>(snd); }
    { const float snd = b2 ? r2[0] : r2[1], kp = b2 ? r2[1] : r2[0]; r1 = kp + shm<4>(snd); }
    r1 += shx<1>(r1); r1 += shx<2>(r1);
    float mx = r1;
    mx = fmaxf(mx, shm<4>(mx)); mx = fmaxf(mx, shm<8>(mx)); mx = max16(mx); mx = max32(mx);
    const float ex = expf(r1 - mx); float sm = ex;
    sm += shm<4>(sm); sm += shm<8>(sm); sm = sum16(sm); sm = sum32(sm);
    return ex / sm;
}
template <bool DRY> __device__ __forceinline__ void ln1_router_mfma(Frame& F, const bf16* X, const float* g, const float* b, const float* wr, unsigned char* ws) {
    constexpr int WP = 2064;
    LAS unsigned char* WH = F.lds; LAS unsigned char* WL = F.lds + 16 * WP;
    LAS float* GB = (LAS float*)(F.lds + 2 * 16 * WP);
    LAS float* PART = GB + 2048;
    LAS float* CST = PART + 1024;
    LAS float* WST = CST + 32 + F.wave * 32;
    { const int e = F.tid & 15, part = F.tid >> 4; float sg = 0.f, sb = 0.f;
      for (int i = 0; i < 32; ++i) { const int c = part * 32 + i; const float w = wr[c * 16 + e]; const float wp = g[c] * w;
          const unsigned hi = f2bf(wp); const float hif = __builtin_bit_cast(float, hi << 16); const unsigned lo = f2bf(wp - hif);
          *(LAS unsigned short*)(WH + e * WP + c * 2) = (unsigned short)hi; *(LAS unsigned short*)(WL + e * WP + c * 2) = (unsigned short)lo;
          sg += hif + __builtin_bit_cast(float, lo << 16); sb += b[c] * w; }
      PART[part * 16 + e] = sg; PART[512 + part * 16 + e] = sb; }
    for (int i = F.tid; i < DM; i += NWAVES * 64) { GB[i] = g[i]; GB[DM + i] = b[i]; }
    __syncthreads();
    if (F.tid < 32) { const int e = F.tid & 15, which = F.tid >> 4; float a = 0.f; for (int p2 = 0; p2 < 32; ++p2) a += PART[which * 512 + p2 * 16 + e]; CST[which * 16 + e] = a; }
    __syncthreads();
    unsigned char* XB8 = ws + (DRY ? WS_DUMMY + 16 * MiB : WS_XB8); float* AFF = (float*)(ws + (DRY ? WS_DUMMY + 100 * MiB : WS_AFF)); float* ST = (float*)(ws + (DRY ? WS_DUMMY : WS_STATS));
    const int lane = F.lane, r16 = lane & 15, q = lane >> 4;
    const float Ge = CST[r16], Bce = CST[16 + r16];
    constexpr int NBLK = TT / 16;
    const int blo = (int)((long)NBLK * F.vcu / F.G), bhi = (int)((long)NBLK * (F.vcu + 1) / F.G);
    for (int blk = blo + F.wave; blk < bhi; blk += NWAVES) {
        const int m0 = blk * 16;
        const bf16* src = X + (size_t)(m0 + r16) * DM + 16 * q;
        u32x4 sr[32];
#pragma unroll
        for (int t = 0; t < 16; ++t) { sr[2 * t] = *(const u32x4*)(src + 64 * t); sr[2 * t + 1] = *(const u32x4*)(src + 64 * t + 8); }
        f32x4 acc = (f32x4){0.f, 0.f, 0.f, 0.f}; float s1 = 0.f, s2 = 0.f;
        const LAS unsigned char* wh = WH + r16 * WP + 32 * q; const LAS unsigned char* wl = WL + r16 * WP + 32 * q;
#pragma unroll
        for (int u = 0; u < 32; ++u) { const u32x4 w = sr[u];
            const bf16x8 bh = *(const LAS bf16x8*)(wh + (u >> 1) * 128 + (u & 1) * 16), bl = *(const LAS bf16x8*)(wl + (u >> 1) * 128 + (u & 1) * 16);
            const bf16x8 a = __builtin_bit_cast(bf16x8, w);
            acc = __builtin_amdgcn_mfma_f32_16x16x32_bf16(a, bh, acc, 0, 0, 0); acc = __builtin_amdgcn_mfma_f32_16x16x32_bf16(a, bl, acc, 0, 0, 0);
#pragma unroll
            for (int d = 0; d < 4; ++d) { const float x0 = __builtin_bit_cast(float, w[d] << 16), x1 = __builtin_bit_cast(float, w[d] & 0xffff0000u); s1 += x0 + x1; s2 = fmaf(x0, x0, s2); s2 = fmaf(x1, x1, s2); }
            if ((u & 3) == 3) asm volatile("" ::: "memory"); }
        s1 = sum16(s1); s1 = sum32(s1); s2 = sum16(s2); s2 = sum32(s2);
        const float mean = s1 * (1.f / DM); const float rstd = 1.f / sqrtf(fmaxf(s2 * (1.f / DM) - mean * mean, 0.f) + LN_EPS);
        if (q == 0) { f32x2v st; st[0] = mean; st[1] = rstd; *(f32x2v*)(ST + (size_t)(m0 + r16) * 2) = st; WST[r16] = mean; WST[16 + r16] = rstd; }
        asm volatile("s_waitcnt lgkmcnt(0)" ::: "memory");
        const f32x4 mu4 = *(const LAS f32x4*)(WST + 4 * q), rs4 = *(const LAS f32x4*)(WST + 16 + 4 * q);
        f32x4 af;
#pragma unroll
        for (int i = 0; i < 4; ++i) { const float lg = rs4[i] * (acc[i] - mu4[i] * Ge) + Bce;
            float mx = lg; mx = fmaxf(mx, shx<1>(mx)); mx = fmaxf(mx, shx<2>(mx)); mx = fmaxf(mx, shm<4>(mx)); mx = fmaxf(mx, shm<8>(mx));
            const float ex = expf(lg - mx); float sm = ex; sm += shx<1>(sm); sm += shx<2>(sm); sm += shm<4>(sm); sm += shm<8>(sm);
            af[i] = ex / sm; }
        { const int m = m0 + 4 * q; const size_t off = (m < T_P) ? (size_t)r16 * T_P + m : (size_t)16 * T_P + (size_t)r16 * T_S + (m - T_P);
          *(f32x4*)(AFF + off) = af; }
        asm volatile("" ::: "memory");
#pragma unroll
        for (int u = 0; u < 32; ++u) asm volatile("" : "+v"(sr[u]));
        const float nmr = -mean * rstd;
        unsigned char* dst = XB8 + (size_t)(m0 + r16) * DM + 16 * q;
#pragma unroll
        for (int t = 0; t < 16; ++t) { u32x4 o;
#pragma unroll
            for (int h = 0; h < 2; ++h) { const u32x4 w = sr[2 * t + h]; const LAS float* gp = GB + 64 * t + 16 * q + 8 * h;
                const f32x4 g0 = *(const LAS f32x4*)gp, g1 = *(const LAS f32x4*)(gp + 4), b0 = *(const LAS f32x4*)(gp + DM), b1 = *(const LAS f32x4*)(gp + DM + 4);
                float x[8];
#pragma unroll
                for (int d = 0; d < 4; ++d) { x[2 * d] = fmaf(__builtin_bit_cast(float, w[d] << 16), rstd, nmr); x[2 * d + 1] = fmaf(__builtin_bit_cast(float, w[d] & 0xffff0000u), rstd, nmr); }
                const unsigned p0 = pk4_fp8(fmaf(x[0], g0[0], b0[0]), fmaf(x[1], g0[1], b0[1]), fmaf(x[2], g0[2], b0[2]), fmaf(x[3], g0[3], b0[3]));
                const unsigned p1 = pk4_fp8(fmaf(x[4], g1[0], b1[0]), fmaf(x[5], g1[1], b1[1]), fmaf(x[6], g1[2], b1[2]), fmaf(x[7], g1[3], b1[3]));
                if (h == 0) { o.x = p0; o.y = p1; } else { o.z = p0; o.w = p1; } }
            *(u32x4*)(dst + 64 * t) = o; asm volatile("" ::: "memory"); }
    }
    __syncthreads();
}
template <bool DRY> __device__ __forceinline__ void ln1_router_phase(Frame& F, const bf16* X, const float* g, const float* b, const float* wr, unsigned char* ws) {
    constexpr int NR = LN1_ROWS;
    LAS float* wl = (LAS float*)F.lds;
    for (int i = F.tid; i < DM * NEXP; i += NWAVES * 64) wl[(i & 15) * DM + (i >> 4)] = wr[i];
    __syncthreads();
    unsigned char* XB8 = ws + (DRY ? WS_DUMMY + 16 * MiB : WS_XB8); float* AFF = (float*)(ws + (DRY ? WS_DUMMY + 100 * MiB : WS_AFF)); float* ST = (float*)(ws + (DRY ? WS_DUMMY : WS_STATS));
    const int lane = F.lane, e_mine = ((lane >> 5) & 1) * 8 + ((lane >> 4) & 1) * 4 + ((lane >> 3) & 1) * 2 + ((lane >> 2) & 1);
    int m = NR * F.gw;
    u32x2 nx[NR][4];
#pragma unroll
    for (int r = 0; r < NR; ++r)
#pragma unroll
        for (int j = 0; j < 4; ++j) nx[r][j] = (u32x2){0u, 0u};
    if (m < TT) {
#pragma unroll
        for (int r = 0; r < NR; ++r)
#pragma unroll
            for (int j = 0; j < 4; ++j) nx[r][j] = *(const u32x2*)(X + (size_t)(m + r) * DM + 4 * lane + 256 * j); }
    for (; m < TT; m += NR * F.NGW) {
        f32x4 v[NR][4];
#pragma unroll
        for (int r = 0; r < NR; ++r)
#pragma unroll
            for (int j = 0; j < 4; ++j) v[r][j] = bf4(nx[r][j]);
        { const int mn = m + NR * F.NGW;
          if (mn < TT) {
#pragma unroll
            for (int r = 0; r < NR; ++r)
#pragma unroll
                for (int j = 0; j < 4; ++j) nx[r][j] = *(const u32x2*)(X + (size_t)(mn + r) * DM + 4 * lane + 256 * j); } }
        float mu[NR], rs[NR];
#pragma unroll
        for (int r = 0; r < NR; ++r) row_ln_stats(v[r], g, b, lane, mu[r], rs[r]);
        if (lane == 0) {
#pragma unroll
            for (int r = 0; r < NR; r += 2) { f32x4 st; st[0] = mu[r]; st[1] = rs[r]; st[2] = mu[r + 1]; st[3] = rs[r + 1]; *(f32x4*)(ST + (size_t)(m + r) * 2) = st; } }
#pragma unroll
        for (int r = 0; r < NR; ++r)
#pragma unroll
            for (int j = 0; j < 4; ++j) *(unsigned*)(XB8 + (size_t)(m + r) * DM + 4 * lane + 256 * j) = pk4_fp8(v[r][j][0], v[r][j][1], v[r][j][2], v[r][j][3]);
        float lg[NR][16];
#pragma unroll
        for (int e = 0; e < 16; ++e) { f32x4 a[NR];
#pragma unroll
            for (int r = 0; r < NR; ++r) a[r] = (f32x4){0.f, 0.f, 0.f, 0.f};
#pragma unroll
            for (int j = 0; j < 4; ++j) { const f32x4 w = *(const LAS f32x4*)(wl + e * DM + 4 * lane + 256 * j);
#pragma unroll
                for (int r = 0; r < NR; ++r) a[r] += v[r][j] * w; }
#pragma unroll
            for (int r = 0; r < NR; ++r) lg[r][e] = (a[r][0] + a[r][1]) + (a[r][2] + a[r][3]);
            if ((e & 3) == 3) asm volatile("" ::: "memory"); }
        float af[NR];
#pragma unroll
        for (int r = 0; r < NR; ++r) af[r] = router_reduce(lg[r], lane);
        if ((lane & 3) == 0) { const size_t off = (m < T_P) ? (size_t)e_mine * T_P + m : (size_t)16 * T_P + (size_t)e_mine * T_S + (m - T_P);
#pragma unroll
            for (int r = 0; r < NR; ++r) AFF[off + r] = af[r]; }
    }
    __syncthreads();
}

constexpr int TK_COPIES = 8, TK_STRIDE = 2048;
template <int NB>
__device__ __forceinline__ void bin_search(LAS unsigned* hist, LAS unsigned* wtot, LAS unsigned* res, unsigned remaining, int tid, int lane, int wave, unsigned& bin, unsigned& rem_out) {
    constexpr int BPT = NB / 512;
    unsigned hb[BPT]; unsigned own = 0;
#pragma unroll
    for (int k = 0; k < BPT; ++k) { unsigned a = 0;
#pragma unroll
        for (int c = 0; c < TK_COPIES; ++c) a += hist[c * TK_STRIDE + tid * BPT + k];
        hb[k] = a; own += a; }
    unsigned x = own;
#pragma unroll
    for (int o = 1; o < 64; o <<= 1) { const unsigned y = (unsigned)__builtin_amdgcn_ds_bpermute((lane + o) << 2, (int)x); if (lane + o < 64) x += y; }
    if (lane == 0) wtot[wave] = x;
    __syncthreads();
    unsigned above = 0;
#pragma unroll
    for (int w = 0; w < 8; ++w) above += (w > wave) ? wtot[w] : 0u;
    const unsigned suf_incl = x + above, suf_excl = suf_incl - own;
    if (suf_excl < remaining && remaining <= suf_incl) {
        unsigned c = suf_excl; bool done = false;
#pragma unroll
        for (int k = BPT - 1; k >= 0; --k) { if (!done && c + hb[k] >= remaining) { res[0] = (unsigned)(tid * BPT + k); res[1] = remaining - c; done = true; } c += hb[k]; }
    }
    __syncthreads();
    bin = res[0]; rem_out = res[1];
    __syncthreads();
}
template <int NPT>
__device__ __forceinline__ void topk_block(Frame& F, const unsigned* vals, int cap, int slotbase, int tokbase, int e, unsigned char* ws) {
    LAS unsigned* hist = (LAS unsigned*)F.lds; LAS unsigned* wtot = hist + TK_COPIES * TK_STRIDE; LAS unsigned* res = wtot + 16;
    const int base = F.wave * (NPT * 64) + F.lane;
    unsigned v[NPT];
#pragma unroll
    for (int j = 0; j < NPT; ++j) v[j] = vals[base + j * 64];
    LAS unsigned* hc = hist + (F.lane & 7) * TK_STRIDE;
    unsigned remaining = (unsigned)cap, prefix = 0, bin;
#define TK_ZERO() do { for (int i = F.tid; i < TK_COPIES * TK_STRIDE; i += 512) hist[i] = 0u; __syncthreads(); } while (0)
#define TK_ADD(idx) (void)__hip_atomic_fetch_add(&hc[(idx)], 1u, __ATOMIC_RELAXED, __HIP_MEMORY_SCOPE_WORKGROUP)
    TK_ZERO();
#pragma unroll
    for (int j = 0; j < NPT; ++j) { unsigned vv = v[j]; asm volatile("" : "+v"(vv) :: "memory"); TK_ADD(vv >> 21); }
    __syncthreads();
    bin_search<2048>(hist, wtot, res, remaining, F.tid, F.lane, F.wave, bin, remaining); prefix = bin;
    TK_ZERO();
#pragma unroll
    for (int j = 0; j < NPT; ++j) { unsigned vv = v[j]; asm volatile("" : "+v"(vv) :: "memory"); if ((vv >> 21) == prefix) TK_ADD((vv >> 10) & 2047u); }
    __syncthreads();
    bin_search<2048>(hist, wtot, res, remaining, F.tid, F.lane, F.wave, bin, remaining); prefix = (prefix << 11) | bin;
    TK_ZERO();
#pragma unroll
    for (int j = 0; j < NPT; ++j) { unsigned vv = v[j]; asm volatile("" : "+v"(vv) :: "memory"); if ((vv >> 10) == prefix) TK_ADD(vv & 1023u); }
    __syncthreads();
    bin_search<1024>(hist, wtot, res, remaining, F.tid, F.lane, F.wave, bin, remaining);
#undef TK_ZERO
#undef TK_ADD
    const unsigned thr = (prefix << 10) | bin, need_eq = remaining;
    unsigned cg = 0, ce = 0;
#pragma unroll
    for (int j = 0; j < NPT; ++j) { unsigned vv = v[j]; asm volatile("" : "+v"(vv)); cg += (unsigned)__popcll(__ballot(vv > thr)); ce += (unsigned)__popcll(__ballot(vv == thr)); asm volatile("" : "+v"(cg), "+v"(ce)); }
    if (F.lane == 0) { wtot[F.wave] = cg; wtot[8 + F.wave] = ce; }
    __syncthreads();
    unsigned run_gt = 0, run_eq = 0;
#pragma unroll
    for (int w = 0; w < 8; ++w) { run_gt += (w < F.wave) ? wtot[w] : 0u; run_eq += (w < F.wave) ? wtot[8 + w] : 0u; }
    int* IDX = (int*)(ws + WS_IDX); float* GATE = (float*)(ws + WS_GATE); int* SLOTOF = (int*)(ws + WS_SLOTOF);
    const unsigned long long ltmask = (1ull << F.lane) - 1ull;
#pragma unroll
    for (int j = 0; j < NPT; ++j) {
        unsigned vv = v[j]; asm volatile("" : "+v"(vv));
        const bool gt = vv > thr, eq = vv == thr;
        const unsigned long long bg = __ballot(gt), be = __ballot(eq);
        const unsigned gb = (unsigned)__popcll(bg & ltmask), eb = (unsigned)__popcll(be & ltmask);
        const unsigned eq_rank = run_eq + eb;
        const bool sel = gt || (eq && eq_rank < need_eq);
        const unsigned slot = run_gt + gb + (eq_rank < need_eq ? eq_rank : need_eq);
        const int tok = tokbase + base + j * 64;
        if (sel) { IDX[slotbase + slot] = tok; GATE[slotbase + slot] = __builtin_bit_cast(float, vv); }
        SLOTOF[(size_t)e * TT + tok] = sel ? (int)(slotbase + slot) : -1;
        run_gt += (unsigned)__popcll(bg); run_eq += (unsigned)__popcll(be); asm volatile("" : "+v"(run_gt), "+v"(run_eq));
    }
    __syncthreads();
}
__device__ __forceinline__ void topk_phase(Frame& F, unsigned char* ws) {
    if (blockIdx.x >= 32) return;
    const int g = blockIdx.x >> 4, e = blockIdx.x & 15;
    const unsigned* aff = (const unsigned*)(ws + WS_AFF);
    if (g == 0) topk_block<T_P / 512>(F, aff + (size_t)e * T_P, CAP_P, e * CAP_P, 0, e, ws);
    else        topk_block<T_S / 512>(F, aff + (size_t)16 * T_P + (size_t)e * T_S, CAP_S, ROWS_P + e * CAP_S, T_P, e, ws);
}

__device__ __forceinline__ void gather_phase(Frame& F, unsigned char* ws) {
    const int* IDX = (const int*)(ws + WS_IDX); const unsigned char* XB8 = ws + WS_XB8; unsigned char* XE = ws + WS_H;
    for (int r = F.gw; r < ROWS_E; r += F.NGW) { const int tok = IDX[r];
        *(u32x4*)(XE + (size_t)r * DM + 16 * F.lane) = *(const u32x4*)(XB8 + (size_t)tok * DM + 16 * F.lane); }
}

template <bool DRY> __device__ __forceinline__ void combine_phase(Frame& F, float* X, const bf16* SB, const float* g1, const float* b1, const float* g, const float* b, unsigned char* ws, bool last_layer) {
    const int* SLOTOF = (const int*)(ws + WS_SLOTOF); const unsigned char* YE = ws + WS_H; bf16* XB = (bf16*)(ws + (DRY ? WS_DUMMY + 16 * MiB : WS_XB)); float* Xo = DRY ? (float*)(ws + WS_DUMMY + 16 * MiB) : X;
    const int lane = F.lane;
    constexpr int NRC = 4;
    int m = NRC * F.gw;
    int so_n = (m < TT) ? SLOTOF[(size_t)(lane & 15) * TT + m + (lane >> 4)] : -1;
    for (; m < TT; m += NRC * F.NGW) {
        const int so = so_n; const int mn = m + NRC * F.NGW;
        so_n = (mn < TT) ? SLOTOF[(size_t)(lane & 15) * TT + mn + (lane >> 4)] : -1;
        f32x4 v[NRC][4];
#pragma unroll
        for (int r = 0; r < NRC; ++r)
#pragma unroll
            for (int j = 0; j < 4; ++j) v[r][j] = bf4(*(const u32x2*)(SB + (size_t)(m + r) * DM + 4 * lane + 256 * j));
        { const f32x4 sa = *(const f32x4*)((const float*)(ws + WS_STATS) + (size_t)m * 2), sb2 = *(const f32x4*)((const float*)(ws + WS_STATS) + (size_t)m * 2 + 4);
#pragma unroll
          for (int j = 0; j < 4; ++j) { const f32x4 gg = *(const f32x4*)(g1 + 4 * lane + 256 * j) * DN_ALPHA, bb = *(const f32x4*)(b1 + 4 * lane + 256 * j) * DN_ALPHA;
              v[0][j] = (v[0][j] - sa[0]) * sa[1] * gg + bb; v[1][j] = (v[1][j] - sa[2]) * sa[3] * gg + bb; v[2][j] = (v[2][j] - sb2[0]) * sb2[1] * gg + bb; v[3][j] = (v[3][j] - sb2[2]) * sb2[3] * gg + bb; } }
        constexpr int CK = 4;
        const unsigned long long bal = __ballot(so >= 0);
        unsigned mk[NRC];
#pragma unroll
        for (int r = 0; r < NRC; ++r) mk[r] = (unsigned)(bal >> (16 * r)) & 0xffffu;
        unsigned w[NRC][CK][4]; float f[NRC][CK];
#pragma unroll
        for (int k = 0; k < CK; ++k)
#pragma unroll
            for (int r = 0; r < NRC; ++r) {
                const int e = mk[r] ? __builtin_ctz(mk[r]) : 0;
                const int sl = __builtin_amdgcn_readlane(so, 16 * r + e);
                const size_t ro = (size_t)(mk[r] ? sl : 0) * DM;
                f[r][k] = mk[r] ? (1.0f / YE_SCALE) : 0.f;
#pragma unroll
                for (int j = 0; j < 4; ++j) w[r][k][j] = *(const unsigned*)(YE + ro + 4 * lane + 256 * j);
                mk[r] &= mk[r] - 1;
            }
#pragma unroll
        for (int k = 0; k < CK; ++k)
#pragma unroll
            for (int r = 0; r < NRC; ++r)
#pragma unroll
                for (int j = 0; j < 4; ++j) {
                    const f32x2v lo = __builtin_amdgcn_cvt_pk_f32_fp8((int)w[r][k][j], false), hi = __builtin_amdgcn_cvt_pk_f32_fp8((int)w[r][k][j], true);
                    v[r][j][0] += lo[0] * f[r][k]; v[r][j][1] += lo[1] * f[r][k]; v[r][j][2] += hi[0] * f[r][k]; v[r][j][3] += hi[1] * f[r][k]; }
#pragma unroll
        for (int r = 0; r < NRC; ++r) {
            unsigned mr = mk[r];
            while (mr) { const int sl = __builtin_amdgcn_readlane(so, 16 * r + __builtin_ctz(mr)); mr &= mr - 1;
#pragma unroll
                for (int j = 0; j < 4; ++j) { const unsigned ww = *(const unsigned*)(YE + (size_t)sl * DM + 4 * lane + 256 * j);
                    const f32x2v lo = __builtin_amdgcn_cvt_pk_f32_fp8((int)ww, false), hi = __builtin_amdgcn_cvt_pk_f32_fp8((int)ww, true);
                    v[r][j][0] += lo[0] * (1.0f / YE_SCALE); v[r][j][1] += lo[1] * (1.0f / YE_SCALE); v[r][j][2] += hi[0] * (1.0f / YE_SCALE); v[r][j][3] += hi[1] * (1.0f / YE_SCALE); } } }
#pragma unroll
        for (int r = 0; r < NRC; ++r) row_ln(v[r], g, b, lane);
        if (last_layer) {
#pragma unroll
            for (int r = 0; r < NRC; ++r)
#pragma unroll
                for (int j = 0; j < 4; ++j) *(f32x4*)(Xo + (size_t)(m + r) * DM + 4 * lane + 256 * j) = v[r][j];
        } else {
#pragma unroll
            for (int r = 0; r < NRC; ++r) store_row_bf(v[r], XB + (size_t)(m + r) * DM, lane); }
    }
}

template <bool NA>
__device__ __forceinline__ void attn_wave(const bf16* __restrict__ Qb, const bf16* __restrict__ Kb, const bf16* __restrict__ Vb, bf16* __restrict__ Ob, int ntiles,
                                          LAS unsigned char* wl, const LAS float* rpbh, int rr, int rs, int qh, int lane) {
    const int r = lane & 31, h = lane >> 5;
    bf16x8 qf[4];
#pragma unroll
    for (int d0 = 0; d0 < 4; ++d0) qf[d0] = *(const bf16x8*)(Qb + (size_t)r * DIN + 16 * d0 + 8 * h);
    f32x16 o0, o1;
#pragma unroll
    for (int i = 0; i < 16; ++i) { o0[i] = 0.f; o1[i] = 0.f; }
    float m = -1e30f, l = 0.f;
    LAS unsigned char* vl = wl; LAS float* wsf = (LAS float*)(wl + 4608);
    const bf16* vsrc = Vb + (size_t)(lane >> 3) * DIN + 8 * (lane & 7);
    const bf16* ksrc = Kb + (size_t)r * DIN + 8 * h;
    const int vwoff = (lane >> 3) * 144 + (lane & 7) * 16;
    const int i16 = lane & 15, tq = i16 >> 2, tp = i16 & 3, blk = (lane >> 4) & 1;
    const int troff = (4 * h + tq) * 144 + (16 * blk + 4 * tp) * 2;
    const int qc = 32 * qh + r; const int cs = qc - 8 < 0 ? 0 : (qc - 8 > 48 ? 48 : qc - 8);
    for (int t = 0; t < ntiles; ++t) {
        const size_t ko = (size_t)(32 * t) * DIN;
        bf16x8 kf[4];
#pragma unroll
        for (int d0 = 0; d0 < 4; ++d0) kf[d0] = *(const bf16x8*)(ksrc + ko + 16 * d0);
        u32x4 vr[4];
#pragma unroll
        for (int i = 0; i < 4; ++i) vr[i] = *(const u32x4*)(vsrc + ko + (size_t)(8 * i) * DIN);
        f32x16 s;
#pragma unroll
        for (int i = 0; i < 16; ++i) s[i] = 0.f;
#pragma unroll
        for (int d0 = 0; d0 < 4; ++d0) s = MFMA32(kf[d0], qf[d0], s);
        unsigned okm = 0xffffu;
        if (NA) {
            okm = 0u; const int kr = rs + (t >> 1), kh = t & 1, brow = (kr - rr + 7) * 31;
#pragma unroll
            for (int i = 0; i < 16; ++i) { const int kc = 32 * kh + crow(i, h); const bool ok = (kc >= cs) && (kc < cs + 16); const int idx = ok ? brow + kc - qc + 15 : 0;
                const float bia = rpbh[idx]; s[i] = ok ? s[i] + bia : -1e30f; okm |= ok ? (1u << i) : 0u; }
        }
        float mx = s[0];
#pragma unroll
        for (int i = 1; i < 16; ++i) mx = fmaxf(mx, s[i]);
        mx = max32(mx);
        const float mn = fmaxf(m, mx), alpha = __builtin_amdgcn_exp2f(m - mn); m = mn;
        float rsum = 0.f;
#pragma unroll
        for (int i = 0; i < 16; ++i) { float p = __builtin_amdgcn_exp2f(s[i] - mn); if (NA) p = ((okm >> i) & 1u) ? p : 0.f; s[i] = p; rsum += p; }
        l = l * alpha + rsum;
#pragma unroll
        for (int i = 0; i < 4; ++i) *(LAS u32x4*)(vl + vwoff + i * 8 * 144) = vr[i];
        if (h == 0) wsf[r] = alpha;
        asm volatile("s_waitcnt lgkmcnt(0)" ::: "memory");
#pragma unroll
        for (int g4 = 0; g4 < 4; ++g4) { const f32x4 a4 = *(const LAS f32x4*)(wsf + 8 * g4 + 4 * h);
#pragma unroll
            for (int j = 0; j < 4; ++j) { o0[4 * g4 + j] *= a4[j]; o1[4 * g4 + j] *= a4[j]; } }
        u32x4 pw0, pw1;
        pw0.x = pg8::cvt_pk_bf16(s[0], s[1]); pw0.y = pg8::cvt_pk_bf16(s[2], s[3]); pw0.z = pg8::cvt_pk_bf16(s[4], s[5]); pw0.w = pg8::cvt_pk_bf16(s[6], s[7]);
        pw1.x = pg8::cvt_pk_bf16(s[8], s[9]); pw1.y = pg8::cvt_pk_bf16(s[10], s[11]); pw1.z = pg8::cvt_pk_bf16(s[12], s[13]); pw1.w = pg8::cvt_pk_bf16(s[14], s[15]);
        const bf16x8 pa0 = __builtin_bit_cast(bf16x8, pw0), pa1 = __builtin_bit_cast(bf16x8, pw1);
#pragma unroll
        for (int sp = 0; sp < 2; ++sp) {
#pragma unroll
            for (int db = 0; db < 2; ++db) {
                const s16x4 lo = tr_read(vl + troff + (16 * sp) * 144 + 64 * db), hi = tr_read(vl + troff + (16 * sp + 8) * 144 + 64 * db);
                const bf16x8 bfr = __builtin_shufflevector(lo, hi, 0, 1, 2, 3, 4, 5, 6, 7);
                if (db == 0) o0 = MFMA32(sp ? pa1 : pa0, bfr, o0); else o1 = MFMA32(sp ? pa1 : pa0, bfr, o1);
            }
        }
        asm volatile("s_waitcnt lgkmcnt(0)" ::: "memory");
    }
    l = sum32(l);
    if (h == 0) wsf[32 + r] = l;
    asm volatile("s_waitcnt lgkmcnt(0)" ::: "memory");
#pragma unroll
    for (int i = 0; i < 16; ++i) { const int q = crow(i, h); const float rl = 1.0f / wsf[32 + q];
        Ob[(size_t)q * DM + r] = (bf16)f2bf(o0[i] * rl); Ob[(size_t)q * DM + 32 + r] = (bf16)f2bf(o1[i] * rl); }
    asm volatile("s_waitcnt lgkmcnt(0)" ::: "memory");
}

__device__ __forceinline__ void sgu_part(Frame& F, int l, const float* sg_b, unsigned char* ws) {
    const bf16* H = (const bf16*)(ws + WS_H); bf16* Y = (bf16*)(ws + WS_HID); const bf16* WSB = (const bf16*)(ws + wset(l) + WS_WSBF);
    const int lane = F.lane, r = lane & 31, h = lane >> 5;
    LAS unsigned char* vnl = F.lds;
    const int pt = F.wave >> 1, ct = F.wave & 1;
    const int i16 = lane & 15, tq = i16 >> 2, tp = i16 & 3, blk = (lane >> 4) & 1;
    u32x4 stg[2];
    { const int u = F.vcu; if (u < NBATCH * 32 * 4) { const int g = u & 3, ch = (u >> 2) & 31, b = u >> 7; const size_t tok0 = (size_t)b * SEQ + ch * 128;
#pragma unroll
        for (int i = 0; i < 2; ++i) { const int idx = F.tid + 512 * i, row = idx >> 3, chunk = idx & 7; stg[i] = *(const u32x4*)(H + (tok0 + row) * DIN + H_VC + 64 * g + 8 * chunk); } } }
    for (int u = F.vcu; u < NBATCH * 32 * 4; u += F.G) {
        const int g = u & 3, ch = (u >> 2) & 31, b = u >> 7; const size_t tok0 = (size_t)b * SEQ + ch * 128;
#pragma unroll
        for (int i = 0; i < 2; ++i) { const int idx = F.tid + 512 * i, row = idx >> 3, chunk = idx & 7; *(LAS u32x4*)(vnl + row * 144 + chunk * 16) = stg[i]; }
        __syncthreads();
        { const int un = u + F.G; if (un < NBATCH * 32 * 4) { const int gn = un & 3, chn = (un >> 2) & 31, bn = un >> 7; const size_t tokn = (size_t)bn * SEQ + chn * 128;
#pragma unroll
            for (int i = 0; i < 2; ++i) { const int idx = F.tid + 512 * i, row = idx >> 3, chunk = idx & 7; stg[i] = *(const u32x4*)(H + (tokn + row) * DIN + H_VC + 64 * gn + 8 * chunk); } } }
        unsigned short uu[16];
#pragma unroll
        for (int i = 0; i < 16; ++i) uu[i] = H[(tok0 + 32 * pt + crow(i, h)) * DIN + H_UC + 64 * g + 32 * ct + r];
        f32x16 z;
#pragma unroll
        for (int i = 0; i < 16; ++i) z[i] = 0.f;
#pragma unroll
        for (int s = 0; s < 8; ++s) {
            const bf16x8 a = *(const bf16x8*)(WSB + ((size_t)(g * 128 + 32 * pt + r) * 128 + 16 * s + 8 * h));
            const s16x4 lo = tr_read(vnl + (16 * s + 8 * h + tq) * 144 + (32 * ct + 16 * blk + 4 * tp) * 2), hi = tr_read(vnl + (16 * s + 8 * h + 4 + tq) * 144 + (32 * ct + 16 * blk + 4 * tp) * 2);
            z = MFMA32(a, __builtin_shufflevector(lo, hi, 0, 1, 2, 3, 4, 5, 6, 7), z);
        }
        const float* bs = sg_b + ((size_t)l * 4 + g) * 128;
#pragma unroll
        for (int i = 0; i < 16; ++i) { const int pp = 32 * pt + crow(i, h); const size_t tok = tok0 + pp; const int c = 32 * ct + r;
            Y[tok * DM + Y_SG + 64 * g + c] = (bf16)f2bf(bf2f(uu[i]) * (z[i] + bs[pp])); }
        __syncthreads();
    }
}
__device__ __forceinline__ void gqa_part(int vcu, int G, int tid, char* lds, unsigned char* ws, const float* qn, const float* kn) {
    const bf16* H = (const bf16*)(ws + WS_H); bf16* Y = (bf16*)(ws + WS_HID);
    float gq = 0.f, gk = 0.f;
    for (int i = 0; i < 64; ++i) { gq = fmaxf(gq, fabsf(qn[i])); gk = fmaxf(gk, fabsf(kn[i])); }
    const bool nomax = (64.0f * C2 * gq * gk) * 1.02f <= 40.0f;
    if (__builtin_amdgcn_readfirstlane(tid >> 6) >= 4) __builtin_amdgcn_s_setprio(1);
    if (nomax) {
        for (int id = vcu; id < NBATCH * 8 * 16; id += G) {
            const int qb = id & 15, hg = (id >> 4) & 3, kvh = (id >> 6) & 1, b = id >> 7, hq = kvh * 4 + hg;
            const size_t t0 = (size_t)b * SEQ;
            attn_body::attn_unit<8, true, GQA_MSUM>((const attn_body::bf16*)(H + (t0 + 256 * qb) * DIN + H_GQ + 64 * hq), (const attn_body::bf16*)(H + t0 * DIN + H_GK + 64 * kvh),
                                          (const attn_body::bf16*)(H + t0 * DIN + H_GV + 64 * kvh), (attn_body::bf16*)(Y + (t0 + 256 * qb) * DM + Y_GQA + 64 * hq), lds, tid);
        }
    } else {
        for (int id = vcu; id < NBATCH * 8 * 16; id += G) {
            const int qb = id & 15, hg = (id >> 4) & 3, kvh = (id >> 6) & 1, b = id >> 7, hq = kvh * 4 + hg;
            const size_t t0 = (size_t)b * SEQ;
            attn_body::attn_unit<8, false>((const attn_body::bf16*)(H + (t0 + 256 * qb) * DIN + H_GQ + 64 * hq), (const attn_body::bf16*)(H + t0 * DIN + H_GK + 64 * kvh),
                                           (const attn_body::bf16*)(H + t0 * DIN + H_GV + 64 * kvh), (attn_body::bf16*)(Y + (t0 + 256 * qb) * DM + Y_GQA + 64 * hq), lds, tid);
        }
    }
    __builtin_amdgcn_s_setprio(0);
    __syncthreads();
}
typedef float f32x4_t __attribute__((ext_vector_type(4)));
#define MFMA16(a, b, c) __builtin_amdgcn_mfma_f32_16x16x32_bf16((a), (b), (c), 0, 0, 0)
constexpr int NA_VP = 144;
__device__ __forceinline__ void na_wave(const bf16* __restrict__ H, const LAS unsigned char* vl, bf16* __restrict__ Y, const LAS float* rpbh, int b, int hd, int rr, int rs, int qb4, int lane) {
    const int n16 = lane & 15, g = lane >> 4;
    const int c0 = 16 * qb4, w0 = (16 * qb4 - 8 < 0) ? 0 : (16 * qb4 - 8 > 32 ? 32 : 16 * qb4 - 8);
    const size_t t0 = (size_t)b * SEQ, qtok = t0 + rr * 64 + c0 + n16;
    bf16x8 qf[2];
#pragma unroll
    for (int ks = 0; ks < 2; ++ks) qf[ks] = *(const bf16x8*)(H + qtok * DIN + H_NAQ + 64 * hd + 32 * ks + 8 * g);
    f32x4_t s[16];
    const bf16* kb = H + (t0 + rs * 64 + w0 + 8 * (n16 >> 2) + (n16 & 3)) * DIN + H_NAK + 64 * hd + 8 * g;
    {
        bf16x8 kf[16][2];
#pragma unroll
        for (int T = 0; T < 16; ++T) { const bf16* kp = kb + (size_t)((T >> 1) * 64 + 4 * (T & 1)) * DIN; kf[T][0] = *(const bf16x8*)kp; kf[T][1] = *(const bf16x8*)(kp + 32); }
        asm volatile("" ::: "memory");
#pragma unroll
        for (int T = 0; T < 16; ++T) { f32x4_t z = {0.f, 0.f, 0.f, 0.f}; z = MFMA16(kf[T][0], qf[0], z); s[T] = MFMA16(kf[T][1], qf[1], z); }
    }
    const int qc = c0 + n16, cs = qc - 8 < 0 ? 0 : (qc - 8 > 48 ? 48 : qc - 8);
    const LAS float* tb[8];
#pragma unroll
    for (int j = 0; j < 8; ++j) { const int kc = w0 + 8 * g + 4 * (j >> 2) + (j & 3); const bool ok = (unsigned)(kc - cs) < 16u; tb[j] = rpbh + (rs - rr + 7) * 32 + (ok ? kc - qc + 15 : 31); }
    float mx = -1e30f;
#pragma unroll
    for (int T = 0; T < 16; ++T)
#pragma unroll
        for (int i = 0; i < 4; ++i) { const float v = s[T][i] + tb[(T & 1) * 4 + i][(T >> 1) * 32]; s[T][i] = v; mx = fmaxf(mx, v); }
    mx = max16(mx); mx = max32(mx);
    float sum = 0.f;
#pragma unroll
    for (int T = 0; T < 16; ++T)
#pragma unroll
        for (int i = 0; i < 4; ++i) { const float p = __builtin_amdgcn_exp2f(s[T][i] - mx); s[T][i] = p; sum += p; }
    sum = sum16(sum); sum = sum32(sum);
    f32x4_t o[4];
#pragma unroll
    for (int db = 0; db < 4; ++db) o[db] = (f32x4_t){0.f, 0.f, 0.f, 0.f};
    const LAS unsigned char* vb = vl + (w0 + 8 * g + (n16 >> 2)) * NA_VP + (n16 & 3) * 8;
#pragma unroll
    for (int kr = 0; kr < 8; ++kr) {
        u32x4 pw; pw.x = pg8::cvt_pk_bf16(s[2 * kr][0], s[2 * kr][1]); pw.y = pg8::cvt_pk_bf16(s[2 * kr][2], s[2 * kr][3]);
        pw.z = pg8::cvt_pk_bf16(s[2 * kr + 1][0], s[2 * kr + 1][1]); pw.w = pg8::cvt_pk_bf16(s[2 * kr + 1][2], s[2 * kr + 1][3]);
        const bf16x8 pb = __builtin_bit_cast(bf16x8, pw);
#pragma unroll
        for (int db = 0; db < 4; ++db) { const LAS unsigned char* vp = vb + (kr * 64) * NA_VP + db * 32;
            const s16x4 lo = tr_read(vp), hi = tr_read(vp + 4 * NA_VP);
            o[db] = MFMA16(__builtin_shufflevector(lo, hi, 0, 1, 2, 3, 4, 5, 6, 7), pb, o[db]); }
    }
    const float rl = 1.0f / sum;
    bf16* yp = Y + qtok * DM + Y_NA + 64 * hd + 4 * g;
#pragma unroll
    for (int db = 0; db < 4; ++db) { u32x2 w; w.x = pg8::cvt_pk_bf16(o[db][0] * rl, o[db][1] * rl); w.y = pg8::cvt_pk_bf16(o[db][2] * rl, o[db][3] * rl); *(u32x2*)(yp + 16 * db) = w; }
}
__device__ __forceinline__ void na_part(Frame& F, int l, const float* na_rpb, unsigned char* ws) {
    const bf16* H = (const bf16*)(ws + WS_H); bf16* Y = (bf16*)(ws + WS_HID);
    LAS float* rpbl = (LAS float*)(F.lds + 90112);
    for (int i = F.tid; i < 4 * 15 * 32; i += 512) { const int c = i & 31, hr = i >> 5; rpbl[i] = (c < 31) ? na_rpb[(size_t)l * 4 * 15 * 31 + hr * 31 + c] * LOG2E : -1e30f; }
    LAS unsigned char* vl = F.lds;
    u32x4 stg[9];
#define NA_VSRC(id_) (H + ((size_t)((id_) >> 7) * SEQ + (2 * ((id_) & 31) - 4 < 0 ? 0 : (2 * ((id_) & 31) - 4 > 56 ? 56 : 2 * ((id_) & 31) - 4)) * 64) * DIN + H_NAV + 64 * (((id_) >> 5) & 3))
    if (F.vcu < NBATCH * 4 * 32) { const bf16* vsrc = NA_VSRC(F.vcu);
#pragma unroll
        for (int i = 0; i < 9; ++i) { const int idx = F.tid + 512 * i, tok = idx >> 3, ch = idx & 7; stg[i] = *(const u32x4*)(vsrc + (size_t)tok * DIN + ch * 8); } }
    for (int id = F.vcu; id < NBATCH * 4 * 32; id += F.G) {
        const int rp = id & 31, hd = (id >> 5) & 3, b = id >> 7, rr0 = 2 * rp;
        const int sb = rr0 - 4 < 0 ? 0 : (rr0 - 4 > 56 ? 56 : rr0 - 4);
        __syncthreads();
#pragma unroll
        for (int i = 0; i < 9; ++i) { const int idx = F.tid + 512 * i, tok = idx >> 3, ch = idx & 7; *(LAS u32x4*)(vl + tok * NA_VP + ch * 16) = stg[i]; }
        __syncthreads();
        { const int idn = id + F.G; if (idn < NBATCH * 4 * 32) { const bf16* vsrc = NA_VSRC(idn);
#pragma unroll
            for (int i = 0; i < 9; ++i) { const int idx = F.tid + 512 * i, tok = idx >> 3, ch = idx & 7; stg[i] = *(const u32x4*)(vsrc + (size_t)tok * DIN + ch * 8); } } }
        const int rr = rr0 + (F.wave >> 2); const int rs = rr - 4 < 0 ? 0 : (rr - 4 > 56 ? 56 : rr - 4);
        na_wave(H, vl + (rs - sb) * 64 * NA_VP, Y, rpbl + hd * 480, b, hd, rr, rs, F.wave & 3, F.lane);
    }
#undef NA_VSRC
    __syncthreads();
}

__device__ __forceinline__ void frame_init(Frame& F, LAS unsigned char* lds, int wave_s) {
    int ln; asm volatile("v_mbcnt_lo_u32_b32 %0, -1, 0\n\tv_mbcnt_hi_u32_b32 %0, -1, %0" : "=v"(ln));
    int t = wave_s * 64 + ln; asm volatile("" : "+v"(t));
    F.lds = lds; F.tid = t; F.lane = t & 63; F.wave = __builtin_amdgcn_readfirstlane(t >> 6);
    int G_ = gridDim.x; asm volatile("" : "+s"(G_));
    F.G = G_; { const int bx = blockIdx.x; F.vcu = (F.G % 8 == 0) ? (bx % 8) * (F.G / 8) + bx / 8 : bx; }
    F.gw = F.vcu * NWAVES + F.wave; F.NGW = F.G * NWAVES;
}
#ifndef MK_FUSED
#define MK_FUSED 1
#endif
struct Args { const float* in[21]; float* out; unsigned char* ws; int l_lo, l_hi, ph_lo, ph_hi, use_bar, pad; };
constexpr int NPH = 10;

__global__ void __launch_bounds__(NWAVES * 64, 2) enc_fwd(Args a) {
    extern __shared__ __attribute__((aligned(16))) unsigned char lds[];
    int wave_s_ = __builtin_amdgcn_readfirstlane((int)threadIdx.x >> 6); asm volatile("" : "+s"(wave_s_));
    Frame F0; frame_init(F0, (LAS unsigned char*)lds, wave_s_);
#define FRAME() Frame F; frame_init(F, (LAS unsigned char*)lds, wave_s_)
    volatile LAS unsigned* MISC = (volatile LAS unsigned*)(F0.lds + MISC_OFF);
    for (int u = F0.tid; u < (LDS_BYTES - LDSCTL_OFF) / 4; u += NWAVES * 64) ((LAS unsigned*)(F0.lds + LDSCTL_OFF))[u] = 0u;
    __syncthreads();
    unsigned* ctl = (unsigned*)(a.ws + WS_CTL);
    XcdBarrier bar; bar.bar = ctl + CW_BAR; bar.x = 0; bar.st = nullptr;
    if (a.use_bar) bar = xcd_barrier_post(ctl + CW_BAR, MISC + 8);
#if MK_FUSED
#define SEAM() xcd_barrier(bar)
#else
#define SEAM() do { if (a.use_bar) xcd_barrier(bar); } while (0)
#endif
    typedef const __attribute__((address_space(4))) Args* KArgP;
#define KA() ({ KArgP p_ = (KArgP)__builtin_amdgcn_kernarg_segment_ptr(); asm volatile("" : "+s"(p_)); p_; })
#if !MK_FUSED
    const int lo = a.ph_lo, hi = a.ph_hi;
#endif
#ifndef ONLY_PH
#define ONLY_PH -1
#endif
#if MK_FUSED
#define IN(k) (ONLY_PH < 0 || ONLY_PH == (k))
#else
#define IN(k) ((ONLY_PH < 0 || ONLY_PH == (k)) && lo <= (k) && (k) < hi)
#endif
#ifndef REP0
#define REP0 1
#endif
#ifndef REP2
#define REP2 1
#endif
#ifndef REP4
#define REP4 1
#endif
#ifndef REP9
#define REP9 1
#endif
#ifndef REP1
#define REP1 1
#endif
#ifndef REP2A
#define REP2A 1
#endif
#ifndef REP2B
#define REP2B 1
#endif
#ifndef REP2C
#define REP2C 1
#endif
#ifndef NA_VAR
#define NA_VAR 1
#endif
#ifndef REP3
#define REP3 1
#endif
#ifndef REPP
#define REPP 1
#endif
#ifndef REP5
#define REP5 1
#endif
#ifndef REP6
#define REP6 1
#endif
#ifndef REP7
#define REP7 1
#endif
#ifndef REP8
#define REP8 1
#endif
#define REPEAT(n) _Pragma("nounroll") for (int rep_ = 0; rep_ < (n); ++rep_)
#if MK_FUSED
    for (int l = 0; l < NLAYER; ++l) {
#else
    for (int l = a.l_lo; l < a.l_hi; ++l) {
#endif
        if (IN(0) && (l == 0 || REP0 > 1)) {
            REPEAT(l == 0 ? REP0 : REP0 - 1) { FRAME(); KArgP k = KA(); conv_phase(F, l, k->in[4], k->in[12], k->in[16], k->in[17], k->in[18], k->in[8], k->ws, 0, 1 << 30, F.gw, F.NGW, true); }
            if (l == 0) REPEAT(REPP) { FRAME(); KArgP k = KA(); prologue_phase(F, k->in[0], k->in[1], k->in[2], k->in[3], k->out, k->ws); }
            SEAM();
        }
        if (IN(1)) REPEAT(REP1) {
            FRAME(); KArgP k = KA(); unsigned char* ws = k->ws;
            pg8::Gemm g{(const bf16*)(ws + WS_XB), (const bf16*)(ws + wset(l) + WS_WIN), TT, DIN, DM, 0};
            pg8::RotOrder S; S.init(TT, DIN, F.G, (int)blockIdx.x);
            EpiIn E{(bf16*)(ws + WS_H), k->in[6] + l * 64, k->in[7] + l * 64, k->in[10] + l * 256, k->in[11] + l * 256, (const float*)(ws + WS_ROPE), (bf16*)(ws + WS_VT)};
            pg8::gemm_phase<EpiIn, pg8::RotOrder, true, true, false, false, false, true>(F.lds, g, S, E, F.tid);
            SEAM();
        }
        if (IN(2)) REPEAT(REP2) {
            REPEAT(REP2A) { FRAME(); KArgP k = KA(); sgu_part(F, l, k->in[9], k->ws); }
            REPEAT(REP2B) { FRAME(); KArgP k = KA(); gqa_part(F.vcu, F.G, F.tid, (char*)lds, k->ws, k->in[6] + l * 64, k->in[7] + l * 64); }
            REPEAT(REP2C) { FRAME(); KArgP k = KA(); na_part(F, l, k->in[5], k->ws); }
            SEAM();
        }
        if (IN(3)) {
            REPEAT(REP3 - 1) {
                FRAME(); KArgP k = KA(); unsigned char* ws = k->ws;
                pg8::Gemm g{(const bf16*)(ws + WS_HID), (const bf16*)(ws + wset(l) + WS_WOUT), TT, DM, DM, 0};
                pg8::StaticOrder S; S.init(TT, DM, F.G, (int)blockIdx.x);
                EpiRes E{(const bf16*)(ws + WS_XB), (bf16*)(ws + WS_DUMMY)};
                pg8::gemm_phase<EpiRes, pg8::StaticOrder, true, true, false, false, false, true>(F.lds, g, S, E, F.tid);
                SEAM();
            }
            FRAME(); KArgP k = KA(); unsigned char* ws = k->ws;
            pg8::Gemm g{(const bf16*)(ws + WS_HID), (const bf16*)(ws + wset(l) + WS_WOUT), TT, DM, DM, 0};
            pg8::StaticOrder S; S.init(TT, DM, F.G, (int)blockIdx.x);
            EpiRes E{(const bf16*)(ws + WS_XB), (bf16*)(ws + WS_SB)};
            pg8::gemm_phase<EpiRes, pg8::StaticOrder, true, true, false, false, false, true>(F.lds, g, S, E, F.tid);
            SEAM();
        }
        if (IN(4)) { REPEAT(REP4 - 1) { FRAME(); KArgP k = KA(); ln1_router_mfma<true>(F, (const bf16*)(k->ws + WS_SB), k->in[13] + l * DM, k->in[14] + l * DM, k->in[15] + (size_t)l * DM * NEXP, k->ws); SEAM(); }
            FRAME(); KArgP k = KA(); ln1_router_mfma<false>(F, (const bf16*)(k->ws + WS_SB), k->in[13] + l * DM, k->in[14] + l * DM, k->in[15] + (size_t)l * DM * NEXP, k->ws); SEAM(); }
        if (IN(5)) REPEAT(REP5) { FRAME(); KArgP k = KA(); topk_phase(F, k->ws);
            if (l + 1 < NLAYER && blockIdx.x >= 32) { FRAME(); KArgP k2 = KA(); conv_phase(F, l + 1, k2->in[4], k2->in[12], k2->in[16], k2->in[17], k2->in[18], k2->in[8], k2->ws, 0, CONV_SPLIT_ITEMS, (blockIdx.x - 32) * NWAVES + F.wave, (gridDim.x - 32) * NWAVES, false); }
            SEAM(); }
        if (IN(7)) REPEAT(REP7) {
            FRAME(); KArgP k = KA(); unsigned char* ws = k->ws;
            pg8::Gemm g{(const bf16*)(ws + WS_XB8), (const bf16*)(ws + wset(l) + WS_WGU), ROWS_E, 4096, DM / 2, (size_t)4096 * DM, (const int*)(ws + WS_IDX)};
            pg8::StaticOrder S; S.init(ROWS_E, 4096, F.G, (int)blockIdx.x);
            EpiSwiglu E{ws + WS_HID};
            pg8::gemm_phase<EpiSwiglu, pg8::StaticOrder, true, true, true, true, true, true>(F.lds, g, S, E, F.tid);
            SEAM();
        }
        if (IN(8)) REPEAT(REP8) {
            FRAME(); KArgP k = KA(); unsigned char* ws = k->ws;
            pg8::Gemm g{(const bf16*)(ws + WS_HID), (const bf16*)(ws + wset(l) + WS_WD), ROWS_E, DM, DEXP / 2, (size_t)DM * DEXP};
            pg8::StaticOrder S; S.init(ROWS_E, DM, F.G, (int)blockIdx.x);
            EpiDown E{ws + WS_H, (const float*)(ws + WS_GATE)};
            pg8::gemm_phase<EpiDown, pg8::StaticOrder, true, true, true, true, false, true>(F.lds, g, S, E, F.tid);
            SEAM();
        }
#if BAL_PROBE_N
        if (IN(8)) REPEAT(BAL_PROBE_N) {
            FRAME(); KArgP k = KA(); unsigned char* ws = k->ws;
            pg8::Gemm g{(const bf16*)(ws + WS_HID), (const bf16*)(ws + wset(l) + WS_WD), ROWS_E, DM, DEXP / 2, (size_t)DM * DEXP};
            pg8::StaticOrder S; S.init(ROWS_E, DM, F.G, (int)blockIdx.x);
            EpiDown E{ws + WS_DUMMY, (const float*)(ws + WS_GATE)};
            pg8::gemm_phase<EpiDown, pg8::StaticOrder, true, true, true, true, false, (BAL_PROBE != 0)>(F.lds, g, S, E, F.tid);
            SEAM();
        }
#endif
        if (IN(9)) { REPEAT(REP9 - 1) { FRAME(); KArgP k = KA(); combine_phase<true>(F, k->out, (const bf16*)(k->ws + WS_SB), k->in[13] + l * DM, k->in[14] + l * DM, k->in[19] + l * DM, k->in[20] + l * DM, k->ws, l + 1 == NLAYER); SEAM(); }
            FRAME(); KArgP k = KA(); combine_phase<false>(F, k->out, (const bf16*)(k->ws + WS_SB), k->in[13] + l * DM, k->in[14] + l * DM, k->in[19] + l * DM, k->in[20] + l * DM, k->ws, l + 1 == NLAYER);
            if (l + 1 < NLAYER) { FRAME(); KArgP k = KA(); conv_phase(F, l + 1, k->in[4], k->in[12], k->in[16], k->in[17], k->in[18], k->in[8], k->ws, CONV_SPLIT_ITEMS, 1 << 30, F.gw, F.NGW, true); }
            SEAM(); }
    }
#undef IN
#undef SEAM
}

extern "C" void kernel_launch(void* const* d_in, const int* in_sizes, int n_in, void* d_out, int out_size, void* d_ws, size_t ws_size, hipStream_t stream) {
    static int grid = 0;
    if (grid == 0) {
        if (n_in != 21 || out_size != TT * DM || ws_size < WS_END) { fprintf(stderr, "kernel_launch: unexpected shapes (n_in %d, out %d, ws %zu)\n", n_in, out_size, ws_size); grid = -1; return; }
        int dev = 0, cus = 0, per_cu = 0;
        if (hipGetDevice(&dev) != hipSuccess || hipDeviceGetAttribute(&cus, hipDeviceAttributeMultiprocessorCount, dev) != hipSuccess) { grid = -1; return; }
        if (hipFuncSetAttribute((const void*)enc_fwd, hipFuncAttributeMaxDynamicSharedMemorySize, LDS_BYTES) != hipSuccess) { fprintf(stderr, "kernel_launch: hipFuncSetAttribute failed\n"); grid = -1; return; }
        if (hipOccupancyMaxActiveBlocksPerMultiprocessor(&per_cu, (const void*)enc_fwd, NWAVES * 64, LDS_BYTES) != hipSuccess || per_cu < 1) fprintf(stderr, "kernel_launch: occupancy query reports %d\n", per_cu);
        (void)hipGetLastError();
        grid = cus;
    }
    if (grid < 0) return;
    if (hipMemsetAsync((char*)d_ws + WS_CTL, 0, CTL_ZERO_BYTES, stream) != hipSuccess) return;
    Args a{};
    for (int i = 0; i < 21; ++i) a.in[i] = (const float*)d_in[i];
    a.out = (float*)d_out; a.ws = (unsigned char*)d_ws; a.pad = 0;
#if MK_FUSED
    a.l_lo = 0; a.l_hi = NLAYER; a.ph_lo = 0; a.ph_hi = NPH; a.use_bar = 1;
    hipLaunchKernelGGL(enc_fwd, dim3(grid), dim3(NWAVES * 64), LDS_BYTES, stream, a);
#else
    a.use_bar = 0;
    for (int l = 0; l < NLAYER; ++l)
        for (int ph = 0; ph < NPH; ++ph) { a.l_lo = l; a.l_hi = l + 1; a.ph_lo = ph; a.ph_hi = ph + 1; hipLaunchKernelGGL(enc_fwd, dim3(grid), dim3(NWAVES * 64), LDS_BYTES, stream, a); }
#endif
}
```
